# Optimizing an MI355X kernel written in HIP

```python
import math
import jax, jax.numpy as jnp
from jax import lax
import numpy as np

D_MODEL = 1024
BATCH = 32
SEQ = 256
DEPTH = 4
DEC_BATCH = 4
DEC_SEQ = 1024
PAST_LEN = 256

GRID_W = 64
N_MIXERS = 3
N_SSM_LAYERS = (DEPTH + 2) // 3
N_GMLP_LAYERS = (DEPTH + 1) // 3
N_CONV_LAYERS = DEPTH // 3

SSM_WIDTH = D_MODEL
SSM_GROUP = 16
SSM_GROUPS = SSM_WIDTH // SSM_GROUP
SSM_STATE = 64
N_DIR = 2
DT_MIN = 1e-3
DT_MAX = 1e-1

GMLP_WIDTH = 2 * D_MODEL
GMLP_CHUNK = 128
GMLP_GROUP_DIM = 128
GMLP_GROUPS = GMLP_WIDTH // GMLP_GROUP_DIM

CONV_WIDTH = 3
FFN_HIDDEN = 4 * D_MODEL
N_MOD = 6
EPS = 1e-6

kernel_name = "hybrid_s5_gmlp_conv_diffusion_step"


def rms_norm(x, g):
    xf = x.astype(jnp.float32)
    y = xf * lax.rsqrt(jnp.mean(xf * xf, axis=-1, keepdims=True) + EPS)
    return (y * g.astype(jnp.float32)).astype(x.dtype)


def layer_norm_plain(x):
    xf = x.astype(jnp.float32)
    mu = jnp.mean(xf, axis=-1, keepdims=True)
    xc = xf - mu
    return (xc * lax.rsqrt(jnp.mean(xc * xc, axis=-1, keepdims=True) + EPS)).astype(x.dtype)


def adaln(cond, w, b):
    m = jax.nn.silu(cond) @ w + b
    return jnp.split(m[:, None, :], N_MOD, axis=-1)


def modulate(h, shift, scale):
    return h * (1.0 + scale) + shift


def grid_pos_embed(n_tokens):
    rows = n_tokens // GRID_W
    t = jnp.arange(rows * GRID_W)
    r = (t // GRID_W).astype(jnp.float32)
    col = (t % GRID_W).astype(jnp.float32)
    quarter = D_MODEL // 4
    freq = 1.0 / (10000.0 ** (jnp.arange(quarter, dtype=jnp.float32) / quarter))
    ar = r[:, None] * freq
    ac = col[:, None] * freq
    return jnp.concatenate([jnp.sin(ar), jnp.cos(ar), jnp.sin(ac), jnp.cos(ac)], axis=-1)


def cmul(ar, ai, br, bi):
    return ar * br - ai * bi, ar * bi + ai * br


def _scan_combine(e1, e2):
    a1r, a1i, b1r, b1i = e1
    a2r, a2i, b2r, b2i = e2
    ar, ai = cmul(a2r, a2i, a1r, a1i)
    br, bi = cmul(a2r, a2i, b1r, b1i)
    return ar, ai, br + b2r, bi + b2i


def zoh(lam_re, lam_im, log_dt, b_re, b_im):
    dt = jnp.exp(log_dt.astype(jnp.float32))[..., None]
    lr = lam_re.astype(jnp.float32)
    li = lam_im.astype(jnp.float32)
    mag = jnp.exp(lr * dt)
    ab_re = mag * jnp.cos(li * dt)
    ab_im = mag * jnp.sin(li * dt)
    den = lr * lr + li * li
    nr, ni = cmul(ab_re - 1.0, ab_im, lr, -li)
    f_re, f_im = nr / den, ni / den
    bb_re, bb_im = cmul(f_re[..., None], f_im[..., None], b_re.astype(jnp.float32), b_im.astype(jnp.float32))
    return ab_re, ab_im, bb_re, bb_im


def ssm_mixer(h, w_in, lam_re, lam_im, log_dt, b_re, b_im, c_re, c_im, d_skip, w_out, h0_re, h0_im):
    bsz, length, _ = h.shape
    u = (h @ w_in).astype(jnp.float32)
    ug = u.reshape(bsz, length, SSM_GROUPS, SSM_GROUP)
    ab_re, ab_im, bb_re, bb_im = zoh(lam_re, lam_im, log_dt, b_re, b_im)
    bu_re = jnp.einsum('blgp,kgnp->kblgn', ug, bb_re)
    bu_im = jnp.einsum('blgp,kgnp->kblgn', ug, bb_im)
    y = d_skip.astype(jnp.float32) * u
    states = []
    for k, rev in ((0, False), (1, True)):
        a_re = jnp.broadcast_to(ab_re[k][None, None], bu_re[k].shape)
        a_im = jnp.broadcast_to(ab_im[k][None, None], bu_im[k].shape)
        acr, aci, sr, si = lax.associative_scan(_scan_combine, (a_re, a_im, bu_re[k], bu_im[k]), reverse=rev, axis=1)
        if h0_re is not None:
            pr, pim = cmul(acr, aci, h0_re[:, k][:, None].astype(jnp.float32), h0_im[:, k][:, None].astype(jnp.float32))
            sr, si = sr + pr, si + pim
        yk = (jnp.einsum('blgn,gpn->blgp', sr, c_re[k].astype(jnp.float32))
              - jnp.einsum('blgn,gpn->blgp', si, c_im[k].astype(jnp.float32)))
        y = y + yk.reshape(bsz, length, SSM_WIDTH)
        states.append((sr, si))
    z = jax.nn.gelu(y.astype(h.dtype))
    a, g = jnp.split(z @ w_out, 2, axis=-1)
    return a * jax.nn.sigmoid(g), states[0], states[1]


def gmlp_mixer(h, w_in, w_s, b_s, w_out):
    bsz, length, _ = h.shape
    z = jax.nn.gelu(h @ w_in)
    u, v = jnp.split(z, 2, axis=-1)
    v = layer_norm_plain(v)
    vc = v.reshape(bsz, length // GMLP_CHUNK, GMLP_CHUNK, GMLP_GROUPS, GMLP_GROUP_DIM)
    s = jnp.einsum('gpq,bcqgd->bcpgd', w_s, vc) + b_s.T[None, None, :, :, None]
    return (u * s.reshape(bsz, length, GMLP_WIDTH)) @ w_out


def conv_mixer(h, w_in, conv_w, w_out):
    gb, gc, xh = jnp.split(h @ w_in, 3, axis=-1)
    y = lax.conv_general_dilated(gc * xh, conv_w[:, None, :], window_strides=(1,),
                                 padding=((CONV_WIDTH // 2, CONV_WIDTH // 2),),
                                 dimension_numbers=('NWC', 'WIO', 'NWC'),
                                 feature_group_count=D_MODEL)
    return (gb * y) @ w_out


def sqrelu_ffn(h, w1, w2):
    return jnp.square(jax.nn.relu(h @ w1)) @ w2


def setup_inputs(seed: int = 0) -> dict:
    key = jax.random.key(seed)
    ks = jax.random.split(key, 32)
    f32 = jnp.float32

    def nrm(k, shape, scale):
        return jax.random.normal(k, shape, f32) * scale

    n_idx = jnp.arange(SSM_STATE, dtype=f32)
    ssm_shape = (N_SSM_LAYERS, N_DIR, SSM_GROUPS, SSM_STATE)
    return {
        "x_prompt": nrm(ks[0], (BATCH, SEQ, D_MODEL), 1.0),
        "x_sample": nrm(ks[1], (DEC_BATCH, DEC_SEQ, D_MODEL), 1.0),
        "state_ssm_re": nrm(ks[2], (DEC_BATCH, N_SSM_LAYERS, N_DIR, SSM_GROUPS, SSM_STATE), 0.05),
        "state_ssm_im": nrm(ks[3], (DEC_BATCH, N_SSM_LAYERS, N_DIR, SSM_GROUPS, SSM_STATE), 0.05),
        "c": nrm(ks[4], (DEC_BATCH, D_MODEL), 1.0),
        "c_ctx": nrm(ks[5], (D_MODEL,), 1.0),
        "w_mod": nrm(ks[6], (DEPTH, D_MODEL, N_MOD * D_MODEL), 0.5 * D_MODEL ** -0.5),
        "b_mod": nrm(ks[7], (DEPTH, N_MOD * D_MODEL), 0.01),
        "g_mix": 1.0 + nrm(ks[8], (DEPTH, D_MODEL), 0.02),
        "g_ffn": 1.0 + nrm(ks[9], (DEPTH, D_MODEL), 0.02),
        "ffn_w1": nrm(ks[10], (DEPTH, D_MODEL, FFN_HIDDEN), D_MODEL ** -0.5),
        "ffn_w2": nrm(ks[11], (DEPTH, FFN_HIDDEN, D_MODEL), FFN_HIDDEN ** -0.5),
        "ssm_w_in": nrm(ks[12], (N_SSM_LAYERS, D_MODEL, SSM_WIDTH), D_MODEL ** -0.5),
        "ssm_lam_re": -0.5 + nrm(ks[13], ssm_shape, 0.01),
        "ssm_lam_im": math.pi * n_idx + nrm(ks[14], ssm_shape, 0.01),
        "ssm_log_dt": jax.random.uniform(ks[15], (N_SSM_LAYERS, N_DIR, SSM_GROUPS), f32,
                                         minval=math.log(DT_MIN), maxval=math.log(DT_MAX)),
        "ssm_b_re": nrm(ks[16], ssm_shape + (SSM_GROUP,), (2.0 * SSM_GROUP) ** -0.5),
        "ssm_b_im": nrm(ks[17], ssm_shape + (SSM_GROUP,), (2.0 * SSM_GROUP) ** -0.5),
        "ssm_c_re": nrm(ks[18], (N_SSM_LAYERS, N_DIR, SSM_GROUPS, SSM_GROUP, SSM_STATE), (2.0 * SSM_STATE) ** -0.5),
        "ssm_c_im": nrm(ks[19], (N_SSM_LAYERS, N_DIR, SSM_GROUPS, SSM_GROUP, SSM_STATE), (2.0 * SSM_STATE) ** -0.5),
        "ssm_d": nrm(ks[20], (N_SSM_LAYERS, SSM_WIDTH), 1.0),
        "ssm_w_out": nrm(ks[21], (N_SSM_LAYERS, SSM_WIDTH, 2 * D_MODEL), SSM_WIDTH ** -0.5),
        "gmlp_w_in": nrm(ks[22], (N_GMLP_LAYERS, D_MODEL, 2 * GMLP_WIDTH), D_MODEL ** -0.5),
        "gmlp_w_s": nrm(ks[23], (N_GMLP_LAYERS, GMLP_GROUPS, GMLP_CHUNK, GMLP_CHUNK), GMLP_CHUNK ** -0.5),
        "gmlp_b_s": 1.0 + nrm(ks[24], (N_GMLP_LAYERS, GMLP_GROUPS, GMLP_CHUNK), 0.02),
        "gmlp_w_out": nrm(ks[25], (N_GMLP_LAYERS, GMLP_WIDTH, D_MODEL), GMLP_WIDTH ** -0.5),
        "conv_w_in": nrm(ks[26], (N_CONV_LAYERS, D_MODEL, 3 * D_MODEL), D_MODEL ** -0.5),
        "conv_w": nrm(ks[27], (N_CONV_LAYERS, CONV_WIDTH, D_MODEL), CONV_WIDTH ** -0.5),
        "conv_w_out": nrm(ks[28], (N_CONV_LAYERS, D_MODEL, D_MODEL), D_MODEL ** -0.5),
        "g_final": 1.0 + nrm(ks[29], (D_MODEL,), 0.02),
    }


def reference(x_prompt, x_sample, state_ssm_re, state_ssm_im, c, c_ctx, w_mod, b_mod, g_mix, g_ffn,
              ffn_w1, ffn_w2, ssm_w_in, ssm_lam_re, ssm_lam_im, ssm_log_dt, ssm_b_re, ssm_b_im,
              ssm_c_re, ssm_c_im, ssm_d, ssm_w_out, gmlp_w_in, gmlp_w_s, gmlp_b_s, gmlp_w_out,
              conv_w_in, conv_w, conv_w_out, g_final):
    xp = x_prompt
    n_lat = x_sample.shape[1]
    xs = x_sample + grid_pos_embed(n_lat).astype(x_sample.dtype)[None]
    cond_p = c_ctx[None, :]
    new_re, new_im = [], []
    for i in range(DEPTH):
        kind, j = i % N_MIXERS, i // N_MIXERS
        mp = adaln(cond_p, w_mod[i], b_mod[i])
        ms = adaln(c, w_mod[i], b_mod[i])
        hp = modulate(rms_norm(xp, g_mix[i]), mp[0], mp[1])
        hs = modulate(rms_norm(xs, g_mix[i]), ms[0], ms[1])
        if kind == 0:
            sp = (ssm_w_in[j], ssm_lam_re[j], ssm_lam_im[j], ssm_log_dt[j], ssm_b_re[j], ssm_b_im[j],
                  ssm_c_re[j], ssm_c_im[j], ssm_d[j], ssm_w_out[j])
            op, (fr, fi), (br, bi) = ssm_mixer(hp, *sp, None, None)
            os_, _, _ = ssm_mixer(hs, *sp, state_ssm_re[:, j], state_ssm_im[:, j])
            new_re.append(jnp.stack([fr[:, -1], br[:, 0]], axis=1))
            new_im.append(jnp.stack([fi[:, -1], bi[:, 0]], axis=1))
        elif kind == 1:
            op = gmlp_mixer(hp, gmlp_w_in[j], gmlp_w_s[j], gmlp_b_s[j], gmlp_w_out[j])
            os_ = gmlp_mixer(hs, gmlp_w_in[j], gmlp_w_s[j], gmlp_b_s[j], gmlp_w_out[j])
        else:
            op = conv_mixer(hp, conv_w_in[j], conv_w[j], conv_w_out[j])
            os_ = conv_mixer(hs, conv_w_in[j], conv_w[j], conv_w_out[j])
        xp = xp + mp[2] * op.astype(xp.dtype)
        xs = xs + ms[2] * os_.astype(xs.dtype)
        xp = xp + mp[5] * sqrelu_ffn(modulate(rms_norm(xp, g_ffn[i]), mp[3], mp[4]), ffn_w1[i], ffn_w2[i])
        xs = xs + ms[5] * sqrelu_ffn(modulate(rms_norm(xs, g_ffn[i]), ms[3], ms[4]), ffn_w1[i], ffn_w2[i])
    y_prompt = rms_norm(xp, g_final)
    y_sample = rms_norm(xs, g_final)
    return (y_prompt, y_sample, jnp.stack(new_re, axis=1), jnp.stack(new_im, axis=1))
```

```cpp
#include <hip/hip_runtime.h>
#include <cstdio>
#include <cstdint>
namespace nv {
constexpr int D = 1024, M = 12288, MP = 8192, FF = 4096;
constexpr float EPS = 1e-6f;

__device__ __forceinline__ float gelu_tanh(float x) {
    const float k0 = 0.7978845608028654f, k1 = 0.044715f;
    float u = k0 * (x + k1 * x * x * x);
    return 0.5f * x * (1.0f + tanhf(u));
}
__device__ __forceinline__ float sigmoidf(float x) { return 1.0f / (1.0f + expf(-x)); }
__device__ __forceinline__ int cond_of_row(int row) { return row < MP ? 0 : 1 + ((row - MP) >> 10); }

__global__ void k_mods(const float* c, const float* c_ctx, const float* w_mod, const float* b_mod, float* mods) {
    __shared__ float sc[5][1024];
    const int l = blockIdx.y, n = blockIdx.x * 256 + threadIdx.x;
    for (int i = threadIdx.x; i < 5 * 1024; i += 256) {
        const int ci = i >> 10, k = i & 1023;
        const float v = ci == 0 ? c_ctx[k] : c[(ci - 1) * 1024 + k];
        sc[ci][k] = v / (1.0f + expf(-v));
    }
    __syncthreads();
    float a[5] = {0.f, 0.f, 0.f, 0.f, 0.f};
    const float* w = w_mod + (size_t)l * 1024 * 6144 + n;
    for (int k = 0; k < 1024; ++k) {
        const float wv = w[(size_t)k * 6144];
#pragma unroll
        for (int ci = 0; ci < 5; ++ci) a[ci] += sc[ci][k] * wv;
    }
    const float b = b_mod[l * 6144 + n];
#pragma unroll
    for (int ci = 0; ci < 5; ++ci) mods[((size_t)l * 5 + ci) * 6144 + n] = a[ci] + b;
}

__global__ void k_init(const float* xp, const float* xs, float* X) {
    const size_t i = (size_t)blockIdx.x * 256 + threadIdx.x;
    const int row = (int)(i >> 10), col = (int)(i & 1023);
    if (row < MP) { X[i] = xp[i]; return; }
    const int t = (row - MP) & 1023;
    const int r = t >> 6, cc = t & 63;
    const int q = col >> 8, fi = col & 255;
    const float freq = expf(-(float)fi * (1.0f / 256.0f) * 9.210340371976184f);
    const float pos = (q < 2) ? (float)r : (float)cc;
    const float ang = pos * freq;
    const float pe = (q & 1) ? cosf(ang) : sinf(ang);
    X[i] = xs[i - (size_t)MP * 1024] + pe;
}

__global__ void k_norm_mod(const float* X, const float* g, const float* mods_l, int shift_idx, float* Hn, int row0) {
    const int row = row0 + blockIdx.x;
    const float* x = X + (size_t)row * D;
    __shared__ float red[4];
    float v[4]; float s = 0.f;
#pragma unroll
    for (int j = 0; j < 4; ++j) { v[j] = x[threadIdx.x + 256 * j]; s += v[j] * v[j]; }
    for (int o = 32; o > 0; o >>= 1) s += __shfl_xor(s, o);
    if ((threadIdx.x & 63) == 0) red[threadIdx.x >> 6] = s;
    __syncthreads();
    s = red[0] + red[1] + red[2] + red[3];
    const float rstd = 1.0f / sqrtf(s * (1.0f / D) + EPS);
    const float* md = mods_l + (size_t)cond_of_row(row) * 6144;
#pragma unroll
    for (int j = 0; j < 4; ++j) {
        const int c = threadIdx.x + 256 * j;
        Hn[(size_t)row * D + c] = v[j] * rstd * g[c] * (1.0f + md[(shift_idx + 1) * 1024 + c]) + md[shift_idx * 1024 + c];
    }
}

__global__ void __launch_bounds__(256) k_gemm(const float* __restrict__ A, int lda, const float* __restrict__ W, int ldw, float* __restrict__ C, int ldc, int K) {
    __shared__ float As[16][64 + 4];
    __shared__ float Ws[16][64 + 4];
    const int tx = threadIdx.x & 15, ty = threadIdx.x >> 4;
    const int m0 = blockIdx.y * 64, n0 = blockIdx.x * 64;
    float acc[4][4];
#pragma unroll
    for (int i = 0; i < 4; ++i)
#pragma unroll
        for (int j = 0; j < 4; ++j) acc[i][j] = 0.f;
    for (int k0 = 0; k0 < K; k0 += 16) {
        {
            const int r = threadIdx.x >> 2, kk = (threadIdx.x & 3) * 4;
            const float4 a = *(const float4*)(A + (size_t)(m0 + r) * lda + k0 + kk);
            As[kk + 0][r] = a.x; As[kk + 1][r] = a.y; As[kk + 2][r] = a.z; As[kk + 3][r] = a.w;
            const int kr = threadIdx.x >> 4, nn = (threadIdx.x & 15) * 4;
            const float4 w = *(const float4*)(W + (size_t)(k0 + kr) * ldw + n0 + nn);
            Ws[kr][nn + 0] = w.x; Ws[kr][nn + 1] = w.y; Ws[kr][nn + 2] = w.z; Ws[kr][nn + 3] = w.w;
        }
        __syncthreads();
#pragma unroll
        for (int k = 0; k < 16; ++k) {
            float a[4], b[4];
#pragma unroll
            for (int i = 0; i < 4; ++i) a[i] = As[k][ty * 4 + i];
#pragma unroll
            for (int j = 0; j < 4; ++j) b[j] = Ws[k][tx * 4 + j];
#pragma unroll
            for (int i = 0; i < 4; ++i)
#pragma unroll
                for (int j = 0; j < 4; ++j) acc[i][j] += a[i] * b[j];
        }
        __syncthreads();
    }
#pragma unroll
    for (int i = 0; i < 4; ++i) {
        float4 o = {acc[i][0], acc[i][1], acc[i][2], acc[i][3]};
        *(float4*)(C + (size_t)(m0 + ty * 4 + i) * ldc + n0 + tx * 4) = o;
    }
}

__global__ void __launch_bounds__(128) k_ssm(const float* __restrict__ U, float* __restrict__ Yf, float* __restrict__ Yb,
                                             const float* lam_re, const float* lam_im, const float* log_dt, const float* b_re, const float* b_im,
                                             const float* c_re, const float* c_im, const float* st_re, const float* st_im, int j,
                                             float* new_re, float* new_im) {
    const int seq = blockIdx.x >> 6, g = blockIdx.x & 63;
    const int k = threadIdx.x >> 6, n = threadIdx.x & 63, lane = threadIdx.x & 63;
    const int L = seq < 32 ? 256 : 1024;
    const int row0 = seq < 32 ? seq * 256 : MP + (seq - 32) * 1024;
    __shared__ float ssr[2][64], ssi[2][64];
    __shared__ float cr[2][16][64], cim[2][16][64];
    __shared__ float us[2][16];
    const int pidx = ((j * 2 + k) * 64 + g);
    const float dt = expf(log_dt[pidx]);
    const float lr = lam_re[pidx * 64 + n], li = lam_im[pidx * 64 + n];
    const float mag = expf(lr * dt);
    const float abr = mag * cosf(li * dt), abi = mag * sinf(li * dt);
    const float den = lr * lr + li * li;
    const float nr = (abr - 1.0f) * lr - abi * (-li), ni = (abr - 1.0f) * (-li) + abi * lr;
    const float fr = nr / den, fi = ni / den;
    float bbr[16], bbi[16];
#pragma unroll
    for (int p = 0; p < 16; ++p) {
        const float br = b_re[((size_t)pidx * 64 + n) * 16 + p], bi = b_im[((size_t)pidx * 64 + n) * 16 + p];
        bbr[p] = fr * br - fi * bi; bbi[p] = fr * bi + fi * br;
    }
    for (int i = lane; i < 16 * 64; i += 64) { cr[k][i >> 6][i & 63] = c_re[(size_t)pidx * 1024 + i]; cim[k][i >> 6][i & 63] = c_im[(size_t)pidx * 1024 + i]; }
    float sr = 0.f, si = 0.f;
    if (seq >= 32) { const size_t o = ((((size_t)(seq - 32) * 2 + j) * 2 + k) * 64 + g) * 64 + n; sr = st_re[o]; si = st_im[o]; }
    float* Y = k == 0 ? Yf : Yb;
    __syncthreads();
    for (int it = 0; it < L; ++it) {
        const int t = k == 0 ? it : L - 1 - it;
        const float* urow = U + (size_t)(row0 + t) * D + g * 16;
        if (lane < 16) us[k][lane] = urow[lane];
        __syncthreads();
        float bur = 0.f, bui = 0.f;
#pragma unroll
        for (int p = 0; p < 16; ++p) { const float uv = us[k][p]; bur += bbr[p] * uv; bui += bbi[p] * uv; }
        const float nsr = abr * sr - abi * si + bur, nsi = abr * si + abi * sr + bui;
        sr = nsr; si = nsi;
        ssr[k][n] = sr; ssi[k][n] = si;
        __syncthreads();
        const int po = lane & 15, nq = lane >> 4;
        float y = 0.f;
#pragma unroll
        for (int q = 0; q < 16; ++q) { const int nn = nq * 16 + q; y += cr[k][po][nn] * ssr[k][nn] - cim[k][po][nn] * ssi[k][nn]; }
        y += __shfl_xor(y, 16); y += __shfl_xor(y, 32);
        if (lane < 16) Y[(size_t)(row0 + t) * D + g * 16 + po] = y;
    }
    if (seq < 32) { const size_t o = ((((size_t)seq * 2 + j) * 2 + k) * 64 + g) * 64 + n; new_re[o] = sr; new_im[o] = si; }
}
__global__ void k_ssm_comb(const float* U, const float* Yf, const float* Yb, const float* dsk, float* Z) {
    const size_t i = (size_t)blockIdx.x * 256 + threadIdx.x; const int c = (int)(i & 1023);
    Z[i] = gelu_tanh(dsk[c] * U[i] + Yf[i] + Yb[i]);
}
__global__ void k_ssm_gate(const float* AG, const float* mods_l, float* X, int row0) {
    const size_t i = (size_t)blockIdx.x * 256 + threadIdx.x; const int r = (int)(i >> 10), c = (int)(i & 1023); const int row = row0 + r;
    const float a = AG[(size_t)r * 2048 + c], gg = AG[(size_t)r * 2048 + 1024 + c];
    X[(size_t)row * D + c] += mods_l[(size_t)cond_of_row(row) * 6144 + 2 * 1024 + c] * a * sigmoidf(gg);
}
__global__ void k_resid(const float* O, const float* mods_l, int gate_idx, float* X, int row0) {
    const size_t i = (size_t)blockIdx.x * 256 + threadIdx.x; const int r = (int)(i >> 10), c = (int)(i & 1023); const int row = row0 + r;
    X[(size_t)row * D + c] += mods_l[(size_t)cond_of_row(row) * 6144 + gate_idx * 1024 + c] * O[i];
}
__global__ void k_sqrelu(float* H, size_t n) { const size_t i = (size_t)blockIdx.x * 256 + threadIdx.x; if (i < n) { const float v = fmaxf(H[i], 0.f); H[i] = v * v; } }
__global__ void k_gelu(float* H, size_t n) { const size_t i = (size_t)blockIdx.x * 256 + threadIdx.x; if (i < n) H[i] = gelu_tanh(H[i]); }
__global__ void k_ln_v(float* Zb) {
    float* v = Zb + (size_t)blockIdx.x * 4096 + 2048;
    __shared__ float red[4], red2[4];
    float x[8]; float s = 0.f;
#pragma unroll
    for (int j = 0; j < 8; ++j) { x[j] = v[threadIdx.x + 256 * j]; s += x[j]; }
    for (int o = 32; o > 0; o >>= 1) s += __shfl_xor(s, o);
    if ((threadIdx.x & 63) == 0) red[threadIdx.x >> 6] = s;
    __syncthreads();
    const float mu = (red[0] + red[1] + red[2] + red[3]) * (1.0f / 2048.0f);
    float q = 0.f;
#pragma unroll
    for (int j = 0; j < 8; ++j) { x[j] -= mu; q += x[j] * x[j]; }
    for (int o = 32; o > 0; o >>= 1) q += __shfl_xor(q, o);
    if ((threadIdx.x & 63) == 0) red2[threadIdx.x >> 6] = q;
    __syncthreads();
    const float rstd = 1.0f / sqrtf((red2[0] + red2[1] + red2[2] + red2[3]) * (1.0f / 2048.0f) + EPS);
#pragma unroll
    for (int j = 0; j < 8; ++j) v[threadIdx.x + 256 * j] = x[j] * rstd;
}
__global__ void k_gmlp_spatial(const float* Zb, const float* w_s, const float* b_s, float* A2) {
    const size_t i = (size_t)blockIdx.x * 256 + threadIdx.x; const int r = (int)(i >> 11), ch = (int)(i & 2047);
    const int g = ch >> 7, p = r & 127, r0 = r - p;
    const float* w = w_s + ((size_t)g * 128 + p) * 128;
    float s = 0.f;
    for (int q = 0; q < 128; ++q) s += w[q] * Zb[(size_t)(r0 + q) * 4096 + 2048 + ch];
    s += b_s[g * 128 + p];
    A2[i] = Zb[(size_t)r * 4096 + ch] * s;
}
__global__ void k_conv(const float* P, const float* cw, float* A2, int L) {
    const size_t i = (size_t)blockIdx.x * 256 + threadIdx.x; const int r = (int)(i >> 10), c = (int)(i & 1023);
    const int t = r % L;
    float y = 0.f;
#pragma unroll
    for (int w = 0; w < 3; ++w) { const int tt = t + w - 1; if (tt >= 0 && tt < L) { const size_t o = (size_t)(r + w - 1) * 3072; y += cw[w * 1024 + c] * P[o + 1024 + c] * P[o + 2048 + c]; } }
    A2[i] = P[(size_t)r * 3072 + c] * y;
}
__global__ void k_final(const float* X, const float* g, float* out) {
    const int row = blockIdx.x; const float* x = X + (size_t)row * D;
    __shared__ float red[4];
    float v[4]; float s = 0.f;
#pragma unroll
    for (int j = 0; j < 4; ++j) { v[j] = x[threadIdx.x + 256 * j]; s += v[j] * v[j]; }
    for (int o = 32; o > 0; o >>= 1) s += __shfl_xor(s, o);
    if ((threadIdx.x & 63) == 0) red[threadIdx.x >> 6] = s;
    __syncthreads();
    s = red[0] + red[1] + red[2] + red[3];
    const float rstd = 1.0f / sqrtf(s * (1.0f / D) + EPS);
#pragma unroll
    for (int j = 0; j < 4; ++j) { const int c = threadIdx.x + 256 * j; out[(size_t)row * D + c] = v[j] * rstd * g[c]; }
}

struct In {
    const float *x_prompt, *x_sample, *st_re, *st_im, *c, *c_ctx, *w_mod, *b_mod, *g_mix, *g_ffn, *ffn_w1, *ffn_w2, *ssm_w_in, *lam_re, *lam_im, *log_dt,
        *b_re, *b_im, *c_re, *c_im, *ssm_d, *ssm_w_out, *gmlp_w_in, *gmlp_w_s, *gmlp_b_s, *gmlp_w_out, *conv_w_in, *conv_w, *conv_w_out, *g_final;
};

static void gemm(const float* A, int lda, const float* W, int ldw, float* C, int ldc, int Mr, int N, int K, hipStream_t s) {
    hipLaunchKernelGGL(k_gemm, dim3(N / 64, Mr / 64), dim3(256), 0, s, A, lda, W, ldw, C, ldc, K);
}

static void run(const In& I, float* out, unsigned char* ws, hipStream_t s) {
    float* X = out; float* new_re = out + (size_t)M * D; float* new_im = new_re + 32 * 2 * 2 * 64 * 64;
    float* mods = (float*)ws;
    float* Hn = (float*)(ws + (1u << 20));
    float* T1 = Hn + (size_t)M * D;
    float* T2 = T1 + (size_t)4096 * 4096;
    float* T3 = T2 + (size_t)4096 * 3072;
    hipLaunchKernelGGL(k_mods, dim3(6144 / 256, 4), dim3(256), 0, s, I.c, I.c_ctx, I.w_mod, I.b_mod, mods);
    hipLaunchKernelGGL(k_init, dim3(M * D / 256), dim3(256), 0, s, I.x_prompt, I.x_sample, X);
    for (int i = 0; i < 4; ++i) {
        const int kind = i % 3, j = i / 3;
        const float* ml = mods + (size_t)i * 5 * 6144;
        hipLaunchKernelGGL(k_norm_mod, dim3(M), dim3(256), 0, s, X, I.g_mix + i * 1024, ml, 0, Hn, 0);
        if (kind == 0) {
            float* U = T1; float* Yf = T3; float* Yb = T3 + (size_t)M * D; float* Z = T1 + (size_t)M * D;
            gemm(Hn, D, I.ssm_w_in + (size_t)j * D * D, D, U, D, M, D, D, s);
            hipLaunchKernelGGL(k_ssm, dim3(36 * 64), dim3(128), 0, s, U, Yf, Yb, I.lam_re, I.lam_im, I.log_dt, I.b_re, I.b_im, I.c_re, I.c_im, I.st_re, I.st_im, j, new_re, new_im);
            hipLaunchKernelGGL(k_ssm_comb, dim3(M * D / 256), dim3(256), 0, s, U, Yf, Yb, I.ssm_d + j * 1024, Z);
            for (int rc = 0; rc < 3; ++rc) {
                float* AG = T3;
                gemm(Z + (size_t)rc * 4096 * D, D, I.ssm_w_out + (size_t)j * D * 2048, 2048, AG, 2048, 4096, 2048, D, s);
                hipLaunchKernelGGL(k_ssm_gate, dim3(4096 * D / 256), dim3(256), 0, s, AG, ml, X, rc * 4096);
            }
        } else if (kind == 1) {
            for (int rc = 0; rc < 3; ++rc) {
                float* Zb = T1; float* A2 = T2; float* O = T3;
                gemm(Hn + (size_t)rc * 4096 * D, D, I.gmlp_w_in, 4096, Zb, 4096, 4096, 4096, D, s);
                hipLaunchKernelGGL(k_gelu, dim3(4096 * 4096 / 256), dim3(256), 0, s, Zb, (size_t)4096 * 4096);
                hipLaunchKernelGGL(k_ln_v, dim3(4096), dim3(256), 0, s, Zb);
                hipLaunchKernelGGL(k_gmlp_spatial, dim3(4096 * 2048 / 256), dim3(256), 0, s, Zb, I.gmlp_w_s, I.gmlp_b_s, A2);
                gemm(A2, 2048, I.gmlp_w_out, D, O, D, 4096, D, 2048, s);
                hipLaunchKernelGGL(k_resid, dim3(4096 * D / 256), dim3(256), 0, s, O, ml, 2, X, rc * 4096);
            }
        } else {
            for (int rc = 0; rc < 3; ++rc) {
                float* P = T1; float* A2 = T2; float* O = T3;
                gemm(Hn + (size_t)rc * 4096 * D, D, I.conv_w_in, 3072, P, 3072, 4096, 3072, D, s);
                hipLaunchKernelGGL(k_conv, dim3(4096 * D / 256), dim3(256), 0, s, P, I.conv_w, A2, rc < 2 ? 256 : 1024);
                gemm(A2, D, I.conv_w_out, D, O, D, 4096, D, D, s);
                hipLaunchKernelGGL(k_resid, dim3(4096 * D / 256), dim3(256), 0, s, O, ml, 2, X, rc * 4096);
            }
        }
        hipLaunchKernelGGL(k_norm_mod, dim3(M), dim3(256), 0, s, X, I.g_ffn + i * 1024, ml, 3, Hn, 0);
        for (int rc = 0; rc < 3; ++rc) {
            float* Hid = T1; float* O = T3;
            gemm(Hn + (size_t)rc * 4096 * D, D, I.ffn_w1 + (size_t)i * D * FF, FF, Hid, FF, 4096, FF, D, s);
            hipLaunchKernelGGL(k_sqrelu, dim3(4096 * 4096 / 256), dim3(256), 0, s, Hid, (size_t)4096 * 4096);
            gemm(Hid, FF, I.ffn_w2 + (size_t)i * FF * D, D, O, D, 4096, D, FF, s);
            hipLaunchKernelGGL(k_resid, dim3(4096 * D / 256), dim3(256), 0, s, O, ml, 5, X, rc * 4096);
        }
    }
    hipLaunchKernelGGL(k_final, dim3(M), dim3(256), 0, s, X, I.g_final, X);
}
}
extern "C" void kernel_launch(void* const* d_in, const int* in_sizes, int n_in, void* d_out, int out_size, void* d_ws, size_t ws_size, hipStream_t stream) {
    if (n_in != 30 || ws_size < (size_t)270 * 1024 * 1024) { fprintf(stderr, "kernel_launch: unexpected n_in %d / ws %zu\n", n_in, ws_size); return; }
    nv::In I;
    const float** p = (const float**)&I;
    for (int i = 0; i < 30; ++i) p[i] = (const float*)d_in[i];
    nv::run(I, (float*)d_out, (unsigned char*)d_ws, stream);
}
```

```cpp
#include <hip/hip_runtime.h>
#include <cstdio>
#include <cstdint>
namespace nv {
constexpr int D = 1024, M = 12288, MP = 8192, FF = 4096;
constexpr float EPS = 1e-6f;

__device__ __forceinline__ float gelu_tanh(float x) {
    const float k0 = 0.7978845608028654f, k1 = 0.044715f;
    float u = k0 * (x + k1 * x * x * x);
    return 0.5f * x * (1.0f + tanhf(u));
}
__device__ __forceinline__ float sigmoidf(float x) { return 1.0f / (1.0f + expf(-x)); }
__device__ __forceinline__ int cond_of_row(int row) { return row < MP ? 0 : 1 + ((row - MP) >> 10); }

__global__ void k_mods(const float* c, const float* c_ctx, const float* w_mod, const float* b_mod, float* mods) {
    __shared__ float sc[5][1024];
    const int l = blockIdx.y, n = blockIdx.x * 256 + threadIdx.x;
    for (int i = threadIdx.x; i < 5 * 1024; i += 256) {
        const int ci = i >> 10, k = i & 1023;
        const float v = ci == 0 ? c_ctx[k] : c[(ci - 1) * 1024 + k];
        sc[ci][k] = v / (1.0f + expf(-v));
    }
    __syncthreads();
    float a[5] = {0.f, 0.f, 0.f, 0.f, 0.f};
    const float* w = w_mod + (size_t)l * 1024 * 6144 + n;
    for (int k = 0; k < 1024; ++k) {
        const float wv = w[(size_t)k * 6144];
#pragma unroll
        for (int ci = 0; ci < 5; ++ci) a[ci] += sc[ci][k] * wv;
    }
    const float b = b_mod[l * 6144 + n];
#pragma unroll
    for (int ci = 0; ci < 5; ++ci) mods[((size_t)l * 5 + ci) * 6144 + n] = a[ci] + b;
}

__global__ void k_init(const float* xp, const float* xs, float* X) {
    const size_t i = (size_t)blockIdx.x * 256 + threadIdx.x;
    const int row = (int)(i >> 10), col = (int)(i & 1023);
    if (row < MP) { X[i] = xp[i]; return; }
    const int t = (row - MP) & 1023;
    const int r = t >> 6, cc = t & 63;
    const int q = col >> 8, fi = col & 255;
    const float freq = expf(-(float)fi * (1.0f / 256.0f) * 9.210340371976184f);
    const float pos = (q < 2) ? (float)r : (float)cc;
    const float ang = pos * freq;
    const float pe = (q & 1) ? cosf(ang) : sinf(ang);
    X[i] = xs[i - (size_t)MP * 1024] + pe;
}

__global__ void k_norm_mod(const float* X, const float* g, const float* mods_l, int shift_idx, float* Hn, int row0) {
    const int row = row0 + blockIdx.x;
    const float* x = X + (size_t)row * D;
    __shared__ float red[4];
    float v[4]; float s = 0.f;
#pragma unroll
    for (int j = 0; j < 4; ++j) { v[j] = x[threadIdx.x + 256 * j]; s += v[j] * v[j]; }
    for (int o = 32; o > 0; o >>= 1) s += __shfl_xor(s, o);
    if ((threadIdx.x & 63) == 0) red[threadIdx.x >> 6] = s;
    __syncthreads();
    s = red[0] + red[1] + red[2] + red[3];
    const float rstd = 1.0f / sqrtf(s * (1.0f / D) + EPS);
    const float* md = mods_l + (size_t)cond_of_row(row) * 6144;
#pragma unroll
    for (int j = 0; j < 4; ++j) {
        const int c = threadIdx.x + 256 * j;
        Hn[(size_t)row * D + c] = v[j] * rstd * g[c] * (1.0f + md[(shift_idx + 1) * 1024 + c]) + md[shift_idx * 1024 + c];
    }
}

__global__ void __launch_bounds__(256) k_gemm(const float* __restrict__ A, int lda, const float* __restrict__ W, int ldw, float* __restrict__ C, int ldc, int K) {
    __shared__ float As[16][64 + 4];
    __shared__ float Ws[16][64 + 4];
    const int tx = threadIdx.x & 15, ty = threadIdx.x >> 4;
    const int m0 = blockIdx.y * 64, n0 = blockIdx.x * 64;
    float acc[4][4];
#pragma unroll
    for (int i = 0; i < 4; ++i)
#pragma unroll
        for (int j = 0; j < 4; ++j) acc[i][j] = 0.f;
    for (int k0 = 0; k0 < K; k0 += 16) {
        {
            const int r = threadIdx.x >> 2, kk = (threadIdx.x & 3) * 4;
            const float4 a = *(const float4*)(A + (size_t)(m0 + r) * lda + k0 + kk);
            As[kk + 0][r] = a.x; As[kk + 1][r] = a.y; As[kk + 2][r] = a.z; As[kk + 3][r] = a.w;
            const int kr = threadIdx.x >> 4, nn = (threadIdx.x & 15) * 4;
            const float4 w = *(const float4*)(W + (size_t)(k0 + kr) * ldw + n0 + nn);
            Ws[kr][nn + 0] = w.x; Ws[kr][nn + 1] = w.y; Ws[kr][nn + 2] = w.z; Ws[kr][nn + 3] = w.w;
        }
        __syncthreads();
#pragma unroll
        for (int k = 0; k < 16; ++k) {
            float a[4], b[4];
#pragma unroll
            for (int i = 0; i < 4; ++i) a[i] = As[k][ty * 4 + i];
#pragma unroll
            for (int j = 0; j < 4; ++j) b[j] = Ws[k][tx * 4 + j];
#pragma unroll
            for (int i = 0; i < 4; ++i)
#pragma unroll
                for (int j = 0; j < 4; ++j) acc[i][j] += a[i] * b[j];
        }
        __syncthreads();
    }
#pragma unroll
    for (int i = 0; i < 4; ++i) {
        float4 o = {acc[i][0], acc[i][1], acc[i][2], acc[i][3]};
        *(float4*)(C + (size_t)(m0 + ty * 4 + i) * ldc + n0 + tx * 4) = o;
    }
}

__global__ void __launch_bounds__(128) k_ssm(const float* __restrict__ U, float* __restrict__ Yf, float* __restrict__ Yb,
                                             const float* lam_re, const float* lam_im, const float* log_dt, const float* b_re, const float* b_im,
                                             const float* c_re, const float* c_im, const float* st_re, const float* st_im, int j,
                                             float* new_re, float* new_im) {
    const int seq = blockIdx.x >> 6, g = blockIdx.x & 63;
    const int k = threadIdx.x >> 6, n = threadIdx.x & 63, lane = threadIdx.x & 63;
    const int L = seq < 32 ? 256 : 1024;
    const int row0 = seq < 32 ? seq * 256 : MP + (seq - 32) * 1024;
    __shared__ float ssr[2][64], ssi[2][64];
    __shared__ float cr[2][16][64], cim[2][16][64];
    __shared__ float us[2][16];
    const int pidx = ((j * 2 + k) * 64 + g);
    const float dt = expf(log_dt[pidx]);
    const float lr = lam_re[pidx * 64 + n], li = lam_im[pidx * 64 + n];
    const float mag = expf(lr * dt);
    const float abr = mag * cosf(li * dt), abi = mag * sinf(li * dt);
    const float den = lr * lr + li * li;
    const float nr = (abr - 1.0f) * lr - abi * (-li), ni = (abr - 1.0f) * (-li) + abi * lr;
    const float fr = nr / den, fi = ni / den;
    float bbr[16], bbi[16];
#pragma unroll
    for (int p = 0; p < 16; ++p) {
        const float br = b_re[((size_t)pidx * 64 + n) * 16 + p], bi = b_im[((size_t)pidx * 64 + n) * 16 + p];
        bbr[p] = fr * br - fi * bi; bbi[p] = fr * bi + fi * br;
    }
    for (int i = lane; i < 16 * 64; i += 64) { cr[k][i >> 6][i & 63] = c_re[(size_t)pidx * 1024 + i]; cim[k][i >> 6][i & 63] = c_im[(size_t)pidx * 1024 + i]; }
    float sr = 0.f, si = 0.f;
    if (seq >= 32) { const size_t o = ((((size_t)(seq - 32) * 2 + j) * 2 + k) * 64 + g) * 64 + n; sr = st_re[o]; si = st_im[o]; }
    float* Y = k == 0 ? Yf : Yb;
    __syncthreads();
    for (int it = 0; it < L; ++it) {
        const int t = k == 0 ? it : L - 1 - it;
        const float* urow = U + (size_t)(row0 + t) * D + g * 16;
        if (lane < 16) us[k][lane] = urow[lane];
        __syncthreads();
        float bur = 0.f, bui = 0.f;
#pragma unroll
        for (int p = 0; p < 16; ++p) { const float uv = us[k][p]; bur += bbr[p] * uv; bui += bbi[p] * uv; }
        const float nsr = abr * sr - abi * si + bur, nsi = abr * si + abi * sr + bui;
        sr = nsr; si = nsi;
        ssr[k][n] = sr; ssi[k][n] = si;
        __syncthreads();
        const int po = lane & 15, nq = lane >> 4;
        float y = 0.f;
#pragma unroll
        for (int q = 0; q < 16; ++q) { const int nn = nq * 16 + q; y += cr[k][po][nn] * ssr[k][nn] - cim[k][po][nn] * ssi[k][nn]; }
        y += __shfl_xor(y, 16); y += __shfl_xor(y, 32);
        if (lane < 16) Y[(size_t)(row0 + t) * D + g * 16 + po] = y;
    }
    if (seq < 32) { const size_t o = ((((size_t)seq * 2 + j) * 2 + k) * 64 + g) * 64 + n; new_re[o] = sr; new_im[o] = si; }
}
__global__ void k_ssm_comb(const float* U, const float* Yf, const float* Yb, const float* dsk, float* Z) {
    const size_t i = (size_t)blockIdx.x * 256 + threadIdx.x; const int c = (int)(i & 1023);
    Z[i] = gelu_tanh(dsk[c] * U[i] + Yf[i] + Yb[i]);
}
__global__ void k_ssm_gate(const float* AG, const float* mods_l, float* X, int row0) {
    const size_t i = (size_t)blockIdx.x * 256 + threadIdx.x; const int r = (int)(i >> 10), c = (int)(i & 1023); const int row = row0 + r;
    const float a = AG[(size_t)r * 2048 + c], gg = AG[(size_t)r * 2048 + 1024 + c];
    X[(size_t)row * D + c] += mods_l[(size_t)cond_of_row(row) * 6144 + 2 * 1024 + c] * a * sigmoidf(gg);
}
__global__ void k_resid(const float* O, const float* mods_l, int gate_idx, float* X, int row0) {
    const size_t i = (size_t)blockIdx.x * 256 + threadIdx.x; const int r = (int)(i >> 10), c = (int)(i & 1023); const int row = row0 + r;
    X[(size_t)row * D + c] += mods_l[(size_t)cond_of_row(row) * 6144 + gate_idx * 1024 + c] * O[i];
}
__global__ void k_sqrelu(float* H, size_t n) { const size_t i = (size_t)blockIdx.x * 256 + threadIdx.x; if (i < n) { const float v = fmaxf(H[i], 0.f); H[i] = v * v; } }
__global__ void k_gelu(float* H, size_t n) { const size_t i = (size_t)blockIdx.x * 256 + threadIdx.x; if (i < n) H[i] = gelu_tanh(H[i]); }
__global__ void k_ln_v(float* Zb) {
    float* v = Zb + (size_t)blockIdx.x * 4096 + 2048;
    __shared__ float red[4], red2[4];
    float x[8]; float s = 0.f;
#pragma unroll
    for (int j = 0; j < 8; ++j) { x[j] = v[threadIdx.x + 256 * j]; s += x[j]; }
    for (int o = 32; o > 0; o >>= 1) s += __shfl_xor(s, o);
    if ((threadIdx.x & 63) == 0) red[threadIdx.x >> 6] = s;
    __syncthreads();
    const float mu = (red[0] + red[1] + red[2] + red[3]) * (1.0f / 2048.0f);
    float q = 0.f;
#pragma unroll
    for (int j = 0; j < 8; ++j) { x[j] -= mu; q += x[j] * x[j]; }
    for (int o = 32; o > 0; o >>= 1) q += __shfl_xor(q, o);
    if ((threadIdx.x & 63) == 0) red2[threadIdx.x >> 6] = q;
    __syncthreads();
    const float rstd = 1.0f / sqrtf((red2[0] + red2[1] + red2[2] + red2[3]) * (1.0f / 2048.0f) + EPS);
#pragma unroll
    for (int j = 0; j < 8; ++j) v[threadIdx.x + 256 * j] = x[j] * rstd;
}
__global__ void k_gmlp_spatial(const float* Zb, const float* w_s, const float* b_s, float* A2) {
    const size_t i = (size_t)blockIdx.x * 256 + threadIdx.x; const int r = (int)(i >> 11), ch = (int)(i & 2047);
    const int g = ch >> 7, p = r & 127, r0 = r - p;
    const float* w = w_s + ((size_t)g * 128 + p) * 128;
    float s = 0.f;
    for (int q = 0; q < 128; ++q) s += w[q] * Zb[(size_t)(r0 + q) * 4096 + 2048 + ch];
    s += b_s[g * 128 + p];
    A2[i] = Zb[(size_t)r * 4096 + ch] * s;
}
__global__ void k_conv(const float* P, const float* cw, float* A2, int L) {
    const size_t i = (size_t)blockIdx.x * 256 + threadIdx.x; const int r = (int)(i >> 10), c = (int)(i & 1023);
    const int t = r % L;
    float y = 0.f;
#pragma unroll
    for (int w = 0; w < 3; ++w) { const int tt = t + w - 1; if (tt >= 0 && tt < L) { const size_t o = (size_t)(r + w - 1) * 3072; y += cw[w * 1024 + c] * P[o + 1024 + c] * P[o + 2048 + c]; } }
    A2[i] = P[(size_t)r * 3072 + c] * y;
}
__global__ void k_final(const float* X, const float* g, float* out) {
    const int row = blockIdx.x; const float* x = X + (size_t)row * D;
    __shared__ float red[4];
    float v[4]; float s = 0.f;
#pragma unroll
    for (int j = 0; j < 4; ++j) { v[j] = x[threadIdx.x + 256 * j]; s += v[j] * v[j]; }
    for (int o = 32; o > 0; o >>= 1) s += __shfl_xor(s, o);
    if ((threadIdx.x & 63) == 0) red[threadIdx.x >> 6] = s;
    __syncthreads();
    s = red[0] + red[1] + red[2] + red[3];
    const float rstd = 1.0f / sqrtf(s * (1.0f / D) + EPS);
#pragma unroll
    for (int j = 0; j < 4; ++j) { const int c = threadIdx.x + 256 * j; out[(size_t)row * D + c] = v[j] * rstd * g[c]; }
}

struct In {
    const float *x_prompt, *x_sample, *st_re, *st_im, *c, *c_ctx, *w_mod, *b_mod, *g_mix, *g_ffn, *ffn_w1, *ffn_w2, *ssm_w_in, *lam_re, *lam_im, *log_dt,
        *b_re, *b_im, *c_re, *c_im, *ssm_d, *ssm_w_out, *gmlp_w_in, *gmlp_w_s, *gmlp_b_s, *gmlp_w_out, *conv_w_in, *conv_w, *conv_w_out, *g_final;
};

static void gemm(const float* A, int lda, const float* W, int ldw, float* C, int ldc, int Mr, int N, int K, hipStream_t s) {
    hipLaunchKernelGGL(k_gemm, dim3(N / 64, Mr / 64), dim3(256), 0, s, A, lda, W, ldw, C, ldc, K);
}

static void run(const In& I, float* out, unsigned char* ws, hipStream_t s, int start_layer = 0) {
    float* X = out; float* new_re = out + (size_t)M * D; float* new_im = new_re + 32 * 2 * 2 * 64 * 64;
    float* mods = (float*)ws;
    float* Hn = (float*)(ws + (1u << 20));
    float* T1 = Hn + (size_t)M * D;
    float* T2 = T1 + (size_t)4096 * 4096;
    float* T3 = T2 + (size_t)4096 * 3072;
    hipLaunchKernelGGL(k_mods, dim3(6144 / 256, 4), dim3(256), 0, s, I.c, I.c_ctx, I.w_mod, I.b_mod, mods);
    if (start_layer == 0) hipLaunchKernelGGL(k_init, dim3(M * D / 256), dim3(256), 0, s, I.x_prompt, I.x_sample, X);
    for (int i = start_layer; i < 4; ++i) {
        const int kind = i % 3, j = i / 3;
        const float* ml = mods + (size_t)i * 5 * 6144;
        hipLaunchKernelGGL(k_norm_mod, dim3(M), dim3(256), 0, s, X, I.g_mix + i * 1024, ml, 0, Hn, 0);
        if (kind == 0) {
            float* U = T1; float* Yf = T3; float* Yb = T3 + (size_t)M * D; float* Z = T1 + (size_t)M * D;
            gemm(Hn, D, I.ssm_w_in + (size_t)j * D * D, D, U, D, M, D, D, s);
            hipLaunchKernelGGL(k_ssm, dim3(36 * 64), dim3(128), 0, s, U, Yf, Yb, I.lam_re, I.lam_im, I.log_dt, I.b_re, I.b_im, I.c_re, I.c_im, I.st_re, I.st_im, j, new_re, new_im);
            hipLaunchKernelGGL(k_ssm_comb, dim3(M * D / 256), dim3(256), 0, s, U, Yf, Yb, I.ssm_d + j * 1024, Z);
            for (int rc = 0; rc < 3; ++rc) {
                float* AG = T3;
                gemm(Z + (size_t)rc * 4096 * D, D, I.ssm_w_out + (size_t)j * D * 2048, 2048, AG, 2048, 4096, 2048, D, s);
                hipLaunchKernelGGL(k_ssm_gate, dim3(4096 * D / 256), dim3(256), 0, s, AG, ml, X, rc * 4096);
            }
        } else if (kind == 1) {
            for (int rc = 0; rc < 3; ++rc) {
                float* Zb = T1; float* A2 = T2; float* O = T3;
                gemm(Hn + (size_t)rc * 4096 * D, D, I.gmlp_w_in, 4096, Zb, 4096, 4096, 4096, D, s);
                hipLaunchKernelGGL(k_gelu, dim3(4096 * 4096 / 256), dim3(256), 0, s, Zb, (size_t)4096 * 4096);
                hipLaunchKernelGGL(k_ln_v, dim3(4096), dim3(256), 0, s, Zb);
                hipLaunchKernelGGL(k_gmlp_spatial, dim3(4096 * 2048 / 256), dim3(256), 0, s, Zb, I.gmlp_w_s, I.gmlp_b_s, A2);
                gemm(A2, 2048, I.gmlp_w_out, D, O, D, 4096, D, 2048, s);
                hipLaunchKernelGGL(k_resid, dim3(4096 * D / 256), dim3(256), 0, s, O, ml, 2, X, rc * 4096);
            }
        } else {
            for (int rc = 0; rc < 3; ++rc) {
                float* P = T1; float* A2 = T2; float* O = T3;
                gemm(Hn + (size_t)rc * 4096 * D, D, I.conv_w_in, 3072, P, 3072, 4096, 3072, D, s);
                hipLaunchKernelGGL(k_conv, dim3(4096 * D / 256), dim3(256), 0, s, P, I.conv_w, A2, rc < 2 ? 256 : 1024);
                gemm(A2, D, I.conv_w_out, D, O, D, 4096, D, D, s);
                hipLaunchKernelGGL(k_resid, dim3(4096 * D / 256), dim3(256), 0, s, O, ml, 2, X, rc * 4096);
            }
        }
        hipLaunchKernelGGL(k_norm_mod, dim3(M), dim3(256), 0, s, X, I.g_ffn + i * 1024, ml, 3, Hn, 0);
        for (int rc = 0; rc < 3; ++rc) {
            float* Hid = T1; float* O = T3;
            gemm(Hn + (size_t)rc * 4096 * D, D, I.ffn_w1 + (size_t)i * D * FF, FF, Hid, FF, 4096, FF, D, s);
            hipLaunchKernelGGL(k_sqrelu, dim3(4096 * 4096 / 256), dim3(256), 0, s, Hid, (size_t)4096 * 4096);
            gemm(Hid, FF, I.ffn_w2 + (size_t)i * FF * D, D, O, D, 4096, D, FF, s);
            hipLaunchKernelGGL(k_resid, dim3(4096 * D / 256), dim3(256), 0, s, O, ml, 5, X, rc * 4096);
        }
    }
    hipLaunchKernelGGL(k_final, dim3(M), dim3(256), 0, s, X, I.g_final, X);
}
}
#include <hip/hip_cooperative_groups.h>
namespace mk {
namespace cg = cooperative_groups;
#define LAS __attribute__((address_space(3)))
#define GAS __attribute__((address_space(1)))
typedef unsigned short bf16_t;
typedef short bf16x8 __attribute__((ext_vector_type(8)));
typedef short s16x4 __attribute__((ext_vector_type(4)));
typedef float f32x4 __attribute__((ext_vector_type(4)));
typedef float f32x2 __attribute__((ext_vector_type(2)));
typedef unsigned u32x4 __attribute__((ext_vector_type(4)));
typedef unsigned u32x2 __attribute__((ext_vector_type(2)));

constexpr int D = 1024, M = 12288, MP = 8192, FF = 4096, NCH = 768;
constexpr float EPS = 1e-6f;
constexpr int BM = 256, BK = 64, HALF = 128, HTB = HALF * BK * 2, STAGE_BYTES = 8 * HTB, NXCD = 8, WGM = 8;

__device__ __forceinline__ unsigned cvt_pk_bf16(float lo, float hi) { unsigned r; asm volatile("v_cvt_pk_bf16_f32 %0, %1, %2" : "=v"(r) : "v"(lo), "v"(hi)); return r; }
__device__ __forceinline__ float bf_lo(unsigned w) { return __uint_as_float(w << 16); }
__device__ __forceinline__ float bf_hi(unsigned w) { return __uint_as_float(w & 0xffff0000u); }
__device__ __forceinline__ float gelu_tanh(float x) {
    const float u = 0.7978845608028654f * (x + 0.044715f * x * x * x);
    return x / (1.0f + __expf(-2.0f * u));
}
__device__ __forceinline__ float sigmoid_f(float x) { return 1.0f / (1.0f + __expf(-x)); }
__device__ __forceinline__ int cond_of_pm(int pm) { return pm < 32 ? 0 : 1 + ((pm - 32) >> 2); }
__device__ __forceinline__ int cond_of_row(int row) { return row < MP ? 0 : 1 + ((row - MP) >> 10); }

__host__ __device__ __forceinline__ int lds_byte(int r, int c) { const int st = (r >> 4) * 2 + (c >> 5), rr = r & 15, cc = c & 31, ob = rr * 64 + cc * 2; return st * 1024 + (ob ^ (((ob >> 9) & 1) << 5)); }
__host__ __device__ __forceinline__ void stage_rc(int b, int& R, int& C) { const int st = b / 1024, sb = b % 1024, swz = sb ^ (((sb >> 9) & 1) << 5); R = (st >> 1) * 16 + swz / 64; C = (st & 1) * 32 + (swz % 64) / 2; }
__host__ __device__ __forceinline__ int perm32(int rho) { const int n = rho >> 4, i = rho & 15; return 8 * (i >> 2) + 4 * n + (i & 3); }

struct Unit { int pm, pn; };
struct Gemm { const char* A; const char* Bt; int K; int lda; int ldb; size_t kstepA, hstepA, tstepA; };
struct ARowMajor { static __device__ __forceinline__ unsigned voff(int R, int C, int lda) { return (unsigned)(R * lda + C) * 2u; } };
struct AGroupChunk { static __device__ __forceinline__ unsigned voff(int R, int C, int) { return (unsigned)((((C >> 4) * NCH + (R >> 4)) * 256) + (R & 15) * 16 + (C & 15)) * 2u; } };
__host__ __device__ inline Gemm gemm_rowmajor(const void* A, int lda, const void* Bt, int ldb, int K) {
    Gemm g; g.A = (const char*)A; g.Bt = (const char*)Bt; g.K = K; g.lda = lda; g.ldb = ldb; g.kstepA = BK * 2; g.hstepA = (size_t)HALF * lda * 2; g.tstepA = 2 * g.hstepA; return g; }
__host__ __device__ inline Gemm gemm_groupchunk(const void* A, const void* Bt, int ldb, int K) {
    Gemm g; g.A = (const char*)A; g.Bt = (const char*)Bt; g.K = K; g.lda = 0; g.ldb = ldb; g.kstepA = (size_t)4 * NCH * 256 * 2; g.hstepA = 8 * 256 * 2; g.tstepA = 16 * 256 * 2; return g; }

struct StaticOrder {
    int nM, nN, nwg, G, c;
    __host__ __device__ void init(int M_, int N_, int G_, int c_) { nM = M_ / BM; nN = N_ / BM; nwg = nM * nN; G = G_; c = c_; }
    __host__ __device__ bool next(int i, Unit& u) const {
        const long L = (long)i * G + c; if (L >= nwg) return false;
        int wgid = (int)L; { const int q = nwg / NXCD, r = nwg % NXCD, xcd = wgid % NXCD, off = wgid / NXCD; wgid = (xcd < r ? xcd * (q + 1) : r * (q + 1) + (xcd - r) * q) + off; }
        const int nig = WGM * nN, gid = wgid / nig, fm = gid * WGM, gsz = (nM - fm) < WGM ? (nM - fm) : WGM;
        u.pm = fm + ((wgid % nig) % gsz); u.pn = (wgid % nig) / gsz; return true;
    }
};
struct SsmOrder {
    int G, c;
    __host__ __device__ bool next(int i, Unit& u) const { const int L = i * G + c; if (L >= 192) return false; u.pm = L; u.pn = L / 3; return true; }
};

template <class Epi, class AL, class Sched>
__device__ __forceinline__ void gemm_phase(LAS unsigned char* lds, const Gemm g, const Sched& S, const Epi& E) {
    int tid = threadIdx.x; asm volatile("" : "+v"(tid));
    const int wid = __builtin_amdgcn_readfirstlane(tid >> 6), lane = tid & 63, wr = wid >> 2, wc = wid & 3, fr = lane & 15, fq = lane >> 4;
    const int K = g.K, nt = K / BK;
    unsigned voffA[2], voffB[2];
#pragma unroll
    for (int i = 0; i < 2; ++i) { int R, C; stage_rc(tid * 16 + i * 8192, R, C); const int Rb = Epi::PERM ? ((R & ~31) + perm32(R & 31)) : R;
        voffA[i] = AL::voff(R, C, g.lda); voffB[i] = (unsigned)(Rb * g.ldb + C) * 2u; }
    const size_t kstepA = g.kstepA, hstepA = g.hstepA, tstepA = g.tstepA;
    const size_t kstepB = (size_t)(BK * 2), hstepB = (size_t)HALF * g.ldb * 2, tstepB = 2 * hstepB;
    const unsigned ldsw = (unsigned)wid * 1024u;
    const int aoff = lds_byte(wr * 64 + fr, fq * 8), boff = lds_byte(wc * 32 + fr, fq * 8);
#define PG8_SA(b, h) (((b) * 2 + (h)) * HTB)
#define PG8_SB(b, h) ((4 + (b) * 2 + (h)) * HTB)
#define PG8_STAGE(bufoff, gbase, voff) do { _Pragma("unroll") for (int _i = 0; _i < 2; ++_i) \
        __builtin_amdgcn_global_load_lds((const unsigned*)((const char*)(gbase) + (voff)[_i]), (LAS unsigned*)(lds + (bufoff) + ldsw + _i * 8192), 16, 0, 0); } while (0)
#define PG8_LDA(dst, b, h) do { _Pragma("unroll") for (int m = 0; m < 4; ++m) _Pragma("unroll") for (int k = 0; k < 2; ++k) dst[m][k] = *(const LAS bf16x8*)(lds + PG8_SA(b, h) + aoff + m * 2048 + k * 1024); } while (0)
#define PG8_LDB(dst, b, h) do { _Pragma("unroll") for (int n = 0; n < 2; ++n) _Pragma("unroll") for (int k = 0; k < 2; ++k) dst[n][k] = *(const LAS bf16x8*)(lds + PG8_SB(b, h) + boff + n * 2048 + k * 1024); } while (0)
#define PG8_MMA(ai, bj, At, Bt) do { __builtin_amdgcn_s_setprio(1); _Pragma("unroll") for (int m = 0; m < 4; ++m) _Pragma("unroll") for (int n = 0; n < 2; ++n) _Pragma("unroll") for (int k = 0; k < 2; ++k) \
        acc[ai][bj][m][n] = __builtin_amdgcn_mfma_f32_16x16x32_bf16(Bt[n][k], At[m][k], acc[ai][bj][m][n], 0, 0, 0); __builtin_amdgcn_s_setprio(0); } while (0)
#define PG8_WAIT_V(n) asm volatile("s_waitcnt vmcnt(" #n ")" ::: "memory")
#define PG8_WAIT_L(n) asm volatile("s_waitcnt lgkmcnt(" #n ")" ::: "memory")
#define PG8_BAR __builtin_amdgcn_s_barrier()
#define PG8_SCHED __builtin_amdgcn_sched_barrier(0)
    Unit cur, nxt; int ui = 0;
    if (!S.next(0, cur)) return;
    f32x4 acc[2][2][4][2];
#pragma unroll
    for (int a = 0; a < 2; ++a)
#pragma unroll
        for (int b = 0; b < 2; ++b)
#pragma unroll
            for (int m = 0; m < 4; ++m)
#pragma unroll
                for (int n = 0; n < 2; ++n) acc[a][b][m][n] = (f32x4){0.f, 0.f, 0.f, 0.f};
    bf16x8 At[4][2], B0[2][2], B1[2][2];
    const char* cA = g.A + (size_t)cur.pm * tstepA; const char* cB = g.Bt + (size_t)cur.pn * tstepB;
    PG8_STAGE(PG8_SB(0, 0), cB, voffB); PG8_STAGE(PG8_SB(0, 1), cB + hstepB, voffB); PG8_STAGE(PG8_SA(0, 0), cA, voffA); PG8_STAGE(PG8_SA(0, 1), cA + hstepA, voffA);
    if (wr == 1) PG8_BAR;
    PG8_WAIT_V(2); PG8_BAR;
    PG8_STAGE(PG8_SB(1, 0), cB + kstepB, voffB); PG8_STAGE(PG8_SA(1, 0), cA + kstepA, voffA); PG8_STAGE(PG8_SB(1, 1), cB + hstepB + kstepB, voffB);
    PG8_WAIT_V(6); PG8_BAR;
    for (;;) {
        const bool has_next = S.next(ui + 1, nxt);
        const char* nA = has_next ? g.A + (size_t)nxt.pm * tstepA : cA; const char* nB = has_next ? g.Bt + (size_t)nxt.pn * tstepB : cB;
        for (int t = 0; t < nt; t += 2) {
            const bool last = (t == nt - 2);
            const char* a1 = cA + (size_t)(t + 1) * kstepA;
            const char* a2 = last ? nA : cA + (size_t)(t + 2) * kstepA; const char* b2 = last ? nB : cB + (size_t)(t + 2) * kstepB;
            const char* a3 = a2 + kstepA; const char* b3 = b2 + kstepB;
            PG8_LDB(B0, 0, 0); PG8_LDB(B1, 0, 1); PG8_SCHED; PG8_LDA(At, 0, 0); PG8_STAGE(PG8_SA(1, 1), a1 + hstepA, voffA);
            PG8_WAIT_V(8); PG8_WAIT_L(0); PG8_BAR; PG8_MMA(0, 0, At, B0); PG8_MMA(0, 1, At, B1); PG8_BAR; PG8_SCHED;
            PG8_LDA(At, 0, 1); PG8_STAGE(PG8_SB(0, 0), b2, voffB); PG8_STAGE(PG8_SB(0, 1), b2 + hstepB, voffB); PG8_STAGE(PG8_SA(0, 0), a2, voffA);
            PG8_WAIT_V(8); PG8_WAIT_L(0); PG8_BAR; PG8_MMA(1, 0, At, B0); PG8_MMA(1, 1, At, B1); PG8_BAR; PG8_SCHED;
            PG8_LDB(B0, 1, 0); PG8_LDB(B1, 1, 1); PG8_SCHED; PG8_LDA(At, 1, 0); PG8_STAGE(PG8_SA(0, 1), a2 + hstepA, voffA);
            PG8_WAIT_V(8); PG8_WAIT_L(0); PG8_BAR; PG8_MMA(0, 0, At, B0); PG8_MMA(0, 1, At, B1); PG8_BAR; PG8_SCHED;
            PG8_LDA(At, 1, 1); PG8_STAGE(PG8_SB(1, 0), b3, voffB); PG8_STAGE(PG8_SB(1, 1), b3 + hstepB, voffB); PG8_STAGE(PG8_SA(1, 0), a3, voffA);
            PG8_WAIT_V(8); PG8_WAIT_L(0); PG8_BAR; PG8_MMA(1, 0, At, B0); PG8_MMA(1, 1, At, B1); PG8_BAR; PG8_SCHED;
        }
        if (wr == 0) PG8_BAR;
        E(acc, cur, wr, wc, fr, fq);
        if (!has_next) break;
#pragma unroll
        for (int a = 0; a < 2; ++a)
#pragma unroll
            for (int b = 0; b < 2; ++b)
#pragma unroll
                for (int m = 0; m < 4; ++m)
#pragma unroll
                    for (int n = 0; n < 2; ++n) acc[a][b][m][n] = (f32x4){0.f, 0.f, 0.f, 0.f};
        cur = nxt; cA = nA; cB = nB; ++ui;
        if (wr == 1) PG8_BAR;
    }
    PG8_WAIT_V(0);
    PG8_BAR;
#undef PG8_SA
#undef PG8_SB
#undef PG8_STAGE
#undef PG8_LDA
#undef PG8_LDB
#undef PG8_MMA
#undef PG8_WAIT_V
#undef PG8_WAIT_L
#undef PG8_BAR
#undef PG8_SCHED
}

typedef const f32x4 (&AccRef)[2][2][4][2];

__device__ __forceinline__ void load_rstd(const float* rowss, int ns, int row0, float (&rs)[2][4]) {
#pragma unroll
    for (int ai = 0; ai < 2; ++ai)
#pragma unroll
        for (int m = 0; m < 4; ++m) { const f32x4* p = (const f32x4*)(rowss + (size_t)(row0 + ai * HALF + m * 16) * 32); f32x4 a = p[0] + p[1] + p[2] + p[3];
            if (ns > 16) a += p[4] + p[5] + p[6] + p[7];
            rs[ai][m] = 1.0f / sqrtf(((a[0] + a[1]) + (a[2] + a[3])) * (1.0f / D) + EPS); }
}

template <int ACT> struct EpiIn {
    static constexpr bool PERM = true;
    bf16_t* O; int ldc; const float* rowss; int ns; const float* sw; int swld; float* vstat;
    __device__ __forceinline__ void operator()(AccRef acc, const Unit& u, int wr, int wc, int fr, int fq) const {
        const int row0 = u.pm * BM + wr * 64 + fr, col0 = u.pn * BM + wc * 32 + 8 * fq;
        float rs[2][4]; load_rstd(rowss, ns, row0, rs);
        const float* swp = sw + (size_t)cond_of_pm(u.pm) * swld + col0;
        float s1[2][4], s2[2][4];
        if (ACT == 2) {
#pragma unroll
            for (int ai = 0; ai < 2; ++ai)
#pragma unroll
                for (int m = 0; m < 4; ++m) { s1[ai][m] = 0.f; s2[ai][m] = 0.f; } }
#pragma unroll
        for (int bj = 0; bj < 2; ++bj) {
            const f32x4 b0 = *(const f32x4*)(swp + bj * HALF), b1 = *(const f32x4*)(swp + bj * HALF + 4);
#pragma unroll
            for (int ai = 0; ai < 2; ++ai)
#pragma unroll
                for (int m = 0; m < 4; ++m) {
                    f32x4 v0 = acc[ai][bj][m][0] * rs[ai][m] + b0, v1 = acc[ai][bj][m][1] * rs[ai][m] + b1;
                    if (ACT == 1) {
#pragma unroll
                        for (int j = 0; j < 4; ++j) { const float a = fmaxf(v0[j], 0.f), b = fmaxf(v1[j], 0.f); v0[j] = a * a; v1[j] = b * b; } }
                    if (ACT == 2) {
#pragma unroll
                        for (int j = 0; j < 4; ++j) { v0[j] = gelu_tanh(v0[j]); v1[j] = gelu_tanh(v1[j]); }
                        s1[ai][m] += (v0[0] + v0[1]) + (v0[2] + v0[3]) + (v1[0] + v1[1]) + (v1[2] + v1[3]);
                        s2[ai][m] += (v0[0] * v0[0] + v0[1] * v0[1]) + (v0[2] * v0[2] + v0[3] * v0[3]) + (v1[0] * v1[0] + v1[1] * v1[1]) + (v1[2] * v1[2] + v1[3] * v1[3]);
                    }
                    u32x4 w; w.x = cvt_pk_bf16(v0[0], v0[1]); w.y = cvt_pk_bf16(v0[2], v0[3]); w.z = cvt_pk_bf16(v1[0], v1[1]); w.w = cvt_pk_bf16(v1[2], v1[3]);
                    *(u32x4*)(O + (size_t)(row0 + ai * HALF + m * 16) * ldc + col0 + bj * HALF) = w;
                }
        }
        if (ACT == 2) { if (u.pn >= 8) {
#pragma unroll
            for (int ai = 0; ai < 2; ++ai)
#pragma unroll
                for (int m = 0; m < 4; ++m) {
                    float a = s1[ai][m], b = s2[ai][m];
                    a += __shfl_xor(a, 16); a += __shfl_xor(a, 32); b += __shfl_xor(b, 16); b += __shfl_xor(b, 32);
                    if (fq == 0) { const int r = row0 + ai * HALF + m * 16; *(f32x2*)(vstat + ((size_t)r * 32 + (u.pn - 8) * 4 + wc) * 2) = (f32x2){a, b}; }
                } } }
    }
};
struct EpiU {
    static constexpr bool PERM = true;
    bf16_t* UgS; const float* rowss; const float* sw;
    __device__ __forceinline__ void operator()(AccRef acc, const Unit& u, int wr, int wc, int fr, int fq) const {
        const int row0 = u.pm * BM + wr * 64 + fr, col0 = u.pn * BM + wc * 32 + 8 * fq;
        float rs[2][4]; load_rstd(rowss, 16, row0, rs);
        const float* swp = sw + (size_t)cond_of_pm(u.pm) * 1024 + col0;
#pragma unroll
        for (int bj = 0; bj < 2; ++bj) {
            const f32x4 b0 = *(const f32x4*)(swp + bj * HALF), b1 = *(const f32x4*)(swp + bj * HALF + 4);
            const int g = (col0 + bj * HALF) >> 4, p0 = (col0 & 15);
#pragma unroll
            for (int ai = 0; ai < 2; ++ai)
#pragma unroll
                for (int m = 0; m < 4; ++m) {
                    const f32x4 v0 = acc[ai][bj][m][0] * rs[ai][m] + b0, v1 = acc[ai][bj][m][1] * rs[ai][m] + b1;
                    u32x4 w; w.x = cvt_pk_bf16(v0[0], v0[1]); w.y = cvt_pk_bf16(v0[2], v0[3]); w.z = cvt_pk_bf16(v1[0], v1[1]); w.w = cvt_pk_bf16(v1[2], v1[3]);
                    const int chunk = u.pm * 16 + ai * 8 + wr * 4 + m;
                    *(u32x4*)(UgS + ((size_t)g * NCH + chunk) * 512 + fr * 16 + p0) = w;
                }
        }
    }
};
struct EpiF32 {
    static constexpr bool PERM = true;
    float* C; int ldc;
    __device__ __forceinline__ void operator()(AccRef acc, const Unit& u, int wr, int wc, int fr, int fq) const {
        const int row0 = u.pm * BM + wr * 64 + fr, col0 = wc * 32 + 8 * fq;
#pragma unroll
        for (int ai = 0; ai < 2; ++ai)
#pragma unroll
            for (int m = 0; m < 4; ++m) { float* rp = C + (size_t)(row0 + ai * HALF + m * 16) * ldc + col0;
#pragma unroll
                for (int bj = 0; bj < 2; ++bj) { *(f32x4*)(rp + bj * HALF) = acc[ai][bj][m][0]; *(f32x4*)(rp + bj * HALF + 4) = acc[ai][bj][m][1]; } }
    }
};
struct EpiY {
    static constexpr bool PERM = true;
    bf16_t* Zg;
    __device__ __forceinline__ void operator()(AccRef acc, const Unit& u, int wr, int wc, int fr, int fq) const {
        const int row0 = u.pm * BM + wr * 64 + fr, col0 = wc * 32 + 8 * fq;
#pragma unroll
        for (int ai = 0; ai < 2; ++ai)
#pragma unroll
            for (int m = 0; m < 4; ++m) { bf16_t* rp = Zg + (size_t)(row0 + ai * HALF + m * 16) * 256 + col0;
#pragma unroll
                for (int bj = 0; bj < 2; ++bj) { const f32x4 v0 = acc[ai][bj][m][0], v1 = acc[ai][bj][m][1];
                    u32x4 w; w.x = cvt_pk_bf16(gelu_tanh(v0[0]), gelu_tanh(v0[1])); w.y = cvt_pk_bf16(gelu_tanh(v0[2]), gelu_tanh(v0[3]));
                    w.z = cvt_pk_bf16(gelu_tanh(v1[0]), gelu_tanh(v1[1])); w.w = cvt_pk_bf16(gelu_tanh(v1[2]), gelu_tanh(v1[3]));
                    *(u32x4*)(rp + bj * HALF) = w; } }
    }
};
template <bool GATED> struct EpiRes {
    static constexpr bool PERM = true;
    float* X; bf16_t* XN; const float* gate; const float* gsn; float* rowss_next;
    __device__ __forceinline__ void operator()(AccRef acc, const Unit& u, int wr, int wc, int fr, int fq) const {
        const int row0 = u.pm * BM + wr * 64 + fr, col0 = u.pn * (GATED ? HALF : BM) + wc * 32 + 8 * fq;
        const int ci = cond_of_pm(u.pm);
        float ss[2][4];
#pragma unroll
        for (int ai = 0; ai < 2; ++ai)
#pragma unroll
            for (int m = 0; m < 4; ++m) ss[ai][m] = 0.f;
#pragma unroll
        for (int bj = 0; bj < (GATED ? 1 : 2); ++bj) {
            const int col = col0 + bj * HALF;
            const f32x4 g0 = *(const f32x4*)(gate + (size_t)ci * 6144 + col), g1 = *(const f32x4*)(gate + (size_t)ci * 6144 + col + 4);
            f32x4 n0 = {0.f, 0.f, 0.f, 0.f}, n1 = n0;
            if (gsn) { n0 = *(const f32x4*)(gsn + ci * 1024 + col); n1 = *(const f32x4*)(gsn + ci * 1024 + col + 4); }
#pragma unroll
            for (int ai = 0; ai < 2; ++ai)
#pragma unroll
                for (int m = 0; m < 4; ++m) {
                    float* xp = X + (size_t)(row0 + ai * HALF + m * 16) * D + col;
                    f32x4 v0 = acc[ai][bj][m][0], v1 = acc[ai][bj][m][1];
                    if (GATED) { const f32x4 q0 = acc[ai][1][m][0], q1 = acc[ai][1][m][1];
#pragma unroll
                        for (int j = 0; j < 4; ++j) { v0[j] *= sigmoid_f(q0[j]); v1[j] *= sigmoid_f(q1[j]); } }
                    const f32x4 x0 = *(const f32x4*)xp + g0 * v0, x1 = *(const f32x4*)(xp + 4) + g1 * v1;
                    *(f32x4*)xp = x0; *(f32x4*)(xp + 4) = x1;
                    if (gsn) {
                        ss[ai][m] += (x0[0] * x0[0] + x0[1] * x0[1]) + (x0[2] * x0[2] + x0[3] * x0[3]) + (x1[0] * x1[0] + x1[1] * x1[1]) + (x1[2] * x1[2] + x1[3] * x1[3]);
                        const f32x4 y0 = x0 * n0, y1 = x1 * n1;
                        u32x4 w; w.x = cvt_pk_bf16(y0[0], y0[1]); w.y = cvt_pk_bf16(y0[2], y0[3]); w.z = cvt_pk_bf16(y1[0], y1[1]); w.w = cvt_pk_bf16(y1[2], y1[3]);
                        *(u32x4*)(XN + (size_t)(row0 + ai * HALF + m * 16) * D + col) = w;
                    }
                }
        }
        if (gsn) {
#pragma unroll
            for (int ai = 0; ai < 2; ++ai)
#pragma unroll
                for (int m = 0; m < 4; ++m) { float a = ss[ai][m]; a += __shfl_xor(a, 16); a += __shfl_xor(a, 32);
                    if (fq == 0) rowss_next[(size_t)(row0 + ai * HALF + m * 16) * 32 + u.pn * 4 + wc] = a; }
        }
    }
};

#define XB_TMO      128
#define XB_XCNT(j)  (256  + 64 * (j))
#define XB_XSUB(j)  (1280 + 64 * (j))
#define XB_XGEN(j)  (2304 + 64 * (j))
#define XB_TOP      3328
#define XB_TOPGEN   3392
#define XCD_BAR_WORDS 3456
#define XB_SPIN_CAP (1u << 18)
__device__ __forceinline__ unsigned xb_ld(unsigned* p)              { return __hip_atomic_load(p, __ATOMIC_RELAXED, __HIP_MEMORY_SCOPE_AGENT); }
__device__ __forceinline__ unsigned xb_add(unsigned* p, unsigned v) { return __hip_atomic_fetch_add(p, v, __ATOMIC_RELAXED, __HIP_MEMORY_SCOPE_AGENT); }
__device__ __forceinline__ unsigned xb_xcc_id() { return (unsigned)__builtin_amdgcn_s_getreg((3 << 11) | 20) & 0xFu; }
#define XB_SPIN(cond, bar) do { unsigned _sp = 0; while (cond) { __builtin_amdgcn_s_sleep(1); \
    if ((++_sp & 255u) == 0u) { if (xb_ld(&(bar)[XB_TMO])) break; if (_sp > XB_SPIN_CAP) { atomicAdd(&(bar)[XB_TMO], 1u); break; } } } } while (0)
struct XcdBarrier { unsigned* bar; unsigned x; volatile LAS unsigned* st; };
__device__ __forceinline__ XcdBarrier xcd_barrier_post(unsigned* bar, volatile LAS unsigned* st) {
    XcdBarrier b; b.bar = bar; b.x = xb_xcc_id(); b.st = st;
    if (threadIdx.x == 0) (void)xb_add(&bar[XB_XCNT(b.x)], 1u);
    return b;
}
__device__ __forceinline__ void xcd_barrier_complete(unsigned* bar, unsigned x, unsigned& nloc, unsigned& nx) {
    const unsigned G = gridDim.x * gridDim.y * gridDim.z;
    unsigned sum, cnt, mine, sp = 0u;
    for (;;) {
        sum = 0u; cnt = 0u; mine = 0u;
#pragma unroll
        for (unsigned j = 0; j < 16; ++j) { const unsigned c = xb_ld(&bar[XB_XCNT(j)]); sum += c; cnt += (c > 0u) ? 1u : 0u; mine = (j == x) ? c : mine; }
        if (sum == G) break;
        __builtin_amdgcn_s_sleep(1);
        if ((++sp & 255u) == 0u) { if (xb_ld(&bar[XB_TMO])) break; if (sp > XB_SPIN_CAP) { atomicAdd(&bar[XB_TMO], 1u); break; } }
    }
    nloc = mine > 0u ? mine : 1u; nx = cnt > 0u ? cnt : 1u;
}
__device__ __forceinline__ void xcd_barrier(const XcdBarrier& b) {
    asm volatile("s_waitcnt vmcnt(0)" ::: "memory");
    __syncthreads();
    if (threadIdx.x == 0) {
        unsigned* bar = b.bar;
        __builtin_amdgcn_s_waitcnt(0);
        unsigned nloc = b.st[0], nx = b.st[1];
        if (nloc == 0u) { xcd_barrier_complete(bar, b.x, nloc, nx); b.st[0] = nloc; b.st[1] = nx; }
        const unsigned old = xb_add(&bar[XB_XSUB(b.x)], 1u);
        const unsigned gen = old / nloc;
        if (old + 1u == (gen + 1u) * nloc) {
            __builtin_amdgcn_fence(__ATOMIC_RELEASE, "agent");
            asm volatile("s_waitcnt vmcnt(0)" ::: "memory");
            const unsigned og = xb_add(&bar[XB_TOP], 1u);
            const unsigned tg = og / nx;
            if (og + 1u == (tg + 1u) * nx) xb_add(&bar[XB_TOPGEN], 1u);
            else XB_SPIN(xb_ld(&bar[XB_TOPGEN]) == tg, bar);
            __builtin_amdgcn_fence(__ATOMIC_ACQUIRE, "agent");
            xb_add(&bar[XB_XGEN(b.x)], 1u);
            asm volatile("s_waitcnt vmcnt(0)" ::: "memory");
        } else {
            XB_SPIN(xb_ld(&bar[XB_XGEN(b.x)]) == gen, bar);
            __builtin_amdgcn_fence(__ATOMIC_ACQUIRE, "agent");
            asm volatile("s_waitcnt vmcnt(0)" ::: "memory");
        }
    }
    __syncthreads();
}

constexpr size_t MiB = 1u << 20;
constexpr size_t WS_CTL = 0, CTL_BYTES = 2 * MiB;
constexpr int CW_BAR = 4096;
constexpr size_t WS_TAB = 2 * MiB;
constexpr size_t TAB_GSA = WS_TAB, TAB_GSB = TAB_GSA + 4 * 5 * 1024 * 4, TAB_SWA = TAB_GSB + 4 * 5 * 1024 * 4, TAB_SWB = TAB_SWA + 4 * 5 * 4096 * 4, TAB_LAMT = TAB_SWB + 4 * 5 * 4096 * 4;
static_assert(TAB_LAMT + 2 * 64 * 2 * 64 * 2 * 4 <= 4 * MiB, "tables");
constexpr size_t WS_W1 = 4 * MiB, WS_W2 = 36 * MiB, WS_SWIN = 68 * MiB, WS_SWOUT = 72 * MiB, WS_GWIN = 80 * MiB, WS_GWOUT = 88 * MiB, WS_GWS = 92 * MiB,
                 WS_CWIN = 93 * MiB, WS_CWOUT = 99 * MiB, WS_BTY = 101 * MiB, WS_BTS = 133 * MiB;
constexpr size_t WS_XN = 149 * MiB;
constexpr size_t WS_R = 173 * MiB;
constexpr size_t WS_R2 = 269 * MiB;
constexpr size_t WS_ROWSS = 317 * MiB;
constexpr size_t WS_VSTAT = 329 * MiB;
constexpr size_t WS_MODS = 332 * MiB;
constexpr size_t WS_END = 333 * MiB;

constexpr int LDS_BYTES = 147456;
constexpr int MISC_OFF = STAGE_BYTES;

struct Args { const float* in[30]; float* out; unsigned char* ws; int ph_lo, ph_hi; };

__device__ __forceinline__ unsigned f2bf(float f) { unsigned u = __builtin_bit_cast(unsigned, f); return (u + 0x7fffu + ((u >> 16) & 1u)) >> 16; }
__device__ __forceinline__ unsigned pk2(float lo, float hi) { return f2bf(lo) | (f2bf(hi) << 16); }
__device__ __forceinline__ float wave_sum(float v) {
#pragma unroll
    for (int o = 1; o < 64; o <<= 1) v += __shfl_xor(v, o);
    return v;
}
template <int MAP> __device__ __forceinline__ int rowmap(int n) {
    if (MAP == 1) { const int half = n >> 10, c = n & 1023; return (c >> 7) * 256 + half * 128 + (c & 127); }
    return n;
}
template <int MAP> __device__ __forceinline__ void transpose_item(const float* W, int K, int N, bf16_t* WT, LAS float* scr, int item, int lane) {
    const int nblk = N / 32, kb = item / nblk, nb = item % nblk, k0 = 64 * kb, n0 = 32 * nb;
#pragma unroll 8
    for (int i = 0; i < 32; ++i) { const int kk = 2 * i + (lane >> 5); scr[kk * 33 + (lane & 31)] = W[(size_t)(k0 + kk) * N + n0 + (lane & 31)]; }
    asm volatile("s_waitcnt lgkmcnt(0)" ::: "memory");
    const int c = lane & 7;
#pragma unroll
    for (int j = 0; j < 4; ++j) { const int n = (lane >> 3) + 8 * j; const LAS float* s = scr + (8 * c) * 33 + n;
        u32x4 o; o.x = pk2(s[0 * 33], s[1 * 33]); o.y = pk2(s[2 * 33], s[3 * 33]); o.z = pk2(s[4 * 33], s[5 * 33]); o.w = pk2(s[6 * 33], s[7 * 33]);
        *(u32x4*)(WT + (size_t)rowmap<MAP>(n0 + n) * K + k0 + 8 * c) = o; }
    asm volatile("s_waitcnt lgkmcnt(0)" ::: "memory");
}

__device__ __forceinline__ void ssm_build(const Args& a, int j, int g, LAS unsigned char* lds, unsigned char* ws) {
    const int tid = threadIdx.x;
    LAS float* PR = (LAS float*)lds;
    LAS float* PI = PR + 2 * 17 * 64;
    LAS float* BR = PI + 2 * 17 * 64;
    LAS float* BI = BR + 2 * 64 * 16;
    LAS float* CR = BI + 2 * 64 * 16;
    LAS float* CI = CR + 2 * 16 * 64;
    LAS float* WR = CI + 2 * 16 * 64;
    LAS float* WI = WR + 2 * 64 * 16;
    LAS float* KT = WI + 2 * 64 * 16;
    const float* lam_re = a.in[13]; const float* lam_im = a.in[14]; const float* log_dt = a.in[15];
    const float* b_re = a.in[16]; const float* b_im = a.in[17]; const float* c_re = a.in[18]; const float* c_im = a.in[19]; const float* dsk = a.in[20];
    __syncthreads();
    if (tid < 128) {
        const int k = tid >> 6, n = tid & 63, pidx = (j * 2 + k) * 64 + g;
        const float dt = expf(log_dt[pidx]);
        const float lr = lam_re[pidx * 64 + n], li = lam_im[pidx * 64 + n];
        for (int e = 0; e <= 16; ++e) { const float mag = expf((float)e * lr * dt); float sn, cs; sincosf((float)e * (li * dt), &sn, &cs); PR[(k * 17 + e) * 64 + n] = mag * cs; PI[(k * 17 + e) * 64 + n] = mag * sn; }
        const float mag = expf(lr * dt); const float abr = mag * cosf(li * dt), abi = mag * sinf(li * dt);
        const float den = lr * lr + li * li;
        const float nr = (abr - 1.0f) * lr + abi * li, ni = -(abr - 1.0f) * li + abi * lr;
        const float fr = nr / den, fi = ni / den;
        for (int p = 0; p < 16; ++p) { const float br = b_re[((size_t)pidx * 64 + n) * 16 + p], bi = b_im[((size_t)pidx * 64 + n) * 16 + p];
            BR[(k * 64 + n) * 16 + p] = fr * br - fi * bi; BI[(k * 64 + n) * 16 + p] = fr * bi + fi * br; }
        float* lamT = (float*)(ws + TAB_LAMT) + (((size_t)j * 64 + g) * 2 + k) * 128;
        lamT[2 * n] = PR[(k * 17 + 16) * 64 + n]; lamT[2 * n + 1] = PI[(k * 17 + 16) * 64 + n];
    }
    for (int i = tid; i < 2048; i += 512) { const int k = i >> 10, r = i & 1023; const size_t o = ((size_t)(j * 2 + k) * 64 + g) * 1024 + r; CR[i] = c_re[o]; CI[i] = c_im[o]; }
    __syncthreads();
    {
        const int k = tid >> 8, po = (tid >> 4) & 15, pi = tid & 15;
        for (int e = 0; e < 16; ++e) {
            for (int i = tid; i < 2048; i += 512) { const int kk = i >> 10, n = (i >> 4) & 63; const float pr = PR[(kk * 17 + e) * 64 + n], pim = PI[(kk * 17 + e) * 64 + n];
                WR[i] = pr * BR[i] - pim * BI[i]; WI[i] = pr * BI[i] + pim * BR[i]; }
            __syncthreads();
            float s = 0.f;
#pragma unroll 8
            for (int n = 0; n < 64; ++n) s += CR[(k * 16 + po) * 64 + n] * WR[(k * 64 + n) * 16 + pi] - CI[(k * 16 + po) * 64 + n] * WI[(k * 64 + n) * 16 + pi];
            KT[((k * 16 + e) * 16 + po) * 16 + pi] = s;
            __syncthreads();
        }
    }
    bf16_t* BtY = (bf16_t*)(ws + WS_BTY) + ((size_t)j * 64 + g) * 256 * 512;
    bf16_t* BtS = (bf16_t*)(ws + WS_BTS) + ((size_t)j * 64 + g) * 256 * 256;
    for (int pc = tid; pc < 256 * 32; pc += 512) {
        const int row = pc >> 5, kc = (pc & 31) * 8, t = row >> 4, po = row & 15, s = kc >> 4, pi0 = kc & 15;
        float v[8];
#pragma unroll
        for (int q = 0; q < 8; ++q) { const int pi = pi0 + q; float x = 0.f;
            if (s <= t) x += KT[((0 * 16 + (t - s)) * 16 + po) * 16 + pi];
            if (s >= t) x += KT[((1 * 16 + (s - t)) * 16 + po) * 16 + pi];
            if (s == t && pi == po) x += dsk[j * 1024 + g * 16 + po];
            v[q] = x; }
        u32x4 o; o.x = pk2(v[0], v[1]); o.y = pk2(v[2], v[3]); o.z = pk2(v[4], v[5]); o.w = pk2(v[6], v[7]);
        *(u32x4*)(BtY + (size_t)row * 512 + kc) = o;
    }
    for (int pc = tid; pc < 256 * 32; pc += 512) {
        const int row = pc >> 5, kc = (pc & 31) * 8, t = row >> 4, po = row & 15, k = kc >> 7, ri = (kc >> 6) & 1, n0 = kc & 63;
        const int e = k == 0 ? t + 1 : 16 - t;
        float v[8];
#pragma unroll
        for (int q = 0; q < 8; ++q) { const int n = n0 + q; const float cr = CR[(k * 16 + po) * 64 + n], cim = CI[(k * 16 + po) * 64 + n], pr = PR[(k * 17 + e) * 64 + n], pim = PI[(k * 17 + e) * 64 + n];
            v[q] = ri == 0 ? (cr * pr - cim * pim) : -(cr * pim + cim * pr); }
        u32x4 o; o.x = pk2(v[0], v[1]); o.y = pk2(v[2], v[3]); o.z = pk2(v[4], v[5]); o.w = pk2(v[6], v[7]);
        *(u32x4*)(BtY + (size_t)row * 512 + 256 + kc) = o;
    }
    for (int pc = tid; pc < 256 * 32; pc += 512) {
        const int row = pc >> 5, kc = (pc & 31) * 8, k = row >> 7, ri = (row >> 6) & 1, n = row & 63, s = kc >> 4, pi0 = kc & 15;
        const int e = k == 0 ? 15 - s : s;
        const float pr = PR[(k * 17 + e) * 64 + n], pim = PI[(k * 17 + e) * 64 + n];
        float v[8];
#pragma unroll
        for (int q = 0; q < 8; ++q) { const float br = BR[(k * 64 + n) * 16 + pi0 + q], bi = BI[(k * 64 + n) * 16 + pi0 + q]; v[q] = ri == 0 ? (pr * br - pim * bi) : (pr * bi + pim * br); }
        u32x4 o; o.x = pk2(v[0], v[1]); o.y = pk2(v[2], v[3]); o.z = pk2(v[4], v[5]); o.w = pk2(v[6], v[7]);
        *(u32x4*)(BtS + (size_t)row * 256 + kc) = o;
    }
    __syncthreads();
}

__device__ __forceinline__ void mods_item(const Args& a, float* mods, LAS float* scr, int item, int lane) {
    const int cg = item % 96, l = item / 96;
    const float* c = a.in[4]; const float* c_ctx = a.in[5]; const float* w_mod = a.in[6]; const float* b_mod = a.in[7];
    const float* w = w_mod + (size_t)l * 1024 * 6144 + cg * 64 + lane;
    float acc[5] = {0.f, 0.f, 0.f, 0.f, 0.f};
    for (int k0 = 0; k0 < 1024; k0 += 64) {
#pragma unroll
        for (int ci = 0; ci < 5; ++ci) { const float v = ci == 0 ? c_ctx[k0 + lane] : c[(ci - 1) * 1024 + k0 + lane]; scr[ci * 64 + lane] = v / (1.0f + expf(-v)); }
        asm volatile("s_waitcnt lgkmcnt(0)" ::: "memory");
        float wv[64];
#pragma unroll
        for (int k = 0; k < 64; ++k) wv[k] = w[(size_t)(k0 + k) * 6144];
#pragma unroll
        for (int k = 0; k < 64; ++k) {
#pragma unroll
            for (int ci = 0; ci < 5; ++ci) acc[ci] += wv[k] * scr[ci * 64 + k]; }
        asm volatile("s_waitcnt lgkmcnt(0)" ::: "memory");
    }
    const float b = b_mod[l * 6144 + cg * 64 + lane];
#pragma unroll
    for (int ci = 0; ci < 5; ++ci) mods[((size_t)l * 5 + ci) * 6144 + cg * 64 + lane] = acc[ci] + b;
}

__device__ __forceinline__ void xinit_row(const Args& a, float* X, int row, int lane) {
    f32x4* o = (f32x4*)(X + (size_t)row * D) + lane;
    if (row < MP) { const f32x4* s = (const f32x4*)(a.in[0] + (size_t)row * D) + lane;
#pragma unroll
        for (int q = 0; q < 4; ++q) o[64 * q] = s[64 * q];
        return; }
    const f32x4* s = (const f32x4*)(a.in[1] + (size_t)(row - MP) * D) + lane;
    const int t = (row - MP) & 1023; const float rr = (float)(t >> 6), cc = (float)(t & 63);
#pragma unroll
    for (int q = 0; q < 4; ++q) {
        f32x4 v = s[64 * q];
        const float pos = q < 2 ? rr : cc;
#pragma unroll
        for (int e = 0; e < 4; ++e) { const int fi = 4 * lane + e; const float freq = expf(-(float)fi * (9.210340371976184f / 256.0f)); const float ang = pos * freq; v[e] += (q & 1) ? cosf(ang) : sinf(ang); }
        o[64 * q] = v;
    }
}

constexpr int NPH = 28;
#ifndef MK_ALLCG
#define MK_ALLCG 0
#endif
__global__ void __launch_bounds__(512, 2) fwd(Args args) {
    extern __shared__ __attribute__((aligned(16))) unsigned char lds_raw[];
    LAS unsigned char* lds = (LAS unsigned char*)lds_raw;
    volatile LAS unsigned* MISC = (volatile LAS unsigned*)(lds + MISC_OFF);
    const int tid = threadIdx.x, lane = tid & 63, wave = __builtin_amdgcn_readfirstlane(tid >> 6);
    const int G = gridDim.x, bx = blockIdx.x, vcu = (G % 8 == 0) ? (bx % 8) * (G / 8) + bx / 8 : bx;
    unsigned* ctl = (unsigned*)(args.ws + WS_CTL);
    for (int u = tid; u < 64; u += 512) MISC[u] = 0u;
    __syncthreads();
    XcdBarrier bar = xcd_barrier_post(ctl + CW_BAR, MISC + 8);
    const int lo = args.ph_lo, hi = args.ph_hi;
    int ph = 0;
#define IN_PH (lo <= ph && ph < hi)
#define SEAM() do { if (IN_PH && ph + 1 < hi) { if (ph == 0 || MK_ALLCG) cg::this_grid().sync(); else xcd_barrier(bar); } ++ph; } while (0)

    const int gw = vcu * 8 + wave, NGW = G * 8;
#define PH_PTRS() unsigned char* ws = args.ws; asm volatile("" : "+s"(ws)); \
    int tid_o_ = threadIdx.x; asm volatile("" : "+v"(tid_o_)); const int tid = tid_o_, lane = tid_o_ & 63; (void)tid; (void)lane; \
    float* X = args.out; bf16_t* XN = (bf16_t*)(ws + WS_XN); float* mods = (float*)(ws + WS_MODS); \
    float* gsA = (float*)(ws + TAB_GSA); float* gsB = (float*)(ws + TAB_GSB); float* swA = (float*)(ws + TAB_SWA); float* swB = (float*)(ws + TAB_SWB); \
    float* rowss = (float*)(ws + WS_ROWSS); float* vstat = (float*)(ws + WS_VSTAT); \
    bf16_t* Hb = (bf16_t*)(ws + WS_R); bf16_t* UgS = (bf16_t*)(ws + WS_R); float* Sloc = (float*)(ws + WS_R + 48 * MiB); bf16_t* Zg = (bf16_t*)(ws + WS_R + 48 * MiB); bf16_t* A2 = (bf16_t*)(ws + WS_R2); \
    (void)X; (void)XN; (void)mods; (void)gsA; (void)gsB; (void)swA; (void)swB; (void)rowss; (void)vstat; (void)Hb; (void)UgS; (void)Sloc; (void)Zg; (void)A2;
#define PH_LAYER() const float* rs_mix = rowss + (size_t)(2 * layer) * M * 32; float* rs_ffn = rowss + (size_t)(2 * layer + 1) * M * 32; float* rs_next = rowss + (size_t)((2 * layer + 2) & 7) * M * 32; \
    const float* modl = mods + (size_t)layer * 5 * 6144; (void)rs_mix; (void)rs_ffn; (void)rs_next; (void)modl;

    if (IN_PH) { PH_PTRS();
        for (int t = bx; t < 128; t += G) ssm_build(args, t >> 6, t & 63, lds, ws);
        __syncthreads();
        LAS float* scr = (LAS float*)(lds + wave * 16384);
        constexpr int I_W1 = 2048, I_W2 = 2048, I_SI = 512, I_SO = 1024, I_GI = 2048, I_GO = 1024, I_CI = 1536, I_CO = 512;
        constexpr int NT = 4 * I_W1 + 4 * I_W2 + 2 * I_SI + 2 * I_SO + I_GI + I_GO + I_CI + I_CO;
        for (int it = gw; it < NT; it += NGW) {
            int r = it;
            if (r < 4 * I_W1) { const int l = r / I_W1; transpose_item<0>(args.in[10] + (size_t)l * D * FF, D, FF, (bf16_t*)(ws + WS_W1) + (size_t)l * D * FF, scr, r % I_W1, lane); continue; } r -= 4 * I_W1;
            if (r < 4 * I_W2) { const int l = r / I_W2; transpose_item<0>(args.in[11] + (size_t)l * D * FF, FF, D, (bf16_t*)(ws + WS_W2) + (size_t)l * D * FF, scr, r % I_W2, lane); continue; } r -= 4 * I_W2;
            if (r < 2 * I_SI) { const int l = r / I_SI; transpose_item<0>(args.in[12] + (size_t)l * D * D, D, D, (bf16_t*)(ws + WS_SWIN) + (size_t)l * D * D, scr, r % I_SI, lane); continue; } r -= 2 * I_SI;
            if (r < 2 * I_SO) { const int l = r / I_SO; transpose_item<1>(args.in[21] + (size_t)l * D * 2048, D, 2048, (bf16_t*)(ws + WS_SWOUT) + (size_t)l * D * 2048, scr, r % I_SO, lane); continue; } r -= 2 * I_SO;
            if (r < I_GI) { transpose_item<0>(args.in[22], D, 4096, (bf16_t*)(ws + WS_GWIN), scr, r, lane); continue; } r -= I_GI;
            if (r < I_GO) { transpose_item<0>(args.in[25], 2048, D, (bf16_t*)(ws + WS_GWOUT), scr, r, lane); continue; } r -= I_GO;
            if (r < I_CI) { transpose_item<0>(args.in[26], D, 3072, (bf16_t*)(ws + WS_CWIN), scr, r, lane); continue; } r -= I_CI;
            transpose_item<0>(args.in[28], D, D, (bf16_t*)(ws + WS_CWOUT), scr, r, lane);
        }
        for (int it = NGW - 1 - gw; it < 4 * 96; it += NGW) mods_item(args, mods, scr, it, lane);
        {
            const float* s = args.in[23]; bf16_t* d = (bf16_t*)(ws + WS_GWS);
            for (int i = (gw * 64 + lane) * 8; i < 16 * 128 * 128; i += NGW * 64 * 8) { const f32x4 a0 = *(const f32x4*)(s + i), a1 = *(const f32x4*)(s + i + 4);
                u32x4 o; o.x = pk2(a0[0], a0[1]); o.y = pk2(a0[2], a0[3]); o.z = pk2(a1[0], a1[1]); o.w = pk2(a1[2], a1[3]); *(u32x4*)(d + i) = o; }
        }
        for (int row = gw; row < M; row += NGW) xinit_row(args, X, row, lane);
    }
    SEAM();
    if (IN_PH) { PH_PTRS();
        for (int i = gw * 64 + lane; i < 4 * 5 * 1024; i += NGW * 64) { const int l = i / 5120, ci = (i / 1024) % 5, c = i & 1023;
            const float* md = mods + ((size_t)l * 5 + ci) * 6144;
            gsA[i] = args.in[8][l * 1024 + c] * (1.0f + md[1024 + c]); gsB[i] = args.in[9][l * 1024 + c] * (1.0f + md[4 * 1024 + c]); }
        constexpr int N_MIX0 = 1024, N_MIX1 = 4096, N_MIX2 = 3072, N_MIX3 = 1024;
        constexpr int NTOT = N_MIX0 + N_MIX1 + N_MIX2 + N_MIX3 + 4 * 4096;
        for (int it0 = gw * 8; it0 < NTOT; it0 += NGW * 8) {
            int r = it0, l, sidx; const bf16_t* WT; float* dst; int dld;
            if (r < N_MIX0) { l = 0; sidx = 0; WT = (const bf16_t*)(ws + WS_SWIN); dst = swA + 0 * 5 * 4096; dld = 1024; }
            else if ((r -= N_MIX0) < N_MIX1) { l = 1; sidx = 0; WT = (const bf16_t*)(ws + WS_GWIN); dst = swA + 1 * 5 * 4096; dld = 4096; }
            else if ((r -= N_MIX1) < N_MIX2) { l = 2; sidx = 0; WT = (const bf16_t*)(ws + WS_CWIN); dst = swA + 2 * 5 * 4096; dld = 3072; }
            else if ((r -= N_MIX2) < N_MIX3) { l = 3; sidx = 0; WT = (const bf16_t*)(ws + WS_SWIN) + (size_t)D * D; dst = swA + 3 * 5 * 4096; dld = 1024; }
            else { r -= N_MIX3; l = r / 4096; r = r % 4096; sidx = 3; WT = (const bf16_t*)(ws + WS_W1) + (size_t)l * D * FF; dst = swB + l * 5 * 4096; dld = 4096; }
            float sh[5][16];
#pragma unroll
            for (int ci = 0; ci < 5; ++ci) { const float* sp = mods + ((size_t)l * 5 + ci) * 6144 + sidx * 1024 + lane * 16;
#pragma unroll
                for (int q = 0; q < 4; ++q) { const f32x4 v = *(const f32x4*)(sp + 4 * q); sh[ci][4 * q] = v[0]; sh[ci][4 * q + 1] = v[1]; sh[ci][4 * q + 2] = v[2]; sh[ci][4 * q + 3] = v[3]; } }
            for (int nn = 0; nn < 8; ++nn) {
                const int n = r + nn;
                const u32x4 w0 = *(const u32x4*)(WT + (size_t)n * D + lane * 16), w1 = *(const u32x4*)(WT + (size_t)n * D + lane * 16 + 8);
                float wf[16] = {bf_lo(w0.x), bf_hi(w0.x), bf_lo(w0.y), bf_hi(w0.y), bf_lo(w0.z), bf_hi(w0.z), bf_lo(w0.w), bf_hi(w0.w),
                                bf_lo(w1.x), bf_hi(w1.x), bf_lo(w1.y), bf_hi(w1.y), bf_lo(w1.z), bf_hi(w1.z), bf_lo(w1.w), bf_hi(w1.w)};
#pragma unroll
                for (int ci = 0; ci < 5; ++ci) { float s = 0.f;
#pragma unroll
                    for (int q = 0; q < 16; ++q) s += wf[q] * sh[ci][q];
                    s = wave_sum(s);
                    if (lane == 0) dst[ci * dld + n] = s; }
            }
        }
        for (int row = gw; row < M; row += NGW) {
            const f32x4* xr = (const f32x4*)(X + (size_t)row * D) + lane; const int ci = cond_of_row(row);
            const float* md = mods + ((size_t)0 * 5 + ci) * 6144; const float* gm = args.in[8];
            f32x4 v[4]; float s = 0.f;
#pragma unroll
            for (int q = 0; q < 4; ++q) { v[q] = xr[64 * q]; s += (v[q][0] * v[q][0] + v[q][1] * v[q][1]) + (v[q][2] * v[q][2] + v[q][3] * v[q][3]); }
            s = wave_sum(s);
            if (lane < 32) rowss[(size_t)row * 32 + lane] = lane == 0 ? s : 0.f;
            u32x2* o = (u32x2*)(XN + (size_t)row * D) + lane;
#pragma unroll
            for (int q = 0; q < 4; ++q) { const int c = 256 * q + 4 * lane; const f32x4 gg = *(const f32x4*)(gm + c), sc = *(const f32x4*)(md + 1024 + c);
                const f32x4 y = v[q] * gg * (sc + 1.0f); u32x2 w; w.x = cvt_pk_bf16(y[0], y[1]); w.y = cvt_pk_bf16(y[2], y[3]); o[64 * q] = w; }
        }
    }
    SEAM();
#pragma unroll 1
    for (int layer = 0; layer < 4; ++layer) {
        const int kind = layer % 3, j = layer / 3;
        if (kind == 0) {
            if (IN_PH) { PH_PTRS(); PH_LAYER(); const Gemm g = gemm_rowmajor(XN, D, (const bf16_t*)(ws + WS_SWIN) + (size_t)j * D * D, D, D); StaticOrder S; S.init(M, D, G, bx);
                EpiU E{UgS, rs_mix, swA + layer * 5 * 4096}; gemm_phase<EpiU, ARowMajor, StaticOrder>(lds, g, S, E); }
            SEAM();
            if (IN_PH) { PH_PTRS(); PH_LAYER(); const Gemm g = gemm_rowmajor(UgS, 512, (const bf16_t*)(ws + WS_BTS) + (size_t)j * 64 * 256 * 256, 256, 256); SsmOrder S{G, bx};
                EpiF32 E{Sloc, 256}; gemm_phase<EpiF32, ARowMajor, SsmOrder>(lds, g, S, E); }
            SEAM();
            if (IN_PH) { PH_PTRS(); PH_LAYER();
                const float* lamT = (const float*)(ws + TAB_LAMT);
                float* new_re = args.out + (size_t)M * D; float* new_im = new_re + 32 * 2 * 2 * 64 * 64;
                for (int task = gw; task < 64 * 36 * 2; task += NGW) {
                    const int k = task & 1, seq = (task >> 1) % 36, g = task / 72;
                    const int c0 = seq < 32 ? seq * 16 : 512 + (seq - 32) * 64, nc = seq < 32 ? 16 : 64;
                    const float lr = lamT[(((size_t)j * 64 + g) * 2 + k) * 128 + 2 * lane], li = lamT[(((size_t)j * 64 + g) * 2 + k) * 128 + 2 * lane + 1];
                    float sr = 0.f, si = 0.f;
                    if (seq >= 32) { const size_t o = ((((size_t)(seq - 32) * 2 + j) * 2 + k) * 64 + g) * 64 + lane; sr = args.in[2][o]; si = args.in[3][o]; }
                    const float* sl = Sloc + ((size_t)g * NCH) * 256 + k * 128 + lane;
                    bf16_t* so = UgS + ((size_t)g * NCH) * 512 + 256 + k * 128 + lane;
                    for (int i = 0; i < nc; ++i) {
                        const int c = k == 0 ? c0 + i : c0 + nc - 1 - i;
                        so[(size_t)c * 512] = (bf16_t)f2bf(sr); so[(size_t)c * 512 + 64] = (bf16_t)f2bf(si);
                        const float ar = sl[(size_t)c * 256], ai = sl[(size_t)c * 256 + 64];
                        const float nr = lr * sr - li * si + ar, ni = lr * si + li * sr + ai; sr = nr; si = ni;
                    }
                    if (seq < 32) { const size_t o = ((((size_t)seq * 2 + j) * 2 + k) * 64 + g) * 64 + lane; new_re[o] = sr; new_im[o] = si; }
                }
            }
            SEAM();
            if (IN_PH) { PH_PTRS(); PH_LAYER(); const Gemm g = gemm_rowmajor(UgS, 512, (const bf16_t*)(ws + WS_BTY) + (size_t)j * 64 * 256 * 512, 512, 512); SsmOrder S{G, bx};
                EpiY E{Zg}; gemm_phase<EpiY, ARowMajor, SsmOrder>(lds, g, S, E); }
            SEAM();
            if (IN_PH) { PH_PTRS(); PH_LAYER(); const Gemm g = gemm_groupchunk(Zg, (const bf16_t*)(ws + WS_SWOUT) + (size_t)j * D * 2048, D, D); StaticOrder S; S.init(M, 2048, G, bx);
                EpiRes<true> E{X, XN, modl + 2 * 1024, gsB + layer * 5 * 1024, rs_ffn}; gemm_phase<EpiRes<true>, AGroupChunk, StaticOrder>(lds, g, S, E); }
            SEAM();
        } else if (kind == 1) {
            if (IN_PH) { PH_PTRS(); PH_LAYER(); const Gemm g = gemm_rowmajor(XN, D, (const bf16_t*)(ws + WS_GWIN), D, D); StaticOrder S; S.init(M, 4096, G, bx);
                EpiIn<2> E{Hb, 4096, rs_mix, 16, swA + layer * 5 * 4096, 4096, vstat}; gemm_phase<EpiIn<2>, ARowMajor, StaticOrder>(lds, g, S, E); }
            SEAM();
            if (IN_PH) { PH_PTRS(); PH_LAYER();
                const bf16_t* Wsb = (const bf16_t*)(ws + WS_GWS); const float* b_s = args.in[24];
                constexpr int VST = 288;
                for (int unit = vcu; unit < 96 * 16; unit += G) {
                    const int c = unit >> 4, g = unit & 15, row0 = c * 128;
                    __syncthreads();
                    LAS f32x2* mr = (LAS f32x2*)(lds + 128 * VST);
                    if (tid < 128) { const f32x4* p = (const f32x4*)(vstat + (size_t)(row0 + tid) * 64); float s1 = 0.f, s2 = 0.f;
#pragma unroll
                        for (int q = 0; q < 16; ++q) { const f32x4 v = p[q]; s1 += v[0] + v[2]; s2 += v[1] + v[3]; }
                        const float mu = s1 * (1.0f / 2048.0f), var = s2 * (1.0f / 2048.0f) - mu * mu; mr[tid] = (f32x2){mu, 1.0f / sqrtf(fmaxf(var, 0.f) + EPS)}; }
                    __syncthreads();
#pragma unroll
                    for (int i = 0; i < 4; ++i) { const int pc = tid + 512 * i, q = pc >> 4, d8 = pc & 15;
                        const u32x4 w = *(const u32x4*)(Hb + (size_t)(row0 + q) * 4096 + 2048 + g * 128 + d8 * 8);
                        const f32x2 st = mr[q]; const float mu = st[0], rstd = st[1];
                        u32x4 o; o.x = cvt_pk_bf16((bf_lo(w.x) - mu) * rstd, (bf_hi(w.x) - mu) * rstd); o.y = cvt_pk_bf16((bf_lo(w.y) - mu) * rstd, (bf_hi(w.y) - mu) * rstd);
                        o.z = cvt_pk_bf16((bf_lo(w.z) - mu) * rstd, (bf_hi(w.z) - mu) * rstd); o.w = cvt_pk_bf16((bf_lo(w.w) - mu) * rstd, (bf_hi(w.w) - mu) * rstd);
                        *(LAS u32x4*)(lds + q * VST + d8 * 16) = o; }
                    __syncthreads();
                    f32x4 acc[8];
#pragma unroll
                    for (int nt = 0; nt < 8; ++nt) acc[nt] = (f32x4){0.f, 0.f, 0.f, 0.f};
                    const int fr = lane & 15, fq = lane >> 4;
#pragma unroll
                    for (int kk = 0; kk < 4; ++kk) {
                        const bf16x8 wf = *(const bf16x8*)(Wsb + ((size_t)g * 128 + wave * 16 + fr) * 128 + kk * 32 + fq * 8);
#pragma unroll
                        for (int nt = 0; nt < 8; ++nt) {
                            const LAS unsigned char* p0 = lds + (kk * 32 + fq * 8 + (fr >> 2)) * VST + (nt * 16 + 4 * (fr & 3)) * 2;
                            const s16x4 lo4 = __builtin_bit_cast(s16x4, __builtin_amdgcn_ds_read_tr16_b64_v4i16((LAS s16x4*)p0));
                            const s16x4 hi4 = __builtin_bit_cast(s16x4, __builtin_amdgcn_ds_read_tr16_b64_v4i16((LAS s16x4*)(p0 + 4 * VST)));
                            const bf16x8 vf = {lo4[0], lo4[1], lo4[2], lo4[3], hi4[0], hi4[1], hi4[2], hi4[3]};
                            acc[nt] = __builtin_amdgcn_mfma_f32_16x16x32_bf16(vf, wf, acc[nt], 0, 0, 0);
                        }
                    }
                    const int p = wave * 16 + fr, row = row0 + p; const float bs = b_s[g * 128 + p];
#pragma unroll
                    for (int nt = 0; nt < 8; ++nt) { const int ch = g * 128 + nt * 16 + 4 * fq;
                        const u32x2 uu = *(const u32x2*)(Hb + (size_t)row * 4096 + ch);
                        u32x2 o; o.x = cvt_pk_bf16(bf_lo(uu.x) * (acc[nt][0] + bs), bf_hi(uu.x) * (acc[nt][1] + bs)); o.y = cvt_pk_bf16(bf_lo(uu.y) * (acc[nt][2] + bs), bf_hi(uu.y) * (acc[nt][3] + bs));
                        *(u32x2*)(A2 + (size_t)row * 2048 + ch) = o; }
                }
                __syncthreads();
            }
            SEAM();
            if (IN_PH) { PH_PTRS(); PH_LAYER(); const Gemm g = gemm_rowmajor(A2, 2048, (const bf16_t*)(ws + WS_GWOUT), 2048, 2048); StaticOrder S; S.init(M, D, G, bx);
                EpiRes<false> E{X, XN, modl + 2 * 1024, gsB + layer * 5 * 1024, rs_ffn}; gemm_phase<EpiRes<false>, ARowMajor, StaticOrder>(lds, g, S, E); }
            SEAM();
        } else {
            if (IN_PH) { PH_PTRS(); PH_LAYER(); const Gemm g = gemm_rowmajor(XN, D, (const bf16_t*)(ws + WS_CWIN), D, D); StaticOrder S; S.init(M, 3072, G, bx);
                EpiIn<0> E{Hb, 3072, rs_mix, 16, swA + layer * 5 * 4096, 3072, nullptr}; gemm_phase<EpiIn<0>, ARowMajor, StaticOrder>(lds, g, S, E); }
            SEAM();
            if (IN_PH) { PH_PTRS(); PH_LAYER();
                const float* cw = args.in[27];
                for (int it = gw * 64 + lane; it < M * 128; it += NGW * 64) {
                    const int row = it >> 7, c8 = (it & 127) * 8;
                    const int L = row < MP ? 256 : 1024, t = row < MP ? (row & 255) : ((row - MP) & 1023);
                    const bf16_t* pr = Hb + (size_t)row * 3072 + c8;
                    float y[8];
#pragma unroll
                    for (int q = 0; q < 8; ++q) y[q] = 0.f;
#pragma unroll
                    for (int w = 0; w < 3; ++w) { const int tt = t + w - 1; if (tt < 0 || tt >= L) continue;
                        const u32x4 gc = *(const u32x4*)(pr + (ptrdiff_t)(w - 1) * 3072 + 1024), xh = *(const u32x4*)(pr + (ptrdiff_t)(w - 1) * 3072 + 2048);
                        const f32x4 k0 = *(const f32x4*)(cw + w * 1024 + c8), k1 = *(const f32x4*)(cw + w * 1024 + c8 + 4);
                        y[0] += k0[0] * bf_lo(gc.x) * bf_lo(xh.x); y[1] += k0[1] * bf_hi(gc.x) * bf_hi(xh.x); y[2] += k0[2] * bf_lo(gc.y) * bf_lo(xh.y); y[3] += k0[3] * bf_hi(gc.y) * bf_hi(xh.y);
                        y[4] += k1[0] * bf_lo(gc.z) * bf_lo(xh.z); y[5] += k1[1] * bf_hi(gc.z) * bf_hi(xh.z); y[6] += k1[2] * bf_lo(gc.w) * bf_lo(xh.w); y[7] += k1[3] * bf_hi(gc.w) * bf_hi(xh.w); }
                    const u32x4 gb = *(const u32x4*)pr;
                    u32x4 o; o.x = cvt_pk_bf16(bf_lo(gb.x) * y[0], bf_hi(gb.x) * y[1]); o.y = cvt_pk_bf16(bf_lo(gb.y) * y[2], bf_hi(gb.y) * y[3]);
                    o.z = cvt_pk_bf16(bf_lo(gb.z) * y[4], bf_hi(gb.z) * y[5]); o.w = cvt_pk_bf16(bf_lo(gb.w) * y[6], bf_hi(gb.w) * y[7]);
                    *(u32x4*)(A2 + (size_t)row * D + c8) = o;
                }
            }
            SEAM();
            if (IN_PH) { PH_PTRS(); PH_LAYER(); const Gemm g = gemm_rowmajor(A2, D, (const bf16_t*)(ws + WS_CWOUT), D, D); StaticOrder S; S.init(M, D, G, bx);
                EpiRes<false> E{X, XN, modl + 2 * 1024, gsB + layer * 5 * 1024, rs_ffn}; gemm_phase<EpiRes<false>, ARowMajor, StaticOrder>(lds, g, S, E); }
            SEAM();
        }
        if (IN_PH) { PH_PTRS(); PH_LAYER(); const Gemm g = gemm_rowmajor(XN, D, (const bf16_t*)(ws + WS_W1) + (size_t)layer * D * FF, D, D); StaticOrder S; S.init(M, FF, G, bx);
            EpiIn<1> E{Hb, FF, rs_ffn, kind == 0 ? 32 : 16, swB + layer * 5 * 4096, 4096, nullptr}; gemm_phase<EpiIn<1>, ARowMajor, StaticOrder>(lds, g, S, E); }
        SEAM();
        if (IN_PH) { PH_PTRS(); PH_LAYER(); const Gemm g = gemm_rowmajor(Hb, FF, (const bf16_t*)(ws + WS_W2) + (size_t)layer * D * FF, FF, FF); StaticOrder S; S.init(M, D, G, bx);
            EpiRes<false> E{X, XN, modl + 5 * 1024, layer < 3 ? gsA + (layer + 1) * 5 * 1024 : nullptr, rs_next}; gemm_phase<EpiRes<false>, ARowMajor, StaticOrder>(lds, g, S, E); }
        SEAM();
    }
    if (IN_PH) { PH_PTRS();
        const float* gf = args.in[29];
        for (int row = gw; row < M; row += NGW) {
            f32x4* xr = (f32x4*)(X + (size_t)row * D) + lane;
            f32x4 v[4]; float s = 0.f;
#pragma unroll
            for (int q = 0; q < 4; ++q) { v[q] = xr[64 * q]; s += (v[q][0] * v[q][0] + v[q][1] * v[q][1]) + (v[q][2] * v[q][2] + v[q][3] * v[q][3]); }
            s = wave_sum(s); const float rstd = 1.0f / sqrtf(s * (1.0f / D) + EPS);
#pragma unroll
            for (int q = 0; q < 4; ++q) xr[64 * q] = v[q] * rstd * *(const f32x4*)(gf + 256 * q + 4 * lane);
        }
    }
    ++ph;
#undef IN_PH
#undef SEAM
}

static bool launch(void* const* d_in, float* out, unsigned char* ws, int lo, int hi, hipStream_t stream) {
    static int grid = 0;
    if (grid == 0) {
        int dev = 0, cus = 0, per_cu = 0;
        if (hipGetDevice(&dev) != hipSuccess || hipDeviceGetAttribute(&cus, hipDeviceAttributeMultiprocessorCount, dev) != hipSuccess) { grid = -1; return false; }
        if (hipFuncSetAttribute((const void*)fwd, hipFuncAttributeMaxDynamicSharedMemorySize, LDS_BYTES) != hipSuccess) { fprintf(stderr, "hipFuncSetAttribute failed\n"); grid = -1; return false; }
        if (hipOccupancyMaxActiveBlocksPerMultiprocessor(&per_cu, (const void*)fwd, 512, LDS_BYTES) != hipSuccess || per_cu < 1) { fprintf(stderr, "occupancy query: %d\n", per_cu); (void)hipGetLastError(); per_cu = 1; }
        grid = cus;
    }
    if (grid < 0) return false;
    Args a{};
    for (int i = 0; i < 30; ++i) a.in[i] = (const float*)d_in[i];
    a.out = out; a.ws = ws; a.ph_lo = lo; a.ph_hi = hi;
    void* kargs[] = {&a};
    const hipError_t e = hipLaunchCooperativeKernel((const void*)fwd, dim3(grid), dim3(512), kargs, LDS_BYTES, stream);
    if (e != hipSuccess) { fprintf(stderr, "cooperative launch failed: %s (grid %d)\n", hipGetErrorString(e), grid); return false; }
    return true;
}
}
#ifndef MK_STAGE
#define MK_STAGE 4
#endif
extern "C" void kernel_launch(void* const* d_in, const int* in_sizes, int n_in, void* d_out, int out_size, void* d_ws, size_t ws_size, hipStream_t stream) {
    if (n_in != 30 || ws_size < mk::WS_END) { fprintf(stderr, "kernel_launch: unexpected n_in %d / ws %zu\n", n_in, ws_size); return; }
    constexpr int ends[5] = {2, 9, 14, 19, 27};
    (void)hipMemsetAsync((char*)d_ws + mk::WS_CTL, 0, mk::CTL_BYTES, stream);
    mk::launch(d_in, (float*)d_out, (unsigned char*)d_ws, 0, ends[MK_STAGE], stream);
#ifdef MK_TWICE
    (void)hipMemsetAsync((char*)d_ws + mk::WS_CTL, 0, mk::CTL_BYTES, stream);
    mk::launch(d_in, (float*)d_out, (unsigned char*)d_ws, 0, ends[MK_STAGE], stream);
#endif
#if MK_STAGE < 4
    nv::In I; const float** p = (const float**)&I;
    for (int i = 0; i < 30; ++i) p[i] = (const float*)d_in[i];
    nv::run(I, (float*)d_out, (unsigned char*)d_ws, stream, MK_STAGE);
#endif
}
```

```cpp
#include <hip/hip_runtime.h>
#include <cstdio>
#include <cstdint>
#include <hip/hip_cooperative_groups.h>
namespace mk {
namespace cg = cooperative_groups;
#define LAS __attribute__((address_space(3)))
#define GAS __attribute__((address_space(1)))
typedef unsigned short bf16_t;
typedef short bf16x8 __attribute__((ext_vector_type(8)));
typedef short s16x4 __attribute__((ext_vector_type(4)));
typedef float f32x4 __attribute__((ext_vector_type(4)));
typedef float f32x2 __attribute__((ext_vector_type(2)));
typedef unsigned u32x4 __attribute__((ext_vector_type(4)));
typedef unsigned u32x2 __attribute__((ext_vector_type(2)));

constexpr int D = 1024, M = 12288, MP = 8192, FF = 4096, NCH = 768;
constexpr float EPS = 1e-6f;
constexpr int BM = 256, BK = 64, HALF = 128, HTB = HALF * BK * 2, STAGE_BYTES = 8 * HTB, NXCD = 8, WGM = 8;

typedef __bf16 bf16x2_t __attribute__((ext_vector_type(2)));
__device__ __forceinline__ unsigned cvt_pk_bf16(float lo, float hi) { const f32x2 v = {lo, hi}; const bf16x2_t b = __builtin_convertvector(v, bf16x2_t); return __builtin_bit_cast(unsigned, b); }
__device__ __forceinline__ float bf_lo(unsigned w) { return __uint_as_float(w << 16); }
__device__ __forceinline__ float bf_hi(unsigned w) { return __uint_as_float(w & 0xffff0000u); }
__device__ __forceinline__ float gelu_tanh(float x) {
    const float u = 0.7978845608028654f * (x + 0.044715f * x * x * x);
    return x / (1.0f + __expf(-2.0f * u));
}
__device__ __forceinline__ float sigmoid_f(float x) { return 1.0f / (1.0f + __expf(-x)); }
__device__ __forceinline__ int cond_of_pm(int pm) { return pm < 32 ? 0 : 1 + ((pm - 32) >> 2); }
__device__ __forceinline__ int cond_of_row(int row) { return row < MP ? 0 : 1 + ((row - MP) >> 10); }

__host__ __device__ __forceinline__ int lds_byte(int r, int c) { const int st = (r >> 4) * 2 + (c >> 5), rr = r & 15, cc = c & 31, ob = rr * 64 + cc * 2; return st * 1024 + (ob ^ (((ob >> 9) & 1) << 5)); }
__host__ __device__ __forceinline__ void stage_rc(int b, int& R, int& C) { const int st = b / 1024, sb = b % 1024, swz = sb ^ (((sb >> 9) & 1) << 5); R = (st >> 1) * 16 + swz / 64; C = (st & 1) * 32 + (swz % 64) / 2; }
__host__ __device__ __forceinline__ int perm32(int rho) { const int n = rho >> 4, i = rho & 15; return 8 * (i >> 2) + 4 * n + (i & 3); }

struct Unit { int pm, pn; };
struct Gemm { const char* A; const char* Bt; int K; int lda; int ldb; size_t kstepA, hstepA, tstepA; };
struct ARowMajor { static __device__ __forceinline__ unsigned voff(int R, int C, int lda) { return (unsigned)(R * lda + C) * 2u; } };
struct AGroupChunk { static __device__ __forceinline__ unsigned voff(int R, int C, int) { return (unsigned)((((C >> 4) * NCH + (R >> 4)) * 256) + (R & 15) * 16 + (C & 15)) * 2u; } };
__host__ __device__ inline Gemm gemm_rowmajor(const void* A, int lda, const void* Bt, int ldb, int K) {
    Gemm g; g.A = (const char*)A; g.Bt = (const char*)Bt; g.K = K; g.lda = lda; g.ldb = ldb; g.kstepA = BK * 2; g.hstepA = (size_t)HALF * lda * 2; g.tstepA = 2 * g.hstepA; return g; }
__host__ __device__ inline Gemm gemm_groupchunk(const void* A, const void* Bt, int ldb, int K) {
    Gemm g; g.A = (const char*)A; g.Bt = (const char*)Bt; g.K = K; g.lda = 0; g.ldb = ldb; g.kstepA = (size_t)4 * NCH * 256 * 2; g.hstepA = 8 * 256 * 2; g.tstepA = 16 * 256 * 2; return g; }

struct StaticOrder {
    int nM, nN, nwg, G, c;
    __host__ __device__ void init(int M_, int N_, int G_, int c_) { nM = M_ / BM; nN = N_ / BM; nwg = nM * nN; G = G_; c = c_; }
    __host__ __device__ bool next(int i, Unit& u) const {
        const long L = (long)i * G + c; if (L >= nwg) return false;
        int wgid = (int)L; { const int q = nwg / NXCD, r = nwg % NXCD, xcd = wgid % NXCD, off = wgid / NXCD; wgid = (xcd < r ? xcd * (q + 1) : r * (q + 1) + (xcd - r) * q) + off; }
        const int nig = WGM * nN, gid = wgid / nig, fm = gid * WGM, gsz = (nM - fm) < WGM ? (nM - fm) : WGM;
        u.pm = fm + ((wgid % nig) % gsz); u.pn = (wgid % nig) / gsz; return true;
    }
};
struct SsmOrder {
    int G, c;
    __host__ __device__ bool next(int i, Unit& u) const { const int L = i * G + c; if (L >= 192) return false; u.pm = L; u.pn = L / 3; return true; }
};

template <class Epi, class AL, class Sched>
__device__ __forceinline__ void gemm_phase(LAS unsigned char* lds, const Gemm g, const Sched& S, const Epi& E) {
    int tid = threadIdx.x; asm volatile("" : "+v"(tid));
    const int wid = __builtin_amdgcn_readfirstlane(tid >> 6), lane = tid & 63, wr = wid >> 2, wc = wid & 3, fr = lane & 15, fq = lane >> 4;
    const int K = g.K, nt = K / BK;
    unsigned voffA[2], voffB[2];
#pragma unroll
    for (int i = 0; i < 2; ++i) { int R, C; stage_rc(tid * 16 + i * 8192, R, C); const int Rb = Epi::PERM ? ((R & ~31) + perm32(R & 31)) : R;
        voffA[i] = AL::voff(R, C, g.lda); voffB[i] = (unsigned)(Rb * g.ldb + C) * 2u; }
    const size_t kstepA = g.kstepA, hstepA = g.hstepA, tstepA = g.tstepA;
    const size_t kstepB = (size_t)(BK * 2), hstepB = (size_t)HALF * g.ldb * 2, tstepB = 2 * hstepB;
    const unsigned ldsw = (unsigned)wid * 1024u;
    const int aoff = lds_byte(wr * 64 + fr, fq * 8), boff = lds_byte(wc * 32 + fr, fq * 8);
#define PG8_SA(b, h) (((b) * 2 + (h)) * HTB)
#define PG8_SB(b, h) ((4 + (b) * 2 + (h)) * HTB)
#define PG8_STAGE(bufoff, gbase, voff) do { _Pragma("unroll") for (int _i = 0; _i < 2; ++_i) \
        __builtin_amdgcn_global_load_lds((const unsigned*)((const char*)(gbase) + (voff)[_i]), (LAS unsigned*)(lds + (bufoff) + ldsw + _i * 8192), 16, 0, 0); } while (0)
#define PG8_LDA(dst, b, h) do { _Pragma("unroll") for (int m = 0; m < 4; ++m) _Pragma("unroll") for (int k = 0; k < 2; ++k) dst[m][k] = *(const LAS bf16x8*)(lds + PG8_SA(b, h) + aoff + m * 2048 + k * 1024); } while (0)
#define PG8_LDB(dst, b, h) do { _Pragma("unroll") for (int n = 0; n < 2; ++n) _Pragma("unroll") for (int k = 0; k < 2; ++k) dst[n][k] = *(const LAS bf16x8*)(lds + PG8_SB(b, h) + boff + n * 2048 + k * 1024); } while (0)
#define PG8_MMA(ai, bj, At, Bt) do { __builtin_amdgcn_s_setprio(1); _Pragma("unroll") for (int m = 0; m < 4; ++m) _Pragma("unroll") for (int n = 0; n < 2; ++n) _Pragma("unroll") for (int k = 0; k < 2; ++k) \
        acc[ai][bj][m][n] = __builtin_amdgcn_mfma_f32_16x16x32_bf16(Bt[n][k], At[m][k], acc[ai][bj][m][n], 0, 0, 0); __builtin_amdgcn_s_setprio(0); } while (0)
#define PG8_WAIT_V(n) asm volatile("s_waitcnt vmcnt(" #n ")" ::: "memory")
#define PG8_WAIT_L(n) asm volatile("s_waitcnt lgkmcnt(" #n ")" ::: "memory")
#define PG8_BAR __builtin_amdgcn_s_barrier()
#define PG8_SCHED __builtin_amdgcn_sched_barrier(0)
    Unit cur, nxt; int ui = 0;
    if (!S.next(0, cur)) return;
    f32x4 acc[2][2][4][2];
#pragma unroll
    for (int a = 0; a < 2; ++a)
#pragma unroll
        for (int b = 0; b < 2; ++b)
#pragma unroll
            for (int m = 0; m < 4; ++m)
#pragma unroll
                for (int n = 0; n < 2; ++n) acc[a][b][m][n] = (f32x4){0.f, 0.f, 0.f, 0.f};
    bf16x8 At[4][2], B0[2][2], B1[2][2];
    const char* cA = g.A + (size_t)cur.pm * tstepA; const char* cB = g.Bt + (size_t)cur.pn * tstepB;
    PG8_STAGE(PG8_SB(0, 0), cB, voffB); PG8_STAGE(PG8_SB(0, 1), cB + hstepB, voffB); PG8_STAGE(PG8_SA(0, 0), cA, voffA); PG8_STAGE(PG8_SA(0, 1), cA + hstepA, voffA);
    if (wr == 1) PG8_BAR;
    PG8_WAIT_V(2); PG8_BAR;
    PG8_STAGE(PG8_SB(1, 0), cB + kstepB, voffB); PG8_STAGE(PG8_SA(1, 0), cA + kstepA, voffA); PG8_STAGE(PG8_SB(1, 1), cB + hstepB + kstepB, voffB);
    PG8_WAIT_V(6); PG8_BAR;
    for (;;) {
        const bool has_next = S.next(ui + 1, nxt);
        const char* nA = has_next ? g.A + (size_t)nxt.pm * tstepA : cA; const char* nB = has_next ? g.Bt + (size_t)nxt.pn * tstepB : cB;
        for (int t = 0; t < nt; t += 2) {
            const bool last = (t == nt - 2);
            const char* a1 = cA + (size_t)(t + 1) * kstepA;
            const char* a2 = last ? nA : cA + (size_t)(t + 2) * kstepA; const char* b2 = last ? nB : cB + (size_t)(t + 2) * kstepB;
            const char* a3 = a2 + kstepA; const char* b3 = b2 + kstepB;
            PG8_LDB(B0, 0, 0); PG8_LDB(B1, 0, 1); PG8_SCHED; PG8_LDA(At, 0, 0); PG8_STAGE(PG8_SA(1, 1), a1 + hstepA, voffA);
            PG8_WAIT_V(8); PG8_WAIT_L(0); PG8_BAR; PG8_MMA(0, 0, At, B0); PG8_MMA(0, 1, At, B1); PG8_BAR; PG8_SCHED;
            PG8_LDA(At, 0, 1); PG8_STAGE(PG8_SB(0, 0), b2, voffB); PG8_STAGE(PG8_SB(0, 1), b2 + hstepB, voffB); PG8_STAGE(PG8_SA(0, 0), a2, voffA);
            PG8_WAIT_V(8); PG8_WAIT_L(0); PG8_BAR; PG8_MMA(1, 0, At, B0); PG8_MMA(1, 1, At, B1); PG8_BAR; PG8_SCHED;
            PG8_LDB(B0, 1, 0); PG8_LDB(B1, 1, 1); PG8_SCHED; PG8_LDA(At, 1, 0); PG8_STAGE(PG8_SA(0, 1), a2 + hstepA, voffA);
            PG8_WAIT_V(8); PG8_WAIT_L(0); PG8_BAR; PG8_MMA(0, 0, At, B0); PG8_MMA(0, 1, At, B1); PG8_BAR; PG8_SCHED;
            PG8_LDA(At, 1, 1); PG8_STAGE(PG8_SB(1, 0), b3, voffB); PG8_STAGE(PG8_SB(1, 1), b3 + hstepB, voffB); PG8_STAGE(PG8_SA(1, 0), a3, voffA);
            PG8_WAIT_V(8); PG8_WAIT_L(0); PG8_BAR; PG8_MMA(1, 0, At, B0); PG8_MMA(1, 1, At, B1); PG8_BAR; PG8_SCHED;
        }
        if (wr == 0) PG8_BAR;
        E(acc, cur, wr, wc, fr, fq);
        if (!has_next) break;
#pragma unroll
        for (int a = 0; a < 2; ++a)
#pragma unroll
            for (int b = 0; b < 2; ++b)
#pragma unroll
                for (int m = 0; m < 4; ++m)
#pragma unroll
                    for (int n = 0; n < 2; ++n) acc[a][b][m][n] = (f32x4){0.f, 0.f, 0.f, 0.f};
        cur = nxt; cA = nA; cB = nB; ++ui;
        if (wr == 1) PG8_BAR;
    }
    PG8_WAIT_V(0);
    PG8_BAR;
#undef PG8_SA
#undef PG8_SB
#undef PG8_STAGE
#undef PG8_LDA
#undef PG8_LDB
#undef PG8_MMA
#undef PG8_WAIT_V
#undef PG8_WAIT_L
#undef PG8_BAR
#undef PG8_SCHED
}

typedef const f32x4 (&AccRef)[2][2][4][2];

__device__ __forceinline__ void load_rstd(const float* rowss, int ns, int row0, int fq, float (&rs)[2][4]) {
    f32x4 a[2][4];
#pragma unroll
    for (int ai = 0; ai < 2; ++ai)
#pragma unroll
        for (int m = 0; m < 4; ++m) { const f32x4* p = (const f32x4*)(rowss + (size_t)(row0 + ai * HALF + m * 16) * 32) + fq; a[ai][m] = p[0] + p[4]; }
#pragma unroll
    for (int ai = 0; ai < 2; ++ai)
#pragma unroll
        for (int m = 0; m < 4; ++m) { float t = (a[ai][m][0] + a[ai][m][1]) + (a[ai][m][2] + a[ai][m][3]); t += __shfl_xor(t, 16); t += __shfl_xor(t, 32);
            rs[ai][m] = 1.0f / sqrtf(t * (1.0f / D) + EPS); }
}

template <int ACT> struct EpiIn {
    static constexpr bool PERM = true;
    bf16_t* O; int ldc; const float* rowss; int ns; const float* sw; int swld; float* vstat;
    __device__ __forceinline__ void operator()(AccRef acc, const Unit& u, int wr, int wc, int fr, int fq) const {
        const int row0 = u.pm * BM + wr * 64 + fr, col0 = u.pn * BM + wc * 32 + 8 * fq;
        float rs[2][4]; load_rstd(rowss, ns, row0, fq, rs);
        const float* swp = sw + (size_t)cond_of_pm(u.pm) * swld + col0;
        float s1[2][4], s2[2][4];
        if (ACT == 2) {
#pragma unroll
            for (int ai = 0; ai < 2; ++ai)
#pragma unroll
                for (int m = 0; m < 4; ++m) { s1[ai][m] = 0.f; s2[ai][m] = 0.f; } }
#pragma unroll
        for (int bj = 0; bj < 2; ++bj) {
            const f32x4 b0 = *(const f32x4*)(swp + bj * HALF), b1 = *(const f32x4*)(swp + bj * HALF + 4);
#pragma unroll
            for (int ai = 0; ai < 2; ++ai)
#pragma unroll
                for (int m = 0; m < 4; ++m) {
                    f32x4 v0 = acc[ai][bj][m][0] * rs[ai][m] + b0, v1 = acc[ai][bj][m][1] * rs[ai][m] + b1;
                    if (ACT == 1) {
#pragma unroll
                        for (int j = 0; j < 4; ++j) { const float a = fmaxf(v0[j], 0.f), b = fmaxf(v1[j], 0.f); v0[j] = a * a; v1[j] = b * b; } }
                    if (ACT == 2) {
#pragma unroll
                        for (int j = 0; j < 4; ++j) { v0[j] = gelu_tanh(v0[j]); v1[j] = gelu_tanh(v1[j]); }
                        s1[ai][m] += (v0[0] + v0[1]) + (v0[2] + v0[3]) + (v1[0] + v1[1]) + (v1[2] + v1[3]);
                        s2[ai][m] += (v0[0] * v0[0] + v0[1] * v0[1]) + (v0[2] * v0[2] + v0[3] * v0[3]) + (v1[0] * v1[0] + v1[1] * v1[1]) + (v1[2] * v1[2] + v1[3] * v1[3]);
                    }
                    u32x4 w; w.x = cvt_pk_bf16(v0[0], v0[1]); w.y = cvt_pk_bf16(v0[2], v0[3]); w.z = cvt_pk_bf16(v1[0], v1[1]); w.w = cvt_pk_bf16(v1[2], v1[3]);
                    *(u32x4*)(O + (size_t)(row0 + ai * HALF + m * 16) * ldc + col0 + bj * HALF) = w;
                }
        }
        if (ACT == 2) { if (u.pn >= 8) {
#pragma unroll
            for (int ai = 0; ai < 2; ++ai)
#pragma unroll
                for (int m = 0; m < 4; ++m) {
                    float a = s1[ai][m], b = s2[ai][m];
                    a += __shfl_xor(a, 16); a += __shfl_xor(a, 32); b += __shfl_xor(b, 16); b += __shfl_xor(b, 32);
                    if (fq == 0) { const int r = row0 + ai * HALF + m * 16; *(f32x2*)(vstat + ((size_t)r * 32 + (u.pn - 8) * 4 + wc) * 2) = (f32x2){a, b}; }
                } } }
    }
};
struct EpiU {
    static constexpr bool PERM = true;
    bf16_t* UgS; const float* rowss; const float* sw;
    __device__ __forceinline__ void operator()(AccRef acc, const Unit& u, int wr, int wc, int fr, int fq) const {
        const int row0 = u.pm * BM + wr * 64 + fr, col0 = u.pn * BM + wc * 32 + 8 * fq;
        float rs[2][4]; load_rstd(rowss, 16, row0, fq, rs);
        const float* swp = sw + (size_t)cond_of_pm(u.pm) * 1024 + col0;
#pragma unroll
        for (int bj = 0; bj < 2; ++bj) {
            const f32x4 b0 = *(const f32x4*)(swp + bj * HALF), b1 = *(const f32x4*)(swp + bj * HALF + 4);
            const int g = (col0 + bj * HALF) >> 4, p0 = (col0 & 15);
#pragma unroll
            for (int ai = 0; ai < 2; ++ai)
#pragma unroll
                for (int m = 0; m < 4; ++m) {
                    const f32x4 v0 = acc[ai][bj][m][0] * rs[ai][m] + b0, v1 = acc[ai][bj][m][1] * rs[ai][m] + b1;
                    u32x4 w; w.x = cvt_pk_bf16(v0[0], v0[1]); w.y = cvt_pk_bf16(v0[2], v0[3]); w.z = cvt_pk_bf16(v1[0], v1[1]); w.w = cvt_pk_bf16(v1[2], v1[3]);
                    const int chunk = u.pm * 16 + ai * 8 + wr * 4 + m;
                    *(u32x4*)(UgS + ((size_t)g * NCH + chunk) * 512 + fr * 16 + p0) = w;
                }
        }
    }
};
struct EpiF32 {
    static constexpr bool PERM = true;
    float* C; int ldc;
    __device__ __forceinline__ void operator()(AccRef acc, const Unit& u, int wr, int wc, int fr, int fq) const {
        const int row0 = u.pm * BM + wr * 64 + fr, col0 = wc * 32 + 8 * fq;
#pragma unroll
        for (int ai = 0; ai < 2; ++ai)
#pragma unroll
            for (int m = 0; m < 4; ++m) { float* rp = C + (size_t)(row0 + ai * HALF + m * 16) * ldc + col0;
#pragma unroll
                for (int bj = 0; bj < 2; ++bj) { *(f32x4*)(rp + bj * HALF) = acc[ai][bj][m][0]; *(f32x4*)(rp + bj * HALF + 4) = acc[ai][bj][m][1]; } }
    }
};
struct EpiY {
    static constexpr bool PERM = true;
    bf16_t* Zg;
    __device__ __forceinline__ void operator()(AccRef acc, const Unit& u, int wr, int wc, int fr, int fq) const {
        const int row0 = u.pm * BM + wr * 64 + fr, col0 = wc * 32 + 8 * fq;
#pragma unroll
        for (int ai = 0; ai < 2; ++ai)
#pragma unroll
            for (int m = 0; m < 4; ++m) { bf16_t* rp = Zg + (size_t)(row0 + ai * HALF + m * 16) * 256 + col0;
#pragma unroll
                for (int bj = 0; bj < 2; ++bj) { const f32x4 v0 = acc[ai][bj][m][0], v1 = acc[ai][bj][m][1];
                    u32x4 w; w.x = cvt_pk_bf16(gelu_tanh(v0[0]), gelu_tanh(v0[1])); w.y = cvt_pk_bf16(gelu_tanh(v0[2]), gelu_tanh(v0[3]));
                    w.z = cvt_pk_bf16(gelu_tanh(v1[0]), gelu_tanh(v1[1])); w.w = cvt_pk_bf16(gelu_tanh(v1[2]), gelu_tanh(v1[3]));
                    *(u32x4*)(rp + bj * HALF) = w; } }
    }
};
template <bool GATED> struct EpiRes {
    static constexpr bool PERM = true;
    float* X; bf16_t* XN; const float* gate; const float* gsn; float* rowss_next;
    __device__ __forceinline__ void operator()(AccRef acc, const Unit& u, int wr, int wc, int fr, int fq) const {
        constexpr int NB = GATED ? 1 : 2;
        const int row0 = u.pm * BM + wr * 64 + fr, col0 = u.pn * (GATED ? HALF : BM) + wc * 32 + 8 * fq;
        const int ci = cond_of_pm(u.pm);
#pragma unroll
        for (int bj = 0; bj < NB; ++bj) {
            const int col = col0 + bj * HALF;
            const f32x4 g0 = *(const f32x4*)(gate + (size_t)ci * 6144 + col), g1 = *(const f32x4*)(gate + (size_t)ci * 6144 + col + 4);
            f32x4 n0 = {0.f, 0.f, 0.f, 0.f}, n1 = n0;
            if (gsn) { n0 = *(const f32x4*)(gsn + ci * 1024 + col); n1 = *(const f32x4*)(gsn + ci * 1024 + col + 4); }
#pragma unroll
            for (int ai = 0; ai < 2; ++ai) {
                f32x4 xv[4][2];
#pragma unroll
                for (int m = 0; m < 4; ++m) { const float* xp = X + (size_t)(row0 + ai * HALF + m * 16) * D + col; xv[m][0] = *(const f32x4*)xp; xv[m][1] = *(const f32x4*)(xp + 4); }
#pragma unroll
                for (int m = 0; m < 4; ++m) {
                    float* xp = X + (size_t)(row0 + ai * HALF + m * 16) * D + col;
                    f32x4 v0 = acc[ai][bj][m][0], v1 = acc[ai][bj][m][1];
                    if (GATED) { const f32x4 q0 = acc[ai][1][m][0], q1 = acc[ai][1][m][1];
#pragma unroll
                        for (int j = 0; j < 4; ++j) { v0[j] *= sigmoid_f(q0[j]); v1[j] *= sigmoid_f(q1[j]); } }
                    const f32x4 x0 = xv[m][0] + g0 * v0, x1 = xv[m][1] + g1 * v1;
                    *(f32x4*)xp = x0; *(f32x4*)(xp + 4) = x1;
                    if (gsn) {
                        float a = (x0[0] * x0[0] + x0[1] * x0[1]) + (x0[2] * x0[2] + x0[3] * x0[3]) + (x1[0] * x1[0] + x1[1] * x1[1]) + (x1[2] * x1[2] + x1[3] * x1[3]);
                        const f32x4 y0 = x0 * n0, y1 = x1 * n1;
                        u32x4 w; w.x = cvt_pk_bf16(y0[0], y0[1]); w.y = cvt_pk_bf16(y0[2], y0[3]); w.z = cvt_pk_bf16(y1[0], y1[1]); w.w = cvt_pk_bf16(y1[2], y1[3]);
                        *(u32x4*)(XN + (size_t)(row0 + ai * HALF + m * 16) * D + col) = w;
                        a += __shfl_xor(a, 16); a += __shfl_xor(a, 32);
                        if (fq == 0) rowss_next[(size_t)(row0 + ai * HALF + m * 16) * 32 + (GATED ? u.pn * 4 + wc : (u.pn * 2 + bj) * 4 + wc)] = a;
                    }
                }
            }
        }
    }
};

#define XB_TMO      128
#define XB_XCNT(j)  (256  + 64 * (j))
#define XB_XSUB(j)  (1280 + 64 * (j))
#define XB_XGEN(j)  (2304 + 64 * (j))
#define XB_TOP      3328
#define XB_TOPGEN   3392
#define XCD_BAR_WORDS 3456
#define XB_SPIN_CAP (1u << 18)
__device__ __forceinline__ unsigned xb_ld(unsigned* p)              { return __hip_atomic_load(p, __ATOMIC_RELAXED, __HIP_MEMORY_SCOPE_AGENT); }
__device__ __forceinline__ unsigned xb_add(unsigned* p, unsigned v) { return __hip_atomic_fetch_add(p, v, __ATOMIC_RELAXED, __HIP_MEMORY_SCOPE_AGENT); }
__device__ __forceinline__ unsigned xb_xcc_id() { return (unsigned)__builtin_amdgcn_s_getreg((3 << 11) | 20) & 0xFu; }
#define XB_SPIN(cond, bar) do { unsigned _sp = 0; while (cond) { __builtin_amdgcn_s_sleep(1); \
    if ((++_sp & 255u) == 0u) { if (xb_ld(&(bar)[XB_TMO])) break; if (_sp > XB_SPIN_CAP) { atomicAdd(&(bar)[XB_TMO], 1u); break; } } } } while (0)
struct XcdBarrier { unsigned* bar; unsigned x; volatile LAS unsigned* st; };
__device__ __forceinline__ XcdBarrier xcd_barrier_post(unsigned* bar, volatile LAS unsigned* st) {
    XcdBarrier b; b.bar = bar; b.x = xb_xcc_id(); b.st = st;
    if (threadIdx.x == 0) (void)xb_add(&bar[XB_XCNT(b.x)], 1u);
    return b;
}
__device__ __forceinline__ void xcd_barrier_complete(unsigned* bar, unsigned x, unsigned& nloc, unsigned& nx) {
    const unsigned G = gridDim.x * gridDim.y * gridDim.z;
    unsigned sum, cnt, mine, sp = 0u;
    for (;;) {
        sum = 0u; cnt = 0u; mine = 0u;
#pragma unroll
        for (unsigned j = 0; j < 16; ++j) { const unsigned c = xb_ld(&bar[XB_XCNT(j)]); sum += c; cnt += (c > 0u) ? 1u : 0u; mine = (j == x) ? c : mine; }
        if (sum == G) break;
        __builtin_amdgcn_s_sleep(1);
        if ((++sp & 255u) == 0u) { if (xb_ld(&bar[XB_TMO])) break; if (sp > XB_SPIN_CAP) { atomicAdd(&bar[XB_TMO], 1u); break; } }
    }
    nloc = mine > 0u ? mine : 1u; nx = cnt > 0u ? cnt : 1u;
}
__device__ __forceinline__ void xcd_barrier(const XcdBarrier& b) {
    asm volatile("s_waitcnt vmcnt(0)" ::: "memory");
    __syncthreads();
    if (threadIdx.x == 0) {
        unsigned* bar = b.bar;
        __builtin_amdgcn_s_waitcnt(0);
        unsigned nloc = b.st[0], nx = b.st[1];
        if (nloc == 0u) { xcd_barrier_complete(bar, b.x, nloc, nx); b.st[0] = nloc; b.st[1] = nx; }
        const unsigned old = xb_add(&bar[XB_XSUB(b.x)], 1u);
        const unsigned gen = old / nloc;
        if (old + 1u == (gen + 1u) * nloc) {
            __builtin_amdgcn_fence(__ATOMIC_RELEASE, "agent");
            asm volatile("s_waitcnt vmcnt(0)" ::: "memory");
            const unsigned og = xb_add(&bar[XB_TOP], 1u);
            const unsigned tg = og / nx;
            if (og + 1u == (tg + 1u) * nx) xb_add(&bar[XB_TOPGEN], 1u);
            else XB_SPIN(xb_ld(&bar[XB_TOPGEN]) == tg, bar);
            __builtin_amdgcn_fence(__ATOMIC_ACQUIRE, "agent");
            xb_add(&bar[XB_XGEN(b.x)], 1u);
            asm volatile("s_waitcnt vmcnt(0)" ::: "memory");
        } else {
            XB_SPIN(xb_ld(&bar[XB_XGEN(b.x)]) == gen, bar);
            __builtin_amdgcn_fence(__ATOMIC_ACQUIRE, "agent");
            asm volatile("s_waitcnt vmcnt(0)" ::: "memory");
        }
    }
    __syncthreads();
}

constexpr size_t MiB = 1u << 20;
constexpr size_t WS_CTL = 0, CTL_BYTES = 2 * MiB;
constexpr int CW_BAR = 4096;
constexpr size_t WS_TAB = 2 * MiB;
constexpr size_t TAB_GSA = WS_TAB, TAB_GSB = TAB_GSA + 4 * 5 * 1024 * 4, TAB_SWA = TAB_GSB + 4 * 5 * 1024 * 4, TAB_SWB = TAB_SWA + 4 * 5 * 4096 * 4, TAB_LAMT = TAB_SWB + 4 * 5 * 4096 * 4;
static_assert(TAB_LAMT + 2 * 64 * 2 * 64 * 2 * 4 <= 4 * MiB, "tables");
constexpr size_t WS_W1 = 4 * MiB, WS_W2 = 36 * MiB, WS_SWIN = 68 * MiB, WS_SWOUT = 72 * MiB, WS_GWIN = 80 * MiB, WS_GWOUT = 88 * MiB, WS_GWS = 92 * MiB,
                 WS_CWIN = 93 * MiB, WS_CWOUT = 99 * MiB, WS_BTY = 101 * MiB, WS_BTS = 133 * MiB;
constexpr size_t WS_XN = 149 * MiB;
constexpr size_t WS_R = 173 * MiB;
constexpr size_t WS_R2 = 269 * MiB;
constexpr size_t WS_ROWSS = 317 * MiB;
constexpr size_t WS_VSTAT = 329 * MiB;
constexpr size_t WS_MODS = 332 * MiB;
constexpr size_t WS_END = 333 * MiB;

constexpr int LDS_BYTES = 147456;
constexpr int MISC_OFF = STAGE_BYTES;

struct Args { const float* in[30]; float* out; unsigned char* ws; int ph_lo, ph_hi; };

__device__ __forceinline__ unsigned f2bf(float f) { unsigned u = __builtin_bit_cast(unsigned, f); return (u + 0x7fffu + ((u >> 16) & 1u)) >> 16; }
__device__ __forceinline__ unsigned pk2(float lo, float hi) { return f2bf(lo) | (f2bf(hi) << 16); }
__device__ __forceinline__ float wave_sum(float v) {
#pragma unroll
    for (int o = 1; o < 64; o <<= 1) v += __shfl_xor(v, o);
    return v;
}
template <int MAP> __device__ __forceinline__ int rowmap(int n) {
    if (MAP == 1) { const int half = n >> 10, c = n & 1023; return (c >> 7) * 256 + half * 128 + (c & 127); }
    return n;
}
template <int MAP> __device__ __forceinline__ void transpose_item(const float* W, int K, int N, bf16_t* WT, LAS float* scr, int item, int lane) {
    const int nblk = N / 32, kb = item / nblk, nb = item % nblk, k0 = 64 * kb, n0 = 32 * nb;
    float wv[32];
#pragma unroll
    for (int i = 0; i < 32; ++i) wv[i] = W[(size_t)(k0 + 2 * i + (lane >> 5)) * N + n0 + (lane & 31)];
#pragma unroll
    for (int i = 0; i < 32; ++i) scr[(2 * i + (lane >> 5)) * 33 + (lane & 31)] = wv[i];
    asm volatile("s_waitcnt lgkmcnt(0)" ::: "memory");
    const int c = lane & 7;
#pragma unroll
    for (int j = 0; j < 4; ++j) { const int n = (lane >> 3) + 8 * j; const LAS float* s = scr + (8 * c) * 33 + n;
        u32x4 o; o.x = pk2(s[0 * 33], s[1 * 33]); o.y = pk2(s[2 * 33], s[3 * 33]); o.z = pk2(s[4 * 33], s[5 * 33]); o.w = pk2(s[6 * 33], s[7 * 33]);
        *(u32x4*)(WT + (size_t)rowmap<MAP>(n0 + n) * K + k0 + 8 * c) = o; }
    asm volatile("s_waitcnt lgkmcnt(0)" ::: "memory");
}

__device__ __forceinline__ void ssm_build(const Args& a, int j, int g, LAS unsigned char* lds, unsigned char* ws) {
    const int tid = threadIdx.x;
    LAS float* PR = (LAS float*)lds;
    LAS float* PI = PR + 2 * 17 * 64;
    LAS float* BR = PI + 2 * 17 * 64;
    LAS float* BI = BR + 2 * 64 * 16;
    LAS float* CR = BI + 2 * 64 * 16;
    LAS float* CI = CR + 2 * 16 * 64;
    LAS float* WR = CI + 2 * 16 * 64;
    LAS float* WI = WR + 2 * 64 * 16;
    LAS float* KT = WI + 2 * 64 * 16;
    const float* lam_re = a.in[13]; const float* lam_im = a.in[14]; const float* log_dt = a.in[15];
    const float* b_re = a.in[16]; const float* b_im = a.in[17]; const float* c_re = a.in[18]; const float* c_im = a.in[19]; const float* dsk = a.in[20];
    __syncthreads();
    if (tid < 128) {
        const int k = tid >> 6, n = tid & 63, pidx = (j * 2 + k) * 64 + g;
        const float dt = expf(log_dt[pidx]);
        const float lr = lam_re[pidx * 64 + n], li = lam_im[pidx * 64 + n];
        for (int e = 0; e <= 16; ++e) { const float mag = expf((float)e * lr * dt); float sn, cs; sincosf((float)e * (li * dt), &sn, &cs); PR[(k * 17 + e) * 64 + n] = mag * cs; PI[(k * 17 + e) * 64 + n] = mag * sn; }
        const float mag = expf(lr * dt); const float abr = mag * cosf(li * dt), abi = mag * sinf(li * dt);
        const float den = lr * lr + li * li;
        const float nr = (abr - 1.0f) * lr + abi * li, ni = -(abr - 1.0f) * li + abi * lr;
        const float fr = nr / den, fi = ni / den;
        for (int p = 0; p < 16; ++p) { const float br = b_re[((size_t)pidx * 64 + n) * 16 + p], bi = b_im[((size_t)pidx * 64 + n) * 16 + p];
            BR[(k * 64 + n) * 16 + p] = fr * br - fi * bi; BI[(k * 64 + n) * 16 + p] = fr * bi + fi * br; }
        float* lamT = (float*)(ws + TAB_LAMT) + (((size_t)j * 64 + g) * 2 + k) * 128;
        lamT[2 * n] = PR[(k * 17 + 16) * 64 + n]; lamT[2 * n + 1] = PI[(k * 17 + 16) * 64 + n];
    }
    for (int i = tid; i < 2048; i += 512) { const int k = i >> 10, r = i & 1023; const size_t o = ((size_t)(j * 2 + k) * 64 + g) * 1024 + r; CR[i] = c_re[o]; CI[i] = c_im[o]; }
    __syncthreads();
    {
        const int k = tid >> 8, po = (tid >> 4) & 15, pi = tid & 15;
        for (int e = 0; e < 16; ++e) {
            for (int i = tid; i < 2048; i += 512) { const int kk = i >> 10, n = (i >> 4) & 63; const float pr = PR[(kk * 17 + e) * 64 + n], pim = PI[(kk * 17 + e) * 64 + n];
                WR[i] = pr * BR[i] - pim * BI[i]; WI[i] = pr * BI[i] + pim * BR[i]; }
            __syncthreads();
            float s = 0.f;
#pragma unroll 8
            for (int n = 0; n < 64; ++n) s += CR[(k * 16 + po) * 64 + n] * WR[(k * 64 + n) * 16 + pi] - CI[(k * 16 + po) * 64 + n] * WI[(k * 64 + n) * 16 + pi];
            KT[((k * 16 + e) * 16 + po) * 16 + pi] = s;
            __syncthreads();
        }
    }
    bf16_t* BtY = (bf16_t*)(ws + WS_BTY) + ((size_t)j * 64 + g) * 256 * 512;
    bf16_t* BtS = (bf16_t*)(ws + WS_BTS) + ((size_t)j * 64 + g) * 256 * 256;
    for (int pc = tid; pc < 256 * 32; pc += 512) {
        const int row = pc >> 5, kc = (pc & 31) * 8, t = row >> 4, po = row & 15, s = kc >> 4, pi0 = kc & 15;
        float v[8];
#pragma unroll
        for (int q = 0; q < 8; ++q) { const int pi = pi0 + q; float x = 0.f;
            if (s <= t) x += KT[((0 * 16 + (t - s)) * 16 + po) * 16 + pi];
            if (s >= t) x += KT[((1 * 16 + (s - t)) * 16 + po) * 16 + pi];
            if (s == t && pi == po) x += dsk[j * 1024 + g * 16 + po];
            v[q] = x; }
        u32x4 o; o.x = pk2(v[0], v[1]); o.y = pk2(v[2], v[3]); o.z = pk2(v[4], v[5]); o.w = pk2(v[6], v[7]);
        *(u32x4*)(BtY + (size_t)row * 512 + kc) = o;
    }
    for (int pc = tid; pc < 256 * 32; pc += 512) {
        const int row = pc >> 5, kc = (pc & 31) * 8, t = row >> 4, po = row & 15, k = kc >> 7, ri = (kc >> 6) & 1, n0 = kc & 63;
        const int e = k == 0 ? t + 1 : 16 - t;
        float v[8];
#pragma unroll
        for (int q = 0; q < 8; ++q) { const int n = n0 + q; const float cr = CR[(k * 16 + po) * 64 + n], cim = CI[(k * 16 + po) * 64 + n], pr = PR[(k * 17 + e) * 64 + n], pim = PI[(k * 17 + e) * 64 + n];
            v[q] = ri == 0 ? (cr * pr - cim * pim) : -(cr * pim + cim * pr); }
        u32x4 o; o.x = pk2(v[0], v[1]); o.y = pk2(v[2], v[3]); o.z = pk2(v[4], v[5]); o.w = pk2(v[6], v[7]);
        *(u32x4*)(BtY + (size_t)row * 512 + 256 + kc) = o;
    }
    for (int pc = tid; pc < 256 * 32; pc += 512) {
        const int row = pc >> 5, kc = (pc & 31) * 8, k = row >> 7, ri = (row >> 6) & 1, n = row & 63, s = kc >> 4, pi0 = kc & 15;
        const int e = k == 0 ? 15 - s : s;
        const float pr = PR[(k * 17 + e) * 64 + n], pim = PI[(k * 17 + e) * 64 + n];
        float v[8];
#pragma unroll
        for (int q = 0; q < 8; ++q) { const float br = BR[(k * 64 + n) * 16 + pi0 + q], bi = BI[(k * 64 + n) * 16 + pi0 + q]; v[q] = ri == 0 ? (pr * br - pim * bi) : (pr * bi + pim * br); }
        u32x4 o; o.x = pk2(v[0], v[1]); o.y = pk2(v[2], v[3]); o.z = pk2(v[4], v[5]); o.w = pk2(v[6], v[7]);
        *(u32x4*)(BtS + (size_t)row * 256 + kc) = o;
    }
    __syncthreads();
}

__device__ __forceinline__ void mods_task(const Args& a, float* mods, LAS unsigned char* lds, int task, int tid) {
    const int cg = task % 48, l = task / 48, wave = tid >> 6, lane = tid & 63, half = lane >> 5, c4 = lane & 31;
    const float* c = a.in[4]; const float* c_ctx = a.in[5]; const float* w_mod = a.in[6]; const float* b_mod = a.in[7];
    LAS float* sil = (LAS float*)lds;
    LAS float* red = sil + 5 * 1024;
    __syncthreads();
    for (int i = tid; i < 5 * 1024; i += 512) { const int ci = i >> 10, k = i & 1023; const float v = ci == 0 ? c_ctx[k] : c[(ci - 1) * 1024 + k]; sil[i] = v / (1.0f + expf(-v)); }
    __syncthreads();
    const float* w = w_mod + ((size_t)l * 1024 + wave * 128 + half) * 6144 + cg * 128 + c4 * 4;
    f32x4 acc[5];
#pragma unroll
    for (int ci = 0; ci < 5; ++ci) acc[ci] = (f32x4){0.f, 0.f, 0.f, 0.f};
#pragma unroll 1
    for (int b = 0; b < 2; ++b) {
        f32x4 wv[32];
#pragma unroll
        for (int i = 0; i < 32; ++i) wv[i] = *(const f32x4*)(w + (size_t)(b * 64 + 2 * i) * 6144);
#pragma unroll
        for (int i = 0; i < 32; ++i) { const int k = wave * 128 + b * 64 + 2 * i + half;
#pragma unroll
            for (int ci = 0; ci < 5; ++ci) acc[ci] += wv[i] * sil[ci * 1024 + k]; }
    }
#pragma unroll
    for (int ci = 0; ci < 5; ++ci) {
#pragma unroll
        for (int q = 0; q < 4; ++q) acc[ci][q] += __shfl_xor(acc[ci][q], 32);
        if (half == 0) *(LAS f32x4*)(red + (wave * 5 + ci) * 128 + c4 * 4) = acc[ci]; }
    __syncthreads();
    for (int i = tid; i < 5 * 128; i += 512) { const int ci = i >> 7, cc = i & 127; float t = 0.f;
#pragma unroll
        for (int wv2 = 0; wv2 < 8; ++wv2) t += red[(wv2 * 5 + ci) * 128 + cc];
        mods[((size_t)l * 5 + ci) * 6144 + cg * 128 + cc] = t + b_mod[l * 6144 + cg * 128 + cc]; }
}

__device__ __forceinline__ void xinit_row(const Args& a, float* X, int row, int lane) {
    f32x4* o = (f32x4*)(X + (size_t)row * D) + lane;
    if (row < MP) { const f32x4* s = (const f32x4*)(a.in[0] + (size_t)row * D) + lane;
#pragma unroll
        for (int q = 0; q < 4; ++q) o[64 * q] = s[64 * q];
        return; }
    const f32x4* s = (const f32x4*)(a.in[1] + (size_t)(row - MP) * D) + lane;
    const int t = (row - MP) & 1023; const float rr = (float)(t >> 6), cc = (float)(t & 63);
    float freq[4];
#pragma unroll
    for (int e = 0; e < 4; ++e) freq[e] = expf(-(float)(4 * lane + e) * (9.210340371976184f / 256.0f));
    f32x4 v[4];
#pragma unroll
    for (int q = 0; q < 4; ++q) v[q] = s[64 * q];
#pragma unroll
    for (int e = 0; e < 4; ++e) { float sr, cr, sc, cc2; sincosf(rr * freq[e], &sr, &cr); sincosf(cc * freq[e], &sc, &cc2); v[0][e] += sr; v[1][e] += cr; v[2][e] += sc; v[3][e] += cc2; }
#pragma unroll
    for (int q = 0; q < 4; ++q) o[64 * q] = v[q];
}

constexpr int NPH = 28;
#ifndef MK_ALLCG
#define MK_ALLCG 0
#endif
__global__ void __launch_bounds__(512, 2) fwd(Args args) {
    extern __shared__ __attribute__((aligned(16))) unsigned char lds_raw[];
    LAS unsigned char* lds = (LAS unsigned char*)lds_raw;
    volatile LAS unsigned* MISC = (volatile LAS unsigned*)(lds + MISC_OFF);
    const int tid = threadIdx.x, lane = tid & 63, wave = __builtin_amdgcn_readfirstlane(tid >> 6);
    const int G = gridDim.x, bx = blockIdx.x, vcu = (G % 8 == 0) ? (bx % 8) * (G / 8) + bx / 8 : bx;
    unsigned* ctl = (unsigned*)(args.ws + WS_CTL);
    for (int u = tid; u < 64; u += 512) MISC[u] = 0u;
    __syncthreads();
    XcdBarrier bar = xcd_barrier_post(ctl + CW_BAR, MISC + 8);
    const int lo = args.ph_lo, hi = args.ph_hi;
    int ph = 0;
#define IN_PH (lo <= ph && ph < hi)
#define SEAM() do { if (IN_PH && ph + 1 < hi) { if (ph == 0 || MK_ALLCG) cg::this_grid().sync(); else xcd_barrier(bar); } ++ph; } while (0)

    const int gw = vcu * 8 + wave, NGW = G * 8;
#define PH_PTRS() unsigned char* ws = args.ws; asm volatile("" : "+s"(ws)); \
    int tid_o_ = threadIdx.x; asm volatile("" : "+v"(tid_o_)); const int tid = tid_o_, lane = tid_o_ & 63; (void)tid; (void)lane; \
    float* X = args.out; bf16_t* XN = (bf16_t*)(ws + WS_XN); float* mods = (float*)(ws + WS_MODS); \
    float* gsA = (float*)(ws + TAB_GSA); float* gsB = (float*)(ws + TAB_GSB); float* swA = (float*)(ws + TAB_SWA); float* swB = (float*)(ws + TAB_SWB); \
    float* rowss = (float*)(ws + WS_ROWSS); float* vstat = (float*)(ws + WS_VSTAT); \
    bf16_t* Hb = (bf16_t*)(ws + WS_R); bf16_t* UgS = (bf16_t*)(ws + WS_R); float* Sloc = (float*)(ws + WS_R + 48 * MiB); bf16_t* Zg = (bf16_t*)(ws + WS_R + 48 * MiB); bf16_t* A2 = (bf16_t*)(ws + WS_R2); \
    (void)X; (void)XN; (void)mods; (void)gsA; (void)gsB; (void)swA; (void)swB; (void)rowss; (void)vstat; (void)Hb; (void)UgS; (void)Sloc; (void)Zg; (void)A2;
#define PH_LAYER() const float* rs_mix = rowss + (size_t)(2 * layer) * M * 32; float* rs_ffn = rowss + (size_t)(2 * layer + 1) * M * 32; float* rs_next = rowss + (size_t)((2 * layer + 2) & 7) * M * 32; \
    const float* modl = mods + (size_t)layer * 5 * 6144; (void)rs_mix; (void)rs_ffn; (void)rs_next; (void)modl;

    if (IN_PH) { PH_PTRS();
        const bool ssm_blk = bx < 128 && G == 256;
        if (G == 256) { if (bx < 128) ssm_build(args, bx >> 6, bx & 63, lds, ws); else for (int t = bx - 128; t < 192; t += 128) mods_task(args, mods, lds, t, tid); }
        else { for (int t = bx; t < 128; t += G) ssm_build(args, t >> 6, t & 63, lds, ws); for (int t = bx; t < 192; t += G) mods_task(args, mods, lds, t, tid); }
        __syncthreads();
        LAS float* scr = (LAS float*)(lds + wave * 16384);
        constexpr int I_W1 = 2048, I_W2 = 2048, I_SI = 512, I_SO = 1024, I_GI = 2048, I_GO = 1024, I_CI = 1536, I_CO = 512;
        constexpr int NT = 4 * I_W1 + 4 * I_W2 + 2 * I_SI + 2 * I_SO + I_GI + I_GO + I_CI + I_CO;
        const int nvw = G == 256 ? 3072 : NGW;
        const int vid0 = G == 256 ? (ssm_blk ? bx * 8 + wave : 1024 + ((bx - 128) * 8 + wave) * 2) : bx * 8 + wave;
        for (int rep = 0; rep < ((G == 256 && !ssm_blk) ? 2 : 1); ++rep)
        for (int it = vid0 + rep; it < NT; it += nvw) {
            int r = it;
            if (r < 4 * I_W1) { const int l = r / I_W1; transpose_item<0>(args.in[10] + (size_t)l * D * FF, D, FF, (bf16_t*)(ws + WS_W1) + (size_t)l * D * FF, scr, r % I_W1, lane); continue; } r -= 4 * I_W1;
            if (r < 4 * I_W2) { const int l = r / I_W2; transpose_item<0>(args.in[11] + (size_t)l * D * FF, FF, D, (bf16_t*)(ws + WS_W2) + (size_t)l * D * FF, scr, r % I_W2, lane); continue; } r -= 4 * I_W2;
            if (r < 2 * I_SI) { const int l = r / I_SI; transpose_item<0>(args.in[12] + (size_t)l * D * D, D, D, (bf16_t*)(ws + WS_SWIN) + (size_t)l * D * D, scr, r % I_SI, lane); continue; } r -= 2 * I_SI;
            if (r < 2 * I_SO) { const int l = r / I_SO; transpose_item<1>(args.in[21] + (size_t)l * D * 2048, D, 2048, (bf16_t*)(ws + WS_SWOUT) + (size_t)l * D * 2048, scr, r % I_SO, lane); continue; } r -= 2 * I_SO;
            if (r < I_GI) { transpose_item<0>(args.in[22], D, 4096, (bf16_t*)(ws + WS_GWIN), scr, r, lane); continue; } r -= I_GI;
            if (r < I_GO) { transpose_item<0>(args.in[25], 2048, D, (bf16_t*)(ws + WS_GWOUT), scr, r, lane); continue; } r -= I_GO;
            if (r < I_CI) { transpose_item<0>(args.in[26], D, 3072, (bf16_t*)(ws + WS_CWIN), scr, r, lane); continue; } r -= I_CI;
            transpose_item<0>(args.in[28], D, D, (bf16_t*)(ws + WS_CWOUT), scr, r, lane);
        }
        {
            const float* s = args.in[23]; bf16_t* d = (bf16_t*)(ws + WS_GWS);
            for (int i = (gw * 64 + lane) * 8; i < 16 * 128 * 128; i += NGW * 64 * 8) { const f32x4 a0 = *(const f32x4*)(s + i), a1 = *(const f32x4*)(s + i + 4);
                u32x4 o; o.x = pk2(a0[0], a0[1]); o.y = pk2(a0[2], a0[3]); o.z = pk2(a1[0], a1[1]); o.w = pk2(a1[2], a1[3]); *(u32x4*)(d + i) = o; }
        }
        for (int row = gw; row < M; row += NGW) xinit_row(args, X, row, lane);
    }
    SEAM();
    if (IN_PH) { PH_PTRS();
        for (int i = gw * 64 + lane; i < 4 * 5 * 1024; i += NGW * 64) { const int l = i / 5120, ci = (i / 1024) % 5, c = i & 1023;
            const float* md = mods + ((size_t)l * 5 + ci) * 6144;
            gsA[i] = args.in[8][l * 1024 + c] * (1.0f + md[1024 + c]); gsB[i] = args.in[9][l * 1024 + c] * (1.0f + md[4 * 1024 + c]); }
        constexpr int N_MIX0 = 1024, N_MIX1 = 4096, N_MIX2 = 3072, N_MIX3 = 1024;
        constexpr int NTOT = N_MIX0 + N_MIX1 + N_MIX2 + N_MIX3 + 4 * 4096;
        for (int it0 = gw * 8; it0 < NTOT; it0 += NGW * 8) {
            int r = it0, l, sidx; const bf16_t* WT; float* dst; int dld;
            if (r < N_MIX0) { l = 0; sidx = 0; WT = (const bf16_t*)(ws + WS_SWIN); dst = swA + 0 * 5 * 4096; dld = 1024; }
            else if ((r -= N_MIX0) < N_MIX1) { l = 1; sidx = 0; WT = (const bf16_t*)(ws + WS_GWIN); dst = swA + 1 * 5 * 4096; dld = 4096; }
            else if ((r -= N_MIX1) < N_MIX2) { l = 2; sidx = 0; WT = (const bf16_t*)(ws + WS_CWIN); dst = swA + 2 * 5 * 4096; dld = 3072; }
            else if ((r -= N_MIX2) < N_MIX3) { l = 3; sidx = 0; WT = (const bf16_t*)(ws + WS_SWIN) + (size_t)D * D; dst = swA + 3 * 5 * 4096; dld = 1024; }
            else { r -= N_MIX3; l = r / 4096; r = r % 4096; sidx = 3; WT = (const bf16_t*)(ws + WS_W1) + (size_t)l * D * FF; dst = swB + l * 5 * 4096; dld = 4096; }
            float sh[5][16];
#pragma unroll
            for (int ci = 0; ci < 5; ++ci) { const float* sp = mods + ((size_t)l * 5 + ci) * 6144 + sidx * 1024 + lane * 16;
#pragma unroll
                for (int q = 0; q < 4; ++q) { const f32x4 v = *(const f32x4*)(sp + 4 * q); sh[ci][4 * q] = v[0]; sh[ci][4 * q + 1] = v[1]; sh[ci][4 * q + 2] = v[2]; sh[ci][4 * q + 3] = v[3]; } }
            for (int nn = 0; nn < 8; ++nn) {
                const int n = r + nn;
                const u32x4 w0 = *(const u32x4*)(WT + (size_t)n * D + lane * 16), w1 = *(const u32x4*)(WT + (size_t)n * D + lane * 16 + 8);
                float wf[16] = {bf_lo(w0.x), bf_hi(w0.x), bf_lo(w0.y), bf_hi(w0.y), bf_lo(w0.z), bf_hi(w0.z), bf_lo(w0.w), bf_hi(w0.w),
                                bf_lo(w1.x), bf_hi(w1.x), bf_lo(w1.y), bf_hi(w1.y), bf_lo(w1.z), bf_hi(w1.z), bf_lo(w1.w), bf_hi(w1.w)};
#pragma unroll
                for (int ci = 0; ci < 5; ++ci) { float s = 0.f;
#pragma unroll
                    for (int q = 0; q < 16; ++q) s += wf[q] * sh[ci][q];
                    s = wave_sum(s);
                    if (lane == 0) dst[ci * dld + n] = s; }
            }
        }
        for (int row = gw; row < M; row += NGW) {
            const f32x4* xr = (const f32x4*)(X + (size_t)row * D) + lane; const int ci = cond_of_row(row);
            const float* md = mods + ((size_t)0 * 5 + ci) * 6144; const float* gm = args.in[8];
            f32x4 v[4]; float s = 0.f;
#pragma unroll
            for (int q = 0; q < 4; ++q) { v[q] = xr[64 * q]; s += (v[q][0] * v[q][0] + v[q][1] * v[q][1]) + (v[q][2] * v[q][2] + v[q][3] * v[q][3]); }
            s = wave_sum(s);
            if (lane < 32) rowss[(size_t)row * 32 + lane] = lane == 0 ? s : 0.f;
            u32x2* o = (u32x2*)(XN + (size_t)row * D) + lane;
#pragma unroll
            for (int q = 0; q < 4; ++q) { const int c = 256 * q + 4 * lane; const f32x4 gg = *(const f32x4*)(gm + c), sc = *(const f32x4*)(md + 1024 + c);
                const f32x4 y = v[q] * gg * (sc + 1.0f); u32x2 w; w.x = cvt_pk_bf16(y[0], y[1]); w.y = cvt_pk_bf16(y[2], y[3]); o[64 * q] = w; }
        }
    }
    SEAM();
#pragma unroll 1
    for (int layer = 0; layer < 4; ++layer) {
        const int kind = layer % 3, j = layer / 3;
        if (kind == 0) {
            if (IN_PH) { PH_PTRS(); PH_LAYER(); const Gemm g = gemm_rowmajor(XN, D, (const bf16_t*)(ws + WS_SWIN) + (size_t)j * D * D, D, D); StaticOrder S; S.init(M, D, G, bx);
                EpiU E{UgS, rs_mix, swA + layer * 5 * 4096}; gemm_phase<EpiU, ARowMajor, StaticOrder>(lds, g, S, E); }
            SEAM();
            if (IN_PH) { PH_PTRS(); PH_LAYER(); const Gemm g = gemm_rowmajor(UgS, 512, (const bf16_t*)(ws + WS_BTS) + (size_t)j * 64 * 256 * 256, 256, 256); SsmOrder S{G, bx};
                EpiF32 E{Sloc, 256}; gemm_phase<EpiF32, ARowMajor, SsmOrder>(lds, g, S, E); }
            SEAM();
            if (IN_PH) { PH_PTRS(); PH_LAYER();
                const float* lamT = (const float*)(ws + TAB_LAMT);
                float* new_re = args.out + (size_t)M * D; float* new_im = new_re + 32 * 2 * 2 * 64 * 64;
                for (int task = gw; task < 64 * 36 * 2; task += NGW) {
                    const int k = task & 1, seq = (task >> 1) % 36, g = task / 72;
                    const int c0 = seq < 32 ? seq * 16 : 512 + (seq - 32) * 64, nc = seq < 32 ? 16 : 64;
                    const float lr = lamT[(((size_t)j * 64 + g) * 2 + k) * 128 + 2 * lane], li = lamT[(((size_t)j * 64 + g) * 2 + k) * 128 + 2 * lane + 1];
                    float sr = 0.f, si = 0.f;
                    if (seq >= 32) { const size_t o = ((((size_t)(seq - 32) * 2 + j) * 2 + k) * 64 + g) * 64 + lane; sr = args.in[2][o]; si = args.in[3][o]; }
                    const float* sl = Sloc + ((size_t)g * NCH) * 256 + k * 128 + lane;
                    bf16_t* so = UgS + ((size_t)g * NCH) * 512 + 256 + k * 128 + lane;
                    for (int i = 0; i < nc; ++i) {
                        const int c = k == 0 ? c0 + i : c0 + nc - 1 - i;
                        so[(size_t)c * 512] = (bf16_t)f2bf(sr); so[(size_t)c * 512 + 64] = (bf16_t)f2bf(si);
                        const float ar = sl[(size_t)c * 256], ai = sl[(size_t)c * 256 + 64];
                        const float nr = lr * sr - li * si + ar, ni = lr * si + li * sr + ai; sr = nr; si = ni;
                    }
                    if (seq < 32) { const size_t o = ((((size_t)seq * 2 + j) * 2 + k) * 64 + g) * 64 + lane; new_re[o] = sr; new_im[o] = si; }
                }
            }
            SEAM();
            if (IN_PH) { PH_PTRS(); PH_LAYER(); const Gemm g = gemm_rowmajor(UgS, 512, (const bf16_t*)(ws + WS_BTY) + (size_t)j * 64 * 256 * 512, 512, 512); SsmOrder S{G, bx};
                EpiY E{Zg}; gemm_phase<EpiY, ARowMajor, SsmOrder>(lds, g, S, E); }
            SEAM();
            if (IN_PH) { PH_PTRS(); PH_LAYER(); const Gemm g = gemm_groupchunk(Zg, (const bf16_t*)(ws + WS_SWOUT) + (size_t)j * D * 2048, D, D); StaticOrder S; S.init(M, 2048, G, bx);
                EpiRes<true> E{X, XN, modl + 2 * 1024, gsB + layer * 5 * 1024, rs_ffn}; gemm_phase<EpiRes<true>, AGroupChunk, StaticOrder>(lds, g, S, E); }
            SEAM();
        } else if (kind == 1) {
            if (IN_PH) { PH_PTRS(); PH_LAYER(); const Gemm g = gemm_rowmajor(XN, D, (const bf16_t*)(ws + WS_GWIN), D, D); StaticOrder S; S.init(M, 4096, G, bx);
                EpiIn<2> E{Hb, 4096, rs_mix, 16, swA + layer * 5 * 4096, 4096, vstat}; gemm_phase<EpiIn<2>, ARowMajor, StaticOrder>(lds, g, S, E); }
            SEAM();
            if (IN_PH) { PH_PTRS(); PH_LAYER();
                const bf16_t* Wsb = (const bf16_t*)(ws + WS_GWS); const float* b_s = args.in[24];
                constexpr int VST = 288;
                for (int unit = vcu; unit < 96 * 16; unit += G) {
                    const int c = unit >> 4, g = unit & 15, row0 = c * 128;
                    __syncthreads();
                    LAS f32x2* mr = (LAS f32x2*)(lds + 128 * VST);
                    if (tid < 128) { const f32x4* p = (const f32x4*)(vstat + (size_t)(row0 + tid) * 64); float s1 = 0.f, s2 = 0.f;
#pragma unroll
                        for (int q = 0; q < 16; ++q) { const f32x4 v = p[q]; s1 += v[0] + v[2]; s2 += v[1] + v[3]; }
                        const float mu = s1 * (1.0f / 2048.0f), var = s2 * (1.0f / 2048.0f) - mu * mu; mr[tid] = (f32x2){mu, 1.0f / sqrtf(fmaxf(var, 0.f) + EPS)}; }
                    __syncthreads();
#pragma unroll
                    for (int i = 0; i < 4; ++i) { const int pc = tid + 512 * i, q = pc >> 4, d8 = pc & 15;
                        const u32x4 w = *(const u32x4*)(Hb + (size_t)(row0 + q) * 4096 + 2048 + g * 128 + d8 * 8);
                        const f32x2 st = mr[q]; const float mu = st[0], rstd = st[1];
                        u32x4 o; o.x = cvt_pk_bf16((bf_lo(w.x) - mu) * rstd, (bf_hi(w.x) - mu) * rstd); o.y = cvt_pk_bf16((bf_lo(w.y) - mu) * rstd, (bf_hi(w.y) - mu) * rstd);
                        o.z = cvt_pk_bf16((bf_lo(w.z) - mu) * rstd, (bf_hi(w.z) - mu) * rstd); o.w = cvt_pk_bf16((bf_lo(w.w) - mu) * rstd, (bf_hi(w.w) - mu) * rstd);
                        *(LAS u32x4*)(lds + q * VST + d8 * 16) = o; }
                    __syncthreads();
                    f32x4 acc[8];
#pragma unroll
                    for (int nt = 0; nt < 8; ++nt) acc[nt] = (f32x4){0.f, 0.f, 0.f, 0.f};
                    const int fr = lane & 15, fq = lane >> 4;
#pragma unroll
                    for (int kk = 0; kk < 4; ++kk) {
                        const bf16x8 wf = *(const bf16x8*)(Wsb + ((size_t)g * 128 + wave * 16 + fr) * 128 + kk * 32 + fq * 8);
#pragma unroll
                        for (int nt = 0; nt < 8; ++nt) {
                            const LAS unsigned char* p0 = lds + (kk * 32 + fq * 8 + (fr >> 2)) * VST + (nt * 16 + 4 * (fr & 3)) * 2;
                            const s16x4 lo4 = __builtin_bit_cast(s16x4, __builtin_amdgcn_ds_read_tr16_b64_v4i16((LAS s16x4*)p0));
                            const s16x4 hi4 = __builtin_bit_cast(s16x4, __builtin_amdgcn_ds_read_tr16_b64_v4i16((LAS s16x4*)(p0 + 4 * VST)));
                            const bf16x8 vf = {lo4[0], lo4[1], lo4[2], lo4[3], hi4[0], hi4[1], hi4[2], hi4[3]};
                            acc[nt] = __builtin_amdgcn_mfma_f32_16x16x32_bf16(vf, wf, acc[nt], 0, 0, 0);
                        }
                    }
                    const int p = wave * 16 + fr, row = row0 + p; const float bs = b_s[g * 128 + p];
#pragma unroll
                    for (int nt = 0; nt < 8; ++nt) { const int ch = g * 128 + nt * 16 + 4 * fq;
                        const u32x2 uu = *(const u32x2*)(Hb + (size_t)row * 4096 + ch);
                        u32x2 o; o.x = cvt_pk_bf16(bf_lo(uu.x) * (acc[nt][0] + bs), bf_hi(uu.x) * (acc[nt][1] + bs)); o.y = cvt_pk_bf16(bf_lo(uu.y) * (acc[nt][2] + bs), bf_hi(uu.y) * (acc[nt][3] + bs));
                        *(u32x2*)(A2 + (size_t)row * 2048 + ch) = o; }
                }
                __syncthreads();
            }
            SEAM();
            if (IN_PH) { PH_PTRS(); PH_LAYER(); const Gemm g = gemm_rowmajor(A2, 2048, (const bf16_t*)(ws + WS_GWOUT), 2048, 2048); StaticOrder S; S.init(M, D, G, bx);
                EpiRes<false> E{X, XN, modl + 2 * 1024, gsB + layer * 5 * 1024, rs_ffn}; gemm_phase<EpiRes<false>, ARowMajor, StaticOrder>(lds, g, S, E); }
            SEAM();
        } else {
            if (IN_PH) { PH_PTRS(); PH_LAYER(); const Gemm g = gemm_rowmajor(XN, D, (const bf16_t*)(ws + WS_CWIN), D, D); StaticOrder S; S.init(M, 3072, G, bx);
                EpiIn<0> E{Hb, 3072, rs_mix, 16, swA + layer * 5 * 4096, 3072, nullptr}; gemm_phase<EpiIn<0>, ARowMajor, StaticOrder>(lds, g, S, E); }
            SEAM();
            if (IN_PH) { PH_PTRS(); PH_LAYER();
                const float* cw = args.in[27];
                for (int it = gw * 64 + lane; it < M * 128; it += NGW * 64) {
                    const int row = it >> 7, c8 = (it & 127) * 8;
                    const int L = row < MP ? 256 : 1024, t = row < MP ? (row & 255) : ((row - MP) & 1023);
                    const bf16_t* pr = Hb + (size_t)row * 3072 + c8;
                    float y[8];
#pragma unroll
                    for (int q = 0; q < 8; ++q) y[q] = 0.f;
#pragma unroll
                    for (int w = 0; w < 3; ++w) { const int tt = t + w - 1; if (tt < 0 || tt >= L) continue;
                        const u32x4 gc = *(const u32x4*)(pr + (ptrdiff_t)(w - 1) * 3072 + 1024), xh = *(const u32x4*)(pr + (ptrdiff_t)(w - 1) * 3072 + 2048);
                        const f32x4 k0 = *(const f32x4*)(cw + w * 1024 + c8), k1 = *(const f32x4*)(cw + w * 1024 + c8 + 4);
                        y[0] += k0[0] * bf_lo(gc.x) * bf_lo(xh.x); y[1] += k0[1] * bf_hi(gc.x) * bf_hi(xh.x); y[2] += k0[2] * bf_lo(gc.y) * bf_lo(xh.y); y[3] += k0[3] * bf_hi(gc.y) * bf_hi(xh.y);
                        y[4] += k1[0] * bf_lo(gc.z) * bf_lo(xh.z); y[5] += k1[1] * bf_hi(gc.z) * bf_hi(xh.z); y[6] += k1[2] * bf_lo(gc.w) * bf_lo(xh.w); y[7] += k1[3] * bf_hi(gc.w) * bf_hi(xh.w); }
                    const u32x4 gb = *(const u32x4*)pr;
                    u32x4 o; o.x = cvt_pk_bf16(bf_lo(gb.x) * y[0], bf_hi(gb.x) * y[1]); o.y = cvt_pk_bf16(bf_lo(gb.y) * y[2], bf_hi(gb.y) * y[3]);
                    o.z = cvt_pk_bf16(bf_lo(gb.z) * y[4], bf_hi(gb.z) * y[5]); o.w = cvt_pk_bf16(bf_lo(gb.w) * y[6], bf_hi(gb.w) * y[7]);
                    *(u32x4*)(A2 + (size_t)row * D + c8) = o;
                }
            }
            SEAM();
            if (IN_PH) { PH_PTRS(); PH_LAYER(); const Gemm g = gemm_rowmajor(A2, D, (const bf16_t*)(ws + WS_CWOUT), D, D); StaticOrder S; S.init(M, D, G, bx);
                EpiRes<false> E{X, XN, modl + 2 * 1024, gsB + layer * 5 * 1024, rs_ffn}; gemm_phase<EpiRes<false>, ARowMajor, StaticOrder>(lds, g, S, E); }
            SEAM();
        }
        if (IN_PH) { PH_PTRS(); PH_LAYER(); const Gemm g = gemm_rowmajor(XN, D, (const bf16_t*)(ws + WS_W1) + (size_t)layer * D * FF, D, D); StaticOrder S; S.init(M, FF, G, bx);
            EpiIn<1> E{Hb, FF, rs_ffn, kind == 0 ? 32 : 16, swB + layer * 5 * 4096, 4096, nullptr}; gemm_phase<EpiIn<1>, ARowMajor, StaticOrder>(lds, g, S, E); }
        SEAM();
        if (IN_PH) { PH_PTRS(); PH_LAYER(); const Gemm g = gemm_rowmajor(Hb, FF, (const bf16_t*)(ws + WS_W2) + (size_t)layer * D * FF, FF, FF); StaticOrder S; S.init(M, D, G, bx);
            EpiRes<false> E{X, XN, modl + 5 * 1024, layer < 3 ? gsA + (layer + 1) * 5 * 1024 : nullptr, rs_next}; gemm_phase<EpiRes<false>, ARowMajor, StaticOrder>(lds, g, S, E); }
        SEAM();
    }
    if (IN_PH) { PH_PTRS();
        const float* gf = args.in[29];
        for (int row = gw; row < M; row += 2 * NGW) {
            f32x4* xr0 = (f32x4*)(X + (size_t)row * D) + lane; f32x4* xr1 = (f32x4*)(X + (size_t)(row + NGW) * D) + lane;
            f32x4 v0[4], v1[4]; float s0 = 0.f, s1 = 0.f;
#pragma unroll
            for (int q = 0; q < 4; ++q) { v0[q] = xr0[64 * q]; v1[q] = xr1[64 * q]; }
#pragma unroll
            for (int q = 0; q < 4; ++q) { s0 += (v0[q][0] * v0[q][0] + v0[q][1] * v0[q][1]) + (v0[q][2] * v0[q][2] + v0[q][3] * v0[q][3]); s1 += (v1[q][0] * v1[q][0] + v1[q][1] * v1[q][1]) + (v1[q][2] * v1[q][2] + v1[q][3] * v1[q][3]); }
            s0 = wave_sum(s0); s1 = wave_sum(s1); const float r0 = 1.0f / sqrtf(s0 * (1.0f / D) + EPS), r1 = 1.0f / sqrtf(s1 * (1.0f / D) + EPS);
#pragma unroll
            for (int q = 0; q < 4; ++q) { const f32x4 gq = *(const f32x4*)(gf + 256 * q + 4 * lane); xr0[64 * q] = v0[q] * r0 * gq; xr1[64 * q] = v1[q] * r1 * gq; }
        }
    }
    ++ph;
#undef IN_PH
#undef SEAM
}

static bool launch(void* const* d_in, float* out, unsigned char* ws, int lo, int hi, hipStream_t stream) {
    static int grid = 0;
    if (grid == 0) {
        int dev = 0, cus = 0, per_cu = 0;
        if (hipGetDevice(&dev) != hipSuccess || hipDeviceGetAttribute(&cus, hipDeviceAttributeMultiprocessorCount, dev) != hipSuccess) { grid = -1; return false; }
        if (hipFuncSetAttribute((const void*)fwd, hipFuncAttributeMaxDynamicSharedMemorySize, LDS_BYTES) != hipSuccess) { fprintf(stderr, "hipFuncSetAttribute failed\n"); grid = -1; return false; }
        if (hipOccupancyMaxActiveBlocksPerMultiprocessor(&per_cu, (const void*)fwd, 512, LDS_BYTES) != hipSuccess || per_cu < 1) { fprintf(stderr, "occupancy query: %d\n", per_cu); (void)hipGetLastError(); per_cu = 1; }
        grid = cus;
    }
    if (grid < 0) return false;
    Args a{};
    for (int i = 0; i < 30; ++i) a.in[i] = (const float*)d_in[i];
    a.out = out; a.ws = ws; a.ph_lo = lo; a.ph_hi = hi;
    void* kargs[] = {&a};
    const hipError_t e = hipLaunchCooperativeKernel((const void*)fwd, dim3(grid), dim3(512), kargs, LDS_BYTES, stream);
    if (e != hipSuccess) { fprintf(stderr, "cooperative launch failed: %s (grid %d)\n", hipGetErrorString(e), grid); return false; }
    return true;
}
}
extern "C" void kernel_launch(void* const* d_in, const int* in_sizes, int n_in, void* d_out, int out_size, void* d_ws, size_t ws_size, hipStream_t stream) {
    if (n_in != 30 || ws_size < mk::WS_END) { fprintf(stderr, "kernel_launch: unexpected n_in %d / ws %zu\n", n_in, ws_size); return; }
    (void)hipMemsetAsync((char*)d_ws + mk::WS_CTL, 0, mk::CTL_BYTES, stream);
    mk::launch(d_in, (float*)d_out, (unsigned char*)d_ws, 0, 27, stream);
}
```

```cpp
#include <hip/hip_runtime.h>
#include <cstdio>
#include <cstdint>
#include <hip/hip_cooperative_groups.h>
namespace mk {
namespace cg = cooperative_groups;
#define LAS __attribute__((address_space(3)))
#define GAS __attribute__((address_space(1)))
typedef unsigned short bf16_t;
typedef short bf16x8 __attribute__((ext_vector_type(8)));
typedef short s16x4 __attribute__((ext_vector_type(4)));
typedef float f32x4 __attribute__((ext_vector_type(4)));
typedef float f32x2 __attribute__((ext_vector_type(2)));
typedef unsigned u32x4 __attribute__((ext_vector_type(4)));
typedef unsigned u32x2 __attribute__((ext_vector_type(2)));

constexpr int D = 1024, M = 12288, MP = 8192, FF = 4096, NCH = 768;
constexpr float EPS = 1e-6f;
constexpr int BM = 256, BK = 64, HALF = 128, HTB = HALF * BK * 2, STAGE_BYTES = 8 * HTB, NXCD = 8, WGM = 8;

typedef __bf16 bf16x2_t __attribute__((ext_vector_type(2)));
__device__ __forceinline__ unsigned cvt_pk_bf16(float lo, float hi) { const f32x2 v = {lo, hi}; const bf16x2_t b = __builtin_convertvector(v, bf16x2_t); return __builtin_bit_cast(unsigned, b); }
__device__ __forceinline__ float bf_lo(unsigned w) { return __uint_as_float(w << 16); }
__device__ __forceinline__ float bf_hi(unsigned w) { return __uint_as_float(w & 0xffff0000u); }
__device__ __forceinline__ float rcp_f(float x) { return __builtin_amdgcn_rcpf(x); }
__device__ __forceinline__ float rsq_f(float x) { return __builtin_amdgcn_rsqf(x); }
__device__ __forceinline__ float gelu_tanh(float x) {
    const float t = x * x * (0.044715f * -2.0f * 0.7978845608028654f * 1.4426950408889634f) + (-2.0f * 0.7978845608028654f * 1.4426950408889634f);
    return x * rcp_f(1.0f + __builtin_amdgcn_exp2f(x * t));
}
__device__ __forceinline__ float sigmoid_f(float x) { return rcp_f(1.0f + __builtin_amdgcn_exp2f(x * -1.4426950408889634f)); }
__device__ __forceinline__ int cond_of_pm(int pm) { return pm < 32 ? 0 : 1 + ((pm - 32) >> 2); }
__device__ __forceinline__ int cond_of_row(int row) { return row < MP ? 0 : 1 + ((row - MP) >> 10); }

__host__ __device__ __forceinline__ int lds_byte(int r, int c) { const int st = (r >> 4) * 2 + (c >> 5), rr = r & 15, cc = c & 31, ob = rr * 64 + cc * 2; return st * 1024 + (ob ^ (((ob >> 9) & 1) << 5)); }
__host__ __device__ __forceinline__ void stage_rc(int b, int& R, int& C) { const int st = b / 1024, sb = b % 1024, swz = sb ^ (((sb >> 9) & 1) << 5); R = (st >> 1) * 16 + swz / 64; C = (st & 1) * 32 + (swz % 64) / 2; }
__host__ __device__ __forceinline__ int perm32(int rho) { const int n = rho >> 4, i = rho & 15; return 8 * (i >> 2) + 4 * n + (i & 3); }

struct Unit { int pm, pn; };
struct Gemm { const GAS char* A; const GAS char* Bt; int K; int lda; int ldb; size_t kstepA, hstepA, tstepA; };
struct ARowMajor { static __device__ __forceinline__ unsigned voff(int R, int C, int lda) { return (unsigned)(R * lda + C) * 2u; } };
struct AGroupChunk { static __device__ __forceinline__ unsigned voff(int R, int C, int) { return (unsigned)((((C >> 4) * NCH + (R >> 4)) * 256) + (R & 15) * 16 + (C & 15)) * 2u; } };
__device__ inline Gemm gemm_rowmajor(const GAS void* A, int lda, const GAS void* Bt, int ldb, int K) {
    Gemm g; g.A = (const GAS char*)A; g.Bt = (const GAS char*)Bt; g.K = K; g.lda = lda; g.ldb = ldb; g.kstepA = BK * 2; g.hstepA = (size_t)HALF * lda * 2; g.tstepA = 2 * g.hstepA; return g; }
__device__ inline Gemm gemm_groupchunk(const GAS void* A, const GAS void* Bt, int ldb, int K) {
    Gemm g; g.A = (const GAS char*)A; g.Bt = (const GAS char*)Bt; g.K = K; g.lda = 0; g.ldb = ldb; g.kstepA = (size_t)4 * NCH * 256 * 2; g.hstepA = 8 * 256 * 2; g.tstepA = 16 * 256 * 2; return g; }

struct StaticOrder {
    int nM, nN, nwg, G, c;
    __host__ __device__ void init(int M_, int N_, int G_, int c_) { nM = M_ / BM; nN = N_ / BM; nwg = nM * nN; G = G_; c = c_; }
    __host__ __device__ bool next(int i, Unit& u) const {
        const long L = (long)i * G + c; if (L >= nwg) return false;
        int wgid = (int)L; { const int q = nwg / NXCD, r = nwg % NXCD, xcd = wgid % NXCD, off = wgid / NXCD; wgid = (xcd < r ? xcd * (q + 1) : r * (q + 1) + (xcd - r) * q) + off; }
        const int nig = WGM * nN, gid = wgid / nig, fm = gid * WGM, gsz = (nM - fm) < WGM ? (nM - fm) : WGM;
        u.pm = fm + ((wgid % nig) % gsz); u.pn = (wgid % nig) / gsz; return true;
    }
};
struct SsmOrder {
    int G, c;
    __host__ __device__ bool next(int i, Unit& u) const { const int L = i * G + c; if (L >= 192) return false; u.pm = L; u.pn = L / 3; return true; }
};

template <class Epi, class AL, class Sched>
__device__ __forceinline__ void gemm_phase(LAS unsigned char* lds, const Gemm g, const Sched& S, const Epi& E) {
    int tid = threadIdx.x; asm volatile("" : "+v"(tid));
    const int wid = __builtin_amdgcn_readfirstlane(tid >> 6), lane = tid & 63, wr = wid >> 2, wc = wid & 3, fr = lane & 15, fq = lane >> 4;
    const int K = g.K, nt = K / BK;
    unsigned voffA[2], voffB[2];
#pragma unroll
    for (int i = 0; i < 2; ++i) { int R, C; stage_rc(tid * 16 + i * 8192, R, C); const int Rb = Epi::PERM ? ((R & ~31) + perm32(R & 31)) : R;
        voffA[i] = AL::voff(R, C, g.lda); voffB[i] = (unsigned)(Rb * g.ldb + C) * 2u; }
    const size_t kstepA = g.kstepA, hstepA = g.hstepA, tstepA = g.tstepA;
    const size_t kstepB = (size_t)(BK * 2), hstepB = (size_t)HALF * g.ldb * 2, tstepB = 2 * hstepB;
    const unsigned ldsw = (unsigned)wid * 1024u;
    const int aoff = lds_byte(wr * 64 + fr, fq * 8), boff = lds_byte(wc * 32 + fr, fq * 8);
#define PG8_SA(b, h) (((b) * 2 + (h)) * HTB)
#define PG8_SB(b, h) ((4 + (b) * 2 + (h)) * HTB)
#define PG8_STAGE(bufoff, gbase, voff) do { _Pragma("unroll") for (int _i = 0; _i < 2; ++_i) \
        __builtin_amdgcn_global_load_lds((const GAS unsigned*)((const GAS char*)(gbase) + (voff)[_i]), (LAS unsigned*)(lds + (bufoff) + ldsw + _i * 8192), 16, 0, 0); } while (0)
#define PG8_LDA(dst, b, h) do { _Pragma("unroll") for (int m = 0; m < 4; ++m) _Pragma("unroll") for (int k = 0; k < 2; ++k) dst[m][k] = *(const LAS bf16x8*)(lds + PG8_SA(b, h) + aoff + m * 2048 + k * 1024); } while (0)
#define PG8_LDB(dst, b, h) do { _Pragma("unroll") for (int n = 0; n < 2; ++n) _Pragma("unroll") for (int k = 0; k < 2; ++k) dst[n][k] = *(const LAS bf16x8*)(lds + PG8_SB(b, h) + boff + n * 2048 + k * 1024); } while (0)
#define PG8_MMA(ai, bj, At, Bt) do { __builtin_amdgcn_s_setprio(1); _Pragma("unroll") for (int m = 0; m < 4; ++m) _Pragma("unroll") for (int n = 0; n < 2; ++n) _Pragma("unroll") for (int k = 0; k < 2; ++k) \
        acc[ai][bj][m][n] = __builtin_amdgcn_mfma_f32_16x16x32_bf16(Bt[n][k], At[m][k], acc[ai][bj][m][n], 0, 0, 0); __builtin_amdgcn_s_setprio(0); } while (0)
#define PG8_WAIT_V(n) asm volatile("s_waitcnt vmcnt(" #n ")" ::: "memory")
#define PG8_WAIT_L(n) asm volatile("s_waitcnt lgkmcnt(" #n ")" ::: "memory")
#define PG8_BAR __builtin_amdgcn_s_barrier()
#define PG8_SCHED __builtin_amdgcn_sched_barrier(0)
    Unit cur, nxt; int ui = 0;
    if (!S.next(0, cur)) return;
    f32x4 acc[2][2][4][2];
#pragma unroll
    for (int a = 0; a < 2; ++a)
#pragma unroll
        for (int b = 0; b < 2; ++b)
#pragma unroll
            for (int m = 0; m < 4; ++m)
#pragma unroll
                for (int n = 0; n < 2; ++n) acc[a][b][m][n] = (f32x4){0.f, 0.f, 0.f, 0.f};
    bf16x8 At[4][2], B0[2][2], B1[2][2];
    const GAS char* cA = g.A + (size_t)cur.pm * tstepA; const GAS char* cB = g.Bt + (size_t)cur.pn * tstepB;
    PG8_STAGE(PG8_SB(0, 0), cB, voffB); PG8_STAGE(PG8_SB(0, 1), cB + hstepB, voffB); PG8_STAGE(PG8_SA(0, 0), cA, voffA); PG8_STAGE(PG8_SA(0, 1), cA + hstepA, voffA);
    if (wr == 1) PG8_BAR;
    PG8_WAIT_V(2); PG8_BAR;
    PG8_STAGE(PG8_SB(1, 0), cB + kstepB, voffB); PG8_STAGE(PG8_SA(1, 0), cA + kstepA, voffA); PG8_STAGE(PG8_SB(1, 1), cB + hstepB + kstepB, voffB);
    PG8_WAIT_V(6); PG8_BAR;
    for (;;) {
        const bool has_next = S.next(ui + 1, nxt);
        const GAS char* nA = has_next ? g.A + (size_t)nxt.pm * tstepA : cA; const GAS char* nB = has_next ? g.Bt + (size_t)nxt.pn * tstepB : cB;
        for (int t = 0; t < nt; t += 2) {
            const bool last = (t == nt - 2);
            const GAS char* a1 = cA + (size_t)(t + 1) * kstepA;
            const GAS char* a2 = last ? nA : cA + (size_t)(t + 2) * kstepA; const GAS char* b2 = last ? nB : cB + (size_t)(t + 2) * kstepB;
            const GAS char* a3 = a2 + kstepA; const GAS char* b3 = b2 + kstepB;
            PG8_LDB(B0, 0, 0); PG8_LDB(B1, 0, 1); PG8_SCHED; PG8_LDA(At, 0, 0); PG8_STAGE(PG8_SA(1, 1), a1 + hstepA, voffA);
            PG8_WAIT_V(8); PG8_WAIT_L(0); PG8_BAR; PG8_MMA(0, 0, At, B0); PG8_MMA(0, 1, At, B1); PG8_BAR; PG8_SCHED;
            PG8_LDA(At, 0, 1); PG8_STAGE(PG8_SB(0, 0), b2, voffB); PG8_STAGE(PG8_SB(0, 1), b2 + hstepB, voffB); PG8_STAGE(PG8_SA(0, 0), a2, voffA);
            PG8_WAIT_V(8); PG8_WAIT_L(0); PG8_BAR; PG8_MMA(1, 0, At, B0); PG8_MMA(1, 1, At, B1); PG8_BAR; PG8_SCHED;
            PG8_LDB(B0, 1, 0); PG8_LDB(B1, 1, 1); PG8_SCHED; PG8_LDA(At, 1, 0); PG8_STAGE(PG8_SA(0, 1), a2 + hstepA, voffA);
            PG8_WAIT_V(8); PG8_WAIT_L(0); PG8_BAR; PG8_MMA(0, 0, At, B0); PG8_MMA(0, 1, At, B1); PG8_BAR; PG8_SCHED;
            PG8_LDA(At, 1, 1); PG8_STAGE(PG8_SB(1, 0), b3, voffB); PG8_STAGE(PG8_SB(1, 1), b3 + hstepB, voffB); PG8_STAGE(PG8_SA(1, 0), a3, voffA);
            PG8_WAIT_V(8); PG8_WAIT_L(0); PG8_BAR; PG8_MMA(1, 0, At, B0); PG8_MMA(1, 1, At, B1); PG8_BAR; PG8_SCHED;
        }
        if (wr == 0) PG8_BAR;
        E(acc, cur, wr, wc, fr, fq);
        if (!has_next) break;
#pragma unroll
        for (int a = 0; a < 2; ++a)
#pragma unroll
            for (int b = 0; b < 2; ++b)
#pragma unroll
                for (int m = 0; m < 4; ++m)
#pragma unroll
                    for (int n = 0; n < 2; ++n) acc[a][b][m][n] = (f32x4){0.f, 0.f, 0.f, 0.f};
        cur = nxt; cA = nA; cB = nB; ++ui;
        if (wr == 1) PG8_BAR;
    }
    PG8_WAIT_V(0);
    PG8_BAR;
#undef PG8_SA
#undef PG8_SB
#undef PG8_STAGE
#undef PG8_LDA
#undef PG8_LDB
#undef PG8_MMA
#undef PG8_WAIT_V
#undef PG8_WAIT_L
#undef PG8_BAR
#undef PG8_SCHED
}

typedef const f32x4 (&AccRef)[2][2][4][2];

__device__ __forceinline__ void load_rstd(const GAS float* rowss, int ns, int row0, int fq, float (&rs)[2][4]) {
    f32x4 a[2][4];
#pragma unroll
    for (int ai = 0; ai < 2; ++ai)
#pragma unroll
        for (int m = 0; m < 4; ++m) { const GAS f32x4* p = (const GAS f32x4*)(rowss + (size_t)(row0 + ai * HALF + m * 16) * 32) + fq; a[ai][m] = p[0] + p[4]; }
#pragma unroll
    for (int ai = 0; ai < 2; ++ai)
#pragma unroll
        for (int m = 0; m < 4; ++m) { float t = (a[ai][m][0] + a[ai][m][1]) + (a[ai][m][2] + a[ai][m][3]); t += __shfl_xor(t, 16); t += __shfl_xor(t, 32);
            rs[ai][m] = rsq_f(t * (1.0f / D) + EPS); }
}

template <int ACT> struct EpiIn {
    static constexpr bool PERM = true;
    GAS bf16_t* O; int ldc; const GAS float* rowss; int ns; const GAS float* sw; int swld; GAS float* vstat;
    __device__ __forceinline__ void operator()(AccRef acc, const Unit& u, int wr, int wc, int fr, int fq) const {
        const int row0 = u.pm * BM + wr * 64 + fr, col0 = u.pn * BM + wc * 32 + 8 * fq;
        float rs[2][4]; load_rstd(rowss, ns, row0, fq, rs);
        const GAS float* swp = sw + (unsigned)(cond_of_pm(u.pm) * swld + col0);
        const bool stats = ACT == 2 && u.pn >= 8;
#pragma unroll
        for (int bj = 0; bj < 2; ++bj) {
            const f32x4 b0 = *(const GAS f32x4*)(swp + bj * HALF), b1 = *(const GAS f32x4*)(swp + bj * HALF + 4);
#pragma unroll
            for (int ai = 0; ai < 2; ++ai)
#pragma unroll
                for (int m = 0; m < 4; ++m) {
                    const unsigned r = (unsigned)(row0 + ai * HALF + m * 16);
                    f32x4 v0 = acc[ai][bj][m][0] * rs[ai][m] + b0, v1 = acc[ai][bj][m][1] * rs[ai][m] + b1;
                    if (ACT == 1) {
#pragma unroll
                        for (int j = 0; j < 4; ++j) { const float a = fmaxf(v0[j], 0.f), b = fmaxf(v1[j], 0.f); v0[j] = a * a; v1[j] = b * b; } }
                    if (ACT == 2) {
#pragma unroll
                        for (int j = 0; j < 4; ++j) { v0[j] = gelu_tanh(v0[j]); v1[j] = gelu_tanh(v1[j]); } }
                    u32x4 w; w.x = cvt_pk_bf16(v0[0], v0[1]); w.y = cvt_pk_bf16(v0[2], v0[3]); w.z = cvt_pk_bf16(v1[0], v1[1]); w.w = cvt_pk_bf16(v1[2], v1[3]);
                    *(GAS u32x4*)(O + (r * (unsigned)ldc + (unsigned)(col0 + bj * HALF))) = w;
                    if (ACT == 2) { if (stats) {
                        float a = (v0[0] + v0[1]) + (v0[2] + v0[3]) + (v1[0] + v1[1]) + (v1[2] + v1[3]);
                        float b = (v0[0] * v0[0] + v0[1] * v0[1]) + (v0[2] * v0[2] + v0[3] * v0[3]) + (v1[0] * v1[0] + v1[1] * v1[1]) + (v1[2] * v1[2] + v1[3] * v1[3]);
                        a += __shfl_xor(a, 16); a += __shfl_xor(a, 32); b += __shfl_xor(b, 16); b += __shfl_xor(b, 32);
                        if (fq == 0) *(GAS f32x2*)(vstat + (r * 64u + (unsigned)(((u.pn - 8) * 2 + bj) * 4 + wc)) * 2u) = (f32x2){a, b}; } }
                }
        }
    }
};
struct EpiU {
    static constexpr bool PERM = true;
    GAS bf16_t* UgS; const GAS float* rowss; const GAS float* sw;
    __device__ __forceinline__ void operator()(AccRef acc, const Unit& u, int wr, int wc, int fr, int fq) const {
        const int row0 = u.pm * BM + wr * 64 + fr, col0 = u.pn * BM + wc * 32 + 8 * fq;
        float rs[2][4]; load_rstd(rowss, 16, row0, fq, rs);
        const GAS float* swp = sw + (size_t)cond_of_pm(u.pm) * 1024 + col0;
#pragma unroll
        for (int bj = 0; bj < 2; ++bj) {
            const f32x4 b0 = *(const GAS f32x4*)(swp + bj * HALF), b1 = *(const GAS f32x4*)(swp + bj * HALF + 4);
            const int g = (col0 + bj * HALF) >> 4, p0 = (col0 & 15);
#pragma unroll
            for (int ai = 0; ai < 2; ++ai)
#pragma unroll
                for (int m = 0; m < 4; ++m) {
                    const f32x4 v0 = acc[ai][bj][m][0] * rs[ai][m] + b0, v1 = acc[ai][bj][m][1] * rs[ai][m] + b1;
                    u32x4 w; w.x = cvt_pk_bf16(v0[0], v0[1]); w.y = cvt_pk_bf16(v0[2], v0[3]); w.z = cvt_pk_bf16(v1[0], v1[1]); w.w = cvt_pk_bf16(v1[2], v1[3]);
                    const int chunk = u.pm * 16 + ai * 8 + wr * 4 + m;
                    *(GAS u32x4*)(UgS + ((size_t)g * NCH + chunk) * 512 + fr * 16 + p0) = w;
                }
        }
    }
};
struct EpiF32 {
    static constexpr bool PERM = true;
    GAS float* C; int ldc;
    __device__ __forceinline__ void operator()(AccRef acc, const Unit& u, int wr, int wc, int fr, int fq) const {
        const int row0 = u.pm * BM + wr * 64 + fr, col0 = wc * 32 + 8 * fq;
#pragma unroll
        for (int ai = 0; ai < 2; ++ai)
#pragma unroll
            for (int m = 0; m < 4; ++m) { GAS float* rp = C + (size_t)(row0 + ai * HALF + m * 16) * ldc + col0;
#pragma unroll
                for (int bj = 0; bj < 2; ++bj) { *(GAS f32x4*)(rp + bj * HALF) = acc[ai][bj][m][0]; *(GAS f32x4*)(rp + bj * HALF + 4) = acc[ai][bj][m][1]; } }
    }
};
struct EpiY {
    static constexpr bool PERM = true;
    GAS bf16_t* Zg;
    __device__ __forceinline__ void operator()(AccRef acc, const Unit& u, int wr, int wc, int fr, int fq) const {
        const int row0 = u.pm * BM + wr * 64 + fr, col0 = wc * 32 + 8 * fq;
#pragma unroll
        for (int ai = 0; ai < 2; ++ai)
#pragma unroll
            for (int m = 0; m < 4; ++m) { GAS bf16_t* rp = Zg + (size_t)(row0 + ai * HALF + m * 16) * 256 + col0;
#pragma unroll
                for (int bj = 0; bj < 2; ++bj) { const f32x4 v0 = acc[ai][bj][m][0], v1 = acc[ai][bj][m][1];
                    u32x4 w; w.x = cvt_pk_bf16(gelu_tanh(v0[0]), gelu_tanh(v0[1])); w.y = cvt_pk_bf16(gelu_tanh(v0[2]), gelu_tanh(v0[3]));
                    w.z = cvt_pk_bf16(gelu_tanh(v1[0]), gelu_tanh(v1[1])); w.w = cvt_pk_bf16(gelu_tanh(v1[2]), gelu_tanh(v1[3]));
                    *(GAS u32x4*)(rp + bj * HALF) = w; } }
    }
};
template <bool GATED> struct EpiRes {
    static constexpr bool PERM = true;
    GAS float* X; GAS bf16_t* XN; const GAS float* gate; const GAS float* gsn; GAS float* rowss_next;
    __device__ __forceinline__ void operator()(AccRef acc, const Unit& u, int wr, int wc, int fr, int fq) const {
        constexpr int NB = GATED ? 1 : 2;
        const int row0 = u.pm * BM + wr * 64 + fr, col0 = u.pn * (GATED ? HALF : BM) + wc * 32 + 8 * fq;
        const int ci = cond_of_pm(u.pm);
#pragma unroll
        for (int bj = 0; bj < NB; ++bj) {
            const int col = col0 + bj * HALF;
            const f32x4 g0 = *(const GAS f32x4*)(gate + (size_t)ci * 6144 + col), g1 = *(const GAS f32x4*)(gate + (size_t)ci * 6144 + col + 4);
            f32x4 n0 = {0.f, 0.f, 0.f, 0.f}, n1 = n0;
            if (gsn) { n0 = *(const GAS f32x4*)(gsn + ci * 1024 + col); n1 = *(const GAS f32x4*)(gsn + ci * 1024 + col + 4); }
#pragma unroll
            for (int ai = 0; ai < 2; ++ai) {
                f32x4 xv[4][2];
#pragma unroll
                for (int m = 0; m < 4; ++m) { const GAS float* xp = X + (size_t)(row0 + ai * HALF + m * 16) * D + col; xv[m][0] = *(const GAS f32x4*)xp; xv[m][1] = *(const GAS f32x4*)(xp + 4); }
#pragma unroll
                for (int m = 0; m < 4; ++m) {
                    GAS float* xp = X + (size_t)(row0 + ai * HALF + m * 16) * D + col;
                    f32x4 v0 = acc[ai][bj][m][0], v1 = acc[ai][bj][m][1];
                    if (GATED) { const f32x4 q0 = acc[ai][1][m][0], q1 = acc[ai][1][m][1];
#pragma unroll
                        for (int j = 0; j < 4; ++j) { v0[j] *= sigmoid_f(q0[j]); v1[j] *= sigmoid_f(q1[j]); } }
                    const f32x4 x0 = xv[m][0] + g0 * v0, x1 = xv[m][1] + g1 * v1;
                    *(GAS f32x4*)xp = x0; *(GAS f32x4*)(xp + 4) = x1;
                    if (gsn) {
                        float a = (x0[0] * x0[0] + x0[1] * x0[1]) + (x0[2] * x0[2] + x0[3] * x0[3]) + (x1[0] * x1[0] + x1[1] * x1[1]) + (x1[2] * x1[2] + x1[3] * x1[3]);
                        const f32x4 y0 = x0 * n0, y1 = x1 * n1;
                        u32x4 w; w.x = cvt_pk_bf16(y0[0], y0[1]); w.y = cvt_pk_bf16(y0[2], y0[3]); w.z = cvt_pk_bf16(y1[0], y1[1]); w.w = cvt_pk_bf16(y1[2], y1[3]);
                        *(GAS u32x4*)(XN + (size_t)(row0 + ai * HALF + m * 16) * D + col) = w;
                        a += __shfl_xor(a, 16); a += __shfl_xor(a, 32);
                        if (fq == 0) rowss_next[(size_t)(row0 + ai * HALF + m * 16) * 32 + (GATED ? u.pn * 4 + wc : (u.pn * 2 + bj) * 4 + wc)] = a;
                    }
                }
            }
        }
    }
};

#define XB_TMO      128
#define XB_XCNT(j)  (256  + 64 * (j))
#define XB_XSUB(j)  (1280 + 64 * (j))
#define XB_XGEN(j)  (2304 + 64 * (j))
#define XB_TOP      3328
#define XB_TOPGEN   3392
#define XCD_BAR_WORDS 3456
#define XB_SPIN_CAP (1u << 18)
__device__ __forceinline__ unsigned xb_ld(GAS unsigned* p)              { return __hip_atomic_load(p, __ATOMIC_RELAXED, __HIP_MEMORY_SCOPE_AGENT); }
__device__ __forceinline__ unsigned xb_add(GAS unsigned* p, unsigned v) { return __hip_atomic_fetch_add(p, v, __ATOMIC_RELAXED, __HIP_MEMORY_SCOPE_AGENT); }
__device__ __forceinline__ unsigned xb_xcc_id() { return (unsigned)__builtin_amdgcn_s_getreg((3 << 11) | 20) & 0xFu; }
#define XB_SPIN(cond, bar) do { unsigned _sp = 0; while (cond) { __builtin_amdgcn_s_sleep(1); \
    if ((++_sp & 255u) == 0u) { if (xb_ld(&(bar)[XB_TMO])) break; if (_sp > XB_SPIN_CAP) { (void)xb_add(&(bar)[XB_TMO], 1u); break; } } } } while (0)
struct XcdBarrier { GAS unsigned* bar; unsigned x; volatile LAS unsigned* st; };
__device__ __forceinline__ XcdBarrier xcd_barrier_post(GAS unsigned* bar, volatile LAS unsigned* st) {
    XcdBarrier b; b.bar = bar; b.x = xb_xcc_id(); b.st = st;
    if (threadIdx.x == 0) (void)xb_add(&bar[XB_XCNT(b.x)], 1u);
    return b;
}
__device__ __forceinline__ void xcd_barrier_complete(GAS unsigned* bar, unsigned x, unsigned& nloc, unsigned& nx) {
    const unsigned G = gridDim.x * gridDim.y * gridDim.z;
    unsigned sum, cnt, mine, sp = 0u;
    for (;;) {
        sum = 0u; cnt = 0u;
#pragma unroll 1
        for (unsigned j = 0; j < 16; ++j) { const unsigned c = xb_ld(&bar[XB_XCNT(j)]); sum += c; cnt += (c > 0u) ? 1u : 0u; }
        mine = xb_ld(&bar[XB_XCNT(x)]);
        if (sum == G) break;
        __builtin_amdgcn_s_sleep(1);
        if ((++sp & 255u) == 0u) { if (xb_ld(&bar[XB_TMO])) break; if (sp > XB_SPIN_CAP) { (void)xb_add(&bar[XB_TMO], 1u); break; } }
    }
    nloc = mine > 0u ? mine : 1u; nx = cnt > 0u ? cnt : 1u;
}
__device__ __forceinline__ void xcd_barrier(const XcdBarrier& b) {
    asm volatile("s_waitcnt vmcnt(0)" ::: "memory");
    __syncthreads();
    if (threadIdx.x == 0) {
        GAS unsigned* bar = b.bar; unsigned bx_ = b.x;
        asm volatile("" : "+s"(bar), "+s"(bx_));
        __builtin_amdgcn_s_waitcnt(0);
        unsigned nloc = b.st[0], nx = b.st[1];
        if (nloc == 0u) { xcd_barrier_complete(bar, bx_, nloc, nx); b.st[0] = nloc; b.st[1] = nx; }
        const unsigned old = xb_add(&bar[XB_XSUB(bx_)], 1u);
        const unsigned gen = old / nloc;
        if (old + 1u == (gen + 1u) * nloc) {
            __builtin_amdgcn_fence(__ATOMIC_RELEASE, "agent");
            asm volatile("s_waitcnt vmcnt(0)" ::: "memory");
            const unsigned og = xb_add(&bar[XB_TOP], 1u);
            const unsigned tg = og / nx;
            if (og + 1u == (tg + 1u) * nx) xb_add(&bar[XB_TOPGEN], 1u);
            else XB_SPIN(xb_ld(&bar[XB_TOPGEN]) == tg, bar);
            __builtin_amdgcn_fence(__ATOMIC_ACQUIRE, "agent");
            xb_add(&bar[XB_XGEN(bx_)], 1u);
            asm volatile("s_waitcnt vmcnt(0)" ::: "memory");
        } else {
            XB_SPIN(xb_ld(&bar[XB_XGEN(bx_)]) == gen, bar);
            __builtin_amdgcn_fence(__ATOMIC_ACQUIRE, "agent");
            asm volatile("s_waitcnt vmcnt(0)" ::: "memory");
        }
    }
    __syncthreads();
}

constexpr size_t MiB = 1u << 20;
constexpr size_t WS_CTL = 0, CTL_BYTES = 2 * MiB;
constexpr int CW_BAR = 4096;
constexpr size_t WS_TAB = 2 * MiB;
constexpr size_t TAB_GSA = WS_TAB, TAB_GSB = TAB_GSA + 4 * 5 * 1024 * 4, TAB_SWA = TAB_GSB + 4 * 5 * 1024 * 4, TAB_SWB = TAB_SWA + 4 * 5 * 4096 * 4, TAB_LAMT = TAB_SWB + 4 * 5 * 4096 * 4;
static_assert(TAB_LAMT + 2 * 64 * 2 * 64 * 2 * 4 <= 4 * MiB, "tables");
constexpr size_t WS_W1 = 4 * MiB, WS_W2 = 36 * MiB, WS_SWIN = 68 * MiB, WS_SWOUT = 72 * MiB, WS_GWIN = 80 * MiB, WS_GWOUT = 88 * MiB, WS_GWS = 92 * MiB,
                 WS_CWIN = 93 * MiB, WS_CWOUT = 99 * MiB, WS_BTY = 101 * MiB, WS_BTS = 133 * MiB;
constexpr size_t WS_XN = 149 * MiB;
constexpr size_t WS_R = 173 * MiB;
constexpr size_t WS_R2 = 269 * MiB;
constexpr size_t WS_ROWSS = 317 * MiB;
constexpr size_t WS_VSTAT = 329 * MiB;
constexpr size_t WS_MODS = 335 * MiB;
constexpr size_t WS_END = 336 * MiB;

constexpr int LDS_BYTES = 147456;
constexpr int MISC_OFF = STAGE_BYTES;

struct Args { const float* in[30]; float* out; unsigned char* ws; int ph_lo, ph_hi; };

__device__ __forceinline__ unsigned f2bf(float f) { unsigned u = __builtin_bit_cast(unsigned, f); return (u + 0x7fffu + ((u >> 16) & 1u)) >> 16; }
__device__ __forceinline__ unsigned pk2(float lo, float hi) { return f2bf(lo) | (f2bf(hi) << 16); }
__device__ __forceinline__ float wave_sum(float v) {
#pragma unroll
    for (int o = 1; o < 64; o <<= 1) v += __shfl_xor(v, o);
    return v;
}
template <int MAP> __device__ __forceinline__ int rowmap(int n) {
    if (MAP == 1) { const int half = n >> 10, c = n & 1023; return (c >> 7) * 256 + half * 128 + (c & 127); }
    return n;
}
template <int MAP> __device__ __forceinline__ void transpose_item(const GAS float* W, int K, int N, GAS bf16_t* WT, LAS float* scr, int item, int lane) {
    const int nblk = N / 32, kb = item / nblk, nb = item % nblk, k0 = 64 * kb, n0 = 32 * nb;
    float wv[32];
#pragma unroll
    for (int i = 0; i < 32; ++i) wv[i] = W[(size_t)(k0 + 2 * i + (lane >> 5)) * N + n0 + (lane & 31)];
#pragma unroll
    for (int i = 0; i < 32; ++i) scr[(2 * i + (lane >> 5)) * 33 + (lane & 31)] = wv[i];
    asm volatile("s_waitcnt lgkmcnt(0)" ::: "memory");
    const int c = lane & 7;
#pragma unroll
    for (int j = 0; j < 4; ++j) { const int n = (lane >> 3) + 8 * j; const LAS float* s = scr + (8 * c) * 33 + n;
        u32x4 o; o.x = pk2(s[0 * 33], s[1 * 33]); o.y = pk2(s[2 * 33], s[3 * 33]); o.z = pk2(s[4 * 33], s[5 * 33]); o.w = pk2(s[6 * 33], s[7 * 33]);
        *(GAS u32x4*)(WT + (size_t)rowmap<MAP>(n0 + n) * K + k0 + 8 * c) = o; }
    asm volatile("s_waitcnt lgkmcnt(0)" ::: "memory");
}

__device__ __forceinline__ void ssm_build(const Args& a, int j, int g, LAS unsigned char* lds, GAS unsigned char* ws) {
    const int tid = threadIdx.x;
    LAS float* PR = (LAS float*)lds;
    LAS float* PI = PR + 2 * 17 * 64;
    LAS float* BR = PI + 2 * 17 * 64;
    LAS float* BI = BR + 2 * 64 * 16;
    LAS float* CR = BI + 2 * 64 * 16;
    LAS float* CI = CR + 2 * 16 * 64;
    LAS float* WR = CI + 2 * 16 * 64;
    LAS float* WI = WR + 2 * 64 * 16;
    LAS float* KT = WI + 2 * 64 * 16;
    const GAS float* lam_re = ((const GAS float*)a.in[13]); const GAS float* lam_im = ((const GAS float*)a.in[14]); const GAS float* log_dt = ((const GAS float*)a.in[15]);
    const GAS float* b_re = ((const GAS float*)a.in[16]); const GAS float* b_im = ((const GAS float*)a.in[17]); const GAS float* c_re = ((const GAS float*)a.in[18]); const GAS float* c_im = ((const GAS float*)a.in[19]); const GAS float* dsk = ((const GAS float*)a.in[20]);
    __syncthreads();
    if (tid < 128) {
        const int k = tid >> 6, n = tid & 63, pidx = (j * 2 + k) * 64 + g;
        const float dt = expf(log_dt[pidx]);
        const float lr = lam_re[pidx * 64 + n], li = lam_im[pidx * 64 + n];
        for (int e = 0; e <= 16; ++e) { const float mag = expf((float)e * lr * dt); float sn, cs; sincosf((float)e * (li * dt), &sn, &cs); PR[(k * 17 + e) * 64 + n] = mag * cs; PI[(k * 17 + e) * 64 + n] = mag * sn; }
        const float mag = expf(lr * dt); const float abr = mag * cosf(li * dt), abi = mag * sinf(li * dt);
        const float den = lr * lr + li * li;
        const float nr = (abr - 1.0f) * lr + abi * li, ni = -(abr - 1.0f) * li + abi * lr;
        const float fr = nr / den, fi = ni / den;
        for (int p = 0; p < 16; ++p) { const float br = b_re[((size_t)pidx * 64 + n) * 16 + p], bi = b_im[((size_t)pidx * 64 + n) * 16 + p];
            BR[(k * 64 + n) * 16 + p] = fr * br - fi * bi; BI[(k * 64 + n) * 16 + p] = fr * bi + fi * br; }
        GAS float* lamT = (GAS float*)(ws + TAB_LAMT) + (((size_t)j * 64 + g) * 2 + k) * 128;
        lamT[2 * n] = PR[(k * 17 + 16) * 64 + n]; lamT[2 * n + 1] = PI[(k * 17 + 16) * 64 + n];
    }
    for (int i = tid; i < 2048; i += 512) { const int k = i >> 10, r = i & 1023; const size_t o = ((size_t)(j * 2 + k) * 64 + g) * 1024 + r; CR[i] = c_re[o]; CI[i] = c_im[o]; }
    __syncthreads();
    {
        const int k = tid >> 8, po = (tid >> 4) & 15, pi = tid & 15;
        for (int e = 0; e < 16; ++e) {
            for (int i = tid; i < 2048; i += 512) { const int kk = i >> 10, n = (i >> 4) & 63; const float pr = PR[(kk * 17 + e) * 64 + n], pim = PI[(kk * 17 + e) * 64 + n];
                WR[i] = pr * BR[i] - pim * BI[i]; WI[i] = pr * BI[i] + pim * BR[i]; }
            __syncthreads();
            float s = 0.f;
#pragma unroll 8
            for (int n = 0; n < 64; ++n) s += CR[(k * 16 + po) * 64 + n] * WR[(k * 64 + n) * 16 + pi] - CI[(k * 16 + po) * 64 + n] * WI[(k * 64 + n) * 16 + pi];
            KT[((k * 16 + e) * 16 + po) * 16 + pi] = s;
            __syncthreads();
        }
    }
    GAS bf16_t* BtY = (GAS bf16_t*)(ws + WS_BTY) + ((size_t)j * 64 + g) * 256 * 512;
    GAS bf16_t* BtS = (GAS bf16_t*)(ws + WS_BTS) + ((size_t)j * 64 + g) * 256 * 256;
    for (int pc = tid; pc < 256 * 32; pc += 512) {
        const int row = pc >> 5, kc = (pc & 31) * 8, t = row >> 4, po = row & 15, s = kc >> 4, pi0 = kc & 15;
        float v[8];
#pragma unroll
        for (int q = 0; q < 8; ++q) { const int pi = pi0 + q; float x = 0.f;
            if (s <= t) x += KT[((0 * 16 + (t - s)) * 16 + po) * 16 + pi];
            if (s >= t) x += KT[((1 * 16 + (s - t)) * 16 + po) * 16 + pi];
            if (s == t && pi == po) x += dsk[j * 1024 + g * 16 + po];
            v[q] = x; }
        u32x4 o; o.x = pk2(v[0], v[1]); o.y = pk2(v[2], v[3]); o.z = pk2(v[4], v[5]); o.w = pk2(v[6], v[7]);
        *(GAS u32x4*)(BtY + (size_t)row * 512 + kc) = o;
    }
    for (int pc = tid; pc < 256 * 32; pc += 512) {
        const int row = pc >> 5, kc = (pc & 31) * 8, t = row >> 4, po = row & 15, k = kc >> 7, ri = (kc >> 6) & 1, n0 = kc & 63;
        const int e = k == 0 ? t + 1 : 16 - t;
        float v[8];
#pragma unroll
        for (int q = 0; q < 8; ++q) { const int n = n0 + q; const float cr = CR[(k * 16 + po) * 64 + n], cim = CI[(k * 16 + po) * 64 + n], pr = PR[(k * 17 + e) * 64 + n], pim = PI[(k * 17 + e) * 64 + n];
            v[q] = ri == 0 ? (cr * pr - cim * pim) : -(cr * pim + cim * pr); }
        u32x4 o; o.x = pk2(v[0], v[1]); o.y = pk2(v[2], v[3]); o.z = pk2(v[4], v[5]); o.w = pk2(v[6], v[7]);
        *(GAS u32x4*)(BtY + (size_t)row * 512 + 256 + kc) = o;
    }
    for (int pc = tid; pc < 256 * 32; pc += 512) {
        const int row = pc >> 5, kc = (pc & 31) * 8, k = row >> 7, ri = (row >> 6) & 1, n = row & 63, s = kc >> 4, pi0 = kc & 15;
        const int e = k == 0 ? 15 - s : s;
        const float pr = PR[(k * 17 + e) * 64 + n], pim = PI[(k * 17 + e) * 64 + n];
        float v[8];
#pragma unroll
        for (int q = 0; q < 8; ++q) { const float br = BR[(k * 64 + n) * 16 + pi0 + q], bi = BI[(k * 64 + n) * 16 + pi0 + q]; v[q] = ri == 0 ? (pr * br - pim * bi) : (pr * bi + pim * br); }
        u32x4 o; o.x = pk2(v[0], v[1]); o.y = pk2(v[2], v[3]); o.z = pk2(v[4], v[5]); o.w = pk2(v[6], v[7]);
        *(GAS u32x4*)(BtS + (size_t)row * 256 + kc) = o;
    }
    __syncthreads();
}

__device__ __forceinline__ void mods_task(const Args& a, GAS float* mods, LAS unsigned char* lds, int task, int tid) {
    const int cg = task % 48, l = task / 48, wave = tid >> 6, lane = tid & 63, half = lane >> 5, c4 = lane & 31;
    const GAS float* c = ((const GAS float*)a.in[4]); const GAS float* c_ctx = ((const GAS float*)a.in[5]); const GAS float* w_mod = ((const GAS float*)a.in[6]); const GAS float* b_mod = ((const GAS float*)a.in[7]);
    LAS float* sil = (LAS float*)lds;
    LAS float* red = sil + 5 * 1024;
    __syncthreads();
    for (int i = tid; i < 5 * 1024; i += 512) { const int ci = i >> 10, k = i & 1023; const float v = ci == 0 ? c_ctx[k] : c[(ci - 1) * 1024 + k]; sil[i] = v / (1.0f + expf(-v)); }
    __syncthreads();
    const GAS float* w = w_mod + ((size_t)l * 1024 + wave * 128 + half) * 6144 + cg * 128 + c4 * 4;
    f32x4 acc[5];
#pragma unroll
    for (int ci = 0; ci < 5; ++ci) acc[ci] = (f32x4){0.f, 0.f, 0.f, 0.f};
#pragma unroll 1
    for (int b = 0; b < 2; ++b) {
        f32x4 wv[32];
#pragma unroll
        for (int i = 0; i < 32; ++i) wv[i] = *(const GAS f32x4*)(w + (size_t)(b * 64 + 2 * i) * 6144);
#pragma unroll
        for (int i = 0; i < 32; ++i) { const int k = wave * 128 + b * 64 + 2 * i + half;
#pragma unroll
            for (int ci = 0; ci < 5; ++ci) acc[ci] += wv[i] * sil[ci * 1024 + k]; }
    }
#pragma unroll
    for (int ci = 0; ci < 5; ++ci) {
#pragma unroll
        for (int q = 0; q < 4; ++q) acc[ci][q] += __shfl_xor(acc[ci][q], 32);
        if (half == 0) *(LAS f32x4*)(red + (wave * 5 + ci) * 128 + c4 * 4) = acc[ci]; }
    __syncthreads();
    for (int i = tid; i < 5 * 128; i += 512) { const int ci = i >> 7, cc = i & 127; float t = 0.f;
#pragma unroll
        for (int wv2 = 0; wv2 < 8; ++wv2) t += red[(wv2 * 5 + ci) * 128 + cc];
        mods[((size_t)l * 5 + ci) * 6144 + cg * 128 + cc] = t + b_mod[l * 6144 + cg * 128 + cc]; }
}

__device__ __forceinline__ void xinit_row(const Args& a, GAS float* X, int row, int lane) {
    GAS f32x4* o = (GAS f32x4*)(X + (size_t)row * D) + lane;
    if (row < MP) { const GAS f32x4* s = (const GAS f32x4*)(((const GAS float*)a.in[0]) + (size_t)row * D) + lane;
#pragma unroll
        for (int q = 0; q < 4; ++q) o[64 * q] = s[64 * q];
        return; }
    const GAS f32x4* s = (const GAS f32x4*)(((const GAS float*)a.in[1]) + (size_t)(row - MP) * D) + lane;
    const int t = (row - MP) & 1023; const float rr = (float)(t >> 6), cc = (float)(t & 63);
    float freq[4];
#pragma unroll
    for (int e = 0; e < 4; ++e) freq[e] = expf(-(float)(4 * lane + e) * (9.210340371976184f / 256.0f));
    f32x4 v[4];
#pragma unroll
    for (int q = 0; q < 4; ++q) v[q] = s[64 * q];
#pragma unroll
    for (int e = 0; e < 4; ++e) { float sr, cr, sc, cc2; sincosf(rr * freq[e], &sr, &cr); sincosf(cc * freq[e], &sc, &cc2); v[0][e] += sr; v[1][e] += cr; v[2][e] += sc; v[3][e] += cc2; }
#pragma unroll
    for (int q = 0; q < 4; ++q) o[64 * q] = v[q];
}


__device__ __forceinline__ void sw_job(const GAS float* mods, int l, int sidx, const GAS bf16_t* WT, int N, GAS float* dst, int dld, int wv, int nw, int lane) {
    float sh[5][16];
#pragma unroll
    for (int ci = 0; ci < 5; ++ci) { const GAS float* sp = mods + ((size_t)l * 5 + ci) * 6144 + sidx * 1024 + lane * 16;
#pragma unroll
        for (int q = 0; q < 4; ++q) { const f32x4 v = *(const GAS f32x4*)(sp + 4 * q); sh[ci][4 * q] = v[0]; sh[ci][4 * q + 1] = v[1]; sh[ci][4 * q + 2] = v[2]; sh[ci][4 * q + 3] = v[3]; } }
    for (int r = wv * 8; r < N; r += nw * 8) {
        u32x4 w0[8], w1[8];
#pragma unroll
        for (int nn = 0; nn < 8; ++nn) { w0[nn] = *(const GAS u32x4*)(WT + (size_t)(r + nn) * D + lane * 16); w1[nn] = *(const GAS u32x4*)(WT + (size_t)(r + nn) * D + lane * 16 + 8); }
#pragma unroll
        for (int nn = 0; nn < 8; ++nn) {
            const float wf[16] = {bf_lo(w0[nn].x), bf_hi(w0[nn].x), bf_lo(w0[nn].y), bf_hi(w0[nn].y), bf_lo(w0[nn].z), bf_hi(w0[nn].z), bf_lo(w0[nn].w), bf_hi(w0[nn].w),
                                  bf_lo(w1[nn].x), bf_hi(w1[nn].x), bf_lo(w1[nn].y), bf_hi(w1[nn].y), bf_lo(w1[nn].z), bf_hi(w1[nn].z), bf_lo(w1[nn].w), bf_hi(w1[nn].w)};
#pragma unroll
            for (int ci = 0; ci < 5; ++ci) { float t = 0.f;
#pragma unroll
                for (int q = 0; q < 16; ++q) t += wf[q] * sh[ci][q];
                t = wave_sum(t);
                if (lane == 0) dst[ci * dld + r + nn] = t; }
        }
    }
}
__device__ __forceinline__ void sw_mix_job(GAS unsigned char* ws, const GAS float* mods, int l, int wv, int nw, int lane) {
    GAS float* swA = (GAS float*)(ws + TAB_SWA);
    if (l == 0) sw_job(mods, 0, 0, (const GAS bf16_t*)(ws + WS_SWIN), 1024, swA, 1024, wv, nw, lane);
    else if (l == 1) sw_job(mods, 1, 0, (const GAS bf16_t*)(ws + WS_GWIN), 4096, swA + 1 * 5 * 4096, 4096, wv, nw, lane);
    else if (l == 2) sw_job(mods, 2, 0, (const GAS bf16_t*)(ws + WS_CWIN), 3072, swA + 2 * 5 * 4096, 3072, wv, nw, lane);
    else sw_job(mods, 3, 0, (const GAS bf16_t*)(ws + WS_SWIN) + (size_t)D * D, 1024, swA + 3 * 5 * 4096, 1024, wv, nw, lane);
}
__device__ __forceinline__ void sw_ffn_job(GAS unsigned char* ws, const GAS float* mods, int l, int wv, int nw, int lane) {
    sw_job(mods, l, 3, (const GAS bf16_t*)(ws + WS_W1) + (size_t)l * D * FF, 4096, (GAS float*)(ws + TAB_SWB) + l * 5 * 4096, 4096, wv, nw, lane);
}

constexpr int NPH = 28;
#ifndef MK_ALLCG
#define MK_ALLCG 0
#endif
__global__ void __launch_bounds__(512, 2) fwd(Args args) {
    extern __shared__ __attribute__((aligned(16))) unsigned char lds_raw[];
    LAS unsigned char* lds = (LAS unsigned char*)lds_raw;
    volatile LAS unsigned* MISC = (volatile LAS unsigned*)(lds + MISC_OFF);
    const int tid = threadIdx.x, lane = tid & 63, wave = __builtin_amdgcn_readfirstlane(tid >> 6);
    const int G = gridDim.x, bx = blockIdx.x, vcu = (G % 8 == 0) ? (bx % 8) * (G / 8) + bx / 8 : bx;
    GAS unsigned* ctl = (GAS unsigned*)((GAS unsigned char*)args.ws + WS_CTL);
    for (int u = tid; u < 64; u += 512) MISC[u] = 0u;
    __syncthreads();
    XcdBarrier bar = xcd_barrier_post(ctl + CW_BAR, MISC + 8);
#ifdef MK_RANGE
    const int lo = args.ph_lo, hi = args.ph_hi;
#else
    constexpr int lo = 0, hi = 27;
#endif
    int ph = 0;
#define IN_PH (lo <= ph && ph < hi)
#define SEAM() do { if (IN_PH && ph + 1 < hi) { if (ph == 0 || MK_ALLCG) cg::this_grid().sync(); else xcd_barrier(bar); } ++ph; } while (0)

    const int gw = vcu * 8 + wave, NGW = G * 8;
#define PH_PTRS() GAS unsigned char* ws = (GAS unsigned char*)args.ws; asm volatile("" : "+s"(ws)); \
    int tid_o_ = threadIdx.x; asm volatile("" : "+v"(tid_o_)); const int tid = tid_o_, lane = tid_o_ & 63; (void)tid; (void)lane; \
    GAS float* X = (GAS float*)args.out; GAS bf16_t* XN = (GAS bf16_t*)(ws + WS_XN); GAS float* mods = (GAS float*)(ws + WS_MODS); \
    GAS float* gsA = (GAS float*)(ws + TAB_GSA); GAS float* gsB = (GAS float*)(ws + TAB_GSB); GAS float* swA = (GAS float*)(ws + TAB_SWA); GAS float* swB = (GAS float*)(ws + TAB_SWB); \
    GAS float* rowss = (GAS float*)(ws + WS_ROWSS); GAS float* vstat = (GAS float*)(ws + WS_VSTAT); \
    GAS bf16_t* Hb = (GAS bf16_t*)(ws + WS_R); GAS bf16_t* UgS = (GAS bf16_t*)(ws + WS_R); GAS float* Sloc = (GAS float*)(ws + WS_R + 48 * MiB); GAS bf16_t* Zg = (GAS bf16_t*)(ws + WS_R + 48 * MiB); GAS bf16_t* A2 = (GAS bf16_t*)(ws + WS_R2); \
    (void)X; (void)XN; (void)mods; (void)gsA; (void)gsB; (void)swA; (void)swB; (void)rowss; (void)vstat; (void)Hb; (void)UgS; (void)Sloc; (void)Zg; (void)A2;
#define PH_LAYER() const GAS float* rs_mix = rowss + (size_t)(2 * layer) * M * 32; GAS float* rs_ffn = rowss + (size_t)(2 * layer + 1) * M * 32; GAS float* rs_next = rowss + (size_t)((2 * layer + 2) & 7) * M * 32; \
    const GAS float* modl = mods + (size_t)layer * 5 * 6144; (void)rs_mix; (void)rs_ffn; (void)rs_next; (void)modl;

    if (IN_PH) { PH_PTRS();
        const bool ssm_blk = bx < 128 && G == 256;
        if (G == 256) { if (bx < 128) ssm_build(args, bx >> 6, bx & 63, lds, ws); else for (int t = bx - 128; t < 192; t += 128) mods_task(args, mods, lds, t, tid); }
        else { for (int t = bx; t < 128; t += G) ssm_build(args, t >> 6, t & 63, lds, ws); for (int t = bx; t < 192; t += G) mods_task(args, mods, lds, t, tid); }
        __syncthreads();
        LAS float* scr = (LAS float*)(lds + wave * 16384);
        constexpr int I_W1 = 2048, I_W2 = 2048, I_SI = 512, I_SO = 1024, I_GI = 2048, I_GO = 1024, I_CI = 1536, I_CO = 512;
        constexpr int NT = 4 * I_W1 + 4 * I_W2 + 2 * I_SI + 2 * I_SO + I_GI + I_GO + I_CI + I_CO;
        const int nvw = G == 256 ? 3072 : NGW;
        const int vid0 = G == 256 ? (ssm_blk ? bx * 8 + wave : 1024 + ((bx - 128) * 8 + wave) * 2) : bx * 8 + wave;
        for (int rep = 0; rep < ((G == 256 && !ssm_blk) ? 2 : 1); ++rep)
        for (int it = vid0 + rep; it < NT; it += nvw) {
            int r = it;
            if (r < 4 * I_W1) { const int l = r / I_W1; transpose_item<0>(((const GAS float*)args.in[10]) + (size_t)l * D * FF, D, FF, (GAS bf16_t*)(ws + WS_W1) + (size_t)l * D * FF, scr, r % I_W1, lane); continue; } r -= 4 * I_W1;
            if (r < 4 * I_W2) { const int l = r / I_W2; transpose_item<0>(((const GAS float*)args.in[11]) + (size_t)l * D * FF, FF, D, (GAS bf16_t*)(ws + WS_W2) + (size_t)l * D * FF, scr, r % I_W2, lane); continue; } r -= 4 * I_W2;
            if (r < 2 * I_SI) { const int l = r / I_SI; transpose_item<0>(((const GAS float*)args.in[12]) + (size_t)l * D * D, D, D, (GAS bf16_t*)(ws + WS_SWIN) + (size_t)l * D * D, scr, r % I_SI, lane); continue; } r -= 2 * I_SI;
            if (r < 2 * I_SO) { const int l = r / I_SO; transpose_item<1>(((const GAS float*)args.in[21]) + (size_t)l * D * 2048, D, 2048, (GAS bf16_t*)(ws + WS_SWOUT) + (size_t)l * D * 2048, scr, r % I_SO, lane); continue; } r -= 2 * I_SO;
            if (r < I_GI) { transpose_item<0>(((const GAS float*)args.in[22]), D, 4096, (GAS bf16_t*)(ws + WS_GWIN), scr, r, lane); continue; } r -= I_GI;
            if (r < I_GO) { transpose_item<0>(((const GAS float*)args.in[25]), 2048, D, (GAS bf16_t*)(ws + WS_GWOUT), scr, r, lane); continue; } r -= I_GO;
            if (r < I_CI) { transpose_item<0>(((const GAS float*)args.in[26]), D, 3072, (GAS bf16_t*)(ws + WS_CWIN), scr, r, lane); continue; } r -= I_CI;
            transpose_item<0>(((const GAS float*)args.in[28]), D, D, (GAS bf16_t*)(ws + WS_CWOUT), scr, r, lane);
        }
        {
            const GAS float* s = ((const GAS float*)args.in[23]); GAS bf16_t* d = (GAS bf16_t*)(ws + WS_GWS);
            for (int i = (gw * 64 + lane) * 8; i < 16 * 128 * 128; i += NGW * 64 * 8) { const f32x4 a0 = *(const GAS f32x4*)(s + i), a1 = *(const GAS f32x4*)(s + i + 4);
                u32x4 o; o.x = pk2(a0[0], a0[1]); o.y = pk2(a0[2], a0[3]); o.z = pk2(a1[0], a1[1]); o.w = pk2(a1[2], a1[3]); *(GAS u32x4*)(d + i) = o; }
        }
        for (int row = gw; row < M; row += NGW) xinit_row(args, X, row, lane);
    }
    SEAM();
    if (IN_PH) { PH_PTRS();
        for (int i = gw * 64 + lane; i < 4 * 5 * 1024; i += NGW * 64) { const int l = i / 5120, ci = (i / 1024) % 5, c = i & 1023;
            const GAS float* md = mods + ((size_t)l * 5 + ci) * 6144;
            gsA[i] = ((const GAS float*)args.in[8])[l * 1024 + c] * (1.0f + md[1024 + c]); gsB[i] = ((const GAS float*)args.in[9])[l * 1024 + c] * (1.0f + md[4 * 1024 + c]); }
        sw_mix_job(ws, mods, 0, gw, NGW, lane);
        for (int row = gw; row < M; row += 3 * NGW) {
            const GAS float* gm = ((const GAS float*)args.in[8]);
            f32x4 v[3][4];
#pragma unroll
            for (int rr = 0; rr < 3; ++rr)
#pragma unroll
                for (int q = 0; q < 4; ++q) v[rr][q] = ((const GAS f32x4*)(X + (size_t)(row + rr * NGW) * D) + lane)[64 * q];
#pragma unroll
            for (int rr = 0; rr < 3; ++rr) {
                const int r = row + rr * NGW, ci = cond_of_row(r); const GAS float* md = mods + ((size_t)0 * 5 + ci) * 6144;
                float t = 0.f;
#pragma unroll
                for (int q = 0; q < 4; ++q) t += (v[rr][q][0] * v[rr][q][0] + v[rr][q][1] * v[rr][q][1]) + (v[rr][q][2] * v[rr][q][2] + v[rr][q][3] * v[rr][q][3]);
                t = wave_sum(t);
                if (lane < 32) rowss[(size_t)r * 32 + lane] = lane == 0 ? t : 0.f;
                GAS u32x2* o = (GAS u32x2*)(XN + (size_t)r * D) + lane;
#pragma unroll
                for (int q = 0; q < 4; ++q) { const int c = 256 * q + 4 * lane; const f32x4 gg = *(const GAS f32x4*)(gm + c), sc = *(const GAS f32x4*)(md + 1024 + c);
                    const f32x4 y = v[rr][q] * gg * (sc + 1.0f); u32x2 w; w.x = cvt_pk_bf16(y[0], y[1]); w.y = cvt_pk_bf16(y[2], y[3]); o[64 * q] = w; }
            }
        }
    }
    SEAM();
#pragma unroll 1
    for (int layer = 0; layer < 4; ++layer) {
        const int kind = layer % 3, j = layer / 3;
        if (kind == 0) {
            if (IN_PH) { PH_PTRS(); PH_LAYER(); const Gemm g = gemm_rowmajor(XN, D, (const GAS bf16_t*)(ws + WS_SWIN) + (size_t)j * D * D, D, D); StaticOrder S; S.init(M, D, G, bx);
                EpiU E{UgS, rs_mix, swA + layer * 5 * 4096}; gemm_phase<EpiU, ARowMajor, StaticOrder>(lds, g, S, E);
                if (layer == 0 && bx >= 192) sw_ffn_job(ws, mods, 0, (bx - 192) * 8 + wave, (G - 192) * 8, lane); }
            SEAM();
            if (IN_PH) { PH_PTRS(); PH_LAYER(); const Gemm g = gemm_rowmajor(UgS, 512, (const GAS bf16_t*)(ws + WS_BTS) + (size_t)j * 64 * 256 * 256, 256, 256); SsmOrder S{G, bx};
                EpiF32 E{Sloc, 256}; gemm_phase<EpiF32, ARowMajor, SsmOrder>(lds, g, S, E); }
            SEAM();
            if (IN_PH) { PH_PTRS(); PH_LAYER();
                const GAS float* lamT = (const GAS float*)(ws + TAB_LAMT);
                GAS float* new_re = (GAS float*)args.out + (size_t)M * D; GAS float* new_im = new_re + 32 * 2 * 2 * 64 * 64;
                for (int task = gw; task < 64 * 36 * 2; task += NGW) {
                    const int k = task & 1, seq = (task >> 1) % 36, g = task / 72;
                    const int c0 = seq < 32 ? seq * 16 : 512 + (seq - 32) * 64, nc = seq < 32 ? 16 : 64;
                    const float lr = lamT[(((size_t)j * 64 + g) * 2 + k) * 128 + 2 * lane], li = lamT[(((size_t)j * 64 + g) * 2 + k) * 128 + 2 * lane + 1];
                    float sr = 0.f, si = 0.f;
                    if (seq >= 32) { const size_t o = ((((size_t)(seq - 32) * 2 + j) * 2 + k) * 64 + g) * 64 + lane; sr = ((const GAS float*)args.in[2])[o]; si = ((const GAS float*)args.in[3])[o]; }
                    const GAS float* sl = Sloc + ((size_t)g * NCH) * 256 + k * 128 + lane;
                    GAS bf16_t* so = UgS + ((size_t)g * NCH) * 512 + 256 + k * 128 + lane;
                    for (int i = 0; i < nc; ++i) {
                        const int c = k == 0 ? c0 + i : c0 + nc - 1 - i;
                        so[(size_t)c * 512] = (bf16_t)f2bf(sr); so[(size_t)c * 512 + 64] = (bf16_t)f2bf(si);
                        const float ar = sl[(size_t)c * 256], ai = sl[(size_t)c * 256 + 64];
                        const float nr = lr * sr - li * si + ar, ni = lr * si + li * sr + ai; sr = nr; si = ni;
                    }
                    if (seq < 32) { const size_t o = ((((size_t)seq * 2 + j) * 2 + k) * 64 + g) * 64 + lane; new_re[o] = sr; new_im[o] = si; }
                }
            }
            SEAM();
            if (IN_PH) { PH_PTRS(); PH_LAYER(); const Gemm g = gemm_rowmajor(UgS, 512, (const GAS bf16_t*)(ws + WS_BTY) + (size_t)j * 64 * 256 * 512, 512, 512); SsmOrder S{G, bx};
                EpiY E{Zg}; gemm_phase<EpiY, ARowMajor, SsmOrder>(lds, g, S, E); }
            SEAM();
            if (IN_PH) { PH_PTRS(); PH_LAYER(); const Gemm g = gemm_groupchunk(Zg, (const GAS bf16_t*)(ws + WS_SWOUT) + (size_t)j * D * 2048, D, D); StaticOrder S; S.init(M, 2048, G, bx);
                EpiRes<true> E{X, XN, modl + 2 * 1024, gsB + layer * 5 * 1024, rs_ffn}; gemm_phase<EpiRes<true>, AGroupChunk, StaticOrder>(lds, g, S, E); }
            SEAM();
        } else if (kind == 1) {
            if (IN_PH) { PH_PTRS(); PH_LAYER(); const Gemm g = gemm_rowmajor(XN, D, (const GAS bf16_t*)(ws + WS_GWIN), D, D); StaticOrder S; S.init(M, 4096, G, bx);
                EpiIn<2> E{Hb, 4096, rs_mix, 16, swA + layer * 5 * 4096, 4096, vstat}; gemm_phase<EpiIn<2>, ARowMajor, StaticOrder>(lds, g, S, E); }
            SEAM();
            if (IN_PH) { PH_PTRS(); PH_LAYER();
                const GAS bf16_t* Wsb = (const GAS bf16_t*)(ws + WS_GWS); const GAS float* b_s = ((const GAS float*)args.in[24]);
                constexpr int VST = 288;
                for (int unit = vcu; unit < 96 * 16; unit += G) {
                    const int c = unit >> 4, g = unit & 15, row0 = c * 128;
                    __syncthreads();
                    LAS f32x2* mr = (LAS f32x2*)(lds + 128 * VST);
                    if (tid < 128) { const GAS f32x4* p = (const GAS f32x4*)(vstat + (size_t)(row0 + tid) * 128); float s1 = 0.f, s2 = 0.f;
#pragma unroll
                        for (int q = 0; q < 32; ++q) { const f32x4 v = p[q]; s1 += v[0] + v[2]; s2 += v[1] + v[3]; }
                        const float mu = s1 * (1.0f / 2048.0f), var = s2 * (1.0f / 2048.0f) - mu * mu; mr[tid] = (f32x2){mu, rsq_f(fmaxf(var, 0.f) + EPS)}; }
                    __syncthreads();
#pragma unroll
                    for (int i = 0; i < 4; ++i) { const int pc = tid + 512 * i, q = pc >> 4, d8 = pc & 15;
                        const u32x4 w = *(const GAS u32x4*)(Hb + (size_t)(row0 + q) * 4096 + 2048 + g * 128 + d8 * 8);
                        const f32x2 st = mr[q]; const float mu = st[0], rstd = st[1];
                        u32x4 o; o.x = cvt_pk_bf16((bf_lo(w.x) - mu) * rstd, (bf_hi(w.x) - mu) * rstd); o.y = cvt_pk_bf16((bf_lo(w.y) - mu) * rstd, (bf_hi(w.y) - mu) * rstd);
                        o.z = cvt_pk_bf16((bf_lo(w.z) - mu) * rstd, (bf_hi(w.z) - mu) * rstd); o.w = cvt_pk_bf16((bf_lo(w.w) - mu) * rstd, (bf_hi(w.w) - mu) * rstd);
                        *(LAS u32x4*)(lds + q * VST + d8 * 16) = o; }
                    __syncthreads();
                    f32x4 acc[8];
#pragma unroll
                    for (int nt = 0; nt < 8; ++nt) acc[nt] = (f32x4){0.f, 0.f, 0.f, 0.f};
                    const int fr = lane & 15, fq = lane >> 4;
#pragma unroll
                    for (int kk = 0; kk < 4; ++kk) {
                        const bf16x8 wf = *(const GAS bf16x8*)(Wsb + ((size_t)g * 128 + wave * 16 + fr) * 128 + kk * 32 + fq * 8);
#pragma unroll
                        for (int nt = 0; nt < 8; ++nt) {
                            const LAS unsigned char* p0 = lds + (kk * 32 + fq * 8 + (fr >> 2)) * VST + (nt * 16 + 4 * (fr & 3)) * 2;
                            const s16x4 lo4 = __builtin_bit_cast(s16x4, __builtin_amdgcn_ds_read_tr16_b64_v4i16((LAS s16x4*)p0));
                            const s16x4 hi4 = __builtin_bit_cast(s16x4, __builtin_amdgcn_ds_read_tr16_b64_v4i16((LAS s16x4*)(p0 + 4 * VST)));
                            const bf16x8 vf = {lo4[0], lo4[1], lo4[2], lo4[3], hi4[0], hi4[1], hi4[2], hi4[3]};
                            acc[nt] = __builtin_amdgcn_mfma_f32_16x16x32_bf16(vf, wf, acc[nt], 0, 0, 0);
                        }
                    }
                    const int p = wave * 16 + fr, row = row0 + p; const float bs = b_s[g * 128 + p];
#pragma unroll
                    for (int nt = 0; nt < 8; ++nt) { const int ch = g * 128 + nt * 16 + 4 * fq;
                        const u32x2 uu = *(const GAS u32x2*)(Hb + (size_t)row * 4096 + ch);
                        u32x2 o; o.x = cvt_pk_bf16(bf_lo(uu.x) * (acc[nt][0] + bs), bf_hi(uu.x) * (acc[nt][1] + bs)); o.y = cvt_pk_bf16(bf_lo(uu.y) * (acc[nt][2] + bs), bf_hi(uu.y) * (acc[nt][3] + bs));
                        *(GAS u32x2*)(A2 + (size_t)row * 2048 + ch) = o; }
                }
                __syncthreads();
            }
            SEAM();
            if (IN_PH) { PH_PTRS(); PH_LAYER(); const Gemm g = gemm_rowmajor(A2, 2048, (const GAS bf16_t*)(ws + WS_GWOUT), 2048, 2048); StaticOrder S; S.init(M, D, G, bx);
                EpiRes<false> E{X, XN, modl + 2 * 1024, gsB + layer * 5 * 1024, rs_ffn}; gemm_phase<EpiRes<false>, ARowMajor, StaticOrder>(lds, g, S, E); }
            SEAM();
        } else {
            if (IN_PH) { PH_PTRS(); PH_LAYER(); const Gemm g = gemm_rowmajor(XN, D, (const GAS bf16_t*)(ws + WS_CWIN), D, D); StaticOrder S; S.init(M, 3072, G, bx);
                EpiIn<0> E{Hb, 3072, rs_mix, 16, swA + layer * 5 * 4096, 3072, nullptr}; gemm_phase<EpiIn<0>, ARowMajor, StaticOrder>(lds, g, S, E); }
            SEAM();
            if (IN_PH) { PH_PTRS(); PH_LAYER();
                const GAS float* cw = ((const GAS float*)args.in[27]);
                for (int it = gw * 64 + lane; it < M * 128; it += NGW * 64) {
                    const int row = it >> 7, c8 = (it & 127) * 8;
                    const int L = row < MP ? 256 : 1024, t = row < MP ? (row & 255) : ((row - MP) & 1023);
                    const GAS bf16_t* pr = Hb + (size_t)row * 3072 + c8;
                    float y[8];
#pragma unroll
                    for (int q = 0; q < 8; ++q) y[q] = 0.f;
#pragma unroll
                    for (int w = 0; w < 3; ++w) { const int tt = t + w - 1; if (tt < 0 || tt >= L) continue;
                        const u32x4 gc = *(const GAS u32x4*)(pr + (ptrdiff_t)(w - 1) * 3072 + 1024), xh = *(const GAS u32x4*)(pr + (ptrdiff_t)(w - 1) * 3072 + 2048);
                        const f32x4 k0 = *(const GAS f32x4*)(cw + w * 1024 + c8), k1 = *(const GAS f32x4*)(cw + w * 1024 + c8 + 4);
                        y[0] += k0[0] * bf_lo(gc.x) * bf_lo(xh.x); y[1] += k0[1] * bf_hi(gc.x) * bf_hi(xh.x); y[2] += k0[2] * bf_lo(gc.y) * bf_lo(xh.y); y[3] += k0[3] * bf_hi(gc.y) * bf_hi(xh.y);
                        y[4] += k1[0] * bf_lo(gc.z) * bf_lo(xh.z); y[5] += k1[1] * bf_hi(gc.z) * bf_hi(xh.z); y[6] += k1[2] * bf_lo(gc.w) * bf_lo(xh.w); y[7] += k1[3] * bf_hi(gc.w) * bf_hi(xh.w); }
                    const u32x4 gb = *(const GAS u32x4*)pr;
                    u32x4 o; o.x = cvt_pk_bf16(bf_lo(gb.x) * y[0], bf_hi(gb.x) * y[1]); o.y = cvt_pk_bf16(bf_lo(gb.y) * y[2], bf_hi(gb.y) * y[3]);
                    o.z = cvt_pk_bf16(bf_lo(gb.z) * y[4], bf_hi(gb.z) * y[5]); o.w = cvt_pk_bf16(bf_lo(gb.w) * y[6], bf_hi(gb.w) * y[7]);
                    *(GAS u32x4*)(A2 + (size_t)row * D + c8) = o;
                }
            }
            SEAM();
            if (IN_PH) { PH_PTRS(); PH_LAYER(); const Gemm g = gemm_rowmajor(A2, D, (const GAS bf16_t*)(ws + WS_CWOUT), D, D); StaticOrder S; S.init(M, D, G, bx);
                EpiRes<false> E{X, XN, modl + 2 * 1024, gsB + layer * 5 * 1024, rs_ffn}; gemm_phase<EpiRes<false>, ARowMajor, StaticOrder>(lds, g, S, E); }
            SEAM();
        }
        if (IN_PH) { PH_PTRS(); PH_LAYER(); const Gemm g = gemm_rowmajor(XN, D, (const GAS bf16_t*)(ws + WS_W1) + (size_t)layer * D * FF, D, D); StaticOrder S; S.init(M, FF, G, bx);
            EpiIn<1> E{Hb, FF, rs_ffn, kind == 0 ? 32 : 16, swB + layer * 5 * 4096, 4096, nullptr}; gemm_phase<EpiIn<1>, ARowMajor, StaticOrder>(lds, g, S, E); }
        SEAM();
        if (IN_PH) { PH_PTRS(); PH_LAYER(); const Gemm g = gemm_rowmajor(Hb, FF, (const GAS bf16_t*)(ws + WS_W2) + (size_t)layer * D * FF, FF, FF); StaticOrder S; S.init(M, D, G, bx);
            EpiRes<false> E{X, XN, modl + 5 * 1024, layer < 3 ? gsA + (layer + 1) * 5 * 1024 : nullptr, rs_next}; gemm_phase<EpiRes<false>, ARowMajor, StaticOrder>(lds, g, S, E);
            if (layer < 3 && bx >= 192) { sw_mix_job(ws, mods, layer + 1, (bx - 192) * 8 + wave, (G - 192) * 8, lane); sw_ffn_job(ws, mods, layer + 1, (bx - 192) * 8 + wave, (G - 192) * 8, lane); } }
        SEAM();
    }
    if (IN_PH) { PH_PTRS();
        const GAS float* gf = ((const GAS float*)args.in[29]);
        for (int row = gw; row < M; row += 3 * NGW) {
            f32x4 v[3][4];
#pragma unroll
            for (int rr = 0; rr < 3; ++rr)
#pragma unroll
                for (int q = 0; q < 4; ++q) v[rr][q] = ((const GAS f32x4*)(X + (size_t)(row + rr * NGW) * D) + lane)[64 * q];
            f32x4 gq[4];
#pragma unroll
            for (int q = 0; q < 4; ++q) gq[q] = *(const GAS f32x4*)(gf + 256 * q + 4 * lane);
#pragma unroll
            for (int rr = 0; rr < 3; ++rr) { float t = 0.f;
#pragma unroll
                for (int q = 0; q < 4; ++q) t += (v[rr][q][0] * v[rr][q][0] + v[rr][q][1] * v[rr][q][1]) + (v[rr][q][2] * v[rr][q][2] + v[rr][q][3] * v[rr][q][3]);
                t = wave_sum(t); const float r0 = rsq_f(t * (1.0f / D) + EPS);
                GAS f32x4* xr = (GAS f32x4*)(X + (size_t)(row + rr * NGW) * D) + lane;
#pragma unroll
                for (int q = 0; q < 4; ++q) xr[64 * q] = v[rr][q] * r0 * gq[q]; }
        }
    }
    ++ph;
#undef IN_PH
#undef SEAM
}

static bool launch(void* const* d_in, float* out, unsigned char* ws, int lo, int hi, hipStream_t stream) {
    static int grid = 0;
    if (grid == 0) {
        int dev = 0, cus = 0, per_cu = 0;
        if (hipGetDevice(&dev) != hipSuccess || hipDeviceGetAttribute(&cus, hipDeviceAttributeMultiprocessorCount, dev) != hipSuccess) { grid = -1; return false; }
        if (hipFuncSetAttribute((const void*)fwd, hipFuncAttributeMaxDynamicSharedMemorySize, LDS_BYTES) != hipSuccess) { fprintf(stderr, "hipFuncSetAttribute failed\n"); grid = -1; return false; }
        if (hipOccupancyMaxActiveBlocksPerMultiprocessor(&per_cu, (const void*)fwd, 512, LDS_BYTES) != hipSuccess || per_cu < 1) { fprintf(stderr, "occupancy query: %d\n", per_cu); (void)hipGetLastError(); per_cu = 1; }
        grid = cus;
    }
    if (grid < 0) return false;
    Args a{};
    for (int i = 0; i < 30; ++i) a.in[i] = (const float*)d_in[i];
    a.out = out; a.ws = ws; a.ph_lo = lo; a.ph_hi = hi;
    void* kargs[] = {&a};
    const hipError_t e = hipLaunchCooperativeKernel((const void*)fwd, dim3(grid), dim3(512), kargs, LDS_BYTES, stream);
    if (e != hipSuccess) { fprintf(stderr, "cooperative launch failed: %s (grid %d)\n", hipGetErrorString(e), grid); return false; }
    return true;
}
}
extern "C" void kernel_launch(void* const* d_in, const int* in_sizes, int n_in, void* d_out, int out_size, void* d_ws, size_t ws_size, hipStream_t stream) {
    if (n_in != 30 || ws_size < mk::WS_END) { fprintf(stderr, "kernel_launch: unexpected n_in %d / ws %zu\n", n_in, ws_size); return; }
    (void)hipMemsetAsync((char*)d_ws + mk::WS_CTL, 0, mk::CTL_BYTES, stream);
    mk::launch(d_in, (float*)d_out, (unsigned char*)d_ws, 0, 27, stream);
}
```

```cpp
#include <hip/hip_runtime.h>
#include <cstdio>
#include <cstdint>
#include <hip/hip_cooperative_groups.h>
namespace mk {
namespace cg = cooperative_groups;
#define LAS __attribute__((address_space(3)))
#define GAS __attribute__((address_space(1)))
typedef unsigned short bf16_t;
typedef short bf16x8 __attribute__((ext_vector_type(8)));
typedef short s16x4 __attribute__((ext_vector_type(4)));
typedef float f32x4 __attribute__((ext_vector_type(4)));
typedef float f32x2 __attribute__((ext_vector_type(2)));
typedef unsigned u32x4 __attribute__((ext_vector_type(4)));
typedef unsigned u32x2 __attribute__((ext_vector_type(2)));

constexpr int D = 1024, M = 12288, MP = 8192, FF = 4096, NCH = 768;
constexpr float EPS = 1e-6f;
constexpr int BM = 256, BK = 64, HALF = 128, HTB = HALF * BK * 2, STAGE_BYTES = 8 * HTB, NXCD = 8, WGM = 8;

typedef __bf16 bf16x2_t __attribute__((ext_vector_type(2)));
__device__ __forceinline__ unsigned cvt_pk_bf16(float lo, float hi) { const f32x2 v = {lo, hi}; const bf16x2_t b = __builtin_convertvector(v, bf16x2_t); return __builtin_bit_cast(unsigned, b); }
__device__ __forceinline__ unsigned f2bf(float f) { unsigned u = __builtin_bit_cast(unsigned, f); return (u + 0x7fffu + ((u >> 16) & 1u)) >> 16; }
__device__ __forceinline__ float bf_lo(unsigned w) { return __uint_as_float(w << 16); }
__device__ __forceinline__ float bf_hi(unsigned w) { return __uint_as_float(w & 0xffff0000u); }
__device__ __forceinline__ float rcp_f(float x) { return __builtin_amdgcn_rcpf(x); }
__device__ __forceinline__ float rsq_f(float x) { return __builtin_amdgcn_rsqf(x); }
__device__ __forceinline__ float gelu_tanh(float x) {
    const float t = x * x * (0.044715f * -2.0f * 0.7978845608028654f * 1.4426950408889634f) + (-2.0f * 0.7978845608028654f * 1.4426950408889634f);
    return x * rcp_f(1.0f + __builtin_amdgcn_exp2f(x * t));
}
__device__ __forceinline__ float sigmoid_f(float x) { return rcp_f(1.0f + __builtin_amdgcn_exp2f(x * -1.4426950408889634f)); }
__device__ __forceinline__ int cond_of_pm(int pm) { return pm < 32 ? 0 : 1 + ((pm - 32) >> 2); }
__device__ __forceinline__ int cond_of_row(int row) { return row < MP ? 0 : 1 + ((row - MP) >> 10); }

__host__ __device__ __forceinline__ int lds_byte(int r, int c) { const int st = (r >> 4) * 2 + (c >> 5), rr = r & 15, cc = c & 31, ob = rr * 64 + cc * 2; return st * 1024 + (ob ^ (((ob >> 9) & 1) << 5)); }
__host__ __device__ __forceinline__ void stage_rc(int b, int& R, int& C) { const int st = b / 1024, sb = b % 1024, swz = sb ^ (((sb >> 9) & 1) << 5); R = (st >> 1) * 16 + swz / 64; C = (st & 1) * 32 + (swz % 64) / 2; }
__host__ __device__ __forceinline__ int perm32(int rho) { const int n = rho >> 4, i = rho & 15; return 8 * (i >> 2) + 4 * n + (i & 3); }

struct Unit { int pm, pn; };
struct Gemm { const GAS char* A; const GAS char* Bt; int K; int lda; int ldb; size_t kstepA, hstepA, tstepA; };
struct ARowMajor { static __device__ __forceinline__ unsigned voff(int R, int C, int lda) { return (unsigned)(R * lda + C) * 2u; } };
struct AGroupChunk { static __device__ __forceinline__ unsigned voff(int R, int C, int) { return (unsigned)((((C >> 4) * NCH + (R >> 4)) * 256) + (R & 15) * 16 + (C & 15)) * 2u; } };
__device__ inline Gemm gemm_rowmajor(const GAS void* A, int lda, const GAS void* Bt, int ldb, int K) {
    Gemm g; g.A = (const GAS char*)A; g.Bt = (const GAS char*)Bt; g.K = K; g.lda = lda; g.ldb = ldb; g.kstepA = BK * 2; g.hstepA = (size_t)HALF * lda * 2; g.tstepA = 2 * g.hstepA; return g; }
__device__ inline Gemm gemm_groupchunk(const GAS void* A, const GAS void* Bt, int ldb, int K) {
    Gemm g; g.A = (const GAS char*)A; g.Bt = (const GAS char*)Bt; g.K = K; g.lda = 0; g.ldb = ldb; g.kstepA = (size_t)4 * NCH * 256 * 2; g.hstepA = 8 * 256 * 2; g.tstepA = 16 * 256 * 2; return g; }

struct StaticOrder {
    int nM, nN, nwg, G, c;
    __host__ __device__ void init(int M_, int N_, int G_, int c_) { nM = M_ / BM; nN = N_ / BM; nwg = nM * nN; G = G_; c = c_; }
    __host__ __device__ bool next(int i, Unit& u) const {
        const long L = (long)i * G + c; if (L >= nwg) return false;
        int wgid = (int)L; { const int q = nwg / NXCD, r = nwg % NXCD, xcd = wgid % NXCD, off = wgid / NXCD; wgid = (xcd < r ? xcd * (q + 1) : r * (q + 1) + (xcd - r) * q) + off; }
        const int nig = WGM * nN, gid = wgid / nig, fm = gid * WGM, gsz = (nM - fm) < WGM ? (nM - fm) : WGM;
        u.pm = fm + ((wgid % nig) % gsz); u.pn = (wgid % nig) / gsz; return true;
    }
};
struct SsmOrder {
    int G, c;
    __host__ __device__ bool next(int i, Unit& u) const { const int L = i * G + c; if (L >= 192) return false; u.pm = L; u.pn = L / 3; return true; }
};

template <class Epi, class AL, class Sched>
__device__ __forceinline__ void gemm_phase(LAS unsigned char* lds, const Gemm g, const Sched& S, const Epi& E) {
    int tid = threadIdx.x; asm volatile("" : "+v"(tid));
    const int wid = __builtin_amdgcn_readfirstlane(tid >> 6), lane = tid & 63, wr = wid >> 2, wc = wid & 3, fr = lane & 15, fq = lane >> 4;
    const int K = g.K, nt = K / BK;
    unsigned voffA[2], voffB[2];
#pragma unroll
    for (int i = 0; i < 2; ++i) { int R, C; stage_rc(tid * 16 + i * 8192, R, C); const int Rb = Epi::PERM ? ((R & ~31) + perm32(R & 31)) : R;
        voffA[i] = AL::voff(R, C, g.lda); voffB[i] = (unsigned)(Rb * g.ldb + C) * 2u; }
    const size_t kstepA = g.kstepA, hstepA = g.hstepA, tstepA = g.tstepA;
    const size_t kstepB = (size_t)(BK * 2), hstepB = (size_t)HALF * g.ldb * 2, tstepB = 2 * hstepB;
    const unsigned ldsw = (unsigned)wid * 1024u;
    const int aoff = lds_byte(wr * 64 + fr, fq * 8), boff = lds_byte(wc * 32 + fr, fq * 8);
#define PG8_SA(b, h) (((b) * 2 + (h)) * HTB)
#define PG8_SB(b, h) ((4 + (b) * 2 + (h)) * HTB)
#define PG8_STAGE(bufoff, gbase, voff) do { _Pragma("unroll") for (int _i = 0; _i < 2; ++_i) \
        __builtin_amdgcn_global_load_lds((const GAS unsigned*)((const GAS char*)(gbase) + (voff)[_i]), (LAS unsigned*)(lds + (bufoff) + ldsw + _i * 8192), 16, 0, 0); } while (0)
#define PG8_LDA(dst, b, h) do { _Pragma("unroll") for (int m = 0; m < 4; ++m) _Pragma("unroll") for (int k = 0; k < 2; ++k) dst[m][k] = *(const LAS bf16x8*)(lds + PG8_SA(b, h) + aoff + m * 2048 + k * 1024); } while (0)
#define PG8_LDB(dst, b, h) do { _Pragma("unroll") for (int n = 0; n < 2; ++n) _Pragma("unroll") for (int k = 0; k < 2; ++k) dst[n][k] = *(const LAS bf16x8*)(lds + PG8_SB(b, h) + boff + n * 2048 + k * 1024); } while (0)
#define PG8_MMA(ai, bj, At, Bt) do { __builtin_amdgcn_s_setprio(1); _Pragma("unroll") for (int m = 0; m < 4; ++m) _Pragma("unroll") for (int n = 0; n < 2; ++n) _Pragma("unroll") for (int k = 0; k < 2; ++k) \
        acc[ai][bj][m][n] = __builtin_amdgcn_mfma_f32_16x16x32_bf16(Bt[n][k], At[m][k], acc[ai][bj][m][n], 0, 0, 0); __builtin_amdgcn_s_setprio(0); } while (0)
#define PG8_WAIT_V(n) asm volatile("s_waitcnt vmcnt(" #n ")" ::: "memory")
#define PG8_WAIT_L(n) asm volatile("s_waitcnt lgkmcnt(" #n ")" ::: "memory")
#define PG8_BAR __builtin_amdgcn_s_barrier()
#define PG8_SCHED __builtin_amdgcn_sched_barrier(0)
    Unit cur, nxt; int ui = 0;
    if (!S.next(0, cur)) return;
    f32x4 acc[2][2][4][2];
#pragma unroll
    for (int a = 0; a < 2; ++a)
#pragma unroll
        for (int b = 0; b < 2; ++b)
#pragma unroll
            for (int m = 0; m < 4; ++m)
#pragma unroll
                for (int n = 0; n < 2; ++n) acc[a][b][m][n] = (f32x4){0.f, 0.f, 0.f, 0.f};
    bf16x8 At[4][2], B0[2][2], B1[2][2];
    const GAS char* cA = g.A + (size_t)cur.pm * tstepA; const GAS char* cB = g.Bt + (size_t)cur.pn * tstepB;
    PG8_STAGE(PG8_SB(0, 0), cB, voffB); PG8_STAGE(PG8_SB(0, 1), cB + hstepB, voffB); PG8_STAGE(PG8_SA(0, 0), cA, voffA); PG8_STAGE(PG8_SA(0, 1), cA + hstepA, voffA);
    if (wr == 1) PG8_BAR;
    PG8_WAIT_V(2); PG8_BAR;
    PG8_STAGE(PG8_SB(1, 0), cB + kstepB, voffB); PG8_STAGE(PG8_SA(1, 0), cA + kstepA, voffA); PG8_STAGE(PG8_SB(1, 1), cB + hstepB + kstepB, voffB);
    PG8_WAIT_V(6); PG8_BAR;
    for (;;) {
        const bool has_next = S.next(ui + 1, nxt);
        const GAS char* nA = has_next ? g.A + (size_t)nxt.pm * tstepA : cA; const GAS char* nB = has_next ? g.Bt + (size_t)nxt.pn * tstepB : cB;
        for (int t = 0; t < nt; t += 2) {
            const bool last = (t == nt - 2);
            const GAS char* a1 = cA + (size_t)(t + 1) * kstepA;
            const GAS char* a2 = last ? nA : cA + (size_t)(t + 2) * kstepA; const GAS char* b2 = last ? nB : cB + (size_t)(t + 2) * kstepB;
            const GAS char* a3 = a2 + kstepA; const GAS char* b3 = b2 + kstepB;
            PG8_LDB(B0, 0, 0); PG8_LDB(B1, 0, 1); PG8_SCHED; PG8_LDA(At, 0, 0); PG8_STAGE(PG8_SA(1, 1), a1 + hstepA, voffA);
            PG8_WAIT_V(8); PG8_WAIT_L(0); PG8_BAR; PG8_MMA(0, 0, At, B0); PG8_MMA(0, 1, At, B1); PG8_BAR; PG8_SCHED;
            PG8_LDA(At, 0, 1); PG8_STAGE(PG8_SB(0, 0), b2, voffB); PG8_STAGE(PG8_SB(0, 1), b2 + hstepB, voffB); PG8_STAGE(PG8_SA(0, 0), a2, voffA);
            PG8_WAIT_V(8); PG8_WAIT_L(0); PG8_BAR; PG8_MMA(1, 0, At, B0); PG8_MMA(1, 1, At, B1); PG8_BAR; PG8_SCHED;
            PG8_LDB(B0, 1, 0); PG8_LDB(B1, 1, 1); PG8_SCHED; PG8_LDA(At, 1, 0); PG8_STAGE(PG8_SA(0, 1), a2 + hstepA, voffA);
            PG8_WAIT_V(8); PG8_WAIT_L(0); PG8_BAR; PG8_MMA(0, 0, At, B0); PG8_MMA(0, 1, At, B1); PG8_BAR; PG8_SCHED;
            PG8_LDA(At, 1, 1); PG8_STAGE(PG8_SB(1, 0), b3, voffB); PG8_STAGE(PG8_SB(1, 1), b3 + hstepB, voffB); PG8_STAGE(PG8_SA(1, 0), a3, voffA);
            PG8_WAIT_V(8); PG8_WAIT_L(0); PG8_BAR; PG8_MMA(1, 0, At, B0); PG8_MMA(1, 1, At, B1); PG8_BAR; PG8_SCHED;
        }
        if (wr == 0) PG8_BAR;
        if constexpr (!Epi::AFTER_DRAIN) E(acc, cur, wr, wc, fr, fq);
        if (!has_next) break;
#pragma unroll
        for (int a = 0; a < 2; ++a)
#pragma unroll
            for (int b = 0; b < 2; ++b)
#pragma unroll
                for (int m = 0; m < 4; ++m)
#pragma unroll
                    for (int n = 0; n < 2; ++n) acc[a][b][m][n] = (f32x4){0.f, 0.f, 0.f, 0.f};
        cur = nxt; cA = nA; cB = nB; ++ui;
        if (wr == 1) PG8_BAR;
    }
    PG8_WAIT_V(0);
    PG8_BAR;
    if constexpr (Epi::AFTER_DRAIN) E.fused(acc, cur, wr, wc, fr, fq, lds, tid);
#undef PG8_SA
#undef PG8_SB
#undef PG8_STAGE
#undef PG8_LDA
#undef PG8_LDB
#undef PG8_MMA
#undef PG8_WAIT_V
#undef PG8_WAIT_L
#undef PG8_BAR
#undef PG8_SCHED
}

typedef const f32x4 (&AccRef)[2][2][4][2];

__device__ __forceinline__ void load_rstd(const GAS float* rowss, int ns, int row0, int fq, float (&rs)[2][4]) {
    f32x4 a[2][4];
#pragma unroll
    for (int ai = 0; ai < 2; ++ai)
#pragma unroll
        for (int m = 0; m < 4; ++m) { const GAS f32x4* p = (const GAS f32x4*)(rowss + (size_t)(row0 + ai * HALF + m * 16) * 32) + fq; a[ai][m] = p[0] + p[4]; }
#pragma unroll
    for (int ai = 0; ai < 2; ++ai)
#pragma unroll
        for (int m = 0; m < 4; ++m) { float t = (a[ai][m][0] + a[ai][m][1]) + (a[ai][m][2] + a[ai][m][3]); t += __shfl_xor(t, 16); t += __shfl_xor(t, 32);
            rs[ai][m] = rsq_f(t * (1.0f / D) + EPS); }
}

template <int ACT> struct EpiIn {
    static constexpr bool PERM = true, AFTER_DRAIN = false;
    GAS bf16_t* O; int ldc; const GAS float* rowss; int ns; const GAS float* sw; int swld; GAS float* vstat;
    __device__ __forceinline__ void operator()(AccRef acc, const Unit& u, int wr, int wc, int fr, int fq) const {
        const int row0 = u.pm * BM + wr * 64 + fr, col0 = u.pn * BM + wc * 32 + 8 * fq;
        float rs[2][4]; load_rstd(rowss, ns, row0, fq, rs);
        const GAS float* swp = sw + (unsigned)(cond_of_pm(u.pm) * swld + col0);
        const bool stats = ACT == 2 && u.pn >= 8;
#pragma unroll
        for (int bj = 0; bj < 2; ++bj) {
            const f32x4 b0 = *(const GAS f32x4*)(swp + bj * HALF), b1 = *(const GAS f32x4*)(swp + bj * HALF + 4);
#pragma unroll
            for (int ai = 0; ai < 2; ++ai)
#pragma unroll
                for (int m = 0; m < 4; ++m) {
                    const unsigned r = (unsigned)(row0 + ai * HALF + m * 16);
                    f32x4 v0 = acc[ai][bj][m][0] * rs[ai][m] + b0, v1 = acc[ai][bj][m][1] * rs[ai][m] + b1;
                    if (ACT == 1) {
#pragma unroll
                        for (int j = 0; j < 4; ++j) { const float a = fmaxf(v0[j], 0.f), b = fmaxf(v1[j], 0.f); v0[j] = a * a; v1[j] = b * b; } }
                    if (ACT == 2) {
#pragma unroll
                        for (int j = 0; j < 4; ++j) { v0[j] = gelu_tanh(v0[j]); v1[j] = gelu_tanh(v1[j]); } }
                    u32x4 w; w.x = cvt_pk_bf16(v0[0], v0[1]); w.y = cvt_pk_bf16(v0[2], v0[3]); w.z = cvt_pk_bf16(v1[0], v1[1]); w.w = cvt_pk_bf16(v1[2], v1[3]);
                    *(GAS u32x4*)(O + (r * (unsigned)ldc + (unsigned)(col0 + bj * HALF))) = w;
                    if (ACT == 2) { if (stats) {
                        float a = (v0[0] + v0[1]) + (v0[2] + v0[3]) + (v1[0] + v1[1]) + (v1[2] + v1[3]);
                        float b = (v0[0] * v0[0] + v0[1] * v0[1]) + (v0[2] * v0[2] + v0[3] * v0[3]) + (v1[0] * v1[0] + v1[1] * v1[1]) + (v1[2] * v1[2] + v1[3] * v1[3]);
                        a += __shfl_xor(a, 16); a += __shfl_xor(a, 32); b += __shfl_xor(b, 16); b += __shfl_xor(b, 32);
                        if (fq == 0) *(GAS f32x2*)(vstat + (r * 64u + (unsigned)(((u.pn - 8) * 2 + bj) * 4 + wc)) * 2u) = (f32x2){a, b}; } }
                }
        }
    }
};
struct EpiU {
    static constexpr bool PERM = true, AFTER_DRAIN = false;
    GAS bf16_t* UgS; const GAS float* rowss; const GAS float* sw;
    __device__ __forceinline__ void operator()(AccRef acc, const Unit& u, int wr, int wc, int fr, int fq) const {
        const int row0 = u.pm * BM + wr * 64 + fr, col0 = u.pn * BM + wc * 32 + 8 * fq;
        float rs[2][4]; load_rstd(rowss, 16, row0, fq, rs);
        const GAS float* swp = sw + (size_t)cond_of_pm(u.pm) * 1024 + col0;
#pragma unroll
        for (int bj = 0; bj < 2; ++bj) {
            const f32x4 b0 = *(const GAS f32x4*)(swp + bj * HALF), b1 = *(const GAS f32x4*)(swp + bj * HALF + 4);
            const int g = (col0 + bj * HALF) >> 4, p0 = (col0 & 15);
#pragma unroll
            for (int ai = 0; ai < 2; ++ai)
#pragma unroll
                for (int m = 0; m < 4; ++m) {
                    const f32x4 v0 = acc[ai][bj][m][0] * rs[ai][m] + b0, v1 = acc[ai][bj][m][1] * rs[ai][m] + b1;
                    u32x4 w; w.x = cvt_pk_bf16(v0[0], v0[1]); w.y = cvt_pk_bf16(v0[2], v0[3]); w.z = cvt_pk_bf16(v1[0], v1[1]); w.w = cvt_pk_bf16(v1[2], v1[3]);
                    const int chunk = u.pm * 16 + ai * 8 + wr * 4 + m;
                    *(GAS u32x4*)(UgS + ((size_t)g * NCH + chunk) * 512 + fr * 16 + p0) = w;
                }
        }
    }
};
struct EpiScan {
    static constexpr bool PERM = true, AFTER_DRAIN = true;
    GAS bf16_t* UgS; const GAS float* lamT; const GAS float* h0_re; const GAS float* h0_im; GAS float* new_re; GAS float* new_im; int j;
    static __device__ __forceinline__ int lidx(int row, int col) { return row * 128 + ((((col >> 2) ^ row) & 31) << 2) + (col & 3); }
    __device__ __forceinline__ void fused(AccRef acc, const Unit& u, int wr, int wc, int fr, int fq, LAS unsigned char* lds, int tid) const {
        LAS float* T = (LAS float*)lds;
        const int g = u.pn, mt = u.pm - 3 * g, n = tid & 63, slot = __builtin_amdgcn_readfirstlane(tid >> 6);
        const int len = mt < 2 ? 16 : 64, nsq = mt < 2 ? 2 : (slot < 4 ? 1 : 0), sl0 = mt < 2 ? slot * 2 : slot;
#pragma unroll 1
        for (int k = 0; k < 2; ++k) {
#pragma unroll
            for (int ai = 0; ai < 2; ++ai)
#pragma unroll
                for (int m = 0; m < 4; ++m) { const int row = ai * HALF + wr * 64 + m * 16 + fr;
#pragma unroll
                    for (int nn = 0; nn < 2; ++nn) { const int col = wc * 32 + 8 * fq + 4 * nn; *(LAS f32x4*)(T + lidx(row, col)) = k == 0 ? acc[ai][0][m][nn] : acc[ai][1][m][nn]; } }
            __syncthreads();
            const float lr = lamT[(((unsigned)j * 64 + g) * 2 + k) * 128 + 2 * n], li = lamT[(((unsigned)j * 64 + g) * 2 + k) * 128 + 2 * n + 1];
            for (int q = 0; q < nsq; ++q) {
                const int sl = sl0 + q, r0 = sl * len;
                float sr = 0.f, si = 0.f;
                if (mt == 2) { const unsigned o = ((((unsigned)sl * 2 + j) * 2 + k) * 64 + g) * 64 + n; sr = h0_re[o]; si = h0_im[o]; }
                GAS bf16_t* so = UgS + ((size_t)g * NCH + mt * 256) * 512 + 256 + k * 128 + n;
                for (int i = 0; i < len; ++i) {
                    const int row = k == 0 ? r0 + i : r0 + len - 1 - i;
                    so[(unsigned)row * 512u] = (bf16_t)f2bf(sr); so[(unsigned)row * 512u + 64u] = (bf16_t)f2bf(si);
                    const float ar = T[lidx(row, n)], ai2 = T[lidx(row, 64 + n)];
                    const float nr = lr * sr - li * si + ar, ni = lr * si + li * sr + ai2; sr = nr; si = ni;
                }
                if (mt < 2) { const unsigned o = ((((unsigned)(mt * 16 + sl) * 2 + j) * 2 + k) * 64 + g) * 64 + n; new_re[o] = sr; new_im[o] = si; }
            }
            __syncthreads();
        }
    }
};
struct EpiY {
    static constexpr bool PERM = true, AFTER_DRAIN = false;
    GAS bf16_t* Zg;
    __device__ __forceinline__ void operator()(AccRef acc, const Unit& u, int wr, int wc, int fr, int fq) const {
        const int row0 = u.pm * BM + wr * 64 + fr, col0 = wc * 32 + 8 * fq;
#pragma unroll
        for (int ai = 0; ai < 2; ++ai)
#pragma unroll
            for (int m = 0; m < 4; ++m) { GAS bf16_t* rp = Zg + (size_t)(row0 + ai * HALF + m * 16) * 256 + col0;
#pragma unroll
                for (int bj = 0; bj < 2; ++bj) { const f32x4 v0 = acc[ai][bj][m][0], v1 = acc[ai][bj][m][1];
                    u32x4 w; w.x = cvt_pk_bf16(gelu_tanh(v0[0]), gelu_tanh(v0[1])); w.y = cvt_pk_bf16(gelu_tanh(v0[2]), gelu_tanh(v0[3]));
                    w.z = cvt_pk_bf16(gelu_tanh(v1[0]), gelu_tanh(v1[1])); w.w = cvt_pk_bf16(gelu_tanh(v1[2]), gelu_tanh(v1[3]));
                    *(GAS u32x4*)(rp + bj * HALF) = w; } }
    }
};
template <bool GATED> struct EpiRes {
    static constexpr bool PERM = true, AFTER_DRAIN = false;
    GAS float* X; GAS bf16_t* XN; const GAS float* gate; const GAS float* gsn; GAS float* rowss_next;
    __device__ __forceinline__ void operator()(AccRef acc, const Unit& u, int wr, int wc, int fr, int fq) const {
        constexpr int NB = GATED ? 1 : 2;
        const int row0 = u.pm * BM + wr * 64 + fr, col0 = u.pn * (GATED ? HALF : BM) + wc * 32 + 8 * fq;
        const int ci = cond_of_pm(u.pm);
#pragma unroll
        for (int bj = 0; bj < NB; ++bj) {
            const int col = col0 + bj * HALF;
            const f32x4 g0 = *(const GAS f32x4*)(gate + (size_t)ci * 6144 + col), g1 = *(const GAS f32x4*)(gate + (size_t)ci * 6144 + col + 4);
            f32x4 n0 = {0.f, 0.f, 0.f, 0.f}, n1 = n0;
            if (gsn) { n0 = *(const GAS f32x4*)(gsn + ci * 1024 + col); n1 = *(const GAS f32x4*)(gsn + ci * 1024 + col + 4); }
#pragma unroll
            for (int ai = 0; ai < 2; ++ai) {
                f32x4 xv[4][2];
#pragma unroll
                for (int m = 0; m < 4; ++m) { const GAS float* xp = X + (size_t)(row0 + ai * HALF + m * 16) * D + col; xv[m][0] = *(const GAS f32x4*)xp; xv[m][1] = *(const GAS f32x4*)(xp + 4); }
#pragma unroll
                for (int m = 0; m < 4; ++m) {
                    GAS float* xp = X + (size_t)(row0 + ai * HALF + m * 16) * D + col;
                    f32x4 v0 = acc[ai][bj][m][0], v1 = acc[ai][bj][m][1];
                    if (GATED) { const f32x4 q0 = acc[ai][1][m][0], q1 = acc[ai][1][m][1];
#pragma unroll
                        for (int j = 0; j < 4; ++j) { v0[j] *= sigmoid_f(q0[j]); v1[j] *= sigmoid_f(q1[j]); } }
                    const f32x4 x0 = xv[m][0] + g0 * v0, x1 = xv[m][1] + g1 * v1;
                    *(GAS f32x4*)xp = x0; *(GAS f32x4*)(xp + 4) = x1;
                    if (gsn) {
                        float a = (x0[0] * x0[0] + x0[1] * x0[1]) + (x0[2] * x0[2] + x0[3] * x0[3]) + (x1[0] * x1[0] + x1[1] * x1[1]) + (x1[2] * x1[2] + x1[3] * x1[3]);
                        const f32x4 y0 = x0 * n0, y1 = x1 * n1;
                        u32x4 w; w.x = cvt_pk_bf16(y0[0], y0[1]); w.y = cvt_pk_bf16(y0[2], y0[3]); w.z = cvt_pk_bf16(y1[0], y1[1]); w.w = cvt_pk_bf16(y1[2], y1[3]);
                        *(GAS u32x4*)(XN + (size_t)(row0 + ai * HALF + m * 16) * D + col) = w;
                        a += __shfl_xor(a, 16); a += __shfl_xor(a, 32);
                        if (fq == 0) rowss_next[(size_t)(row0 + ai * HALF + m * 16) * 32 + (GATED ? u.pn * 4 + wc : (u.pn * 2 + bj) * 4 + wc)] = a;
                    }
                }
            }
        }
    }
};

#define XB_TMO      128
#define XB_XCNT(j)  (256  + 64 * (j))
#define XB_XSUB(j)  (1280 + 64 * (j))
#define XB_XGEN(j)  (2304 + 64 * (j))
#define XB_TOP      3328
#define XB_TOPGEN   3392
#define XCD_BAR_WORDS 3456
#define XB_SPIN_CAP (1u << 18)
__device__ __forceinline__ unsigned xb_ld(GAS unsigned* p)              { return __hip_atomic_load(p, __ATOMIC_RELAXED, __HIP_MEMORY_SCOPE_AGENT); }
__device__ __forceinline__ unsigned xb_add(GAS unsigned* p, unsigned v) { return __hip_atomic_fetch_add(p, v, __ATOMIC_RELAXED, __HIP_MEMORY_SCOPE_AGENT); }
__device__ __forceinline__ unsigned xb_xcc_id() { return (unsigned)__builtin_amdgcn_s_getreg((3 << 11) | 20) & 0xFu; }
#define XB_SPIN(cond, bar) do { unsigned _sp = 0; while (cond) { __builtin_amdgcn_s_sleep(1); \
    if ((++_sp & 255u) == 0u) { if (xb_ld(&(bar)[XB_TMO])) break; if (_sp > XB_SPIN_CAP) { (void)xb_add(&(bar)[XB_TMO], 1u); break; } } } } while (0)
struct XcdBarrier { GAS unsigned* bar; unsigned x; volatile LAS unsigned* st; };
__device__ __forceinline__ XcdBarrier xcd_barrier_post(GAS unsigned* bar, volatile LAS unsigned* st) {
    XcdBarrier b; b.bar = bar; b.x = xb_xcc_id(); b.st = st;
    if (threadIdx.x == 0) (void)xb_add(&bar[XB_XCNT(b.x)], 1u);
    return b;
}
__device__ __forceinline__ void xcd_barrier_complete(GAS unsigned* bar, unsigned x, unsigned& nloc, unsigned& nx) {
    const unsigned G = gridDim.x * gridDim.y * gridDim.z;
    unsigned sum, cnt, mine, sp = 0u;
    for (;;) {
        sum = 0u; cnt = 0u;
#pragma unroll 1
        for (unsigned j = 0; j < 16; ++j) { const unsigned c = xb_ld(&bar[XB_XCNT(j)]); sum += c; cnt += (c > 0u) ? 1u : 0u; }
        mine = xb_ld(&bar[XB_XCNT(x)]);
        if (sum == G) break;
        __builtin_amdgcn_s_sleep(1);
        if ((++sp & 255u) == 0u) { if (xb_ld(&bar[XB_TMO])) break; if (sp > XB_SPIN_CAP) { (void)xb_add(&bar[XB_TMO], 1u); break; } }
    }
    nloc = mine > 0u ? mine : 1u; nx = cnt > 0u ? cnt : 1u;
}
__device__ __forceinline__ void xcd_barrier(const XcdBarrier& b) {
    asm volatile("s_waitcnt vmcnt(0)" ::: "memory");
    __syncthreads();
    if (threadIdx.x == 0) {
        GAS unsigned* bar = b.bar; unsigned bx_ = b.x;
        asm volatile("" : "+s"(bar), "+s"(bx_));
        __builtin_amdgcn_s_waitcnt(0);
        unsigned nloc = b.st[0], nx = b.st[1];
        if (nloc == 0u) { xcd_barrier_complete(bar, bx_, nloc, nx); b.st[0] = nloc; b.st[1] = nx; }
        const unsigned old = xb_add(&bar[XB_XSUB(bx_)], 1u);
        const unsigned gen = old / nloc;
        if (old + 1u == (gen + 1u) * nloc) {
            __builtin_amdgcn_fence(__ATOMIC_RELEASE, "agent");
            asm volatile("s_waitcnt vmcnt(0)" ::: "memory");
            const unsigned og = xb_add(&bar[XB_TOP], 1u);
            const unsigned tg = og / nx;
            if (og + 1u == (tg + 1u) * nx) xb_add(&bar[XB_TOPGEN], 1u);
            else XB_SPIN(xb_ld(&bar[XB_TOPGEN]) == tg, bar);
            __builtin_amdgcn_fence(__ATOMIC_ACQUIRE, "agent");
            xb_add(&bar[XB_XGEN(bx_)], 1u);
            asm volatile("s_waitcnt vmcnt(0)" ::: "memory");
        } else {
            XB_SPIN(xb_ld(&bar[XB_XGEN(bx_)]) == gen, bar);
            __builtin_amdgcn_fence(__ATOMIC_ACQUIRE, "agent");
            asm volatile("s_waitcnt vmcnt(0)" ::: "memory");
        }
    }
    __syncthreads();
}

constexpr size_t MiB = 1u << 20;
constexpr size_t WS_CTL = 0, CTL_BYTES = 2 * MiB;
constexpr int CW_BAR = 4096;
constexpr size_t WS_TAB = 2 * MiB;
constexpr size_t TAB_GSA = WS_TAB, TAB_GSB = TAB_GSA + 4 * 5 * 1024 * 4, TAB_SWA = TAB_GSB + 4 * 5 * 1024 * 4, TAB_SWB = TAB_SWA + 4 * 5 * 4096 * 4, TAB_LAMT = TAB_SWB + 4 * 5 * 4096 * 4;
static_assert(TAB_LAMT + 2 * 64 * 2 * 64 * 2 * 4 <= 4 * MiB, "tables");
constexpr size_t WS_W1 = 4 * MiB, WS_W2 = 36 * MiB, WS_SWIN = 68 * MiB, WS_SWOUT = 72 * MiB, WS_GWIN = 80 * MiB, WS_GWOUT = 88 * MiB, WS_GWS = 92 * MiB,
                 WS_CWIN = 93 * MiB, WS_CWOUT = 99 * MiB, WS_BTY = 101 * MiB, WS_BTS = 133 * MiB;
constexpr size_t WS_XN = 149 * MiB;
constexpr size_t WS_R = 173 * MiB;
constexpr size_t WS_R2 = 269 * MiB;
constexpr size_t WS_ROWSS = 317 * MiB;
constexpr size_t WS_VSTAT = 329 * MiB;
constexpr size_t WS_MODS = 335 * MiB;
constexpr size_t WS_END = 336 * MiB;

constexpr int LDS_BYTES = 147456;
constexpr int MISC_OFF = STAGE_BYTES;

struct Args { const float* in[30]; float* out; unsigned char* ws; int ph_lo, ph_hi; };

__device__ __forceinline__ unsigned pk2(float lo, float hi) { return f2bf(lo) | (f2bf(hi) << 16); }
__device__ __forceinline__ float wave_sum(float v) {
#pragma unroll
    for (int o = 1; o < 64; o <<= 1) v += __shfl_xor(v, o);
    return v;
}
template <int MAP> __device__ __forceinline__ int rowmap(int n) {
    if (MAP == 1) { const int half = n >> 10, c = n & 1023; return (c >> 7) * 256 + half * 128 + (c & 127); }
    return n;
}
template <int MAP> __device__ __forceinline__ void transpose_item(const GAS float* W, int K, int N, GAS bf16_t* WT, LAS float* scr, int item, int lane) {
    const int nblk = N / 32, kb = item / nblk, nb = item % nblk, k0 = 64 * kb, n0 = 32 * nb;
    float wv[32];
#pragma unroll
    for (int i = 0; i < 32; ++i) wv[i] = W[(size_t)(k0 + 2 * i + (lane >> 5)) * N + n0 + (lane & 31)];
#pragma unroll
    for (int i = 0; i < 32; ++i) scr[(2 * i + (lane >> 5)) * 33 + (lane & 31)] = wv[i];
    asm volatile("s_waitcnt lgkmcnt(0)" ::: "memory");
    const int c = lane & 7;
#pragma unroll
    for (int j = 0; j < 4; ++j) { const int n = (lane >> 3) + 8 * j; const LAS float* s = scr + (8 * c) * 33 + n;
        u32x4 o; o.x = pk2(s[0 * 33], s[1 * 33]); o.y = pk2(s[2 * 33], s[3 * 33]); o.z = pk2(s[4 * 33], s[5 * 33]); o.w = pk2(s[6 * 33], s[7 * 33]);
        *(GAS u32x4*)(WT + (size_t)rowmap<MAP>(n0 + n) * K + k0 + 8 * c) = o; }
    asm volatile("s_waitcnt lgkmcnt(0)" ::: "memory");
}

__device__ __forceinline__ void ssm_build(const Args& a, int j, int g, LAS unsigned char* lds, GAS unsigned char* ws) {
    const int tid = threadIdx.x;
    LAS float* PR = (LAS float*)lds;
    LAS float* PI = PR + 2 * 17 * 64;
    LAS float* BR = PI + 2 * 17 * 64;
    LAS float* BI = BR + 2 * 64 * 16;
    LAS float* CR = BI + 2 * 64 * 16;
    LAS float* CI = CR + 2 * 16 * 64;
    LAS float* WR = CI + 2 * 16 * 64;
    LAS float* WI = WR + 2 * 64 * 16;
    LAS float* KT = WI + 2 * 64 * 16;
    const GAS float* lam_re = ((const GAS float*)a.in[13]); const GAS float* lam_im = ((const GAS float*)a.in[14]); const GAS float* log_dt = ((const GAS float*)a.in[15]);
    const GAS float* b_re = ((const GAS float*)a.in[16]); const GAS float* b_im = ((const GAS float*)a.in[17]); const GAS float* c_re = ((const GAS float*)a.in[18]); const GAS float* c_im = ((const GAS float*)a.in[19]); const GAS float* dsk = ((const GAS float*)a.in[20]);
    __syncthreads();
    if (tid < 128) {
        const int k = tid >> 6, n = tid & 63, pidx = (j * 2 + k) * 64 + g;
        const float dt = expf(log_dt[pidx]);
        const float lr = lam_re[pidx * 64 + n], li = lam_im[pidx * 64 + n];
        for (int e = 0; e <= 16; ++e) { const float mag = expf((float)e * lr * dt); float sn, cs; sincosf((float)e * (li * dt), &sn, &cs); PR[(k * 17 + e) * 64 + n] = mag * cs; PI[(k * 17 + e) * 64 + n] = mag * sn; }
        const float mag = expf(lr * dt); const float abr = mag * cosf(li * dt), abi = mag * sinf(li * dt);
        const float den = lr * lr + li * li;
        const float nr = (abr - 1.0f) * lr + abi * li, ni = -(abr - 1.0f) * li + abi * lr;
        const float fr = nr / den, fi = ni / den;
        for (int p = 0; p < 16; ++p) { const float br = b_re[((size_t)pidx * 64 + n) * 16 + p], bi = b_im[((size_t)pidx * 64 + n) * 16 + p];
            BR[(k * 64 + n) * 16 + p] = fr * br - fi * bi; BI[(k * 64 + n) * 16 + p] = fr * bi + fi * br; }
        GAS float* lamT = (GAS float*)(ws + TAB_LAMT) + (((size_t)j * 64 + g) * 2 + k) * 128;
        lamT[2 * n] = PR[(k * 17 + 16) * 64 + n]; lamT[2 * n + 1] = PI[(k * 17 + 16) * 64 + n];
    }
    for (int i = tid; i < 2048; i += 512) { const int k = i >> 10, r = i & 1023; const size_t o = ((size_t)(j * 2 + k) * 64 + g) * 1024 + r; CR[i] = c_re[o]; CI[i] = c_im[o]; }
    __syncthreads();
    {
        const int k = tid >> 8, po = (tid >> 4) & 15, pi = tid & 15;
        for (int e = 0; e < 16; ++e) {
            for (int i = tid; i < 2048; i += 512) { const int kk = i >> 10, n = (i >> 4) & 63; const float pr = PR[(kk * 17 + e) * 64 + n], pim = PI[(kk * 17 + e) * 64 + n];
                WR[i] = pr * BR[i] - pim * BI[i]; WI[i] = pr * BI[i] + pim * BR[i]; }
            __syncthreads();
            float s = 0.f;
#pragma unroll 8
            for (int n = 0; n < 64; ++n) s += CR[(k * 16 + po) * 64 + n] * WR[(k * 64 + n) * 16 + pi] - CI[(k * 16 + po) * 64 + n] * WI[(k * 64 + n) * 16 + pi];
            KT[((k * 16 + e) * 16 + po) * 16 + pi] = s;
            __syncthreads();
        }
    }
    GAS bf16_t* BtY = (GAS bf16_t*)(ws + WS_BTY) + ((size_t)j * 64 + g) * 256 * 512;
    GAS bf16_t* BtS = (GAS bf16_t*)(ws + WS_BTS) + ((size_t)j * 64 + g) * 256 * 256;
    for (int pc = tid; pc < 256 * 32; pc += 512) {
        const int row = pc >> 5, kc = (pc & 31) * 8, t = row >> 4, po = row & 15, s = kc >> 4, pi0 = kc & 15;
        float v[8];
#pragma unroll
        for (int q = 0; q < 8; ++q) { const int pi = pi0 + q; float x = 0.f;
            if (s <= t) x += KT[((0 * 16 + (t - s)) * 16 + po) * 16 + pi];
            if (s >= t) x += KT[((1 * 16 + (s - t)) * 16 + po) * 16 + pi];
            if (s == t && pi == po) x += dsk[j * 1024 + g * 16 + po];
            v[q] = x; }
        u32x4 o; o.x = pk2(v[0], v[1]); o.y = pk2(v[2], v[3]); o.z = pk2(v[4], v[5]); o.w = pk2(v[6], v[7]);
        *(GAS u32x4*)(BtY + (size_t)row * 512 + kc) = o;
    }
    for (int pc = tid; pc < 256 * 32; pc += 512) {
        const int row = pc >> 5, kc = (pc & 31) * 8, t = row >> 4, po = row & 15, k = kc >> 7, ri = (kc >> 6) & 1, n0 = kc & 63;
        const int e = k == 0 ? t + 1 : 16 - t;
        float v[8];
#pragma unroll
        for (int q = 0; q < 8; ++q) { const int n = n0 + q; const float cr = CR[(k * 16 + po) * 64 + n], cim = CI[(k * 16 + po) * 64 + n], pr = PR[(k * 17 + e) * 64 + n], pim = PI[(k * 17 + e) * 64 + n];
            v[q] = ri == 0 ? (cr * pr - cim * pim) : -(cr * pim + cim * pr); }
        u32x4 o; o.x = pk2(v[0], v[1]); o.y = pk2(v[2], v[3]); o.z = pk2(v[4], v[5]); o.w = pk2(v[6], v[7]);
        *(GAS u32x4*)(BtY + (size_t)row * 512 + 256 + kc) = o;
    }
    for (int pc = tid; pc < 256 * 32; pc += 512) {
        const int row = pc >> 5, kc = (pc & 31) * 8, k = row >> 7, ri = (row >> 6) & 1, n = row & 63, s = kc >> 4, pi0 = kc & 15;
        const int e = k == 0 ? 15 - s : s;
        const float pr = PR[(k * 17 + e) * 64 + n], pim = PI[(k * 17 + e) * 64 + n];
        float v[8];
#pragma unroll
        for (int q = 0; q < 8; ++q) { const float br = BR[(k * 64 + n) * 16 + pi0 + q], bi = BI[(k * 64 + n) * 16 + pi0 + q]; v[q] = ri == 0 ? (pr * br - pim * bi) : (pr * bi + pim * br); }
        u32x4 o; o.x = pk2(v[0], v[1]); o.y = pk2(v[2], v[3]); o.z = pk2(v[4], v[5]); o.w = pk2(v[6], v[7]);
        *(GAS u32x4*)(BtS + (size_t)row * 256 + kc) = o;
    }
    __syncthreads();
}

__device__ __forceinline__ void mods_task(const Args& a, GAS float* mods, LAS unsigned char* lds, int task, int tid) {
    const int cg = task % 48, l = task / 48, wave = tid >> 6, lane = tid & 63, half = lane >> 5, c4 = lane & 31;
    const GAS float* c = ((const GAS float*)a.in[4]); const GAS float* c_ctx = ((const GAS float*)a.in[5]); const GAS float* w_mod = ((const GAS float*)a.in[6]); const GAS float* b_mod = ((const GAS float*)a.in[7]);
    LAS float* sil = (LAS float*)lds;
    LAS float* red = sil + 5 * 1024;
    __syncthreads();
    for (int i = tid; i < 5 * 1024; i += 512) { const int ci = i >> 10, k = i & 1023; const float v = ci == 0 ? c_ctx[k] : c[(ci - 1) * 1024 + k]; sil[i] = v / (1.0f + expf(-v)); }
    __syncthreads();
    const GAS float* w = w_mod + ((size_t)l * 1024 + wave * 128 + half) * 6144 + cg * 128 + c4 * 4;
    f32x4 acc[5];
#pragma unroll
    for (int ci = 0; ci < 5; ++ci) acc[ci] = (f32x4){0.f, 0.f, 0.f, 0.f};
#pragma unroll 1
    for (int b = 0; b < 2; ++b) {
        f32x4 wv[32];
#pragma unroll
        for (int i = 0; i < 32; ++i) wv[i] = *(const GAS f32x4*)(w + (size_t)(b * 64 + 2 * i) * 6144);
#pragma unroll
        for (int i = 0; i < 32; ++i) { const int k = wave * 128 + b * 64 + 2 * i + half;
#pragma unroll
            for (int ci = 0; ci < 5; ++ci) acc[ci] += wv[i] * sil[ci * 1024 + k]; }
    }
#pragma unroll
    for (int ci = 0; ci < 5; ++ci) {
#pragma unroll
        for (int q = 0; q < 4; ++q) acc[ci][q] += __shfl_xor(acc[ci][q], 32);
        if (half == 0) *(LAS f32x4*)(red + (wave * 5 + ci) * 128 + c4 * 4) = acc[ci]; }
    __syncthreads();
    for (int i = tid; i < 5 * 128; i += 512) { const int ci = i >> 7, cc = i & 127; float t = 0.f;
#pragma unroll
        for (int wv2 = 0; wv2 < 8; ++wv2) t += red[(wv2 * 5 + ci) * 128 + cc];
        mods[((size_t)l * 5 + ci) * 6144 + cg * 128 + cc] = t + b_mod[l * 6144 + cg * 128 + cc]; }
}

__device__ __forceinline__ void xinit_row(const Args& a, GAS float* X, int row, int lane) {
    GAS f32x4* o = (GAS f32x4*)(X + (size_t)row * D) + lane;
    if (row < MP) { const GAS f32x4* s = (const GAS f32x4*)(((const GAS float*)a.in[0]) + (size_t)row * D) + lane;
#pragma unroll
        for (int q = 0; q < 4; ++q) o[64 * q] = s[64 * q];
        return; }
    const GAS f32x4* s = (const GAS f32x4*)(((const GAS float*)a.in[1]) + (size_t)(row - MP) * D) + lane;
    const int t = (row - MP) & 1023; const float rr = (float)(t >> 6), cc = (float)(t & 63);
    float freq[4];
#pragma unroll
    for (int e = 0; e < 4; ++e) freq[e] = expf(-(float)(4 * lane + e) * (9.210340371976184f / 256.0f));
    f32x4 v[4];
#pragma unroll
    for (int q = 0; q < 4; ++q) v[q] = s[64 * q];
#pragma unroll
    for (int e = 0; e < 4; ++e) { float sr, cr, sc, cc2; sincosf(rr * freq[e], &sr, &cr); sincosf(cc * freq[e], &sc, &cc2); v[0][e] += sr; v[1][e] += cr; v[2][e] += sc; v[3][e] += cc2; }
#pragma unroll
    for (int q = 0; q < 4; ++q) o[64 * q] = v[q];
}


__device__ __forceinline__ void sw_job(const GAS float* mods, int l, int sidx, const GAS bf16_t* WT, int N, GAS float* dst, int dld, int wv, int nw, int lane) {
    float sh[5][16];
#pragma unroll
    for (int ci = 0; ci < 5; ++ci) { const GAS float* sp = mods + ((size_t)l * 5 + ci) * 6144 + sidx * 1024 + lane * 16;
#pragma unroll
        for (int q = 0; q < 4; ++q) { const f32x4 v = *(const GAS f32x4*)(sp + 4 * q); sh[ci][4 * q] = v[0]; sh[ci][4 * q + 1] = v[1]; sh[ci][4 * q + 2] = v[2]; sh[ci][4 * q + 3] = v[3]; } }
    for (int r = wv * 8; r < N; r += nw * 8) {
        u32x4 w0[8], w1[8];
#pragma unroll
        for (int nn = 0; nn < 8; ++nn) { w0[nn] = *(const GAS u32x4*)(WT + (size_t)(r + nn) * D + lane * 16); w1[nn] = *(const GAS u32x4*)(WT + (size_t)(r + nn) * D + lane * 16 + 8); }
#pragma unroll
        for (int nn = 0; nn < 8; ++nn) {
            const float wf[16] = {bf_lo(w0[nn].x), bf_hi(w0[nn].x), bf_lo(w0[nn].y), bf_hi(w0[nn].y), bf_lo(w0[nn].z), bf_hi(w0[nn].z), bf_lo(w0[nn].w), bf_hi(w0[nn].w),
                                  bf_lo(w1[nn].x), bf_hi(w1[nn].x), bf_lo(w1[nn].y), bf_hi(w1[nn].y), bf_lo(w1[nn].z), bf_hi(w1[nn].z), bf_lo(w1[nn].w), bf_hi(w1[nn].w)};
#pragma unroll
            for (int ci = 0; ci < 5; ++ci) { float t = 0.f;
#pragma unroll
                for (int q = 0; q < 16; ++q) t += wf[q] * sh[ci][q];
                t = wave_sum(t);
                if (lane == 0) dst[ci * dld + r + nn] = t; }
        }
    }
}
__device__ __forceinline__ void sw_mix_job(GAS unsigned char* ws, const GAS float* mods, int l, int wv, int nw, int lane) {
    GAS float* swA = (GAS float*)(ws + TAB_SWA);
    if (l == 0) sw_job(mods, 0, 0, (const GAS bf16_t*)(ws + WS_SWIN), 1024, swA, 1024, wv, nw, lane);
    else if (l == 1) sw_job(mods, 1, 0, (const GAS bf16_t*)(ws + WS_GWIN), 4096, swA + 1 * 5 * 4096, 4096, wv, nw, lane);
    else if (l == 2) sw_job(mods, 2, 0, (const GAS bf16_t*)(ws + WS_CWIN), 3072, swA + 2 * 5 * 4096, 3072, wv, nw, lane);
    else sw_job(mods, 3, 0, (const GAS bf16_t*)(ws + WS_SWIN) + (size_t)D * D, 1024, swA + 3 * 5 * 4096, 1024, wv, nw, lane);
}
__device__ __forceinline__ void sw_ffn_job(GAS unsigned char* ws, const GAS float* mods, int l, int wv, int nw, int lane) {
    sw_job(mods, l, 3, (const GAS bf16_t*)(ws + WS_W1) + (size_t)l * D * FF, 4096, (GAS float*)(ws + TAB_SWB) + l * 5 * 4096, 4096, wv, nw, lane);
}

constexpr int NPH = 28;
#ifndef MK_ALLCG
#define MK_ALLCG 0
#endif
__global__ void __launch_bounds__(512, 2) fwd(Args args) {
    extern __shared__ __attribute__((aligned(16))) unsigned char lds_raw[];
    LAS unsigned char* lds = (LAS unsigned char*)lds_raw;
    volatile LAS unsigned* MISC = (volatile LAS unsigned*)(lds + MISC_OFF);
    const int tid = threadIdx.x, lane = tid & 63, wave = __builtin_amdgcn_readfirstlane(tid >> 6);
    const int G = gridDim.x, bx = blockIdx.x, vcu = (G % 8 == 0) ? (bx % 8) * (G / 8) + bx / 8 : bx;
    GAS unsigned* ctl = (GAS unsigned*)((GAS unsigned char*)args.ws + WS_CTL);
    for (int u = tid; u < 64; u += 512) MISC[u] = 0u;
    __syncthreads();
    XcdBarrier bar = xcd_barrier_post(ctl + CW_BAR, MISC + 8);
#ifdef MK_RANGE
    const int lo = args.ph_lo, hi = args.ph_hi;
#else
    constexpr int lo = 0, hi = 23;
#endif
    int ph = 0;
#define IN_PH (lo <= ph && ph < hi)
#define SEAM() do { if (IN_PH && ph + 1 < hi) { if (ph == 0 || MK_ALLCG) cg::this_grid().sync(); else xcd_barrier(bar); } ++ph; } while (0)

    const int gw = vcu * 8 + wave, NGW = G * 8;
#define PH_PTRS() GAS unsigned char* ws = (GAS unsigned char*)args.ws; asm volatile("" : "+s"(ws)); \
    int tid_o_ = threadIdx.x; asm volatile("" : "+v"(tid_o_)); const int tid = tid_o_, lane = tid_o_ & 63; (void)tid; (void)lane; \
    GAS float* X = (GAS float*)args.out; GAS bf16_t* XN = (GAS bf16_t*)(ws + WS_XN); GAS float* mods = (GAS float*)(ws + WS_MODS); \
    GAS float* gsA = (GAS float*)(ws + TAB_GSA); GAS float* gsB = (GAS float*)(ws + TAB_GSB); GAS float* swA = (GAS float*)(ws + TAB_SWA); GAS float* swB = (GAS float*)(ws + TAB_SWB); \
    GAS float* rowss = (GAS float*)(ws + WS_ROWSS); GAS float* vstat = (GAS float*)(ws + WS_VSTAT); \
    GAS bf16_t* Hb = (GAS bf16_t*)(ws + WS_R); GAS bf16_t* UgS = (GAS bf16_t*)(ws + WS_R); GAS float* Sloc = (GAS float*)(ws + WS_R + 48 * MiB); GAS bf16_t* Zg = (GAS bf16_t*)(ws + WS_R + 48 * MiB); GAS bf16_t* A2 = (GAS bf16_t*)(ws + WS_R2); \
    (void)X; (void)XN; (void)mods; (void)gsA; (void)gsB; (void)swA; (void)swB; (void)rowss; (void)vstat; (void)Hb; (void)UgS; (void)Sloc; (void)Zg; (void)A2;
#define PH_LAYER() const GAS float* rs_mix = rowss + (size_t)(2 * layer) * M * 32; GAS float* rs_ffn = rowss + (size_t)(2 * layer + 1) * M * 32; GAS float* rs_next = rowss + (size_t)((2 * layer + 2) & 7) * M * 32; \
    const GAS float* modl = mods + (size_t)layer * 5 * 6144; (void)rs_mix; (void)rs_ffn; (void)rs_next; (void)modl;

    if (IN_PH) { PH_PTRS();
        const bool ssm_blk = bx < 128 && G == 256;
        if (G == 256) { if (bx < 128) ssm_build(args, bx >> 6, bx & 63, lds, ws); else for (int t = bx - 128; t < 192; t += 128) mods_task(args, mods, lds, t, tid); }
        else { for (int t = bx; t < 128; t += G) ssm_build(args, t >> 6, t & 63, lds, ws); for (int t = bx; t < 192; t += G) mods_task(args, mods, lds, t, tid); }
        __syncthreads();
        LAS float* scr = (LAS float*)(lds + wave * 16384);
        constexpr int I_W1 = 2048, I_W2 = 2048, I_SI = 512, I_SO = 1024, I_GI = 2048, I_GO = 1024, I_CI = 1536, I_CO = 512;
        constexpr int NT = 4 * I_W1 + 4 * I_W2 + 2 * I_SI + 2 * I_SO + I_GI + I_GO + I_CI + I_CO;
        const int nvw = G == 256 ? 3072 : NGW;
        const int vid0 = G == 256 ? (ssm_blk ? bx * 8 + wave : 1024 + ((bx - 128) * 8 + wave) * 2) : bx * 8 + wave;
        for (int rep = 0; rep < ((G == 256 && !ssm_blk) ? 2 : 1); ++rep)
        for (int it = vid0 + rep; it < NT; it += nvw) {
            int r = it;
            if (r < 4 * I_W1) { const int l = r / I_W1; transpose_item<0>(((const GAS float*)args.in[10]) + (size_t)l * D * FF, D, FF, (GAS bf16_t*)(ws + WS_W1) + (size_t)l * D * FF, scr, r % I_W1, lane); continue; } r -= 4 * I_W1;
            if (r < 4 * I_W2) { const int l = r / I_W2; transpose_item<0>(((const GAS float*)args.in[11]) + (size_t)l * D * FF, FF, D, (GAS bf16_t*)(ws + WS_W2) + (size_t)l * D * FF, scr, r % I_W2, lane); continue; } r -= 4 * I_W2;
            if (r < 2 * I_SI) { const int l = r / I_SI; transpose_item<0>(((const GAS float*)args.in[12]) + (size_t)l * D * D, D, D, (GAS bf16_t*)(ws + WS_SWIN) + (size_t)l * D * D, scr, r % I_SI, lane); continue; } r -= 2 * I_SI;
            if (r < 2 * I_SO) { const int l = r / I_SO; transpose_item<1>(((const GAS float*)args.in[21]) + (size_t)l * D * 2048, D, 2048, (GAS bf16_t*)(ws + WS_SWOUT) + (size_t)l * D * 2048, scr, r % I_SO, lane); continue; } r -= 2 * I_SO;
            if (r < I_GI) { transpose_item<0>(((const GAS float*)args.in[22]), D, 4096, (GAS bf16_t*)(ws + WS_GWIN), scr, r, lane); continue; } r -= I_GI;
            if (r < I_GO) { transpose_item<0>(((const GAS float*)args.in[25]), 2048, D, (GAS bf16_t*)(ws + WS_GWOUT), scr, r, lane); continue; } r -= I_GO;
            if (r < I_CI) { transpose_item<0>(((const GAS float*)args.in[26]), D, 3072, (GAS bf16_t*)(ws + WS_CWIN), scr, r, lane); continue; } r -= I_CI;
            transpose_item<0>(((const GAS float*)args.in[28]), D, D, (GAS bf16_t*)(ws + WS_CWOUT), scr, r, lane);
        }
        {
            const GAS float* s = ((const GAS float*)args.in[23]); GAS bf16_t* d = (GAS bf16_t*)(ws + WS_GWS);
            for (int i = (gw * 64 + lane) * 8; i < 16 * 128 * 128; i += NGW * 64 * 8) { const f32x4 a0 = *(const GAS f32x4*)(s + i), a1 = *(const GAS f32x4*)(s + i + 4);
                u32x4 o; o.x = pk2(a0[0], a0[1]); o.y = pk2(a0[2], a0[3]); o.z = pk2(a1[0], a1[1]); o.w = pk2(a1[2], a1[3]); *(GAS u32x4*)(d + i) = o; }
        }
        for (int row = gw; row < M; row += NGW) xinit_row(args, X, row, lane);
    }
    SEAM();
    if (IN_PH) { PH_PTRS();
        for (int i = gw * 64 + lane; i < 4 * 5 * 1024; i += NGW * 64) { const int l = i / 5120, ci = (i / 1024) % 5, c = i & 1023;
            const GAS float* md = mods + ((size_t)l * 5 + ci) * 6144;
            gsA[i] = ((const GAS float*)args.in[8])[l * 1024 + c] * (1.0f + md[1024 + c]); gsB[i] = ((const GAS float*)args.in[9])[l * 1024 + c] * (1.0f + md[4 * 1024 + c]); }
        sw_mix_job(ws, mods, 0, gw, NGW, lane);
        for (int row = gw; row < M; row += 3 * NGW) {
            const GAS float* gm = ((const GAS float*)args.in[8]);
            f32x4 v[3][4];
#pragma unroll
            for (int rr = 0; rr < 3; ++rr)
#pragma unroll
                for (int q = 0; q < 4; ++q) v[rr][q] = ((const GAS f32x4*)(X + (size_t)(row + rr * NGW) * D) + lane)[64 * q];
#pragma unroll
            for (int rr = 0; rr < 3; ++rr) {
                const int r = row + rr * NGW, ci = cond_of_row(r); const GAS float* md = mods + ((size_t)0 * 5 + ci) * 6144;
                float t = 0.f;
#pragma unroll
                for (int q = 0; q < 4; ++q) t += (v[rr][q][0] * v[rr][q][0] + v[rr][q][1] * v[rr][q][1]) + (v[rr][q][2] * v[rr][q][2] + v[rr][q][3] * v[rr][q][3]);
                t = wave_sum(t);
                if (lane < 32) rowss[(size_t)r * 32 + lane] = lane == 0 ? t : 0.f;
                GAS u32x2* o = (GAS u32x2*)(XN + (size_t)r * D) + lane;
#pragma unroll
                for (int q = 0; q < 4; ++q) { const int c = 256 * q + 4 * lane; const f32x4 gg = *(const GAS f32x4*)(gm + c), sc = *(const GAS f32x4*)(md + 1024 + c);
                    const f32x4 y = v[rr][q] * gg * (sc + 1.0f); u32x2 w; w.x = cvt_pk_bf16(y[0], y[1]); w.y = cvt_pk_bf16(y[2], y[3]); o[64 * q] = w; }
            }
        }
    }
    SEAM();
#pragma unroll 1
    for (int layer = 0; layer < 4; ++layer) {
        const int kind = layer % 3, j = layer / 3;
        if (kind == 0) {
            if (IN_PH) { PH_PTRS(); PH_LAYER(); const Gemm g = gemm_rowmajor(XN, D, (const GAS bf16_t*)(ws + WS_SWIN) + (size_t)j * D * D, D, D); StaticOrder S; S.init(M, D, G, bx);
                EpiU E{UgS, rs_mix, swA + layer * 5 * 4096}; gemm_phase<EpiU, ARowMajor, StaticOrder>(lds, g, S, E);
                if (layer == 0 && bx >= 192) sw_ffn_job(ws, mods, 0, (bx - 192) * 8 + wave, (G - 192) * 8, lane); }
            SEAM();
            if (IN_PH) { PH_PTRS(); PH_LAYER(); SsmOrder S{G, bx};
                { const Gemm g = gemm_rowmajor(UgS, 512, (const GAS bf16_t*)(ws + WS_BTS) + (size_t)j * 64 * 256 * 256, 256, 256);
                  EpiScan E{UgS, (const GAS float*)(ws + TAB_LAMT), ((const GAS float*)args.in[2]), ((const GAS float*)args.in[3]), (GAS float*)args.out + (size_t)M * D, (GAS float*)args.out + (size_t)M * D + 32 * 2 * 2 * 64 * 64, j};
                  gemm_phase<EpiScan, ARowMajor, SsmOrder>(lds, g, S, E); }
                asm volatile("s_waitcnt vmcnt(0)" ::: "memory"); __syncthreads(); __builtin_amdgcn_fence(__ATOMIC_ACQUIRE, "agent"); asm volatile("s_waitcnt vmcnt(0)" ::: "memory"); __syncthreads();
                { const Gemm g = gemm_rowmajor(UgS, 512, (const GAS bf16_t*)(ws + WS_BTY) + (size_t)j * 64 * 256 * 512, 512, 512);
                  EpiY E{Zg}; gemm_phase<EpiY, ARowMajor, SsmOrder>(lds, g, S, E); } }
            SEAM();
            if (IN_PH) { PH_PTRS(); PH_LAYER(); const Gemm g = gemm_groupchunk(Zg, (const GAS bf16_t*)(ws + WS_SWOUT) + (size_t)j * D * 2048, D, D); StaticOrder S; S.init(M, 2048, G, bx);
                EpiRes<true> E{X, XN, modl + 2 * 1024, gsB + layer * 5 * 1024, rs_ffn}; gemm_phase<EpiRes<true>, AGroupChunk, StaticOrder>(lds, g, S, E); }
            SEAM();
        } else if (kind == 1) {
            if (IN_PH) { PH_PTRS(); PH_LAYER(); const Gemm g = gemm_rowmajor(XN, D, (const GAS bf16_t*)(ws + WS_GWIN), D, D); StaticOrder S; S.init(M, 4096, G, bx);
                EpiIn<2> E{Hb, 4096, rs_mix, 16, swA + layer * 5 * 4096, 4096, vstat}; gemm_phase<EpiIn<2>, ARowMajor, StaticOrder>(lds, g, S, E); }
            SEAM();
            if (IN_PH) { PH_PTRS(); PH_LAYER();
                const GAS bf16_t* Wsb = (const GAS bf16_t*)(ws + WS_GWS); const GAS float* b_s = ((const GAS float*)args.in[24]);
                constexpr int VST = 288;
                for (int unit = vcu; unit < 96 * 16; unit += G) {
                    const int c = unit >> 4, g = unit & 15, row0 = c * 128;
                    __syncthreads();
                    LAS f32x2* mr = (LAS f32x2*)(lds + 128 * VST);
                    if (tid < 128) { const GAS f32x4* p = (const GAS f32x4*)(vstat + (size_t)(row0 + tid) * 128); float s1 = 0.f, s2 = 0.f;
#pragma unroll
                        for (int q = 0; q < 32; ++q) { const f32x4 v = p[q]; s1 += v[0] + v[2]; s2 += v[1] + v[3]; }
                        const float mu = s1 * (1.0f / 2048.0f), var = s2 * (1.0f / 2048.0f) - mu * mu; mr[tid] = (f32x2){mu, rsq_f(fmaxf(var, 0.f) + EPS)}; }
                    __syncthreads();
#pragma unroll
                    for (int i = 0; i < 4; ++i) { const int pc = tid + 512 * i, q = pc >> 4, d8 = pc & 15;
                        const u32x4 w = *(const GAS u32x4*)(Hb + (size_t)(row0 + q) * 4096 + 2048 + g * 128 + d8 * 8);
                        const f32x2 st = mr[q]; const float mu = st[0], rstd = st[1];
                        u32x4 o; o.x = cvt_pk_bf16((bf_lo(w.x) - mu) * rstd, (bf_hi(w.x) - mu) * rstd); o.y = cvt_pk_bf16((bf_lo(w.y) - mu) * rstd, (bf_hi(w.y) - mu) * rstd);
                        o.z = cvt_pk_bf16((bf_lo(w.z) - mu) * rstd, (bf_hi(w.z) - mu) * rstd); o.w = cvt_pk_bf16((bf_lo(w.w) - mu) * rstd, (bf_hi(w.w) - mu) * rstd);
                        *(LAS u32x4*)(lds + q * VST + d8 * 16) = o; }
                    __syncthreads();
                    f32x4 acc[8];
#pragma unroll
                    for (int nt = 0; nt < 8; ++nt) acc[nt] = (f32x4){0.f, 0.f, 0.f, 0.f};
                    const int fr = lane & 15, fq = lane >> 4;
#pragma unroll
                    for (int kk = 0; kk < 4; ++kk) {
                        const bf16x8 wf = *(const GAS bf16x8*)(Wsb + ((size_t)g * 128 + wave * 16 + fr) * 128 + kk * 32 + fq * 8);
#pragma unroll
                        for (int nt = 0; nt < 8; ++nt) {
                            const LAS unsigned char* p0 = lds + (kk * 32 + fq * 8 + (fr >> 2)) * VST + (nt * 16 + 4 * (fr & 3)) * 2;
                            const s16x4 lo4 = __builtin_bit_cast(s16x4, __builtin_amdgcn_ds_read_tr16_b64_v4i16((LAS s16x4*)p0));
                            const s16x4 hi4 = __builtin_bit_cast(s16x4, __builtin_amdgcn_ds_read_tr16_b64_v4i16((LAS s16x4*)(p0 + 4 * VST)));
                            const bf16x8 vf = {lo4[0], lo4[1], lo4[2], lo4[3], hi4[0], hi4[1], hi4[2], hi4[3]};
                            acc[nt] = __builtin_amdgcn_mfma_f32_16x16x32_bf16(vf, wf, acc[nt], 0, 0, 0);
                        }
                    }
                    const int p = wave * 16 + fr, row = row0 + p; const float bs = b_s[g * 128 + p];
#pragma unroll
                    for (int nt = 0; nt < 8; ++nt) { const int ch = g * 128 + nt * 16 + 4 * fq;
                        const u32x2 uu = *(const GAS u32x2*)(Hb + (size_t)row * 4096 + ch);
                        u32x2 o; o.x = cvt_pk_bf16(bf_lo(uu.x) * (acc[nt][0] + bs), bf_hi(uu.x) * (acc[nt][1] + bs)); o.y = cvt_pk_bf16(bf_lo(uu.y) * (acc[nt][2] + bs), bf_hi(uu.y) * (acc[nt][3] + bs));
                        *(GAS u32x2*)(A2 + (size_t)row * 2048 + ch) = o; }
                }
                __syncthreads();
            }
            SEAM();
            if (IN_PH) { PH_PTRS(); PH_LAYER(); const Gemm g = gemm_rowmajor(A2, 2048, (const GAS bf16_t*)(ws + WS_GWOUT), 2048, 2048); StaticOrder S; S.init(M, D, G, bx);
                EpiRes<false> E{X, XN, modl + 2 * 1024, gsB + layer * 5 * 1024, rs_ffn}; gemm_phase<EpiRes<false>, ARowMajor, StaticOrder>(lds, g, S, E); }
            SEAM();
        } else {
            if (IN_PH) { PH_PTRS(); PH_LAYER(); const Gemm g = gemm_rowmajor(XN, D, (const GAS bf16_t*)(ws + WS_CWIN), D, D); StaticOrder S; S.init(M, 3072, G, bx);
                EpiIn<0> E{Hb, 3072, rs_mix, 16, swA + layer * 5 * 4096, 3072, nullptr}; gemm_phase<EpiIn<0>, ARowMajor, StaticOrder>(lds, g, S, E); }
            SEAM();
            if (IN_PH) { PH_PTRS(); PH_LAYER();
                const GAS float* cw = ((const GAS float*)args.in[27]);
                for (int it = gw * 64 + lane; it < M * 128; it += NGW * 64) {
                    const int row = it >> 7, c8 = (it & 127) * 8;
                    const int L = row < MP ? 256 : 1024, t = row < MP ? (row & 255) : ((row - MP) & 1023);
                    const GAS bf16_t* pr = Hb + (size_t)row * 3072 + c8;
                    float y[8];
#pragma unroll
                    for (int q = 0; q < 8; ++q) y[q] = 0.f;
#pragma unroll
                    for (int w = 0; w < 3; ++w) { const int tt = t + w - 1; if (tt < 0 || tt >= L) continue;
                        const u32x4 gc = *(const GAS u32x4*)(pr + (ptrdiff_t)(w - 1) * 3072 + 1024), xh = *(const GAS u32x4*)(pr + (ptrdiff_t)(w - 1) * 3072 + 2048);
                        const f32x4 k0 = *(const GAS f32x4*)(cw + w * 1024 + c8), k1 = *(const GAS f32x4*)(cw + w * 1024 + c8 + 4);
                        y[0] += k0[0] * bf_lo(gc.x) * bf_lo(xh.x); y[1] += k0[1] * bf_hi(gc.x) * bf_hi(xh.x); y[2] += k0[2] * bf_lo(gc.y) * bf_lo(xh.y); y[3] += k0[3] * bf_hi(gc.y) * bf_hi(xh.y);
                        y[4] += k1[0] * bf_lo(gc.z) * bf_lo(xh.z); y[5] += k1[1] * bf_hi(gc.z) * bf_hi(xh.z); y[6] += k1[2] * bf_lo(gc.w) * bf_lo(xh.w); y[7] += k1[3] * bf_hi(gc.w) * bf_hi(xh.w); }
                    const u32x4 gb = *(const GAS u32x4*)pr;
                    u32x4 o; o.x = cvt_pk_bf16(bf_lo(gb.x) * y[0], bf_hi(gb.x) * y[1]); o.y = cvt_pk_bf16(bf_lo(gb.y) * y[2], bf_hi(gb.y) * y[3]);
                    o.z = cvt_pk_bf16(bf_lo(gb.z) * y[4], bf_hi(gb.z) * y[5]); o.w = cvt_pk_bf16(bf_lo(gb.w) * y[6], bf_hi(gb.w) * y[7]);
                    *(GAS u32x4*)(A2 + (size_t)row * D + c8) = o;
                }
            }
            SEAM();
            if (IN_PH) { PH_PTRS(); PH_LAYER(); const Gemm g = gemm_rowmajor(A2, D, (const GAS bf16_t*)(ws + WS_CWOUT), D, D); StaticOrder S; S.init(M, D, G, bx);
                EpiRes<false> E{X, XN, modl + 2 * 1024, gsB + layer * 5 * 1024, rs_ffn}; gemm_phase<EpiRes<false>, ARowMajor, StaticOrder>(lds, g, S, E); }
            SEAM();
        }
        if (IN_PH) { PH_PTRS(); PH_LAYER(); const Gemm g = gemm_rowmajor(XN, D, (const GAS bf16_t*)(ws + WS_W1) + (size_t)layer * D * FF, D, D); StaticOrder S; S.init(M, FF, G, bx);
            EpiIn<1> E{Hb, FF, rs_ffn, kind == 0 ? 32 : 16, swB + layer * 5 * 4096, 4096, nullptr}; gemm_phase<EpiIn<1>, ARowMajor, StaticOrder>(lds, g, S, E); }
        SEAM();
        if (IN_PH) { PH_PTRS(); PH_LAYER(); const Gemm g = gemm_rowmajor(Hb, FF, (const GAS bf16_t*)(ws + WS_W2) + (size_t)layer * D * FF, FF, FF); StaticOrder S; S.init(M, D, G, bx);
            EpiRes<false> E{X, XN, modl + 5 * 1024, layer < 3 ? gsA + (layer + 1) * 5 * 1024 : nullptr, rs_next}; gemm_phase<EpiRes<false>, ARowMajor, StaticOrder>(lds, g, S, E);
            if (layer < 3 && bx >= 192) { sw_mix_job(ws, mods, layer + 1, (bx - 192) * 8 + wave, (G - 192) * 8, lane); sw_ffn_job(ws, mods, layer + 1, (bx - 192) * 8 + wave, (G - 192) * 8, lane); } }
        SEAM();
    }
    if (IN_PH) { PH_PTRS();
        const GAS float* gf = ((const GAS float*)args.in[29]);
        for (int row = gw; row < M; row += 3 * NGW) {
            f32x4 v[3][4];
#pragma unroll
            for (int rr = 0; rr < 3; ++rr)
#pragma unroll
                for (int q = 0; q < 4; ++q) v[rr][q] = ((const GAS f32x4*)(X + (size_t)(row + rr * NGW) * D) + lane)[64 * q];
            f32x4 gq[4];
#pragma unroll
            for (int q = 0; q < 4; ++q) gq[q] = *(const GAS f32x4*)(gf + 256 * q + 4 * lane);
#pragma unroll
            for (int rr = 0; rr < 3; ++rr) { float t = 0.f;
#pragma unroll
                for (int q = 0; q < 4; ++q) t += (v[rr][q][0] * v[rr][q][0] + v[rr][q][1] * v[rr][q][1]) + (v[rr][q][2] * v[rr][q][2] + v[rr][q][3] * v[rr][q][3]);
                t = wave_sum(t); const float r0 = rsq_f(t * (1.0f / D) + EPS);
                GAS f32x4* xr = (GAS f32x4*)(X + (size_t)(row + rr * NGW) * D) + lane;
#pragma unroll
                for (int q = 0; q < 4; ++q) xr[64 * q] = v[rr][q] * r0 * gq[q]; }
        }
    }
    ++ph;
#undef IN_PH
#undef SEAM
}

static bool launch(void* const* d_in, float* out, unsigned char* ws, int lo, int hi, hipStream_t stream) {
    static int grid = 0;
    if (grid == 0) {
        int dev = 0, cus = 0, per_cu = 0;
        if (hipGetDevice(&dev) != hipSuccess || hipDeviceGetAttribute(&cus, hipDeviceAttributeMultiprocessorCount, dev) != hipSuccess) { grid = -1; return false; }
        if (hipFuncSetAttribute((const void*)fwd, hipFuncAttributeMaxDynamicSharedMemorySize, LDS_BYTES) != hipSuccess) { fprintf(stderr, "hipFuncSetAttribute failed\n"); grid = -1; return false; }
        if (hipOccupancyMaxActiveBlocksPerMultiprocessor(&per_cu, (const void*)fwd, 512, LDS_BYTES) != hipSuccess || per_cu < 1) { fprintf(stderr, "occupancy query: %d\n", per_cu); (void)hipGetLastError(); per_cu = 1; }
        grid = cus;
    }
    if (grid < 0) return false;
    Args a{};
    for (int i = 0; i < 30; ++i) a.in[i] = (const float*)d_in[i];
    a.out = out; a.ws = ws; a.ph_lo = lo; a.ph_hi = hi;
    void* kargs[] = {&a};
    const hipError_t e = hipLaunchCooperativeKernel((const void*)fwd, dim3(grid), dim3(512), kargs, LDS_BYTES, stream);
    if (e != hipSuccess) { fprintf(stderr, "cooperative launch failed: %s (grid %d)\n", hipGetErrorString(e), grid); return false; }
    return true;
}
}
extern "C" void kernel_launch(void* const* d_in, const int* in_sizes, int n_in, void* d_out, int out_size, void* d_ws, size_t ws_size, hipStream_t stream) {
    if (n_in != 30 || ws_size < mk::WS_END) { fprintf(stderr, "kernel_launch: unexpected n_in %d / ws %zu\n", n_in, ws_size); return; }
    (void)hipMemsetAsync((char*)d_ws + mk::WS_CTL, 0, mk::CTL_BYTES, stream);
    mk::launch(d_in, (float*)d_out, (unsigned char*)d_ws, 0, 23, stream);
}
```

```cpp
#include <hip/hip_runtime.h>
#include <cstdio>
#include <cstdint>
#include <hip/hip_cooperative_groups.h>
namespace mk {
namespace cg = cooperative_groups;
#define LAS __attribute__((address_space(3)))
#define GAS __attribute__((address_space(1)))
typedef unsigned short bf16_t;
typedef short bf16x8 __attribute__((ext_vector_type(8)));
typedef short s16x4 __attribute__((ext_vector_type(4)));
typedef float f32x4 __attribute__((ext_vector_type(4)));
typedef float f32x2 __attribute__((ext_vector_type(2)));
typedef unsigned u32x4 __attribute__((ext_vector_type(4)));
typedef unsigned u32x2 __attribute__((ext_vector_type(2)));

constexpr int D = 1024, M = 12288, MP = 8192, FF = 4096, NCH = 768;
constexpr float EPS = 1e-6f;
constexpr int BM = 256, BK = 64, HALF = 128, HTB = HALF * BK * 2, STAGE_BYTES = 8 * HTB, NXCD = 8, WGM = 8;

typedef __bf16 bf16x2_t __attribute__((ext_vector_type(2)));
__device__ __forceinline__ unsigned cvt_pk_bf16(float lo, float hi) { const f32x2 v = {lo, hi}; const bf16x2_t b = __builtin_convertvector(v, bf16x2_t); return __builtin_bit_cast(unsigned, b); }
__device__ __forceinline__ unsigned f2bf(float f) { unsigned u = __builtin_bit_cast(unsigned, f); return (u + 0x7fffu + ((u >> 16) & 1u)) >> 16; }
__device__ __forceinline__ float bf_lo(unsigned w) { return __uint_as_float(w << 16); }
__device__ __forceinline__ float bf_hi(unsigned w) { return __uint_as_float(w & 0xffff0000u); }
__device__ __forceinline__ float rcp_f(float x) { return __builtin_amdgcn_rcpf(x); }
__device__ __forceinline__ float rsq_f(float x) { return __builtin_amdgcn_rsqf(x); }
__device__ __forceinline__ float gelu_tanh(float x) {
    const float t = x * x * (0.044715f * -2.0f * 0.7978845608028654f * 1.4426950408889634f) + (-2.0f * 0.7978845608028654f * 1.4426950408889634f);
    return x * rcp_f(1.0f + __builtin_amdgcn_exp2f(x * t));
}
__device__ __forceinline__ float sigmoid_f(float x) { return rcp_f(1.0f + __builtin_amdgcn_exp2f(x * -1.4426950408889634f)); }
__device__ __forceinline__ int lane_id() { return (int)__builtin_amdgcn_mbcnt_hi(~0u, __builtin_amdgcn_mbcnt_lo(~0u, 0u)); }
__device__ __forceinline__ int cond_of_pm(int pm) { return pm < 32 ? 0 : 1 + ((pm - 32) >> 2); }
__device__ __forceinline__ int cond_of_row(int row) { return row < MP ? 0 : 1 + ((row - MP) >> 10); }

__host__ __device__ __forceinline__ int lds_byte(int r, int c) { const int st = (r >> 4) * 2 + (c >> 5), rr = r & 15, cc = c & 31, ob = rr * 64 + cc * 2; return st * 1024 + (ob ^ (((ob >> 9) & 1) << 5)); }
__host__ __device__ __forceinline__ void stage_rc(int b, int& R, int& C) { const int st = b / 1024, sb = b % 1024, swz = sb ^ (((sb >> 9) & 1) << 5); R = (st >> 1) * 16 + swz / 64; C = (st & 1) * 32 + (swz % 64) / 2; }
__host__ __device__ __forceinline__ int perm32(int rho) { const int n = rho >> 4, i = rho & 15; return 8 * (i >> 2) + 4 * n + (i & 3); }

struct Unit { int pm, pn; };
struct Gemm { const GAS char* A; const GAS char* Bt; int K; int lda; int ldb; size_t kstepA, hstepA, tstepA; int mode; };
struct ARowMajor { static __device__ __forceinline__ unsigned voff(int R, int C, int lda) { return (unsigned)(R * lda + C) * 2u; } };
struct AGroupChunk { static __device__ __forceinline__ unsigned voff(int R, int C, int) { return (unsigned)((((C >> 4) * NCH + (R >> 4)) * 256) + (R & 15) * 16 + (C & 15)) * 2u; } };
__device__ inline Gemm gemm_rowmajor(const GAS void* A, int lda, const GAS void* Bt, int ldb, int K) {
    Gemm g; g.A = (const GAS char*)A; g.Bt = (const GAS char*)Bt; g.K = K; g.lda = lda; g.ldb = ldb; g.kstepA = BK * 2; g.hstepA = (size_t)HALF * lda * 2; g.tstepA = 2 * g.hstepA; g.mode = 0; return g; }
__device__ inline Gemm gemm_groupchunk(const GAS void* A, const GAS void* Bt, int ldb, int K) {
    Gemm g; g.A = (const GAS char*)A; g.Bt = (const GAS char*)Bt; g.K = K; g.lda = 0; g.ldb = ldb; g.kstepA = (size_t)4 * NCH * 256 * 2; g.hstepA = 8 * 256 * 2; g.tstepA = 16 * 256 * 2; g.mode = 0; return g; }

struct StaticOrder {
    int nM, nN, nwg, G, c;
    __host__ __device__ void init(int M_, int N_, int G_, int c_) { nM = M_ / BM; nN = N_ / BM; nwg = nM * nN; G = G_; c = c_; }
    __host__ __device__ bool next(int i, Unit& u) const {
        const long L = (long)i * G + c; if (L >= nwg) return false;
        int wgid = (int)L; { const int q = nwg / NXCD, r = nwg % NXCD, xcd = wgid % NXCD, off = wgid / NXCD; wgid = (xcd < r ? xcd * (q + 1) : r * (q + 1) + (xcd - r) * q) + off; }
        const int nig = WGM * nN, gid = wgid / nig, fm = gid * WGM, gsz = (nM - fm) < WGM ? (nM - fm) : WGM;
        u.pm = fm + ((wgid % nig) % gsz); u.pn = (wgid % nig) / gsz; return true;
    }
};
struct SsmOrder {
    int G, c;
    __host__ __device__ bool next(int i, Unit& u) const { const int L = i * G + c; if (L >= 192) return false; u.pm = L; u.pn = L / 3; return true; }
};

template <class Epi, class AL, class Sched>
__device__ __forceinline__ void gemm_phase(LAS unsigned char* lds, const Gemm g, const Sched& S, const Epi& E, int wave_) {
    int tid = wave_ * 64 + lane_id(); asm volatile("" : "+v"(tid));
    const int wid = __builtin_amdgcn_readfirstlane(tid >> 6), lane = tid & 63, wr = wid >> 2, wc = wid & 3, fr = lane & 15, fq = lane >> 4;
    const int K = g.K, nt = K / BK;
    unsigned voffA[2], voffB[2];
#pragma unroll
    for (int i = 0; i < 2; ++i) { int R, C; stage_rc(tid * 16 + i * 8192, R, C); const int Rb = Epi::PERM ? ((R & ~31) + perm32(R & 31)) : R;
        voffA[i] = AL::voff(R, C, g.lda); voffB[i] = (unsigned)(Rb * g.ldb + C) * 2u; }
    const size_t kstepA = g.kstepA, hstepA = g.hstepA, tstepA = g.tstepA;
    const size_t kstepB = (size_t)(BK * 2), hstepB = (size_t)HALF * g.ldb * 2, tstepB = 2 * hstepB;
    const unsigned ldsw = (unsigned)wid * 1024u;
    const int aoff = lds_byte(wr * 64 + fr, fq * 8), boff = lds_byte(wc * 32 + fr, fq * 8);
#define PG8_SA(b, h) (((b) * 2 + (h)) * HTB)
#define PG8_SB(b, h) ((4 + (b) * 2 + (h)) * HTB)
#define PG8_STAGE(bufoff, gbase, voff) do { _Pragma("unroll") for (int _i = 0; _i < 2; ++_i) \
        __builtin_amdgcn_global_load_lds((const GAS unsigned*)((const GAS char*)(gbase) + (voff)[_i]), (LAS unsigned*)(lds + (bufoff) + ldsw + _i * 8192), 16, 0, 0); } while (0)
#define PG8_LDA(dst, b, h) do { _Pragma("unroll") for (int m = 0; m < 4; ++m) _Pragma("unroll") for (int k = 0; k < 2; ++k) dst[m][k] = *(const LAS bf16x8*)(lds + PG8_SA(b, h) + aoff + m * 2048 + k * 1024); } while (0)
#define PG8_LDB(dst, b, h) do { _Pragma("unroll") for (int n = 0; n < 2; ++n) _Pragma("unroll") for (int k = 0; k < 2; ++k) dst[n][k] = *(const LAS bf16x8*)(lds + PG8_SB(b, h) + boff + n * 2048 + k * 1024); } while (0)
#define PG8_MMA(ai, bj, At, Bt) do { __builtin_amdgcn_s_setprio(1); _Pragma("unroll") for (int m = 0; m < 4; ++m) _Pragma("unroll") for (int n = 0; n < 2; ++n) _Pragma("unroll") for (int k = 0; k < 2; ++k) \
        acc[ai][bj][m][n] = __builtin_amdgcn_mfma_f32_16x16x32_bf16(Bt[n][k], At[m][k], acc[ai][bj][m][n], 0, 0, 0); __builtin_amdgcn_s_setprio(0); } while (0)
#define PG8_WAIT_V(n) asm volatile("s_waitcnt vmcnt(" #n ")" ::: "memory")
#define PG8_WAIT_L(n) asm volatile("s_waitcnt lgkmcnt(" #n ")" ::: "memory")
#define PG8_BAR __builtin_amdgcn_s_barrier()
#define PG8_SCHED __builtin_amdgcn_sched_barrier(0)
    Unit cur, nxt; int ui = 0;
    if (!S.next(0, cur)) return;
    f32x4 acc[2][2][4][2];
#pragma unroll
    for (int a = 0; a < 2; ++a)
#pragma unroll
        for (int b = 0; b < 2; ++b)
#pragma unroll
            for (int m = 0; m < 4; ++m)
#pragma unroll
                for (int n = 0; n < 2; ++n) acc[a][b][m][n] = (f32x4){0.f, 0.f, 0.f, 0.f};
    bf16x8 At[4][2], B0[2][2], B1[2][2];
    const GAS char* cA = g.A + (size_t)cur.pm * tstepA; const GAS char* cB = g.Bt + (size_t)cur.pn * tstepB;
    PG8_STAGE(PG8_SB(0, 0), cB, voffB); PG8_STAGE(PG8_SB(0, 1), cB + hstepB, voffB); PG8_STAGE(PG8_SA(0, 0), cA, voffA); PG8_STAGE(PG8_SA(0, 1), cA + hstepA, voffA);
    if (wr == 1) PG8_BAR;
    PG8_WAIT_V(2); PG8_BAR;
    PG8_STAGE(PG8_SB(1, 0), cB + kstepB, voffB); PG8_STAGE(PG8_SA(1, 0), cA + kstepA, voffA); PG8_STAGE(PG8_SB(1, 1), cB + hstepB + kstepB, voffB);
    PG8_WAIT_V(6); PG8_BAR;
    for (;;) {
        const bool has_next = S.next(ui + 1, nxt);
        const GAS char* nA = has_next ? g.A + (size_t)nxt.pm * tstepA : cA; const GAS char* nB = has_next ? g.Bt + (size_t)nxt.pn * tstepB : cB;
        for (int t = 0; t < nt; t += 2) {
            const bool last = (t == nt - 2);
            const GAS char* a1 = cA + (size_t)(t + 1) * kstepA;
            const GAS char* a2 = last ? nA : cA + (size_t)(t + 2) * kstepA; const GAS char* b2 = last ? nB : cB + (size_t)(t + 2) * kstepB;
            const GAS char* a3 = a2 + kstepA; const GAS char* b3 = b2 + kstepB;
            PG8_LDB(B0, 0, 0); PG8_LDB(B1, 0, 1); PG8_SCHED; PG8_LDA(At, 0, 0); PG8_STAGE(PG8_SA(1, 1), a1 + hstepA, voffA);
            PG8_WAIT_V(8); PG8_WAIT_L(0); PG8_BAR; PG8_MMA(0, 0, At, B0); PG8_MMA(0, 1, At, B1); PG8_BAR; PG8_SCHED;
            PG8_LDA(At, 0, 1); PG8_STAGE(PG8_SB(0, 0), b2, voffB); PG8_STAGE(PG8_SB(0, 1), b2 + hstepB, voffB); PG8_STAGE(PG8_SA(0, 0), a2, voffA);
            PG8_WAIT_V(8); PG8_WAIT_L(0); PG8_BAR; PG8_MMA(1, 0, At, B0); PG8_MMA(1, 1, At, B1); PG8_BAR; PG8_SCHED;
            PG8_LDB(B0, 1, 0); PG8_LDB(B1, 1, 1); PG8_SCHED; PG8_LDA(At, 1, 0); PG8_STAGE(PG8_SA(0, 1), a2 + hstepA, voffA);
            PG8_WAIT_V(8); PG8_WAIT_L(0); PG8_BAR; PG8_MMA(0, 0, At, B0); PG8_MMA(0, 1, At, B1); PG8_BAR; PG8_SCHED;
            PG8_LDA(At, 1, 1); PG8_STAGE(PG8_SB(1, 0), b3, voffB); PG8_STAGE(PG8_SB(1, 1), b3 + hstepB, voffB); PG8_STAGE(PG8_SA(1, 0), a3, voffA);
            PG8_WAIT_V(8); PG8_WAIT_L(0); PG8_BAR; PG8_MMA(1, 0, At, B0); PG8_MMA(1, 1, At, B1); PG8_BAR; PG8_SCHED;
        }
        if (wr == 0) PG8_BAR;
        int el_ = lane_id(); asm volatile("" : "+v"(el_));
        const int efr = el_ & 15, efq = el_ >> 4;
#ifdef MK_RANGE
        if constexpr (!Epi::AFTER_DRAIN) { if (g.mode != 1) E(acc, cur, ui, lds, wr, wc, efr, efq); else { asm volatile("" :: "v"(acc[0][0][0][0]), "v"(acc[1][1][3][1])); } }
#else
        if constexpr (!Epi::AFTER_DRAIN) E(acc, cur, ui, lds, wr, wc, efr, efq);
#endif
        if (!has_next) break;
#pragma unroll
        for (int a = 0; a < 2; ++a)
#pragma unroll
            for (int b = 0; b < 2; ++b)
#pragma unroll
                for (int m = 0; m < 4; ++m)
#pragma unroll
                    for (int n = 0; n < 2; ++n) acc[a][b][m][n] = (f32x4){0.f, 0.f, 0.f, 0.f};
        cur = nxt; cA = nA; cB = nB; ++ui;
        if (wr == 1) PG8_BAR;
    }
    PG8_WAIT_V(0);
    PG8_BAR;
    if constexpr (Epi::AFTER_DRAIN) E.fused(acc, cur, wr, wc, fr, fq, lds, tid);
#undef PG8_SA
#undef PG8_SB
#undef PG8_STAGE
#undef PG8_LDA
#undef PG8_LDB
#undef PG8_MMA
#undef PG8_WAIT_V
#undef PG8_WAIT_L
#undef PG8_BAR
#undef PG8_SCHED
}

typedef const f32x4 (&AccRef)[2][2][4][2];

constexpr int PTR_OFF = STAGE_BYTES + 256 + 10240;
__device__ __forceinline__ unsigned long long ldsptr(const LAS unsigned char* lds, int k) { const unsigned long long v = ((const LAS unsigned long long*)(lds + PTR_OFF))[k];
    return ((unsigned long long)(unsigned)__builtin_amdgcn_readfirstlane((int)(unsigned)(v >> 32)) << 32) | (unsigned)__builtin_amdgcn_readfirstlane((int)(unsigned)v); }
__device__ __forceinline__ const GAS float* inp(const LAS unsigned char* lds, int k) { return (const GAS float*)ldsptr(lds, k); }
constexpr int TAB_OFF = STAGE_BYTES + 256, T_RS = TAB_OFF, T_SW = T_RS + 3072, T_GATE = T_SW + 3072, T_GSN = T_GATE + 2048;
template <class Sched> __device__ __forceinline__ void fill_tables_in(LAS unsigned char* lds, const Sched& S, const GAS float* rowss, const GAS float* sw, int swld, int tid) {
    LAS float* trs = (LAS float*)(lds + T_RS); LAS float* tsw = (LAS float*)(lds + T_SW);
#pragma unroll 1
    for (int i = 0; i < 3; ++i) { Unit u; if (!S.next(i, u)) break;
        if (tid < 256) { const GAS f32x4* p = (const GAS f32x4*)(rowss + (size_t)(u.pm * BM + tid) * 32);
            const f32x4 a = ((p[0] + p[1]) + (p[2] + p[3])) + ((p[4] + p[5]) + (p[6] + p[7]));
            trs[i * 256 + tid] = rsq_f(((a[0] + a[1]) + (a[2] + a[3])) * (1.0f / D) + EPS); }
        else tsw[i * 256 + tid - 256] = sw[(unsigned)(cond_of_pm(u.pm) * swld + u.pn * BM + tid - 256)];
    }
    __syncthreads();
}
template <int NCOL, class Sched> __device__ __forceinline__ void fill_tables_res(LAS unsigned char* lds, const Sched& S, const GAS float* gate, const GAS float* gsn, int tid) {
    LAS float* tg = (LAS float*)(lds + T_GATE); LAS float* tn = (LAS float*)(lds + T_GSN);
#pragma unroll 1
    for (int i = 0; i < 2; ++i) { Unit u; if (!S.next(i, u)) break; const int ci = cond_of_pm(u.pm);
        if (tid < NCOL) tg[i * 256 + tid] = gate[(unsigned)(ci * 6144 + u.pn * NCOL + tid)];
        else if (tid >= 256 && tid < 256 + NCOL) tn[i * 256 + tid - 256] = gsn ? gsn[(unsigned)(ci * 1024 + u.pn * NCOL + tid - 256)] : 0.f;
    }
    __syncthreads();
}
__device__ __forceinline__ void load_rstd(const LAS unsigned char* lds, int ui, int wr, int fr, float (&rs)[2][4]) {
    const LAS float* trs = (const LAS float*)(lds + T_RS) + ui * 256 + wr * 64 + fr;
#pragma unroll
    for (int ai = 0; ai < 2; ++ai)
#pragma unroll
        for (int m = 0; m < 4; ++m) rs[ai][m] = trs[ai * HALF + m * 16];
}

template <int ACT, int LDC> struct EpiIn {
    static constexpr bool PERM = true, AFTER_DRAIN = false;
    GAS bf16_t* O; GAS float* vstat;
    __device__ __forceinline__ void operator()(AccRef acc, const Unit& u, int ui, const LAS unsigned char* lds, int wr, int wc, int fr, int fq) const {
        const int row0 = u.pm * BM + wr * 64 + fr, col0 = u.pn * BM + wc * 32 + 8 * fq;
        float rs[2][4]; load_rstd(lds, ui, wr, fr, rs);
        const LAS float* swp = (const LAS float*)(lds + T_SW) + ui * 256 + wc * 32 + 8 * fq;
        const bool stats = ACT == 2 && u.pn >= 8;
#pragma unroll
        for (int bj = 0; bj < 2; ++bj) {
            const f32x4 b0 = *(const LAS f32x4*)(swp + bj * HALF), b1 = *(const LAS f32x4*)(swp + bj * HALF + 4);
#pragma unroll
            for (int ai = 0; ai < 2; ++ai)
#pragma unroll
                for (int m = 0; m < 4; ++m) {
                    const unsigned r = (unsigned)(row0 + ai * HALF + m * 16);
                    f32x4 v0 = acc[ai][bj][m][0] * rs[ai][m] + b0, v1 = acc[ai][bj][m][1] * rs[ai][m] + b1;
                    if (ACT == 1) {
#pragma unroll
                        for (int j = 0; j < 4; ++j) { const float a = fmaxf(v0[j], 0.f), b = fmaxf(v1[j], 0.f); v0[j] = a * a; v1[j] = b * b; } }
                    if (ACT == 2) {
#pragma unroll
                        for (int j = 0; j < 4; ++j) { v0[j] = gelu_tanh(v0[j]); v1[j] = gelu_tanh(v1[j]); } }
                    u32x4 w; w.x = cvt_pk_bf16(v0[0], v0[1]); w.y = cvt_pk_bf16(v0[2], v0[3]); w.z = cvt_pk_bf16(v1[0], v1[1]); w.w = cvt_pk_bf16(v1[2], v1[3]);
                    *(GAS u32x4*)(O + (r * (unsigned)LDC + (unsigned)(col0 + bj * HALF))) = w;
                    if (ACT == 2) { if (stats) {
                        float a = (v0[0] + v0[1]) + (v0[2] + v0[3]) + (v1[0] + v1[1]) + (v1[2] + v1[3]);
                        float b = (v0[0] * v0[0] + v0[1] * v0[1]) + (v0[2] * v0[2] + v0[3] * v0[3]) + (v1[0] * v1[0] + v1[1] * v1[1]) + (v1[2] * v1[2] + v1[3] * v1[3]);
                        a += __shfl_xor(a, 16); a += __shfl_xor(a, 32); b += __shfl_xor(b, 16); b += __shfl_xor(b, 32);
                        if (fq == 0) *(GAS f32x2*)(vstat + (r * 64u + (unsigned)(((u.pn - 8) * 2 + bj) * 4 + wc)) * 2u) = (f32x2){a, b}; } }
                }
        }
    }
};
struct EpiU {
    static constexpr bool PERM = true, AFTER_DRAIN = false;
    GAS bf16_t* UgS;
    __device__ __forceinline__ void operator()(AccRef acc, const Unit& u, int ui, const LAS unsigned char* lds, int wr, int wc, int fr, int fq) const {
        const int col0 = u.pn * BM + wc * 32 + 8 * fq;
        float rs[2][4]; load_rstd(lds, ui, wr, fr, rs);
        const LAS float* swp = (const LAS float*)(lds + T_SW) + ui * 256 + wc * 32 + 8 * fq;
#pragma unroll
        for (int bj = 0; bj < 2; ++bj) {
            const f32x4 b0 = *(const LAS f32x4*)(swp + bj * HALF), b1 = *(const LAS f32x4*)(swp + bj * HALF + 4);
            const int g = (col0 + bj * HALF) >> 4, p0 = (col0 & 15);
#pragma unroll
            for (int ai = 0; ai < 2; ++ai)
#pragma unroll
                for (int m = 0; m < 4; ++m) {
                    const f32x4 v0 = acc[ai][bj][m][0] * rs[ai][m] + b0, v1 = acc[ai][bj][m][1] * rs[ai][m] + b1;
                    u32x4 w; w.x = cvt_pk_bf16(v0[0], v0[1]); w.y = cvt_pk_bf16(v0[2], v0[3]); w.z = cvt_pk_bf16(v1[0], v1[1]); w.w = cvt_pk_bf16(v1[2], v1[3]);
                    const int chunk = u.pm * 16 + ai * 8 + wr * 4 + m;
                    *(GAS u32x4*)(UgS + ((unsigned)(g * NCH + chunk) * 512u + (unsigned)(fr * 16 + p0))) = w;
                }
        }
    }
};
struct EpiScan {
    static constexpr bool PERM = true, AFTER_DRAIN = true;
    GAS bf16_t* UgS; const GAS float* lamT; const GAS float* h0_re; const GAS float* h0_im; GAS float* new_re; GAS float* new_im; int j;
    static __device__ __forceinline__ int lidx(int row, int col) { return row * 128 + ((((col >> 2) ^ row) & 31) << 2) + (col & 3); }
    __device__ __forceinline__ void fused(AccRef acc, const Unit& u, int wr, int wc, int fr, int fq, LAS unsigned char* lds, int tid) const {
        LAS float* T = (LAS float*)lds;
        const int g = u.pn, mt = u.pm - 3 * g, n = tid & 63, slot = __builtin_amdgcn_readfirstlane(tid >> 6);
        const int len = mt < 2 ? 16 : 64, nsq = mt < 2 ? 2 : (slot < 4 ? 1 : 0), sl0 = mt < 2 ? slot * 2 : slot;
#pragma unroll 1
        for (int k = 0; k < 2; ++k) {
#pragma unroll
            for (int ai = 0; ai < 2; ++ai)
#pragma unroll
                for (int m = 0; m < 4; ++m) { const int row = ai * HALF + wr * 64 + m * 16 + fr;
#pragma unroll
                    for (int nn = 0; nn < 2; ++nn) { const int col = wc * 32 + 8 * fq + 4 * nn; *(LAS f32x4*)(T + lidx(row, col)) = k == 0 ? acc[ai][0][m][nn] : acc[ai][1][m][nn]; } }
            __syncthreads();
            const float lr = lamT[(((unsigned)j * 64 + g) * 2 + k) * 128 + 2 * n], li = lamT[(((unsigned)j * 64 + g) * 2 + k) * 128 + 2 * n + 1];
            for (int q = 0; q < nsq; ++q) {
                const int sl = sl0 + q, r0 = sl * len;
                float sr = 0.f, si = 0.f;
                if (mt == 2) { const unsigned o = ((((unsigned)sl * 2 + j) * 2 + k) * 64 + g) * 64 + n; sr = h0_re[o]; si = h0_im[o]; }
                GAS bf16_t* so = UgS + ((size_t)g * NCH + mt * 256) * 512 + 256 + k * 128 + n;
                for (int i = 0; i < len; ++i) {
                    const int row = k == 0 ? r0 + i : r0 + len - 1 - i;
                    so[(unsigned)row * 512u] = (bf16_t)f2bf(sr); so[(unsigned)row * 512u + 64u] = (bf16_t)f2bf(si);
                    const float ar = T[lidx(row, n)], ai2 = T[lidx(row, 64 + n)];
                    const float nr = lr * sr - li * si + ar, ni = lr * si + li * sr + ai2; sr = nr; si = ni;
                }
                if (mt < 2) { const unsigned o = ((((unsigned)(mt * 16 + sl) * 2 + j) * 2 + k) * 64 + g) * 64 + n; new_re[o] = sr; new_im[o] = si; }
            }
            __syncthreads();
        }
    }
};
struct EpiY {
    static constexpr bool PERM = true, AFTER_DRAIN = false;
    GAS bf16_t* Zg;
    __device__ __forceinline__ void operator()(AccRef acc, const Unit& u, int ui, const LAS unsigned char* lds, int wr, int wc, int fr, int fq) const {
        const int row0 = u.pm * BM + wr * 64 + fr, col0 = wc * 32 + 8 * fq;
#pragma unroll
        for (int ai = 0; ai < 2; ++ai)
#pragma unroll
            for (int m = 0; m < 4; ++m) { GAS bf16_t* rp = Zg + (size_t)(row0 + ai * HALF + m * 16) * 256 + col0;
#pragma unroll
                for (int bj = 0; bj < 2; ++bj) { const f32x4 v0 = acc[ai][bj][m][0], v1 = acc[ai][bj][m][1];
                    u32x4 w; w.x = cvt_pk_bf16(gelu_tanh(v0[0]), gelu_tanh(v0[1])); w.y = cvt_pk_bf16(gelu_tanh(v0[2]), gelu_tanh(v0[3]));
                    w.z = cvt_pk_bf16(gelu_tanh(v1[0]), gelu_tanh(v1[1])); w.w = cvt_pk_bf16(gelu_tanh(v1[2]), gelu_tanh(v1[3]));
                    *(GAS u32x4*)(rp + bj * HALF) = w; } }
    }
};
template <bool GATED> struct EpiRes {
    static constexpr bool PERM = true, AFTER_DRAIN = false;
    GAS float* X; GAS bf16_t* XN; GAS float* rowss_next; bool has_next;
    __device__ __forceinline__ void operator()(AccRef acc, const Unit& u, int ui, const LAS unsigned char* lds, int wr, int wc, int fr, int fq) const {
        constexpr int NB = GATED ? 1 : 2, NBATCH = 2 * NB;
        const int row0 = u.pm * BM + wr * 64 + fr, col0 = u.pn * (GATED ? HALF : BM) + wc * 32 + 8 * fq;
        const LAS float* tg = (const LAS float*)(lds + T_GATE) + ui * 256 + wc * 32 + 8 * fq; const LAS float* tn = (const LAS float*)(lds + T_GSN) + ui * 256 + wc * 32 + 8 * fq;
        f32x4 x0_[2][2], x1_[2][2], x2_[2][2];
#define RES_LOAD(dst, b_) do { const int bj_ = (b_) / 4, ai_ = ((b_) / 2) % 2, mh_ = (b_) % 2; _Pragma("unroll") for (int mm = 0; mm < 2; ++mm) { \
            const GAS float* xp = X + ((unsigned)(row0 + ai_ * HALF + (mh_ * 2 + mm) * 16) * (unsigned)D + (unsigned)(col0 + bj_ * HALF)); dst[mm][0] = *(const GAS f32x4*)xp; dst[mm][1] = *(const GAS f32x4*)(xp + 4); } } while (0)
#define RES_PROC(src, b_) do { const int bj = (b_) / 4, ai = ((b_) / 2) % 2, mh = (b_) % 2; \
            const f32x4 g0 = *(const LAS f32x4*)(tg + bj * HALF), g1 = *(const LAS f32x4*)(tg + bj * HALF + 4), n0 = *(const LAS f32x4*)(tn + bj * HALF), n1 = *(const LAS f32x4*)(tn + bj * HALF + 4); \
            _Pragma("unroll") for (int mm = 0; mm < 2; ++mm) { const int m = mh * 2 + mm; \
                const unsigned r = (unsigned)(row0 + ai * HALF + m * 16), off = r * (unsigned)D + (unsigned)(col0 + bj * HALF); \
                f32x4 v0 = acc[ai][bj][m][0], v1 = acc[ai][bj][m][1]; \
                if (GATED) { const f32x4 q0 = acc[ai][1][m][0], q1 = acc[ai][1][m][1]; \
                    _Pragma("unroll") for (int j = 0; j < 4; ++j) { v0[j] *= sigmoid_f(q0[j]); v1[j] *= sigmoid_f(q1[j]); } } \
                const f32x4 x0 = src[mm][0] + g0 * v0, x1 = src[mm][1] + g1 * v1; \
                *(GAS f32x4*)(X + off) = x0; *(GAS f32x4*)(X + off + 4) = x1; \
                if (has_next) { \
                    float a = (x0[0] * x0[0] + x0[1] * x0[1]) + (x0[2] * x0[2] + x0[3] * x0[3]) + (x1[0] * x1[0] + x1[1] * x1[1]) + (x1[2] * x1[2] + x1[3] * x1[3]); \
                    const f32x4 y0 = x0 * n0, y1 = x1 * n1; \
                    u32x4 w; w.x = cvt_pk_bf16(y0[0], y0[1]); w.y = cvt_pk_bf16(y0[2], y0[3]); w.z = cvt_pk_bf16(y1[0], y1[1]); w.w = cvt_pk_bf16(y1[2], y1[3]); \
                    *(GAS u32x4*)(XN + off) = w; \
                    a += __shfl_xor(a, 16); a += __shfl_xor(a, 32); \
                    if (fq == 0) rowss_next[r * 32u + (unsigned)(GATED ? u.pn * 4 + wc : (u.pn * 2 + bj) * 4 + wc)] = a; } } } while (0)
        constexpr int NBT = 4 * NB;
        RES_LOAD(x0_, 0); RES_LOAD(x1_, 1); RES_LOAD(x2_, 2);
        RES_PROC(x0_, 0); RES_LOAD(x0_, 3);
        RES_PROC(x1_, 1); if (NBT > 4) RES_LOAD(x1_, 4);
        RES_PROC(x2_, 2); if (NBT > 4) RES_LOAD(x2_, 5);
        RES_PROC(x0_, 3);
        if (NBT > 4) { RES_LOAD(x0_, 6); RES_PROC(x1_, 4); RES_LOAD(x1_, 7); RES_PROC(x2_, 5); RES_PROC(x0_, 6); RES_PROC(x1_, 7); }
#undef RES_LOAD
#undef RES_PROC
    }
};

#define XB_TMO      128
#define XB_XCNT(j)  (256  + 64 * (j))
#define XB_XSUB(j)  (1280 + 64 * (j))
#define XB_XGEN(j)  (2304 + 64 * (j))
#define XB_TOP      3328
#define XB_TOPGEN   3392
#define XCD_BAR_WORDS 3456
#define XB_SPIN_CAP (1u << 18)
__device__ __forceinline__ unsigned xb_ld(GAS unsigned* p)              { return __hip_atomic_load(p, __ATOMIC_RELAXED, __HIP_MEMORY_SCOPE_AGENT); }
__device__ __forceinline__ unsigned xb_add(GAS unsigned* p, unsigned v) { return __hip_atomic_fetch_add(p, v, __ATOMIC_RELAXED, __HIP_MEMORY_SCOPE_AGENT); }
__device__ __forceinline__ unsigned xb_xcc_id() { return (unsigned)__builtin_amdgcn_s_getreg((3 << 11) | 20) & 0xFu; }
#define XB_SPIN(cond, bar) do { unsigned _sp = 0; while (cond) { __builtin_amdgcn_s_sleep(1); \
    if ((++_sp & 255u) == 0u) { if (xb_ld(&(bar)[XB_TMO])) break; if (_sp > XB_SPIN_CAP) { (void)xb_add(&(bar)[XB_TMO], 1u); break; } } } } while (0)
struct XcdBarrier { GAS unsigned* bar; unsigned x; volatile LAS unsigned* st; };
__device__ __forceinline__ XcdBarrier xcd_barrier_post(GAS unsigned* bar, volatile LAS unsigned* st) {
    XcdBarrier b; b.bar = bar; b.x = xb_xcc_id(); b.st = st;
    if (threadIdx.x == 0) (void)xb_add(&bar[XB_XCNT(b.x)], 1u);
    return b;
}
__device__ __forceinline__ void xcd_barrier_complete(GAS unsigned* bar, unsigned x, unsigned& nloc, unsigned& nx) {
    const unsigned G = gridDim.x * gridDim.y * gridDim.z;
    unsigned sum, cnt, mine, sp = 0u;
    for (;;) {
        sum = 0u; cnt = 0u;
#pragma unroll 1
        for (unsigned j = 0; j < 16; ++j) { const unsigned c = xb_ld(&bar[XB_XCNT(j)]); sum += c; cnt += (c > 0u) ? 1u : 0u; }
        mine = xb_ld(&bar[XB_XCNT(x)]);
        if (sum == G) break;
        __builtin_amdgcn_s_sleep(1);
        if ((++sp & 255u) == 0u) { if (xb_ld(&bar[XB_TMO])) break; if (sp > XB_SPIN_CAP) { (void)xb_add(&bar[XB_TMO], 1u); break; } }
    }
    nloc = mine > 0u ? mine : 1u; nx = cnt > 0u ? cnt : 1u;
}
__device__ __forceinline__ void xcd_barrier(const XcdBarrier& b, bool leader) {
    asm volatile("s_waitcnt vmcnt(0)" ::: "memory");
    __syncthreads();
    if (leader) {
        GAS unsigned* bar = b.bar; unsigned bx_ = b.x;
        asm volatile("" : "+s"(bar), "+s"(bx_));
        __builtin_amdgcn_s_waitcnt(0);
        unsigned nloc = b.st[0], nx = b.st[1];
        if (nloc == 0u) { xcd_barrier_complete(bar, bx_, nloc, nx); b.st[0] = nloc; b.st[1] = nx; }
        const unsigned old = xb_add(&bar[XB_XSUB(bx_)], 1u);
        const unsigned gen = old / nloc;
        if (old + 1u == (gen + 1u) * nloc) {
            __builtin_amdgcn_fence(__ATOMIC_RELEASE, "agent");
            asm volatile("s_waitcnt vmcnt(0)" ::: "memory");
            const unsigned og = xb_add(&bar[XB_TOP], 1u);
            const unsigned tg = og / nx;
            if (og + 1u == (tg + 1u) * nx) xb_add(&bar[XB_TOPGEN], 1u);
            else XB_SPIN(xb_ld(&bar[XB_TOPGEN]) == tg, bar);
            __builtin_amdgcn_fence(__ATOMIC_ACQUIRE, "agent");
            xb_add(&bar[XB_XGEN(bx_)], 1u);
            asm volatile("s_waitcnt vmcnt(0)" ::: "memory");
        } else {
            XB_SPIN(xb_ld(&bar[XB_XGEN(bx_)]) == gen, bar);
            __builtin_amdgcn_fence(__ATOMIC_ACQUIRE, "agent");
            asm volatile("s_waitcnt vmcnt(0)" ::: "memory");
        }
    }
    __syncthreads();
}

constexpr size_t MiB = 1u << 20;
constexpr size_t WS_CTL = 0, CTL_BYTES = 2 * MiB;
constexpr int CW_BAR = 4096;
constexpr size_t WS_TAB = 2 * MiB;
constexpr size_t TAB_GSA = WS_TAB, TAB_GSB = TAB_GSA + 4 * 5 * 1024 * 4, TAB_SWA = TAB_GSB + 4 * 5 * 1024 * 4, TAB_SWB = TAB_SWA + 4 * 5 * 4096 * 4, TAB_LAMT = TAB_SWB + 4 * 5 * 4096 * 4;
static_assert(TAB_LAMT + 2 * 64 * 2 * 64 * 2 * 4 <= 4 * MiB, "tables");
constexpr size_t WS_W1 = 4 * MiB, WS_W2 = 36 * MiB, WS_SWIN = 68 * MiB, WS_SWOUT = 72 * MiB, WS_GWIN = 80 * MiB, WS_GWOUT = 88 * MiB, WS_GWS = 92 * MiB,
                 WS_CWIN = 93 * MiB, WS_CWOUT = 99 * MiB, WS_BTY = 101 * MiB, WS_BTS = 133 * MiB;
constexpr size_t WS_XN = 149 * MiB;
constexpr size_t WS_R = 173 * MiB;
constexpr size_t WS_R2 = 269 * MiB;
constexpr size_t WS_ROWSS = 317 * MiB;
constexpr size_t WS_VSTAT = 329 * MiB;
constexpr size_t WS_MODS = 335 * MiB;
constexpr size_t WS_END = 336 * MiB;

constexpr int LDS_BYTES = 147456;
constexpr int MISC_OFF = STAGE_BYTES;

struct Args { const float* in[30]; float* out; unsigned char* ws; int ph_lo, ph_hi; int mode, pad; };

__device__ __forceinline__ unsigned pk2(float lo, float hi) { return f2bf(lo) | (f2bf(hi) << 16); }
__device__ __forceinline__ float wave_sum(float v) {
#pragma unroll
    for (int o = 1; o < 64; o <<= 1) v += __shfl_xor(v, o);
    return v;
}
template <int MAP> __device__ __forceinline__ int rowmap(int n) {
    if (MAP == 1) { const int half = n >> 10, c = n & 1023; return (c >> 7) * 256 + half * 128 + (c & 127); }
    return n;
}
template <int MAP> __device__ __forceinline__ void transpose_item(const GAS float* W, int K, int N, GAS bf16_t* WT, LAS float* scr, int item, int lane) {
    const int nblk = N / 32, kb = item / nblk, nb = item % nblk, k0 = 64 * kb, n0 = 32 * nb;
    float wv[32];
#pragma unroll
    for (int i = 0; i < 32; ++i) wv[i] = W[(size_t)(k0 + 2 * i + (lane >> 5)) * N + n0 + (lane & 31)];
#pragma unroll
    for (int i = 0; i < 32; ++i) scr[(2 * i + (lane >> 5)) * 33 + (lane & 31)] = wv[i];
    asm volatile("s_waitcnt lgkmcnt(0)" ::: "memory");
    const int c = lane & 7;
#pragma unroll
    for (int j = 0; j < 4; ++j) { const int n = (lane >> 3) + 8 * j; const LAS float* s = scr + (8 * c) * 33 + n;
        u32x4 o; o.x = pk2(s[0 * 33], s[1 * 33]); o.y = pk2(s[2 * 33], s[3 * 33]); o.z = pk2(s[4 * 33], s[5 * 33]); o.w = pk2(s[6 * 33], s[7 * 33]);
        *(GAS u32x4*)(WT + (size_t)rowmap<MAP>(n0 + n) * K + k0 + 8 * c) = o; }
    asm volatile("s_waitcnt lgkmcnt(0)" ::: "memory");
}

__device__ __forceinline__ void ssm_build(const Args& a, int j, int g, LAS unsigned char* lds, GAS unsigned char* ws, int tid) {
    LAS float* PR = (LAS float*)lds;
    LAS float* PI = PR + 2 * 17 * 64;
    LAS float* BR = PI + 2 * 17 * 64;
    LAS float* BI = BR + 2 * 64 * 16;
    LAS float* CR = BI + 2 * 64 * 16;
    LAS float* CI = CR + 2 * 16 * 64;
    LAS float* WR = CI + 2 * 16 * 64;
    LAS float* WI = WR + 2 * 64 * 16;
    LAS float* KT = WI + 2 * 64 * 16;
    const GAS float* lam_re = inp(lds, 13); const GAS float* lam_im = inp(lds, 14); const GAS float* log_dt = inp(lds, 15);
    const GAS float* b_re = inp(lds, 16); const GAS float* b_im = inp(lds, 17); const GAS float* c_re = inp(lds, 18); const GAS float* c_im = inp(lds, 19); const GAS float* dsk = inp(lds, 20);
    __syncthreads();
    if (tid < 128) {
        const int k = tid >> 6, n = tid & 63, pidx = (j * 2 + k) * 64 + g;
        const float dt = expf(log_dt[pidx]);
        const float lr = lam_re[pidx * 64 + n], li = lam_im[pidx * 64 + n];
        for (int e = 0; e <= 16; ++e) { const float mag = expf((float)e * lr * dt); float sn, cs; sincosf((float)e * (li * dt), &sn, &cs); PR[(k * 17 + e) * 64 + n] = mag * cs; PI[(k * 17 + e) * 64 + n] = mag * sn; }
        const float mag = expf(lr * dt); const float abr = mag * cosf(li * dt), abi = mag * sinf(li * dt);
        const float den = lr * lr + li * li;
        const float nr = (abr - 1.0f) * lr + abi * li, ni = -(abr - 1.0f) * li + abi * lr;
        const float fr = nr / den, fi = ni / den;
        for (int p = 0; p < 16; ++p) { const float br = b_re[((size_t)pidx * 64 + n) * 16 + p], bi = b_im[((size_t)pidx * 64 + n) * 16 + p];
            BR[(k * 64 + n) * 16 + p] = fr * br - fi * bi; BI[(k * 64 + n) * 16 + p] = fr * bi + fi * br; }
        GAS float* lamT = (GAS float*)(ws + TAB_LAMT) + (((size_t)j * 64 + g) * 2 + k) * 128;
        lamT[2 * n] = PR[(k * 17 + 16) * 64 + n]; lamT[2 * n + 1] = PI[(k * 17 + 16) * 64 + n];
    }
    for (int i = tid; i < 2048; i += 512) { const int k = i >> 10, r = i & 1023; const size_t o = ((size_t)(j * 2 + k) * 64 + g) * 1024 + r; CR[i] = c_re[o]; CI[i] = c_im[o]; }
    __syncthreads();
    {
        const int k = tid >> 8, po = (tid >> 4) & 15, pi = tid & 15;
        for (int e = 0; e < 16; ++e) {
            for (int i = tid; i < 2048; i += 512) { const int kk = i >> 10, n = (i >> 4) & 63; const float pr = PR[(kk * 17 + e) * 64 + n], pim = PI[(kk * 17 + e) * 64 + n];
                WR[i] = pr * BR[i] - pim * BI[i]; WI[i] = pr * BI[i] + pim * BR[i]; }
            __syncthreads();
            float s = 0.f;
#pragma unroll 8
            for (int n = 0; n < 64; ++n) s += CR[(k * 16 + po) * 64 + n] * WR[(k * 64 + n) * 16 + pi] - CI[(k * 16 + po) * 64 + n] * WI[(k * 64 + n) * 16 + pi];
            KT[((k * 16 + e) * 16 + po) * 16 + pi] = s;
            __syncthreads();
        }
    }
    GAS bf16_t* BtY = (GAS bf16_t*)(ws + WS_BTY) + ((size_t)j * 64 + g) * 256 * 512;
    GAS bf16_t* BtS = (GAS bf16_t*)(ws + WS_BTS) + ((size_t)j * 64 + g) * 256 * 256;
    for (int pc = tid; pc < 256 * 32; pc += 512) {
        const int row = pc >> 5, kc = (pc & 31) * 8, t = row >> 4, po = row & 15, s = kc >> 4, pi0 = kc & 15;
        float v[8];
#pragma unroll
        for (int q = 0; q < 8; ++q) { const int pi = pi0 + q; float x = 0.f;
            if (s <= t) x += KT[((0 * 16 + (t - s)) * 16 + po) * 16 + pi];
            if (s >= t) x += KT[((1 * 16 + (s - t)) * 16 + po) * 16 + pi];
            if (s == t && pi == po) x += dsk[j * 1024 + g * 16 + po];
            v[q] = x; }
        u32x4 o; o.x = pk2(v[0], v[1]); o.y = pk2(v[2], v[3]); o.z = pk2(v[4], v[5]); o.w = pk2(v[6], v[7]);
        *(GAS u32x4*)(BtY + (size_t)row * 512 + kc) = o;
    }
    for (int pc = tid; pc < 256 * 32; pc += 512) {
        const int row = pc >> 5, kc = (pc & 31) * 8, t = row >> 4, po = row & 15, k = kc >> 7, ri = (kc >> 6) & 1, n0 = kc & 63;
        const int e = k == 0 ? t + 1 : 16 - t;
        float v[8];
#pragma unroll
        for (int q = 0; q < 8; ++q) { const int n = n0 + q; const float cr = CR[(k * 16 + po) * 64 + n], cim = CI[(k * 16 + po) * 64 + n], pr = PR[(k * 17 + e) * 64 + n], pim = PI[(k * 17 + e) * 64 + n];
            v[q] = ri == 0 ? (cr * pr - cim * pim) : -(cr * pim + cim * pr); }
        u32x4 o; o.x = pk2(v[0], v[1]); o.y = pk2(v[2], v[3]); o.z = pk2(v[4], v[5]); o.w = pk2(v[6], v[7]);
        *(GAS u32x4*)(BtY + (size_t)row * 512 + 256 + kc) = o;
    }
    for (int pc = tid; pc < 256 * 32; pc += 512) {
        const int row = pc >> 5, kc = (pc & 31) * 8, k = row >> 7, ri = (row >> 6) & 1, n = row & 63, s = kc >> 4, pi0 = kc & 15;
        const int e = k == 0 ? 15 - s : s;
        const float pr = PR[(k * 17 + e) * 64 + n], pim = PI[(k * 17 + e) * 64 + n];
        float v[8];
#pragma unroll
        for (int q = 0; q < 8; ++q) { const float br = BR[(k * 64 + n) * 16 + pi0 + q], bi = BI[(k * 64 + n) * 16 + pi0 + q]; v[q] = ri == 0 ? (pr * br - pim * bi) : (pr * bi + pim * br); }
        u32x4 o; o.x = pk2(v[0], v[1]); o.y = pk2(v[2], v[3]); o.z = pk2(v[4], v[5]); o.w = pk2(v[6], v[7]);
        *(GAS u32x4*)(BtS + (size_t)row * 256 + kc) = o;
    }
    __syncthreads();
}

__device__ __forceinline__ void mods_task(const Args& a, GAS float* mods, LAS unsigned char* lds, int task, int tid) {
    const int cg = task % 48, l = task / 48, wave = tid >> 6, lane = tid & 63, half = lane >> 5, c4 = lane & 31;
    const GAS float* c = inp(lds, 4); const GAS float* c_ctx = inp(lds, 5); const GAS float* w_mod = inp(lds, 6); const GAS float* b_mod = inp(lds, 7);
    LAS float* sil = (LAS float*)lds;
    LAS float* red = sil + 5 * 1024;
    __syncthreads();
    for (int i = tid; i < 5 * 1024; i += 512) { const int ci = i >> 10, k = i & 1023; const float v = ci == 0 ? c_ctx[k] : c[(ci - 1) * 1024 + k]; sil[i] = v / (1.0f + expf(-v)); }
    __syncthreads();
    const GAS float* w = w_mod + ((size_t)l * 1024 + wave * 128 + half) * 6144 + cg * 128 + c4 * 4;
    f32x4 acc[5];
#pragma unroll
    for (int ci = 0; ci < 5; ++ci) acc[ci] = (f32x4){0.f, 0.f, 0.f, 0.f};
#pragma unroll 1
    for (int b = 0; b < 2; ++b) {
        f32x4 wv[32];
#pragma unroll
        for (int i = 0; i < 32; ++i) wv[i] = *(const GAS f32x4*)(w + (size_t)(b * 64 + 2 * i) * 6144);
#pragma unroll
        for (int i = 0; i < 32; ++i) { const int k = wave * 128 + b * 64 + 2 * i + half;
#pragma unroll
            for (int ci = 0; ci < 5; ++ci) acc[ci] += wv[i] * sil[ci * 1024 + k]; }
    }
#pragma unroll
    for (int ci = 0; ci < 5; ++ci) {
#pragma unroll
        for (int q = 0; q < 4; ++q) acc[ci][q] += __shfl_xor(acc[ci][q], 32);
        if (half == 0) *(LAS f32x4*)(red + (wave * 5 + ci) * 128 + c4 * 4) = acc[ci]; }
    __syncthreads();
    for (int i = tid; i < 5 * 128; i += 512) { const int ci = i >> 7, cc = i & 127; float t = 0.f;
#pragma unroll
        for (int wv2 = 0; wv2 < 8; ++wv2) t += red[(wv2 * 5 + ci) * 128 + cc];
        mods[((size_t)l * 5 + ci) * 6144 + cg * 128 + cc] = t + b_mod[l * 6144 + cg * 128 + cc]; }
}

__device__ __forceinline__ void xinit_row(const LAS unsigned char* lds, GAS float* X, int row, int lane) {
    GAS f32x4* o = (GAS f32x4*)(X + (size_t)row * D) + lane;
    if (row < MP) { const GAS f32x4* s = (const GAS f32x4*)(inp(lds, 0) + (size_t)row * D) + lane;
#pragma unroll
        for (int q = 0; q < 4; ++q) o[64 * q] = s[64 * q];
        return; }
    const GAS f32x4* s = (const GAS f32x4*)(inp(lds, 1) + (size_t)(row - MP) * D) + lane;
    const int t = (row - MP) & 1023; const float rr = (float)(t >> 6), cc = (float)(t & 63);
    float freq[4];
#pragma unroll
    for (int e = 0; e < 4; ++e) freq[e] = expf(-(float)(4 * lane + e) * (9.210340371976184f / 256.0f));
    f32x4 v[4];
#pragma unroll
    for (int q = 0; q < 4; ++q) v[q] = s[64 * q];
#pragma unroll
    for (int e = 0; e < 4; ++e) { float sr, cr, sc, cc2; sincosf(rr * freq[e], &sr, &cr); sincosf(cc * freq[e], &sc, &cc2); v[0][e] += sr; v[1][e] += cr; v[2][e] += sc; v[3][e] += cc2; }
#pragma unroll
    for (int q = 0; q < 4; ++q) o[64 * q] = v[q];
}


__device__ __forceinline__ void sw_job(const GAS float* mods, int l, int sidx, const GAS bf16_t* WT, int N, GAS float* dst, int dld, int wv, int nw, int lane) {
    float sh[5][16];
#pragma unroll
    for (int ci = 0; ci < 5; ++ci) { const GAS float* sp = mods + ((size_t)l * 5 + ci) * 6144 + sidx * 1024 + lane * 16;
#pragma unroll
        for (int q = 0; q < 4; ++q) { const f32x4 v = *(const GAS f32x4*)(sp + 4 * q); sh[ci][4 * q] = v[0]; sh[ci][4 * q + 1] = v[1]; sh[ci][4 * q + 2] = v[2]; sh[ci][4 * q + 3] = v[3]; } }
    for (int r = wv * 8; r < N; r += nw * 8) {
        u32x4 w0[8], w1[8];
#pragma unroll
        for (int nn = 0; nn < 8; ++nn) { w0[nn] = *(const GAS u32x4*)(WT + (size_t)(r + nn) * D + lane * 16); w1[nn] = *(const GAS u32x4*)(WT + (size_t)(r + nn) * D + lane * 16 + 8); }
#pragma unroll
        for (int nn = 0; nn < 8; ++nn) {
            const float wf[16] = {bf_lo(w0[nn].x), bf_hi(w0[nn].x), bf_lo(w0[nn].y), bf_hi(w0[nn].y), bf_lo(w0[nn].z), bf_hi(w0[nn].z), bf_lo(w0[nn].w), bf_hi(w0[nn].w),
                                  bf_lo(w1[nn].x), bf_hi(w1[nn].x), bf_lo(w1[nn].y), bf_hi(w1[nn].y), bf_lo(w1[nn].z), bf_hi(w1[nn].z), bf_lo(w1[nn].w), bf_hi(w1[nn].w)};
#pragma unroll
            for (int ci = 0; ci < 5; ++ci) { float t = 0.f;
#pragma unroll
                for (int q = 0; q < 16; ++q) t += wf[q] * sh[ci][q];
                t = wave_sum(t);
                if (lane == 0) dst[ci * dld + r + nn] = t; }
        }
    }
}
__device__ __forceinline__ void sw_mix_job(GAS unsigned char* ws, const GAS float* mods, int l, int wv, int nw, int lane) {
    GAS float* swA = (GAS float*)(ws + TAB_SWA);
    if (l == 0) sw_job(mods, 0, 0, (const GAS bf16_t*)(ws + WS_SWIN), 1024, swA, 1024, wv, nw, lane);
    else if (l == 1) sw_job(mods, 1, 0, (const GAS bf16_t*)(ws + WS_GWIN), 4096, swA + 1 * 5 * 4096, 4096, wv, nw, lane);
    else if (l == 2) sw_job(mods, 2, 0, (const GAS bf16_t*)(ws + WS_CWIN), 3072, swA + 2 * 5 * 4096, 3072, wv, nw, lane);
    else sw_job(mods, 3, 0, (const GAS bf16_t*)(ws + WS_SWIN) + (size_t)D * D, 1024, swA + 3 * 5 * 4096, 1024, wv, nw, lane);
}
__device__ __forceinline__ void sw_ffn_job(GAS unsigned char* ws, const GAS float* mods, int l, int wv, int nw, int lane) {
    sw_job(mods, l, 3, (const GAS bf16_t*)(ws + WS_W1) + (size_t)l * D * FF, 4096, (GAS float*)(ws + TAB_SWB) + l * 5 * 4096, 4096, wv, nw, lane);
}

constexpr int NPH = 28;
#ifdef MK_RANGE
#define GMODE(g) g.mode = args.mode
#else
#define GMODE(g)
#endif
#ifndef MK_ALLCG
#define MK_ALLCG 0
#endif
__global__ void __launch_bounds__(512, 2) fwd(Args args) {
    extern __shared__ __attribute__((aligned(16))) unsigned char lds_raw[];
    LAS unsigned char* lds_k = (LAS unsigned char*)lds_raw;
    volatile LAS unsigned* MISC = (volatile LAS unsigned*)(lds_k + MISC_OFF);
    const int tid = threadIdx.x, lane = tid & 63, wave = __builtin_amdgcn_readfirstlane(tid >> 6);
    const int G = gridDim.x, bx = blockIdx.x;
    GAS unsigned* ctl = (GAS unsigned*)((GAS unsigned char*)args.ws + WS_CTL);
    for (int u = tid; u < 64; u += 512) MISC[u] = 0u;
    if (tid == 0) { LAS unsigned long long* pt = (LAS unsigned long long*)(lds_k + PTR_OFF);
#pragma unroll
        for (int k = 0; k < 30; ++k) pt[k] = (unsigned long long)args.in[k];
        pt[30] = (unsigned long long)args.out; pt[31] = (unsigned long long)args.ws; }
    __syncthreads();
    (void)xcd_barrier_post(ctl + CW_BAR, MISC + 8);
#ifdef MK_RANGE
    const int lo = args.ph_lo, hi = args.ph_hi;
#else
    constexpr int lo = 0, hi = 23;
#endif
    int ph = 0;
#define IN_PH (lo <= ph && ph < hi)
#define SEAM() do { if (IN_PH && ph + 1 < hi) { if (ph == 0 || MK_ALLCG) cg::this_grid().sync(); else { LAS unsigned char* lds_s_ = lds_k; asm volatile("" : "+s"(lds_s_)); XcdBarrier b_; b_.bar = (GAS unsigned*)((GAS unsigned char*)ldsptr(lds_s_, 31) + WS_CTL) + CW_BAR; b_.x = xb_xcc_id(); b_.st = (volatile LAS unsigned*)(lds_s_ + MISC_OFF) + 8; xcd_barrier(b_, wave == 0 && lane_id() == 0); } } ++ph; } while (0)

#define PH_PTRS() LAS unsigned char* lds = lds_k; asm volatile("" : "+s"(lds)); GAS unsigned char* ws = (GAS unsigned char*)ldsptr(lds, 31); asm volatile("" : "+s"(ws)); \
    int tid_o_ = wave * 64 + lane_id(); asm volatile("" : "+v"(tid_o_)); const int tid = tid_o_, lane = tid_o_ & 63; (void)tid; (void)lane; \
    const int vcu = (G % 8 == 0) ? (bx % 8) * (G / 8) + bx / 8 : bx, gw = vcu * 8 + wave, NGW = G * 8; (void)vcu; (void)gw; (void)NGW; \
    GAS float* X = (GAS float*)ldsptr(lds, 30); GAS bf16_t* XN = (GAS bf16_t*)(ws + WS_XN); GAS float* mods = (GAS float*)(ws + WS_MODS); \
    GAS float* gsA = (GAS float*)(ws + TAB_GSA); GAS float* gsB = (GAS float*)(ws + TAB_GSB); GAS float* swA = (GAS float*)(ws + TAB_SWA); GAS float* swB = (GAS float*)(ws + TAB_SWB); \
    GAS float* rowss = (GAS float*)(ws + WS_ROWSS); GAS float* vstat = (GAS float*)(ws + WS_VSTAT); \
    GAS bf16_t* Hb = (GAS bf16_t*)(ws + WS_R); GAS bf16_t* UgS = (GAS bf16_t*)(ws + WS_R); GAS float* Sloc = (GAS float*)(ws + WS_R + 48 * MiB); GAS bf16_t* Zg = (GAS bf16_t*)(ws + WS_R + 48 * MiB); GAS bf16_t* A2 = (GAS bf16_t*)(ws + WS_R2); \
    (void)X; (void)XN; (void)mods; (void)gsA; (void)gsB; (void)swA; (void)swB; (void)rowss; (void)vstat; (void)Hb; (void)UgS; (void)Sloc; (void)Zg; (void)A2;
#define PH_LAYER() const GAS float* rs_mix = rowss + (size_t)(2 * layer) * M * 32; GAS float* rs_ffn = rowss + (size_t)(2 * layer + 1) * M * 32; GAS float* rs_next = rowss + (size_t)((2 * layer + 2) & 7) * M * 32; \
    const GAS float* modl = mods + (size_t)layer * 5 * 6144; (void)rs_mix; (void)rs_ffn; (void)rs_next; (void)modl;

    if (IN_PH) { PH_PTRS();
        const bool ssm_blk = bx < 128 && G == 256;
        if (G == 256) { if (bx < 128) ssm_build(args, bx >> 6, bx & 63, lds, ws, tid); else for (int t = bx - 128; t < 192; t += 128) mods_task(args, mods, lds, t, tid); }
        else { for (int t = bx; t < 128; t += G) ssm_build(args, t >> 6, t & 63, lds, ws, tid); for (int t = bx; t < 192; t += G) mods_task(args, mods, lds, t, tid); }
        __syncthreads();
        LAS float* scr = (LAS float*)(lds + wave * 16384);
        constexpr int I_W1 = 2048, I_W2 = 2048, I_SI = 512, I_SO = 1024, I_GI = 2048, I_GO = 1024, I_CI = 1536, I_CO = 512;
        constexpr int NT = 4 * I_W1 + 4 * I_W2 + 2 * I_SI + 2 * I_SO + I_GI + I_GO + I_CI + I_CO;
        const int nvw = G == 256 ? 3072 : NGW;
        const int vid0 = G == 256 ? (ssm_blk ? bx * 8 + wave : 1024 + ((bx - 128) * 8 + wave) * 2) : bx * 8 + wave;
        for (int rep = 0; rep < ((G == 256 && !ssm_blk) ? 2 : 1); ++rep)
        for (int it = vid0 + rep; it < NT; it += nvw) {
            int r = it;
            if (r < 4 * I_W1) { const int l = r / I_W1; transpose_item<0>(inp(lds, 10) + (size_t)l * D * FF, D, FF, (GAS bf16_t*)(ws + WS_W1) + (size_t)l * D * FF, scr, r % I_W1, lane); continue; } r -= 4 * I_W1;
            if (r < 4 * I_W2) { const int l = r / I_W2; transpose_item<0>(inp(lds, 11) + (size_t)l * D * FF, FF, D, (GAS bf16_t*)(ws + WS_W2) + (size_t)l * D * FF, scr, r % I_W2, lane); continue; } r -= 4 * I_W2;
            if (r < 2 * I_SI) { const int l = r / I_SI; transpose_item<0>(inp(lds, 12) + (size_t)l * D * D, D, D, (GAS bf16_t*)(ws + WS_SWIN) + (size_t)l * D * D, scr, r % I_SI, lane); continue; } r -= 2 * I_SI;
            if (r < 2 * I_SO) { const int l = r / I_SO; transpose_item<1>(inp(lds, 21) + (size_t)l * D * 2048, D, 2048, (GAS bf16_t*)(ws + WS_SWOUT) + (size_t)l * D * 2048, scr, r % I_SO, lane); continue; } r -= 2 * I_SO;
            if (r < I_GI) { transpose_item<0>(inp(lds, 22), D, 4096, (GAS bf16_t*)(ws + WS_GWIN), scr, r, lane); continue; } r -= I_GI;
            if (r < I_GO) { transpose_item<0>(inp(lds, 25), 2048, D, (GAS bf16_t*)(ws + WS_GWOUT), scr, r, lane); continue; } r -= I_GO;
            if (r < I_CI) { transpose_item<0>(inp(lds, 26), D, 3072, (GAS bf16_t*)(ws + WS_CWIN), scr, r, lane); continue; } r -= I_CI;
            transpose_item<0>(inp(lds, 28), D, D, (GAS bf16_t*)(ws + WS_CWOUT), scr, r, lane);
        }
        {
            const GAS float* s = inp(lds, 23); GAS bf16_t* d = (GAS bf16_t*)(ws + WS_GWS);
            for (int i = (gw * 64 + lane) * 8; i < 16 * 128 * 128; i += NGW * 64 * 8) { const f32x4 a0 = *(const GAS f32x4*)(s + i), a1 = *(const GAS f32x4*)(s + i + 4);
                u32x4 o; o.x = pk2(a0[0], a0[1]); o.y = pk2(a0[2], a0[3]); o.z = pk2(a1[0], a1[1]); o.w = pk2(a1[2], a1[3]); *(GAS u32x4*)(d + i) = o; }
        }
        for (int row = gw; row < M; row += NGW) xinit_row(lds, X, row, lane);
    }
    SEAM();
    if (IN_PH) { PH_PTRS();
        for (int i = gw * 64 + lane; i < 4 * 5 * 1024; i += NGW * 64) { const int l = i / 5120, ci = (i / 1024) % 5, c = i & 1023;
            const GAS float* md = mods + ((size_t)l * 5 + ci) * 6144;
            gsA[i] = inp(lds, 8)[l * 1024 + c] * (1.0f + md[1024 + c]); gsB[i] = inp(lds, 9)[l * 1024 + c] * (1.0f + md[4 * 1024 + c]); }
        sw_mix_job(ws, mods, 0, gw, NGW, lane);
        for (int row = gw; row < M; row += 3 * NGW) {
            const GAS float* gm = inp(lds, 8);
            f32x4 v[3][4];
#pragma unroll
            for (int rr = 0; rr < 3; ++rr)
#pragma unroll
                for (int q = 0; q < 4; ++q) v[rr][q] = ((const GAS f32x4*)(X + (size_t)(row + rr * NGW) * D) + lane)[64 * q];
#pragma unroll
            for (int rr = 0; rr < 3; ++rr) {
                const int r = row + rr * NGW, ci = cond_of_row(r); const GAS float* md = mods + ((size_t)0 * 5 + ci) * 6144;
                float t = 0.f;
#pragma unroll
                for (int q = 0; q < 4; ++q) t += (v[rr][q][0] * v[rr][q][0] + v[rr][q][1] * v[rr][q][1]) + (v[rr][q][2] * v[rr][q][2] + v[rr][q][3] * v[rr][q][3]);
                t = wave_sum(t);
                if (lane < 32) rowss[(size_t)r * 32 + lane] = lane == 0 ? t : 0.f;
                GAS u32x2* o = (GAS u32x2*)(XN + (size_t)r * D) + lane;
#pragma unroll
                for (int q = 0; q < 4; ++q) { const int c = 256 * q + 4 * lane; const f32x4 gg = *(const GAS f32x4*)(gm + c), sc = *(const GAS f32x4*)(md + 1024 + c);
                    const f32x4 y = v[rr][q] * gg * (sc + 1.0f); u32x2 w; w.x = cvt_pk_bf16(y[0], y[1]); w.y = cvt_pk_bf16(y[2], y[3]); o[64 * q] = w; }
            }
        }
    }
    SEAM();
#pragma unroll 1
    for (int layer = 0; layer < 4; ++layer) {
        const int kind = layer % 3, j = layer / 3;
        if (kind == 0) {
            if (IN_PH) { PH_PTRS(); PH_LAYER(); Gemm g = gemm_rowmajor(XN, D, (const GAS bf16_t*)(ws + WS_SWIN) + (size_t)j * D * D, D, D); GMODE(g); StaticOrder S; S.init(M, D, G, bx);
                fill_tables_in(lds, S, rs_mix, swA + layer * 5 * 4096, 1024, tid); EpiU E{UgS}; gemm_phase<EpiU, ARowMajor, StaticOrder>(lds, g, S, E, wave);
                if (layer == 0 && bx >= 192) sw_ffn_job(ws, mods, 0, (bx - 192) * 8 + wave, (G - 192) * 8, lane); }
            SEAM();
            if (IN_PH) { PH_PTRS(); PH_LAYER(); SsmOrder S{G, bx};
                { Gemm g = gemm_rowmajor(UgS, 512, (const GAS bf16_t*)(ws + WS_BTS) + (size_t)j * 64 * 256 * 256, 256, 256); GMODE(g);
                  EpiScan E{UgS, (const GAS float*)(ws + TAB_LAMT), inp(lds, 2), inp(lds, 3), (GAS float*)ldsptr(lds, 30) + (size_t)M * D, (GAS float*)ldsptr(lds, 30) + (size_t)M * D + 32 * 2 * 2 * 64 * 64, j};
                  gemm_phase<EpiScan, ARowMajor, SsmOrder>(lds, g, S, E, wave); }
                asm volatile("s_waitcnt vmcnt(0)" ::: "memory"); __syncthreads(); __builtin_amdgcn_fence(__ATOMIC_ACQUIRE, "agent"); asm volatile("s_waitcnt vmcnt(0)" ::: "memory"); __syncthreads();
                { Gemm g = gemm_rowmajor(UgS, 512, (const GAS bf16_t*)(ws + WS_BTY) + (size_t)j * 64 * 256 * 512, 512, 512); GMODE(g);
                  EpiY E{Zg}; gemm_phase<EpiY, ARowMajor, SsmOrder>(lds, g, S, E, wave); } }
            SEAM();
            if (IN_PH) { PH_PTRS(); PH_LAYER(); Gemm g = gemm_groupchunk(Zg, (const GAS bf16_t*)(ws + WS_SWOUT) + (size_t)j * D * 2048, D, D); GMODE(g); StaticOrder S; S.init(M, 2048, G, bx);
                fill_tables_res<128>(lds, S, modl + 2 * 1024, gsB + layer * 5 * 1024, tid); EpiRes<true> E{X, XN, rs_ffn, true}; gemm_phase<EpiRes<true>, AGroupChunk, StaticOrder>(lds, g, S, E, wave); }
            SEAM();
        } else if (kind == 1) {
            if (IN_PH) { PH_PTRS(); PH_LAYER(); Gemm g = gemm_rowmajor(XN, D, (const GAS bf16_t*)(ws + WS_GWIN), D, D); GMODE(g); StaticOrder S; S.init(M, 4096, G, bx);
                fill_tables_in(lds, S, rs_mix, swA + layer * 5 * 4096, 4096, tid); EpiIn<2, 4096> E{Hb, vstat}; gemm_phase<EpiIn<2, 4096>, ARowMajor, StaticOrder>(lds, g, S, E, wave); }
            SEAM();
            if (IN_PH) { PH_PTRS(); PH_LAYER();
                const GAS bf16_t* Wsb = (const GAS bf16_t*)(ws + WS_GWS); const GAS float* b_s = inp(lds, 24);
                constexpr int VST = 288;
                for (int unit = vcu; unit < 96 * 16; unit += G) {
                    const int c = unit >> 4, g = unit & 15, row0 = c * 128;
                    __syncthreads();
                    LAS f32x2* mr = (LAS f32x2*)(lds + 128 * VST);
                    if (tid < 128) { const GAS f32x4* p = (const GAS f32x4*)(vstat + (size_t)(row0 + tid) * 128); float s1 = 0.f, s2 = 0.f;
#pragma unroll
                        for (int q = 0; q < 32; ++q) { const f32x4 v = p[q]; s1 += v[0] + v[2]; s2 += v[1] + v[3]; }
                        const float mu = s1 * (1.0f / 2048.0f), var = s2 * (1.0f / 2048.0f) - mu * mu; mr[tid] = (f32x2){mu, rsq_f(fmaxf(var, 0.f) + EPS)}; }
                    __syncthreads();
#pragma unroll
                    for (int i = 0; i < 4; ++i) { const int pc = tid + 512 * i, q = pc >> 4, d8 = pc & 15;
                        const u32x4 w = *(const GAS u32x4*)(Hb + (size_t)(row0 + q) * 4096 + 2048 + g * 128 + d8 * 8);
                        const f32x2 st = mr[q]; const float mu = st[0], rstd = st[1];
                        u32x4 o; o.x = cvt_pk_bf16((bf_lo(w.x) - mu) * rstd, (bf_hi(w.x) - mu) * rstd); o.y = cvt_pk_bf16((bf_lo(w.y) - mu) * rstd, (bf_hi(w.y) - mu) * rstd);
                        o.z = cvt_pk_bf16((bf_lo(w.z) - mu) * rstd, (bf_hi(w.z) - mu) * rstd); o.w = cvt_pk_bf16((bf_lo(w.w) - mu) * rstd, (bf_hi(w.w) - mu) * rstd);
                        *(LAS u32x4*)(lds + q * VST + d8 * 16) = o; }
                    __syncthreads();
                    f32x4 acc[8];
#pragma unroll
                    for (int nt = 0; nt < 8; ++nt) acc[nt] = (f32x4){0.f, 0.f, 0.f, 0.f};
                    const int fr = lane & 15, fq = lane >> 4;
#pragma unroll
                    for (int kk = 0; kk < 4; ++kk) {
                        const bf16x8 wf = *(const GAS bf16x8*)(Wsb + ((size_t)g * 128 + wave * 16 + fr) * 128 + kk * 32 + fq * 8);
#pragma unroll
                        for (int nt = 0; nt < 8; ++nt) {
                            const LAS unsigned char* p0 = lds + (kk * 32 + fq * 8 + (fr >> 2)) * VST + (nt * 16 + 4 * (fr & 3)) * 2;
                            const s16x4 lo4 = __builtin_bit_cast(s16x4, __builtin_amdgcn_ds_read_tr16_b64_v4i16((LAS s16x4*)p0));
                            const s16x4 hi4 = __builtin_bit_cast(s16x4, __builtin_amdgcn_ds_read_tr16_b64_v4i16((LAS s16x4*)(p0 + 4 * VST)));
                            const bf16x8 vf = {lo4[0], lo4[1], lo4[2], lo4[3], hi4[0], hi4[1], hi4[2], hi4[3]};
                            acc[nt] = __builtin_amdgcn_mfma_f32_16x16x32_bf16(vf, wf, acc[nt], 0, 0, 0);
                        }
                    }
                    const int p = wave * 16 + fr, row = row0 + p; const float bs = b_s[g * 128 + p];
#pragma unroll
                    for (int nt = 0; nt < 8; ++nt) { const int ch = g * 128 + nt * 16 + 4 * fq;
                        const u32x2 uu = *(const GAS u32x2*)(Hb + (size_t)row * 4096 + ch);
                        u32x2 o; o.x = cvt_pk_bf16(bf_lo(uu.x) * (acc[nt][0] + bs), bf_hi(uu.x) * (acc[nt][1] + bs)); o.y = cvt_pk_bf16(bf_lo(uu.y) * (acc[nt][2] + bs), bf_hi(uu.y) * (acc[nt][3] + bs));
                        *(GAS u32x2*)(A2 + (size_t)row * 2048 + ch) = o; }
                }
                __syncthreads();
            }
            SEAM();
            if (IN_PH) { PH_PTRS(); PH_LAYER(); Gemm g = gemm_rowmajor(A2, 2048, (const GAS bf16_t*)(ws + WS_GWOUT), 2048, 2048); GMODE(g); StaticOrder S; S.init(M, D, G, bx);
                fill_tables_res<256>(lds, S, modl + 2 * 1024, gsB + layer * 5 * 1024, tid); EpiRes<false> E{X, XN, rs_ffn, true}; gemm_phase<EpiRes<false>, ARowMajor, StaticOrder>(lds, g, S, E, wave); }
            SEAM();
        } else {
            if (IN_PH) { PH_PTRS(); PH_LAYER(); Gemm g = gemm_rowmajor(XN, D, (const GAS bf16_t*)(ws + WS_CWIN), D, D); GMODE(g); StaticOrder S; S.init(M, 3072, G, bx);
                fill_tables_in(lds, S, rs_mix, swA + layer * 5 * 4096, 3072, tid); EpiIn<0, 3072> E{Hb, nullptr}; gemm_phase<EpiIn<0, 3072>, ARowMajor, StaticOrder>(lds, g, S, E, wave); }
            SEAM();
            if (IN_PH) { PH_PTRS(); PH_LAYER();
                const GAS float* cw = inp(lds, 27);
                for (int it = gw * 64 + lane; it < M * 128; it += NGW * 64) {
                    const int row = it >> 7, c8 = (it & 127) * 8;
                    const int L = row < MP ? 256 : 1024, t = row < MP ? (row & 255) : ((row - MP) & 1023);
                    const GAS bf16_t* pr = Hb + (size_t)row * 3072 + c8;
                    float y[8];
#pragma unroll
                    for (int q = 0; q < 8; ++q) y[q] = 0.f;
#pragma unroll
                    for (int w = 0; w < 3; ++w) { const int tt = t + w - 1; if (tt < 0 || tt >= L) continue;
                        const u32x4 gc = *(const GAS u32x4*)(pr + (ptrdiff_t)(w - 1) * 3072 + 1024), xh = *(const GAS u32x4*)(pr + (ptrdiff_t)(w - 1) * 3072 + 2048);
                        const f32x4 k0 = *(const GAS f32x4*)(cw + w * 1024 + c8), k1 = *(const GAS f32x4*)(cw + w * 1024 + c8 + 4);
                        y[0] += k0[0] * bf_lo(gc.x) * bf_lo(xh.x); y[1] += k0[1] * bf_hi(gc.x) * bf_hi(xh.x); y[2] += k0[2] * bf_lo(gc.y) * bf_lo(xh.y); y[3] += k0[3] * bf_hi(gc.y) * bf_hi(xh.y);
                        y[4] += k1[0] * bf_lo(gc.z) * bf_lo(xh.z); y[5] += k1[1] * bf_hi(gc.z) * bf_hi(xh.z); y[6] += k1[2] * bf_lo(gc.w) * bf_lo(xh.w); y[7] += k1[3] * bf_hi(gc.w) * bf_hi(xh.w); }
                    const u32x4 gb = *(const GAS u32x4*)pr;
                    u32x4 o; o.x = cvt_pk_bf16(bf_lo(gb.x) * y[0], bf_hi(gb.x) * y[1]); o.y = cvt_pk_bf16(bf_lo(gb.y) * y[2], bf_hi(gb.y) * y[3]);
                    o.z = cvt_pk_bf16(bf_lo(gb.z) * y[4], bf_hi(gb.z) * y[5]); o.w = cvt_pk_bf16(bf_lo(gb.w) * y[6], bf_hi(gb.w) * y[7]);
                    *(GAS u32x4*)(A2 + (size_t)row * D + c8) = o;
                }
            }
            SEAM();
            if (IN_PH) { PH_PTRS(); PH_LAYER(); Gemm g = gemm_rowmajor(A2, D, (const GAS bf16_t*)(ws + WS_CWOUT), D, D); GMODE(g); StaticOrder S; S.init(M, D, G, bx);
                fill_tables_res<256>(lds, S, modl + 2 * 1024, gsB + layer * 5 * 1024, tid); EpiRes<false> E{X, XN, rs_ffn, true}; gemm_phase<EpiRes<false>, ARowMajor, StaticOrder>(lds, g, S, E, wave); }
            SEAM();
        }
        if (IN_PH) { PH_PTRS(); PH_LAYER(); Gemm g = gemm_rowmajor(XN, D, (const GAS bf16_t*)(ws + WS_W1) + (size_t)layer * D * FF, D, D); GMODE(g); StaticOrder S; S.init(M, FF, G, bx);
            fill_tables_in(lds, S, rs_ffn, swB + layer * 5 * 4096, 4096, tid); EpiIn<1, 4096> E{Hb, nullptr}; gemm_phase<EpiIn<1, 4096>, ARowMajor, StaticOrder>(lds, g, S, E, wave); }
        SEAM();
        if (IN_PH) { PH_PTRS(); PH_LAYER(); Gemm g = gemm_rowmajor(Hb, FF, (const GAS bf16_t*)(ws + WS_W2) + (size_t)layer * D * FF, FF, FF); GMODE(g); StaticOrder S; S.init(M, D, G, bx);
            fill_tables_res<256>(lds, S, modl + 5 * 1024, layer < 3 ? gsA + (layer + 1) * 5 * 1024 : (const GAS float*)nullptr, tid); EpiRes<false> E{X, XN, rs_next, layer < 3}; gemm_phase<EpiRes<false>, ARowMajor, StaticOrder>(lds, g, S, E, wave);
            if (layer < 3 && bx >= 192) { sw_mix_job(ws, mods, layer + 1, (bx - 192) * 8 + wave, (G - 192) * 8, lane); sw_ffn_job(ws, mods, layer + 1, (bx - 192) * 8 + wave, (G - 192) * 8, lane); } }
        SEAM();
    }
    if (IN_PH) { PH_PTRS();
        const GAS float* gf = inp(lds, 29);
        for (int row = gw; row < M; row += 3 * NGW) {
            f32x4 v[3][4];
#pragma unroll
            for (int rr = 0; rr < 3; ++rr)
#pragma unroll
                for (int q = 0; q < 4; ++q) v[rr][q] = ((const GAS f32x4*)(X + (size_t)(row + rr * NGW) * D) + lane)[64 * q];
            f32x4 gq[4];
#pragma unroll
            for (int q = 0; q < 4; ++q) gq[q] = *(const GAS f32x4*)(gf + 256 * q + 4 * lane);
#pragma unroll
            for (int rr = 0; rr < 3; ++rr) { float t = 0.f;
#pragma unroll
                for (int q = 0; q < 4; ++q) t += (v[rr][q][0] * v[rr][q][0] + v[rr][q][1] * v[rr][q][1]) + (v[rr][q][2] * v[rr][q][2] + v[rr][q][3] * v[rr][q][3]);
                t = wave_sum(t); const float r0 = rsq_f(t * (1.0f / D) + EPS);
                GAS f32x4* xr = (GAS f32x4*)(X + (size_t)(row + rr * NGW) * D) + lane;
#pragma unroll
                for (int q = 0; q < 4; ++q) xr[64 * q] = v[rr][q] * r0 * gq[q]; }
        }
    }
    ++ph;
#undef IN_PH
#undef SEAM
}

static bool launch(void* const* d_in, float* out, unsigned char* ws, int lo, int hi, hipStream_t stream, int mode = 0) {
    static int grid = 0;
    if (grid == 0) {
        int dev = 0, cus = 0, per_cu = 0;
        if (hipGetDevice(&dev) != hipSuccess || hipDeviceGetAttribute(&cus, hipDeviceAttributeMultiprocessorCount, dev) != hipSuccess) { grid = -1; return false; }
        if (hipFuncSetAttribute((const void*)fwd, hipFuncAttributeMaxDynamicSharedMemorySize, LDS_BYTES) != hipSuccess) { fprintf(stderr, "hipFuncSetAttribute failed\n"); grid = -1; return false; }
        if (hipOccupancyMaxActiveBlocksPerMultiprocessor(&per_cu, (const void*)fwd, 512, LDS_BYTES) != hipSuccess || per_cu < 1) { fprintf(stderr, "occupancy query: %d\n", per_cu); (void)hipGetLastError(); per_cu = 1; }
        grid = cus;
    }
    if (grid < 0) return false;
    Args a{};
    for (int i = 0; i < 30; ++i) a.in[i] = (const float*)d_in[i];
    a.out = out; a.ws = ws; a.ph_lo = lo; a.ph_hi = hi; a.mode = mode;
    void* kargs[] = {&a};
    const hipError_t e = hipLaunchCooperativeKernel((const void*)fwd, dim3(grid), dim3(512), kargs, LDS_BYTES, stream);
    if (e != hipSuccess) { fprintf(stderr, "cooperative launch failed: %s (grid %d)\n", hipGetErrorString(e), grid); return false; }
    return true;
}
}
extern "C" void kernel_launch(void* const* d_in, const int* in_sizes, int n_in, void* d_out, int out_size, void* d_ws, size_t ws_size, hipStream_t stream) {
    if (n_in != 30 || ws_size < mk::WS_END) { fprintf(stderr, "kernel_launch: unexpected n_in %d / ws %zu\n", n_in, ws_size); return; }
    (void)hipMemsetAsync((char*)d_ws + mk::WS_CTL, 0, mk::CTL_BYTES, stream);
    mk::launch(d_in, (float*)d_out, (unsigned char*)d_ws, 0, 23, stream);
}
```

```cpp
#include <hip/hip_runtime.h>
#include <cstdio>
#include <cstdint>
#include <hip/hip_cooperative_groups.h>
namespace mk {
namespace cg = cooperative_groups;
#define LAS __attribute__((address_space(3)))
#define GAS __attribute__((address_space(1)))
typedef unsigned short bf16_t;
typedef short bf16x8 __attribute__((ext_vector_type(8)));
typedef short s16x4 __attribute__((ext_vector_type(4)));
typedef float f32x4 __attribute__((ext_vector_type(4)));
typedef float f32x2 __attribute__((ext_vector_type(2)));
typedef unsigned u32x4 __attribute__((ext_vector_type(4)));
typedef unsigned u32x2 __attribute__((ext_vector_type(2)));

constexpr int D = 1024, M = 12288, MP = 8192, FF = 4096, NCH = 768;
constexpr float EPS = 1e-6f;
constexpr int BM = 256, BK = 64, HALF = 128, HTB = HALF * BK * 2, STAGE_BYTES = 8 * HTB, NXCD = 8, WGM = 8;

typedef __bf16 bf16x2_t __attribute__((ext_vector_type(2)));
__device__ __forceinline__ unsigned cvt_pk_bf16(float lo, float hi) { const f32x2 v = {lo, hi}; const bf16x2_t b = __builtin_convertvector(v, bf16x2_t); return __builtin_bit_cast(unsigned, b); }
__device__ __forceinline__ unsigned f2bf(float f) { unsigned u = __builtin_bit_cast(unsigned, f); return (u + 0x7fffu + ((u >> 16) & 1u)) >> 16; }
__device__ __forceinline__ float bf_lo(unsigned w) { return __uint_as_float(w << 16); }
__device__ __forceinline__ float bf_hi(unsigned w) { return __uint_as_float(w & 0xffff0000u); }
__device__ __forceinline__ float rcp_f(float x) { return __builtin_amdgcn_rcpf(x); }
__device__ __forceinline__ float rsq_f(float x) { return __builtin_amdgcn_rsqf(x); }
__device__ __forceinline__ float gelu_tanh(float x) {
    const float t = x * x * (0.044715f * -2.0f * 0.7978845608028654f * 1.4426950408889634f) + (-2.0f * 0.7978845608028654f * 1.4426950408889634f);
    return x * rcp_f(1.0f + __builtin_amdgcn_exp2f(x * t));
}
__device__ __forceinline__ float sigmoid_f(float x) { return rcp_f(1.0f + __builtin_amdgcn_exp2f(x * -1.4426950408889634f)); }
__device__ __forceinline__ int lane_id() { int r; asm volatile("v_mbcnt_lo_u32_b32 %0, -1, 0\n\tv_mbcnt_hi_u32_b32 %0, -1, %0" : "=v"(r)); return r; }
__device__ __forceinline__ int cond_of_pm(int pm) { return pm < 32 ? 0 : 1 + ((pm - 32) >> 2); }
__device__ __forceinline__ int cond_of_row(int row) { return row < MP ? 0 : 1 + ((row - MP) >> 10); }

__host__ __device__ __forceinline__ int lds_byte(int r, int c) { const int st = (r >> 4) * 2 + (c >> 5), rr = r & 15, cc = c & 31, ob = rr * 64 + cc * 2; return st * 1024 + (ob ^ (((ob >> 9) & 1) << 5)); }
__host__ __device__ __forceinline__ void stage_rc(int b, int& R, int& C) { const int st = b / 1024, sb = b % 1024, swz = sb ^ (((sb >> 9) & 1) << 5); R = (st >> 1) * 16 + swz / 64; C = (st & 1) * 32 + (swz % 64) / 2; }
__host__ __device__ __forceinline__ int perm32(int rho) { const int n = rho >> 4, i = rho & 15; return 8 * (i >> 2) + 4 * n + (i & 3); }

struct Unit { int pm, pn; };
struct Gemm { const GAS char* A; const GAS char* Bt; int K; int lda; int ldb; size_t kstepA, hstepA, tstepA; int mode; };
struct ARowMajor { static __device__ __forceinline__ unsigned voff(int R, int C, int lda) { return (unsigned)(R * lda + C) * 2u; } };
struct AGroupChunk { static __device__ __forceinline__ unsigned voff(int R, int C, int) { return (unsigned)((((C >> 4) * NCH + (R >> 4)) * 256) + (R & 15) * 16 + (C & 15)) * 2u; } };
__device__ inline Gemm gemm_rowmajor(const GAS void* A, int lda, const GAS void* Bt, int ldb, int K) {
    Gemm g; g.A = (const GAS char*)A; g.Bt = (const GAS char*)Bt; g.K = K; g.lda = lda; g.ldb = ldb; g.kstepA = BK * 2; g.hstepA = (size_t)HALF * lda * 2; g.tstepA = 2 * g.hstepA; g.mode = 0; return g; }
__device__ inline Gemm gemm_groupchunk(const GAS void* A, const GAS void* Bt, int ldb, int K) {
    Gemm g; g.A = (const GAS char*)A; g.Bt = (const GAS char*)Bt; g.K = K; g.lda = 0; g.ldb = ldb; g.kstepA = (size_t)4 * NCH * 256 * 2; g.hstepA = 8 * 256 * 2; g.tstepA = 16 * 256 * 2; g.mode = 0; return g; }

struct StaticOrder {
    int nM, nN, nwg, G, c;
    __host__ __device__ void init(int M_, int N_, int G_, int c_) { nM = M_ / BM; nN = N_ / BM; nwg = nM * nN; G = G_; c = c_; }
    __host__ __device__ bool next(int i, Unit& u) const {
        const long L = (long)i * G + c; if (L >= nwg) return false;
        int wgid = (int)L; { const int q = nwg / NXCD, r = nwg % NXCD, xcd = wgid % NXCD, off = wgid / NXCD; wgid = (xcd < r ? xcd * (q + 1) : r * (q + 1) + (xcd - r) * q) + off; }
        const int nig = WGM * nN, gid = wgid / nig, fm = gid * WGM, gsz = (nM - fm) < WGM ? (nM - fm) : WGM;
        u.pm = fm + ((wgid % nig) % gsz); u.pn = (wgid % nig) / gsz; return true;
    }
};
struct SsmOrder {
    int G, c;
    __host__ __device__ bool next(int i, Unit& u) const { const int L = i * G + c; if (L >= 192) return false; u.pm = L; u.pn = L / 3; return true; }
};

template <class Epi, class AL, class Sched>
__device__ __forceinline__ void gemm_phase(LAS unsigned char* lds, const Gemm g, const Sched& S, const Epi& E, int wave_) {
    int tid = wave_ * 64 + lane_id(); asm volatile("" : "+v"(tid));
    const int wid = __builtin_amdgcn_readfirstlane(tid >> 6), lane = tid & 63, wr = wid >> 2, wc = wid & 3, fr = lane & 15, fq = lane >> 4;
    const int K = g.K, nt = K / BK;
    unsigned voffA[2], voffB[2];
#pragma unroll
    for (int i = 0; i < 2; ++i) { int R, C; stage_rc(tid * 16 + i * 8192, R, C); const int Rb = Epi::PERM ? ((R & ~31) + perm32(R & 31)) : R;
        voffA[i] = AL::voff(R, C, g.lda); voffB[i] = (unsigned)(Rb * g.ldb + C) * 2u; }
    const size_t kstepA = g.kstepA, hstepA = g.hstepA, tstepA = g.tstepA;
    const size_t kstepB = (size_t)(BK * 2), hstepB = (size_t)HALF * g.ldb * 2, tstepB = 2 * hstepB;
    const unsigned ldsw = (unsigned)wid * 1024u;
    const int aoff = lds_byte(wr * 64 + fr, fq * 8), boff = lds_byte(wc * 32 + fr, fq * 8);
#define PG8_SA(b, h) (((b) * 2 + (h)) * HTB)
#define PG8_SB(b, h) ((4 + (b) * 2 + (h)) * HTB)
#define PG8_STAGE(bufoff, gbase, voff) do { _Pragma("unroll") for (int _i = 0; _i < 2; ++_i) \
        __builtin_amdgcn_global_load_lds((const GAS unsigned*)((const GAS char*)(gbase) + (voff)[_i]), (LAS unsigned*)(lds + (bufoff) + ldsw + _i * 8192), 16, 0, 0); } while (0)
#define PG8_LDA(dst, b, h) do { _Pragma("unroll") for (int m = 0; m < 4; ++m) _Pragma("unroll") for (int k = 0; k < 2; ++k) dst[m][k] = *(const LAS bf16x8*)(lds + PG8_SA(b, h) + aoff + m * 2048 + k * 1024); } while (0)
#define PG8_LDB(dst, b, h) do { _Pragma("unroll") for (int n = 0; n < 2; ++n) _Pragma("unroll") for (int k = 0; k < 2; ++k) dst[n][k] = *(const LAS bf16x8*)(lds + PG8_SB(b, h) + boff + n * 2048 + k * 1024); } while (0)
#define PG8_MMA(ai, bj, At, Bt) do { __builtin_amdgcn_s_setprio(1); _Pragma("unroll") for (int m = 0; m < 4; ++m) _Pragma("unroll") for (int n = 0; n < 2; ++n) _Pragma("unroll") for (int k = 0; k < 2; ++k) \
        acc[ai][bj][m][n] = __builtin_amdgcn_mfma_f32_16x16x32_bf16(Bt[n][k], At[m][k], acc[ai][bj][m][n], 0, 0, 0); __builtin_amdgcn_s_setprio(0); } while (0)
#define PG8_WAIT_V(n) asm volatile("s_waitcnt vmcnt(" #n ")" ::: "memory")
#define PG8_WAIT_L(n) asm volatile("s_waitcnt lgkmcnt(" #n ")" ::: "memory")
#define PG8_BAR __builtin_amdgcn_s_barrier()
#define PG8_SCHED __builtin_amdgcn_sched_barrier(0)
    Unit cur, nxt; int ui = 0;
    if (!S.next(0, cur)) return;
    f32x4 acc[2][2][4][2];
#pragma unroll
    for (int a = 0; a < 2; ++a)
#pragma unroll
        for (int b = 0; b < 2; ++b)
#pragma unroll
            for (int m = 0; m < 4; ++m)
#pragma unroll
                for (int n = 0; n < 2; ++n) acc[a][b][m][n] = (f32x4){0.f, 0.f, 0.f, 0.f};
    bf16x8 At[4][2], B0[2][2], B1[2][2];
    const GAS char* cA = g.A + (size_t)cur.pm * tstepA; const GAS char* cB = g.Bt + (size_t)cur.pn * tstepB;
    PG8_STAGE(PG8_SB(0, 0), cB, voffB); PG8_STAGE(PG8_SB(0, 1), cB + hstepB, voffB); PG8_STAGE(PG8_SA(0, 0), cA, voffA); PG8_STAGE(PG8_SA(0, 1), cA + hstepA, voffA);
    if (wr == 1) PG8_BAR;
    PG8_WAIT_V(2); PG8_BAR;
    PG8_STAGE(PG8_SB(1, 0), cB + kstepB, voffB); PG8_STAGE(PG8_SA(1, 0), cA + kstepA, voffA); PG8_STAGE(PG8_SB(1, 1), cB + hstepB + kstepB, voffB);
    PG8_WAIT_V(6); PG8_BAR;
    for (;;) {
        const bool has_next = S.next(ui + 1, nxt);
        const GAS char* nA = has_next ? g.A + (size_t)nxt.pm * tstepA : cA; const GAS char* nB = has_next ? g.Bt + (size_t)nxt.pn * tstepB : cB;
        for (int t = 0; t < nt; t += 2) {
            const bool last = (t == nt - 2);
            const GAS char* a1 = cA + (size_t)(t + 1) * kstepA;
            const GAS char* a2 = last ? nA : cA + (size_t)(t + 2) * kstepA; const GAS char* b2 = last ? nB : cB + (size_t)(t + 2) * kstepB;
            const GAS char* a3 = a2 + kstepA; const GAS char* b3 = b2 + kstepB;
            PG8_LDB(B0, 0, 0); PG8_LDB(B1, 0, 1); PG8_SCHED; PG8_LDA(At, 0, 0); PG8_STAGE(PG8_SA(1, 1), a1 + hstepA, voffA);
            PG8_WAIT_V(8); PG8_WAIT_L(0); PG8_BAR; PG8_MMA(0, 0, At, B0); PG8_MMA(0, 1, At, B1); PG8_BAR; PG8_SCHED;
            PG8_LDA(At, 0, 1); PG8_STAGE(PG8_SB(0, 0), b2, voffB); PG8_STAGE(PG8_SB(0, 1), b2 + hstepB, voffB); PG8_STAGE(PG8_SA(0, 0), a2, voffA);
            PG8_WAIT_V(8); PG8_WAIT_L(0); PG8_BAR; PG8_MMA(1, 0, At, B0); PG8_MMA(1, 1, At, B1); PG8_BAR; PG8_SCHED;
            PG8_LDB(B0, 1, 0); PG8_LDB(B1, 1, 1); PG8_SCHED; PG8_LDA(At, 1, 0); PG8_STAGE(PG8_SA(0, 1), a2 + hstepA, voffA);
            PG8_WAIT_V(8); PG8_WAIT_L(0); PG8_BAR; PG8_MMA(0, 0, At, B0); PG8_MMA(0, 1, At, B1); PG8_BAR; PG8_SCHED;
            PG8_LDA(At, 1, 1); PG8_STAGE(PG8_SB(1, 0), b3, voffB); PG8_STAGE(PG8_SB(1, 1), b3 + hstepB, voffB); PG8_STAGE(PG8_SA(1, 0), a3, voffA);
            PG8_WAIT_V(8); PG8_WAIT_L(0); PG8_BAR; PG8_MMA(1, 0, At, B0); PG8_MMA(1, 1, At, B1); PG8_BAR; PG8_SCHED;
        }
        if (wr == 0) PG8_BAR;
        int el_ = lane_id(); asm volatile("" : "+v"(el_));
        const int efr = el_ & 15, efq = el_ >> 4;
#ifdef MK_RANGE
        if constexpr (!Epi::AFTER_DRAIN) { if (g.mode != 1) E(acc, cur, ui, lds, wr, wc, efr, efq); else { asm volatile("" :: "v"(acc[0][0][0][0]), "v"(acc[1][1][3][1])); } }
#else
        if constexpr (!Epi::AFTER_DRAIN) E(acc, cur, ui, lds, wr, wc, efr, efq);
#endif
        if (!has_next) break;
#pragma unroll
        for (int a = 0; a < 2; ++a)
#pragma unroll
            for (int b = 0; b < 2; ++b)
#pragma unroll
                for (int m = 0; m < 4; ++m)
#pragma unroll
                    for (int n = 0; n < 2; ++n) acc[a][b][m][n] = (f32x4){0.f, 0.f, 0.f, 0.f};
        cur = nxt; cA = nA; cB = nB; ++ui;
        if (wr == 1) PG8_BAR;
    }
    PG8_WAIT_V(0);
    PG8_BAR;
    if constexpr (Epi::AFTER_DRAIN) E.fused(acc, cur, wr, wc, fr, fq, lds, tid);
#undef PG8_SA
#undef PG8_SB
#undef PG8_STAGE
#undef PG8_LDA
#undef PG8_LDB
#undef PG8_MMA
#undef PG8_WAIT_V
#undef PG8_WAIT_L
#undef PG8_BAR
#undef PG8_SCHED
}

typedef const f32x4 (&AccRef)[2][2][4][2];

constexpr int PTR_OFF = STAGE_BYTES + 256 + 10240;
__device__ __forceinline__ unsigned long long ldsptr(const LAS unsigned char* lds, int k) { const unsigned long long v = ((const LAS unsigned long long*)(lds + PTR_OFF))[k];
    return ((unsigned long long)(unsigned)__builtin_amdgcn_readfirstlane((int)(unsigned)(v >> 32)) << 32) | (unsigned)__builtin_amdgcn_readfirstlane((int)(unsigned)v); }
__device__ __forceinline__ const GAS float* inp(const LAS unsigned char* lds, int k) { return (const GAS float*)ldsptr(lds, k); }
constexpr int TAB_OFF = STAGE_BYTES + 256, T_RS = TAB_OFF, T_SW = T_RS + 3072, T_GATE = T_SW + 3072, T_GSN = T_GATE + 2048;
template <class Sched> __device__ __forceinline__ void fill_tables_in(LAS unsigned char* lds, const Sched& S, const GAS float* rowss, const GAS float* sw, int swld, int tid) {
    LAS float* trs = (LAS float*)(lds + T_RS); LAS float* tsw = (LAS float*)(lds + T_SW);
#pragma unroll 1
    for (int i = 0; i < 3; ++i) { Unit u; if (!S.next(i, u)) break;
        if (tid < 256) { const GAS f32x4* p = (const GAS f32x4*)(rowss + (size_t)(u.pm * BM + tid) * 32);
            const f32x4 a = ((p[0] + p[1]) + (p[2] + p[3])) + ((p[4] + p[5]) + (p[6] + p[7]));
            trs[i * 256 + tid] = rsq_f(((a[0] + a[1]) + (a[2] + a[3])) * (1.0f / D) + EPS); }
        else tsw[i * 256 + tid - 256] = sw[(unsigned)(cond_of_pm(u.pm) * swld + u.pn * BM + tid - 256)];
    }
    __syncthreads();
}
template <int NCOL, class Sched> __device__ __forceinline__ void fill_tables_res(LAS unsigned char* lds, const Sched& S, const GAS float* gate, const GAS float* gsn, int tid) {
    LAS float* tg = (LAS float*)(lds + T_GATE); LAS float* tn = (LAS float*)(lds + T_GSN);
#pragma unroll 1
    for (int i = 0; i < 2; ++i) { Unit u; if (!S.next(i, u)) break; const int ci = cond_of_pm(u.pm);
        if (tid < NCOL) tg[i * 256 + tid] = gate[(unsigned)(ci * 6144 + u.pn * NCOL + tid)];
        else if (tid >= 256 && tid < 256 + NCOL) tn[i * 256 + tid - 256] = gsn ? gsn[(unsigned)(ci * 1024 + u.pn * NCOL + tid - 256)] : 0.f;
    }
    __syncthreads();
}
__device__ __forceinline__ void load_rstd(const LAS unsigned char* lds, int ui, int wr, int fr, float (&rs)[2][4]) {
    const LAS float* trs = (const LAS float*)(lds + T_RS) + ui * 256 + wr * 64 + fr;
#pragma unroll
    for (int ai = 0; ai < 2; ++ai)
#pragma unroll
        for (int m = 0; m < 4; ++m) rs[ai][m] = trs[ai * HALF + m * 16];
}

template <int ACT, int LDC> struct EpiIn {
    static constexpr bool PERM = true, AFTER_DRAIN = false;
    GAS bf16_t* O; GAS float* vstat;
    __device__ __forceinline__ void operator()(AccRef acc, const Unit& u, int ui, const LAS unsigned char* lds, int wr, int wc, int fr, int fq) const {
        const int row0 = u.pm * BM + wr * 64 + fr, col0 = u.pn * BM + wc * 32 + 8 * fq;
        float rs[2][4]; load_rstd(lds, ui, wr, fr, rs);
        const LAS float* swp = (const LAS float*)(lds + T_SW) + ui * 256 + wc * 32 + 8 * fq;
        const bool stats = ACT == 2 && u.pn >= 8;
#pragma unroll
        for (int bj = 0; bj < 2; ++bj) {
            const f32x4 b0 = *(const LAS f32x4*)(swp + bj * HALF), b1 = *(const LAS f32x4*)(swp + bj * HALF + 4);
#pragma unroll
            for (int ai = 0; ai < 2; ++ai)
#pragma unroll
                for (int m = 0; m < 4; ++m) {
                    const unsigned r = (unsigned)(row0 + ai * HALF + m * 16);
                    f32x4 v0 = acc[ai][bj][m][0] * rs[ai][m] + b0, v1 = acc[ai][bj][m][1] * rs[ai][m] + b1;
                    if (ACT == 1) {
#pragma unroll
                        for (int j = 0; j < 4; ++j) { const float a = fmaxf(v0[j], 0.f), b = fmaxf(v1[j], 0.f); v0[j] = a * a; v1[j] = b * b; } }
                    if (ACT == 2) {
#pragma unroll
                        for (int j = 0; j < 4; ++j) { v0[j] = gelu_tanh(v0[j]); v1[j] = gelu_tanh(v1[j]); } }
                    u32x4 w; w.x = cvt_pk_bf16(v0[0], v0[1]); w.y = cvt_pk_bf16(v0[2], v0[3]); w.z = cvt_pk_bf16(v1[0], v1[1]); w.w = cvt_pk_bf16(v1[2], v1[3]);
                    *(GAS u32x4*)(O + (r * (unsigned)LDC + (unsigned)(col0 + bj * HALF))) = w;
                    if (ACT == 2) { if (stats) {
                        float a = (v0[0] + v0[1]) + (v0[2] + v0[3]) + (v1[0] + v1[1]) + (v1[2] + v1[3]);
                        float b = (v0[0] * v0[0] + v0[1] * v0[1]) + (v0[2] * v0[2] + v0[3] * v0[3]) + (v1[0] * v1[0] + v1[1] * v1[1]) + (v1[2] * v1[2] + v1[3] * v1[3]);
                        a += __shfl_xor(a, 16); a += __shfl_xor(a, 32); b += __shfl_xor(b, 16); b += __shfl_xor(b, 32);
                        if (fq == 0) *(GAS f32x2*)(vstat + (r * 64u + (unsigned)(((u.pn - 8) * 2 + bj) * 4 + wc)) * 2u) = (f32x2){a, b}; } }
                }
        }
    }
};
struct EpiU {
    static constexpr bool PERM = true, AFTER_DRAIN = false;
    GAS bf16_t* UgS;
    __device__ __forceinline__ void operator()(AccRef acc, const Unit& u, int ui, const LAS unsigned char* lds, int wr, int wc, int fr, int fq) const {
        const int col0 = u.pn * BM + wc * 32 + 8 * fq;
        float rs[2][4]; load_rstd(lds, ui, wr, fr, rs);
        const LAS float* swp = (const LAS float*)(lds + T_SW) + ui * 256 + wc * 32 + 8 * fq;
#pragma unroll
        for (int bj = 0; bj < 2; ++bj) {
            const f32x4 b0 = *(const LAS f32x4*)(swp + bj * HALF), b1 = *(const LAS f32x4*)(swp + bj * HALF + 4);
            const int g = (col0 + bj * HALF) >> 4, p0 = (col0 & 15);
#pragma unroll
            for (int ai = 0; ai < 2; ++ai)
#pragma unroll
                for (int m = 0; m < 4; ++m) {
                    const f32x4 v0 = acc[ai][bj][m][0] * rs[ai][m] + b0, v1 = acc[ai][bj][m][1] * rs[ai][m] + b1;
                    u32x4 w; w.x = cvt_pk_bf16(v0[0], v0[1]); w.y = cvt_pk_bf16(v0[2], v0[3]); w.z = cvt_pk_bf16(v1[0], v1[1]); w.w = cvt_pk_bf16(v1[2], v1[3]);
                    const int chunk = u.pm * 16 + ai * 8 + wr * 4 + m;
                    *(GAS u32x4*)(UgS + ((unsigned)(g * NCH + chunk) * 512u + (unsigned)(fr * 16 + p0))) = w;
                }
        }
    }
};
struct EpiScan {
    static constexpr bool PERM = true, AFTER_DRAIN = true;
    GAS bf16_t* UgS; const GAS float* lamT; const GAS float* h0_re; const GAS float* h0_im; GAS float* new_re; GAS float* new_im; int j;
    static __device__ __forceinline__ int lidx(int row, int col) { return row * 128 + ((((col >> 2) ^ row) & 31) << 2) + (col & 3); }
    __device__ __forceinline__ void fused(AccRef acc, const Unit& u, int wr, int wc, int fr, int fq, LAS unsigned char* lds, int tid) const {
        LAS float* T = (LAS float*)lds;
        const int g = u.pn, mt = u.pm - 3 * g, n = tid & 63, slot = __builtin_amdgcn_readfirstlane(tid >> 6);
        const int len = mt < 2 ? 16 : 64, nsq = mt < 2 ? 2 : (slot < 4 ? 1 : 0), sl0 = mt < 2 ? slot * 2 : slot;
#pragma unroll 1
        for (int k = 0; k < 2; ++k) {
#pragma unroll
            for (int ai = 0; ai < 2; ++ai)
#pragma unroll
                for (int m = 0; m < 4; ++m) { const int row = ai * HALF + wr * 64 + m * 16 + fr;
#pragma unroll
                    for (int nn = 0; nn < 2; ++nn) { const int col = wc * 32 + 8 * fq + 4 * nn; *(LAS f32x4*)(T + lidx(row, col)) = k == 0 ? acc[ai][0][m][nn] : acc[ai][1][m][nn]; } }
            __syncthreads();
            const float lr = lamT[(((unsigned)j * 64 + g) * 2 + k) * 128 + 2 * n], li = lamT[(((unsigned)j * 64 + g) * 2 + k) * 128 + 2 * n + 1];
            for (int q = 0; q < nsq; ++q) {
                const int sl = sl0 + q, r0 = sl * len;
                float sr = 0.f, si = 0.f;
                if (mt == 2) { const unsigned o = ((((unsigned)sl * 2 + j) * 2 + k) * 64 + g) * 64 + n; sr = h0_re[o]; si = h0_im[o]; }
                GAS bf16_t* so = UgS + ((size_t)g * NCH + mt * 256) * 512 + 256 + k * 128 + n;
                for (int i = 0; i < len; ++i) {
                    const int row = k == 0 ? r0 + i : r0 + len - 1 - i;
                    so[(unsigned)row * 512u] = (bf16_t)f2bf(sr); so[(unsigned)row * 512u + 64u] = (bf16_t)f2bf(si);
                    const float ar = T[lidx(row, n)], ai2 = T[lidx(row, 64 + n)];
                    const float nr = lr * sr - li * si + ar, ni = lr * si + li * sr + ai2; sr = nr; si = ni;
                }
                if (mt < 2) { const unsigned o = ((((unsigned)(mt * 16 + sl) * 2 + j) * 2 + k) * 64 + g) * 64 + n; new_re[o] = sr; new_im[o] = si; }
            }
            __syncthreads();
        }
    }
};
struct EpiY {
    static constexpr bool PERM = true, AFTER_DRAIN = false;
    GAS bf16_t* Zg;
    __device__ __forceinline__ void operator()(AccRef acc, const Unit& u, int ui, const LAS unsigned char* lds, int wr, int wc, int fr, int fq) const {
        const int row0 = u.pm * BM + wr * 64 + fr, col0 = wc * 32 + 8 * fq;
#pragma unroll
        for (int ai = 0; ai < 2; ++ai)
#pragma unroll
            for (int m = 0; m < 4; ++m) { GAS bf16_t* rp = Zg + (size_t)(row0 + ai * HALF + m * 16) * 256 + col0;
#pragma unroll
                for (int bj = 0; bj < 2; ++bj) { const f32x4 v0 = acc[ai][bj][m][0], v1 = acc[ai][bj][m][1];
                    u32x4 w; w.x = cvt_pk_bf16(gelu_tanh(v0[0]), gelu_tanh(v0[1])); w.y = cvt_pk_bf16(gelu_tanh(v0[2]), gelu_tanh(v0[3]));
                    w.z = cvt_pk_bf16(gelu_tanh(v1[0]), gelu_tanh(v1[1])); w.w = cvt_pk_bf16(gelu_tanh(v1[2]), gelu_tanh(v1[3]));
                    *(GAS u32x4*)(rp + bj * HALF) = w; } }
    }
};
template <bool GATED> struct EpiRes {
    static constexpr bool PERM = true, AFTER_DRAIN = false;
    GAS float* X; GAS bf16_t* XN; GAS float* rowss_next; bool has_next;
    __device__ __forceinline__ void operator()(AccRef acc, const Unit& u, int ui, const LAS unsigned char* lds, int wr, int wc, int fr, int fq) const {
        constexpr int NB = GATED ? 1 : 2, NBATCH = 2 * NB;
        const int row0 = u.pm * BM + wr * 64 + fr, col0 = u.pn * (GATED ? HALF : BM) + wc * 32 + 8 * fq;
        const LAS float* tg = (const LAS float*)(lds + T_GATE) + ui * 256 + wc * 32 + 8 * fq; const LAS float* tn = (const LAS float*)(lds + T_GSN) + ui * 256 + wc * 32 + 8 * fq;
        f32x4 x0_[2][2], x1_[2][2], x2_[2][2];
#define RES_LOAD(dst, b_) do { const int bj_ = (b_) / 4, ai_ = ((b_) / 2) % 2, mh_ = (b_) % 2; _Pragma("unroll") for (int mm = 0; mm < 2; ++mm) { \
            const GAS float* xp = X + ((unsigned)(row0 + ai_ * HALF + (mh_ * 2 + mm) * 16) * (unsigned)D + (unsigned)(col0 + bj_ * HALF)); dst[mm][0] = *(const GAS f32x4*)xp; dst[mm][1] = *(const GAS f32x4*)(xp + 4); } } while (0)
#define RES_PROC(src, b_) do { const int bj = (b_) / 4, ai = ((b_) / 2) % 2, mh = (b_) % 2; \
            const f32x4 g0 = *(const LAS f32x4*)(tg + bj * HALF), g1 = *(const LAS f32x4*)(tg + bj * HALF + 4), n0 = *(const LAS f32x4*)(tn + bj * HALF), n1 = *(const LAS f32x4*)(tn + bj * HALF + 4); \
            _Pragma("unroll") for (int mm = 0; mm < 2; ++mm) { const int m = mh * 2 + mm; \
                const unsigned r = (unsigned)(row0 + ai * HALF + m * 16), off = r * (unsigned)D + (unsigned)(col0 + bj * HALF); \
                f32x4 v0 = acc[ai][bj][m][0], v1 = acc[ai][bj][m][1]; \
                if (GATED) { const f32x4 q0 = acc[ai][1][m][0], q1 = acc[ai][1][m][1]; \
                    _Pragma("unroll") for (int j = 0; j < 4; ++j) { v0[j] *= sigmoid_f(q0[j]); v1[j] *= sigmoid_f(q1[j]); } } \
                const f32x4 x0 = src[mm][0] + g0 * v0, x1 = src[mm][1] + g1 * v1; \
                *(GAS f32x4*)(X + off) = x0; *(GAS f32x4*)(X + off + 4) = x1; \
                if (has_next) { \
                    float a = (x0[0] * x0[0] + x0[1] * x0[1]) + (x0[2] * x0[2] + x0[3] * x0[3]) + (x1[0] * x1[0] + x1[1] * x1[1]) + (x1[2] * x1[2] + x1[3] * x1[3]); \
                    const f32x4 y0 = x0 * n0, y1 = x1 * n1; \
                    u32x4 w; w.x = cvt_pk_bf16(y0[0], y0[1]); w.y = cvt_pk_bf16(y0[2], y0[3]); w.z = cvt_pk_bf16(y1[0], y1[1]); w.w = cvt_pk_bf16(y1[2], y1[3]); \
                    *(GAS u32x4*)(XN + off) = w; \
                    a += __shfl_xor(a, 16); a += __shfl_xor(a, 32); \
                    if (fq == 0) rowss_next[r * 32u + (unsigned)(GATED ? u.pn * 4 + wc : (u.pn * 2 + bj) * 4 + wc)] = a; } } } while (0)
        constexpr int NBT = 4 * NB;
        RES_LOAD(x0_, 0); RES_LOAD(x1_, 1); RES_LOAD(x2_, 2);
        RES_PROC(x0_, 0); RES_LOAD(x0_, 3);
        RES_PROC(x1_, 1); if (NBT > 4) RES_LOAD(x1_, 4);
        RES_PROC(x2_, 2); if (NBT > 4) RES_LOAD(x2_, 5);
        RES_PROC(x0_, 3);
        if (NBT > 4) { RES_LOAD(x0_, 6); RES_PROC(x1_, 4); RES_LOAD(x1_, 7); RES_PROC(x2_, 5); RES_PROC(x0_, 6); RES_PROC(x1_, 7); }
#undef RES_LOAD
#undef RES_PROC
    }
};

#define XB_TMO      128
#define XB_XCNT(j)  (256  + 64 * (j))
#define XB_XSUB(j)  (1280 + 64 * (j))
#define XB_XGEN(j)  (2304 + 64 * (j))
#define XB_TOP      3328
#define XB_TOPGEN   3392
#define XCD_BAR_WORDS 3456
#define XB_SPIN_CAP (1u << 18)
__device__ __forceinline__ unsigned xb_ld(GAS unsigned* p)              { return __hip_atomic_load(p, __ATOMIC_RELAXED, __HIP_MEMORY_SCOPE_AGENT); }
__device__ __forceinline__ unsigned xb_add(GAS unsigned* p, unsigned v) { return __hip_atomic_fetch_add(p, v, __ATOMIC_RELAXED, __HIP_MEMORY_SCOPE_AGENT); }
__device__ __forceinline__ unsigned xb_xcc_id() { return (unsigned)__builtin_amdgcn_s_getreg((3 << 11) | 20) & 0xFu; }
#define XB_SPIN(cond, bar) do { unsigned _sp = 0; while (cond) { __builtin_amdgcn_s_sleep(1); \
    if ((++_sp & 255u) == 0u) { if (xb_ld(&(bar)[XB_TMO])) break; if (_sp > XB_SPIN_CAP) { (void)xb_add(&(bar)[XB_TMO], 1u); break; } } } } while (0)
struct XcdBarrier { GAS unsigned* bar; unsigned x; volatile LAS unsigned* st; };
__device__ __forceinline__ XcdBarrier xcd_barrier_post(GAS unsigned* bar, volatile LAS unsigned* st) {
    XcdBarrier b; b.bar = bar; b.x = xb_xcc_id(); b.st = st;
    if (threadIdx.x == 0) (void)xb_add(&bar[XB_XCNT(b.x)], 1u);
    return b;
}
__device__ __forceinline__ void xcd_barrier_complete(GAS unsigned* bar, unsigned x, unsigned& nloc, unsigned& nx) {
    const unsigned G = gridDim.x * gridDim.y * gridDim.z;
    unsigned sum, cnt, mine, sp = 0u;
    for (;;) {
        sum = 0u; cnt = 0u;
#pragma unroll 1
        for (unsigned j = 0; j < 16; ++j) { const unsigned c = xb_ld(&bar[XB_XCNT(j)]); sum += c; cnt += (c > 0u) ? 1u : 0u; }
        mine = xb_ld(&bar[XB_XCNT(x)]);
        if (sum == G) break;
        __builtin_amdgcn_s_sleep(1);
        if ((++sp & 255u) == 0u) { if (xb_ld(&bar[XB_TMO])) break; if (sp > XB_SPIN_CAP) { (void)xb_add(&bar[XB_TMO], 1u); break; } }
    }
    nloc = mine > 0u ? mine : 1u; nx = cnt > 0u ? cnt : 1u;
}
__device__ __forceinline__ void xcd_barrier(const XcdBarrier& b, bool leader) {
    asm volatile("s_waitcnt vmcnt(0)" ::: "memory");
    __syncthreads();
    if (leader) {
        GAS unsigned* bar = b.bar; unsigned bx_ = b.x;
        asm volatile("" : "+s"(bar), "+s"(bx_));
        __builtin_amdgcn_s_waitcnt(0);
        unsigned nloc = b.st[0], nx = b.st[1];
        if (nloc == 0u) { xcd_barrier_complete(bar, bx_, nloc, nx); b.st[0] = nloc; b.st[1] = nx; }
        const unsigned old = xb_add(&bar[XB_XSUB(bx_)], 1u);
        const unsigned gen = old / nloc;
        if (old + 1u == (gen + 1u) * nloc) {
            __builtin_amdgcn_fence(__ATOMIC_RELEASE, "agent");
            asm volatile("s_waitcnt vmcnt(0)" ::: "memory");
            const unsigned og = xb_add(&bar[XB_TOP], 1u);
            const unsigned tg = og / nx;
            if (og + 1u == (tg + 1u) * nx) xb_add(&bar[XB_TOPGEN], 1u);
            else XB_SPIN(xb_ld(&bar[XB_TOPGEN]) == tg, bar);
            __builtin_amdgcn_fence(__ATOMIC_ACQUIRE, "agent");
            xb_add(&bar[XB_XGEN(bx_)], 1u);
            asm volatile("s_waitcnt vmcnt(0)" ::: "memory");
        } else {
            XB_SPIN(xb_ld(&bar[XB_XGEN(bx_)]) == gen, bar);
            __builtin_amdgcn_fence(__ATOMIC_ACQUIRE, "agent");
            asm volatile("s_waitcnt vmcnt(0)" ::: "memory");
        }
    }
    __syncthreads();
}

constexpr size_t MiB = 1u << 20;
constexpr size_t WS_CTL = 0, CTL_BYTES = 2 * MiB;
constexpr int CW_BAR = 4096;
constexpr size_t WS_TAB = 2 * MiB;
constexpr size_t TAB_GSA = WS_TAB, TAB_GSB = TAB_GSA + 4 * 5 * 1024 * 4, TAB_SWA = TAB_GSB + 4 * 5 * 1024 * 4, TAB_SWB = TAB_SWA + 4 * 5 * 4096 * 4, TAB_LAMT = TAB_SWB + 4 * 5 * 4096 * 4;
static_assert(TAB_LAMT + 2 * 64 * 2 * 64 * 2 * 4 <= 4 * MiB, "tables");
constexpr size_t WS_W1 = 4 * MiB, WS_W2 = 36 * MiB, WS_SWIN = 68 * MiB, WS_SWOUT = 72 * MiB, WS_GWIN = 80 * MiB, WS_GWOUT = 88 * MiB, WS_GWS = 92 * MiB,
                 WS_CWIN = 93 * MiB, WS_CWOUT = 99 * MiB, WS_BTY = 101 * MiB, WS_BTS = 133 * MiB;
constexpr size_t WS_XN = 149 * MiB;
constexpr size_t WS_R = 173 * MiB;
constexpr size_t WS_R2 = 269 * MiB;
constexpr size_t WS_ROWSS = 317 * MiB;
constexpr size_t WS_VSTAT = 329 * MiB;
constexpr size_t WS_MODS = 335 * MiB;
constexpr size_t WS_END = 336 * MiB;

constexpr int LDS_BYTES = 147456;
constexpr int MISC_OFF = STAGE_BYTES;

struct Args { const float* in[30]; float* out; unsigned char* ws; int ph_lo, ph_hi; int mode, pad; };

__device__ __forceinline__ unsigned pk2(float lo, float hi) { return f2bf(lo) | (f2bf(hi) << 16); }
__device__ __forceinline__ float wave_sum(float v) {
#pragma unroll
    for (int o = 1; o < 64; o <<= 1) v += __shfl_xor(v, o);
    return v;
}
template <int MAP> __device__ __forceinline__ int rowmap(int n) {
    if (MAP == 1) { const int half = n >> 10, c = n & 1023; return (c >> 7) * 256 + half * 128 + (c & 127); }
    return n;
}
template <int MAP> __device__ __forceinline__ void transpose_item(const GAS float* W, int K, int N, GAS bf16_t* WT, LAS float* scr, int item, int lane) {
    const int nblk = N / 32, kb = item / nblk, nb = item % nblk, k0 = 64 * kb, n0 = 32 * nb;
    float wv[32];
#pragma unroll
    for (int i = 0; i < 32; ++i) wv[i] = W[(size_t)(k0 + 2 * i + (lane >> 5)) * N + n0 + (lane & 31)];
#pragma unroll
    for (int i = 0; i < 32; ++i) scr[(2 * i + (lane >> 5)) * 33 + (lane & 31)] = wv[i];
    asm volatile("s_waitcnt lgkmcnt(0)" ::: "memory");
    const int c = lane & 7;
#pragma unroll
    for (int j = 0; j < 4; ++j) { const int n = (lane >> 3) + 8 * j; const LAS float* s = scr + (8 * c) * 33 + n;
        u32x4 o; o.x = pk2(s[0 * 33], s[1 * 33]); o.y = pk2(s[2 * 33], s[3 * 33]); o.z = pk2(s[4 * 33], s[5 * 33]); o.w = pk2(s[6 * 33], s[7 * 33]);
        *(GAS u32x4*)(WT + (size_t)rowmap<MAP>(n0 + n) * K + k0 + 8 * c) = o; }
    asm volatile("s_waitcnt lgkmcnt(0)" ::: "memory");
}

__device__ __forceinline__ void ssm_build(const Args& a, int j, int g, int part, LAS unsigned char* lds, GAS unsigned char* ws, int tid) {
#ifdef MK_RANGE
    const int PMODE = a.mode;
#else
    constexpr int PMODE = 0;
#endif
    LAS float* PR = (LAS float*)lds;
    LAS float* PI = PR + 2 * 17 * 64;
    LAS float* BR = PI + 2 * 17 * 64;
    LAS float* BI = BR + 2 * 64 * 16;
    LAS float* CR = BI + 2 * 64 * 16;
    LAS float* CI = CR + 2 * 16 * 64;
    LAS float* WR = CI + 2 * 16 * 64;
    LAS float* WI = WR + 2 * 64 * 16;
    LAS float* KT = WI + 2 * 64 * 16;
    const GAS float* lam_re = inp(lds, 13); const GAS float* lam_im = inp(lds, 14); const GAS float* log_dt = inp(lds, 15);
    const GAS float* b_re = inp(lds, 16); const GAS float* b_im = inp(lds, 17); const GAS float* c_re = inp(lds, 18); const GAS float* c_im = inp(lds, 19); const GAS float* dsk = inp(lds, 20);
    __syncthreads();
    LAS float* FR = WR; LAS float* FI = WR + 128; LAS float* DSK = WR + 256;
    if (tid >= 128 && tid < 144) DSK[tid - 128] = dsk[j * 1024 + g * 16 + tid - 128];
    if (tid < 128) {
        const int k = tid >> 6, n = tid & 63, pidx = (j * 2 + k) * 64 + g;
        const float dt = expf(log_dt[pidx]);
        const float lr = lam_re[pidx * 64 + n], li = lam_im[pidx * 64 + n];
        const float mag = expf(lr * dt); float sn, cs; sincosf(li * dt, &sn, &cs); const float abr = mag * cs, abi = mag * sn;
        const float den = lr * lr + li * li;
        const float nr = (abr - 1.0f) * lr + abi * li, ni = -(abr - 1.0f) * li + abi * lr;
        FR[tid] = nr / den; FI[tid] = ni / den;
    }
#pragma unroll 1
    for (int i = tid; i < 2 * 17 * 64; i += 512) {
        const int k = i / (17 * 64), e = (i >> 6) % 17, n = i & 63, pidx = (j * 2 + k) * 64 + g;
        const float dt = expf(log_dt[pidx]); const float lr = lam_re[pidx * 64 + n], li = lam_im[pidx * 64 + n];
        const float mag = expf((float)e * lr * dt); float sn, cs; sincosf((float)e * (li * dt), &sn, &cs); PR[i] = mag * cs; PI[i] = mag * sn; }
    for (int i = tid; i < 2048; i += 512) { const int k = i >> 10, po = (i >> 6) & 15, n = i & 63; const size_t o = ((size_t)(j * 2 + k) * 64 + g) * 1024 + (i & 1023);
        CR[(k * 64 + n) * 16 + po] = c_re[o]; CI[(k * 64 + n) * 16 + po] = c_im[o]; }
    __syncthreads();
    for (int i = tid; i < 2048; i += 512) { const int kn = i >> 4; const size_t o = ((size_t)(j * 2 + (kn >> 6)) * 64 + g) * 1024 + (i & 1023);
        const float br = b_re[o], bi = b_im[o], fr = FR[kn], fi = FI[kn]; BR[i] = fr * br - fi * bi; BI[i] = fr * bi + fi * br; }
    if (part == 1 && tid < 128) { const int k = tid >> 6, n = tid & 63; GAS float* lamT = (GAS float*)(ws + TAB_LAMT) + (((size_t)j * 64 + g) * 2 + k) * 128;
        lamT[2 * n] = PR[(k * 17 + 16) * 64 + n]; lamT[2 * n + 1] = PI[(k * 17 + 16) * 64 + n]; }
    __syncthreads();
    if (part == 0 && PMODE != 6) {
        const int e = tid >> 5, k = (tid >> 4) & 1, po4 = (tid >> 2) & 3, pi4 = tid & 3;
        float acc[4][4];
#pragma unroll
        for (int x = 0; x < 4; ++x)
#pragma unroll
            for (int y = 0; y < 4; ++y) acc[x][y] = 0.f;
#pragma unroll 2
        for (int n = 0; n < 64; ++n) {
            const float pr = PR[(k * 17 + e) * 64 + n], pim = PI[(k * 17 + e) * 64 + n];
            const f32x4 br = *(const LAS f32x4*)(BR + (k * 64 + n) * 16 + 4 * pi4), bi = *(const LAS f32x4*)(BI + (k * 64 + n) * 16 + 4 * pi4);
            const f32x4 cr = *(const LAS f32x4*)(CR + (k * 64 + n) * 16 + 4 * po4), ci = *(const LAS f32x4*)(CI + (k * 64 + n) * 16 + 4 * po4);
            const f32x4 wr = br * pr - bi * pim, wi = bi * pr + br * pim;
#pragma unroll
            for (int x = 0; x < 4; ++x)
#pragma unroll
                for (int y = 0; y < 4; ++y) acc[x][y] += cr[x] * wr[y] - ci[x] * wi[y];
        }
#pragma unroll
        for (int x = 0; x < 4; ++x) *(LAS f32x4*)(KT + ((k * 16 + e) * 16 + 4 * po4 + x) * 16 + 4 * pi4) = (f32x4){acc[x][0], acc[x][1], acc[x][2], acc[x][3]};
    }
    __syncthreads();
    GAS bf16_t* BtY = (GAS bf16_t*)(ws + WS_BTY) + ((size_t)j * 64 + g) * 256 * 512;
    GAS bf16_t* BtS = (GAS bf16_t*)(ws + WS_BTS) + ((size_t)j * 64 + g) * 256 * 256;
    if (part == 0) {
    if (PMODE != 7)
#pragma unroll 1
    for (int pc = tid; pc < 256 * 32; pc += 512) {
        const int row = pc >> 5, kc = (pc & 31) * 8, t = row >> 4, po = row & 15, s = kc >> 4, pi0 = kc & 15;
        float v[8];
#pragma unroll
        for (int q = 0; q < 8; ++q) { const int pi = pi0 + q; float x = 0.f;
            if (s <= t) x += KT[((0 * 16 + (t - s)) * 16 + po) * 16 + pi];
            if (s >= t) x += KT[((1 * 16 + (s - t)) * 16 + po) * 16 + pi];
            if (s == t && pi == po) x += DSK[po];
            v[q] = x; }
        u32x4 o; o.x = pk2(v[0], v[1]); o.y = pk2(v[2], v[3]); o.z = pk2(v[4], v[5]); o.w = pk2(v[6], v[7]);
        *(GAS u32x4*)(BtY + (size_t)row * 512 + kc) = o;
    }
    if (PMODE != 8)
#pragma unroll 1
    for (int pc = tid; pc < 256 * 32; pc += 512) {
        const int row = pc >> 5, kc = (pc & 31) * 8, t = row >> 4, po = row & 15, k = kc >> 7, ri = (kc >> 6) & 1, n0 = kc & 63;
        const int e = k == 0 ? t + 1 : 16 - t;
        float v[8];
#pragma unroll
        for (int q = 0; q < 8; ++q) { const int n = n0 + q; const float cr = CR[(k * 64 + n) * 16 + po], cim = CI[(k * 64 + n) * 16 + po], pr = PR[(k * 17 + e) * 64 + n], pim = PI[(k * 17 + e) * 64 + n];
            v[q] = ri == 0 ? (cr * pr - cim * pim) : -(cr * pim + cim * pr); }
        u32x4 o; o.x = pk2(v[0], v[1]); o.y = pk2(v[2], v[3]); o.z = pk2(v[4], v[5]); o.w = pk2(v[6], v[7]);
        *(GAS u32x4*)(BtY + (size_t)row * 512 + 256 + kc) = o;
    }
    } else {
    for (int pc = tid; pc < 256 * 32; pc += 512) {
        const int row = pc >> 5, kc = (pc & 31) * 8, k = row >> 7, ri = (row >> 6) & 1, n = row & 63, s = kc >> 4, pi0 = kc & 15;
        const int e = k == 0 ? 15 - s : s;
        const float pr = PR[(k * 17 + e) * 64 + n], pim = PI[(k * 17 + e) * 64 + n];
        float v[8];
#pragma unroll
        for (int q = 0; q < 8; ++q) { const float br = BR[(k * 64 + n) * 16 + pi0 + q], bi = BI[(k * 64 + n) * 16 + pi0 + q]; v[q] = ri == 0 ? (pr * br - pim * bi) : (pr * bi + pim * br); }
        u32x4 o; o.x = pk2(v[0], v[1]); o.y = pk2(v[2], v[3]); o.z = pk2(v[4], v[5]); o.w = pk2(v[6], v[7]);
        *(GAS u32x4*)(BtS + (size_t)row * 256 + kc) = o;
    }
    }
    __syncthreads();
}

__device__ __forceinline__ void mods_task(const Args& a, GAS float* mods, LAS unsigned char* lds, int task, int tid) {
    const int cg = task % 48, l = task / 48, wave = tid >> 6, lane = tid & 63, half = lane >> 5, c4 = lane & 31;
    const GAS float* c = inp(lds, 4); const GAS float* c_ctx = inp(lds, 5); const GAS float* w_mod = inp(lds, 6); const GAS float* b_mod = inp(lds, 7);
    LAS float* sil = (LAS float*)lds;
    LAS float* red = sil + 5 * 1024;
    __syncthreads();
    for (int i = tid; i < 5 * 1024; i += 512) { const int ci = i >> 10, k = i & 1023; const float v = ci == 0 ? c_ctx[k] : c[(ci - 1) * 1024 + k]; sil[i] = v / (1.0f + expf(-v)); }
    __syncthreads();
    const GAS float* w = w_mod + ((size_t)l * 1024 + wave * 128 + half) * 6144 + cg * 128 + c4 * 4;
    f32x4 acc[5];
#pragma unroll
    for (int ci = 0; ci < 5; ++ci) acc[ci] = (f32x4){0.f, 0.f, 0.f, 0.f};
#pragma unroll 1
    for (int b = 0; b < 2; ++b) {
        f32x4 wv[32];
#pragma unroll
        for (int i = 0; i < 32; ++i) wv[i] = *(const GAS f32x4*)(w + (size_t)(b * 64 + 2 * i) * 6144);
#pragma unroll
        for (int i = 0; i < 32; ++i) { const int k = wave * 128 + b * 64 + 2 * i + half;
#pragma unroll
            for (int ci = 0; ci < 5; ++ci) acc[ci] += wv[i] * sil[ci * 1024 + k]; }
    }
#pragma unroll
    for (int ci = 0; ci < 5; ++ci) {
#pragma unroll
        for (int q = 0; q < 4; ++q) acc[ci][q] += __shfl_xor(acc[ci][q], 32);
        if (half == 0) *(LAS f32x4*)(red + (wave * 5 + ci) * 128 + c4 * 4) = acc[ci]; }
    __syncthreads();
    for (int i = tid; i < 5 * 128; i += 512) { const int ci = i >> 7, cc = i & 127; float t = 0.f;
#pragma unroll
        for (int wv2 = 0; wv2 < 8; ++wv2) t += red[(wv2 * 5 + ci) * 128 + cc];
        mods[((size_t)l * 5 + ci) * 6144 + cg * 128 + cc] = t + b_mod[l * 6144 + cg * 128 + cc]; }
}

__device__ __forceinline__ void xinit_row(const LAS unsigned char* lds, GAS float* X, int row, int lane) {
    GAS f32x4* o = (GAS f32x4*)(X + (size_t)row * D) + lane;
    if (row < MP) { const GAS f32x4* s = (const GAS f32x4*)(inp(lds, 0) + (size_t)row * D) + lane;
#pragma unroll
        for (int q = 0; q < 4; ++q) o[64 * q] = s[64 * q];
        return; }
    const GAS f32x4* s = (const GAS f32x4*)(inp(lds, 1) + (size_t)(row - MP) * D) + lane;
    const int t = (row - MP) & 1023; const float rr = (float)(t >> 6), cc = (float)(t & 63);
    float freq[4];
#pragma unroll
    for (int e = 0; e < 4; ++e) freq[e] = expf(-(float)(4 * lane + e) * (9.210340371976184f / 256.0f));
    f32x4 v[4];
#pragma unroll
    for (int q = 0; q < 4; ++q) v[q] = s[64 * q];
#pragma unroll
    for (int e = 0; e < 4; ++e) { float sr, cr, sc, cc2; sincosf(rr * freq[e], &sr, &cr); sincosf(cc * freq[e], &sc, &cc2); v[0][e] += sr; v[1][e] += cr; v[2][e] += sc; v[3][e] += cc2; }
#pragma unroll
    for (int q = 0; q < 4; ++q) o[64 * q] = v[q];
}


__device__ __forceinline__ void sw_job(const GAS float* mods, int l, int sidx, const GAS bf16_t* WT, int N, GAS float* dst, int dld, int wv, int nw, int lane) {
    float sh[5][16];
#pragma unroll
    for (int ci = 0; ci < 5; ++ci) { const GAS float* sp = mods + ((size_t)l * 5 + ci) * 6144 + sidx * 1024 + lane * 16;
#pragma unroll
        for (int q = 0; q < 4; ++q) { const f32x4 v = *(const GAS f32x4*)(sp + 4 * q); sh[ci][4 * q] = v[0]; sh[ci][4 * q + 1] = v[1]; sh[ci][4 * q + 2] = v[2]; sh[ci][4 * q + 3] = v[3]; } }
    for (int r = wv * 8; r < N; r += nw * 8) {
        u32x4 w0[8], w1[8];
#pragma unroll
        for (int nn = 0; nn < 8; ++nn) { w0[nn] = *(const GAS u32x4*)(WT + (size_t)(r + nn) * D + lane * 16); w1[nn] = *(const GAS u32x4*)(WT + (size_t)(r + nn) * D + lane * 16 + 8); }
#pragma unroll
        for (int nn = 0; nn < 8; ++nn) {
            const float wf[16] = {bf_lo(w0[nn].x), bf_hi(w0[nn].x), bf_lo(w0[nn].y), bf_hi(w0[nn].y), bf_lo(w0[nn].z), bf_hi(w0[nn].z), bf_lo(w0[nn].w), bf_hi(w0[nn].w),
                                  bf_lo(w1[nn].x), bf_hi(w1[nn].x), bf_lo(w1[nn].y), bf_hi(w1[nn].y), bf_lo(w1[nn].z), bf_hi(w1[nn].z), bf_lo(w1[nn].w), bf_hi(w1[nn].w)};
#pragma unroll
            for (int ci = 0; ci < 5; ++ci) { float t = 0.f;
#pragma unroll
                for (int q = 0; q < 16; ++q) t += wf[q] * sh[ci][q];
                t = wave_sum(t);
                if (lane == 0) dst[ci * dld + r + nn] = t; }
        }
    }
}
__device__ __forceinline__ void sw_mix_job(GAS unsigned char* ws, const GAS float* mods, int l, int wv, int nw, int lane) {
    GAS float* swA = (GAS float*)(ws + TAB_SWA);
    if (l == 0) sw_job(mods, 0, 0, (const GAS bf16_t*)(ws + WS_SWIN), 1024, swA, 1024, wv, nw, lane);
    else if (l == 1) sw_job(mods, 1, 0, (const GAS bf16_t*)(ws + WS_GWIN), 4096, swA + 1 * 5 * 4096, 4096, wv, nw, lane);
    else if (l == 2) sw_job(mods, 2, 0, (const GAS bf16_t*)(ws + WS_CWIN), 3072, swA + 2 * 5 * 4096, 3072, wv, nw, lane);
    else sw_job(mods, 3, 0, (const GAS bf16_t*)(ws + WS_SWIN) + (size_t)D * D, 1024, swA + 3 * 5 * 4096, 1024, wv, nw, lane);
}
__device__ __forceinline__ void sw_ffn_job(GAS unsigned char* ws, const GAS float* mods, int l, int wv, int nw, int lane) {
    sw_job(mods, l, 3, (const GAS bf16_t*)(ws + WS_W1) + (size_t)l * D * FF, 4096, (GAS float*)(ws + TAB_SWB) + l * 5 * 4096, 4096, wv, nw, lane);
}


constexpr int I_W1 = 2048, I_W2 = 2048, I_SI = 512, I_SO = 1024, I_GI = 2048, I_GO = 1024, I_CI = 1536, I_CO = 512;
constexpr int IT_W1 = 0, IT_W2 = 4 * I_W1, IT_SI = IT_W2 + 4 * I_W2, IT_SO = IT_SI + 2 * I_SI, IT_GI = IT_SO + 2 * I_SO, IT_GO = IT_GI + I_GI, IT_CI = IT_GO + I_GO, IT_CO = IT_CI + I_CI, IT_END = IT_CO + I_CO;
__device__ __forceinline__ void convert_items(const LAS unsigned char* lds, GAS unsigned char* ws, LAS float* scr, int first, int count, int wv, int nw, int lane) {
    for (int it = first + wv; it < first + count; it += nw) {
        int r = it;
        if (r < IT_W2) { const int l = r / I_W1; transpose_item<0>(inp(lds, 10) + (size_t)l * D * FF, D, FF, (GAS bf16_t*)(ws + WS_W1) + (size_t)l * D * FF, scr, r % I_W1, lane); continue; } r -= IT_W2;
        if (r < 4 * I_W2) { const int l = r / I_W2; transpose_item<0>(inp(lds, 11) + (size_t)l * D * FF, FF, D, (GAS bf16_t*)(ws + WS_W2) + (size_t)l * D * FF, scr, r % I_W2, lane); continue; } r -= 4 * I_W2;
        if (r < 2 * I_SI) { const int l = r / I_SI; transpose_item<0>(inp(lds, 12) + (size_t)l * D * D, D, D, (GAS bf16_t*)(ws + WS_SWIN) + (size_t)l * D * D, scr, r % I_SI, lane); continue; } r -= 2 * I_SI;
        if (r < 2 * I_SO) { const int l = r / I_SO; transpose_item<1>(inp(lds, 21) + (size_t)l * D * 2048, D, 2048, (GAS bf16_t*)(ws + WS_SWOUT) + (size_t)l * D * 2048, scr, r % I_SO, lane); continue; } r -= 2 * I_SO;
        if (r < I_GI) { transpose_item<0>(inp(lds, 22), D, 4096, (GAS bf16_t*)(ws + WS_GWIN), scr, r, lane); continue; } r -= I_GI;
        if (r < I_GO) { transpose_item<0>(inp(lds, 25), 2048, D, (GAS bf16_t*)(ws + WS_GWOUT), scr, r, lane); continue; } r -= I_GO;
        if (r < I_CI) { transpose_item<0>(inp(lds, 26), D, 3072, (GAS bf16_t*)(ws + WS_CWIN), scr, r, lane); continue; } r -= I_CI;
        transpose_item<0>(inp(lds, 28), D, D, (GAS bf16_t*)(ws + WS_CWOUT), scr, r, lane);
    }
}
constexpr int NPH = 28;
#ifdef MK_RANGE
#define GMODE(g) g.mode = args.mode
#else
#define GMODE(g)
#endif
#ifndef MK_ALLCG
#define MK_ALLCG 0
#endif
__global__ void __launch_bounds__(512, 2) fwd(Args args) {
    extern __shared__ __attribute__((aligned(16))) unsigned char lds_raw[];
    LAS unsigned char* lds_k = (LAS unsigned char*)lds_raw;
    volatile LAS unsigned* MISC = (volatile LAS unsigned*)(lds_k + MISC_OFF);
    const int tid = threadIdx.x, lane = tid & 63, wave = __builtin_amdgcn_readfirstlane(tid >> 6);
    const int G = gridDim.x, bx = blockIdx.x;
    GAS unsigned* ctl = (GAS unsigned*)((GAS unsigned char*)args.ws + WS_CTL);
    for (int u = tid; u < 64; u += 512) MISC[u] = 0u;
    if (tid == 0) { LAS unsigned long long* pt = (LAS unsigned long long*)(lds_k + PTR_OFF);
#pragma unroll
        for (int k = 0; k < 30; ++k) pt[k] = (unsigned long long)args.in[k];
        pt[30] = (unsigned long long)args.out; pt[31] = (unsigned long long)args.ws; }
    __syncthreads();
    (void)xcd_barrier_post(ctl + CW_BAR, MISC + 8);
#ifdef MK_RANGE
    const int lo = args.ph_lo, hi = args.ph_hi;
#else
    constexpr int lo = 0, hi = 23;
#endif
    int ph = 0;
#define IN_PH (lo <= ph && ph < hi)
#define SEAM() do { if (IN_PH && ph + 1 < hi) { if (ph == 0 || MK_ALLCG) cg::this_grid().sync(); else { LAS unsigned char* lds_s_ = lds_k; asm volatile("" : "+s"(lds_s_)); XcdBarrier b_; b_.bar = (GAS unsigned*)((GAS unsigned char*)ldsptr(lds_s_, 31) + WS_CTL) + CW_BAR; b_.x = xb_xcc_id(); b_.st = (volatile LAS unsigned*)(lds_s_ + MISC_OFF) + 8; xcd_barrier(b_, wave == 0 && lane_id() == 0); } } ++ph; } while (0)

#define PH_PTRS() LAS unsigned char* lds = lds_k; asm volatile("" : "+s"(lds)); GAS unsigned char* ws = (GAS unsigned char*)ldsptr(lds, 31); asm volatile("" : "+s"(ws)); \
    int tid_o_ = wave * 64 + lane_id(); asm volatile("" : "+v"(tid_o_)); const int tid = tid_o_, lane = tid_o_ & 63; (void)tid; (void)lane; \
    const int vcu = (G % 8 == 0) ? (bx % 8) * (G / 8) + bx / 8 : bx, gw = vcu * 8 + wave, NGW = G * 8; (void)vcu; (void)gw; (void)NGW; \
    GAS float* X = (GAS float*)ldsptr(lds, 30); GAS bf16_t* XN = (GAS bf16_t*)(ws + WS_XN); GAS float* mods = (GAS float*)(ws + WS_MODS); \
    GAS float* gsA = (GAS float*)(ws + TAB_GSA); GAS float* gsB = (GAS float*)(ws + TAB_GSB); GAS float* swA = (GAS float*)(ws + TAB_SWA); GAS float* swB = (GAS float*)(ws + TAB_SWB); \
    GAS float* rowss = (GAS float*)(ws + WS_ROWSS); GAS float* vstat = (GAS float*)(ws + WS_VSTAT); \
    GAS bf16_t* Hb = (GAS bf16_t*)(ws + WS_R); GAS bf16_t* UgS = (GAS bf16_t*)(ws + WS_R); GAS float* Sloc = (GAS float*)(ws + WS_R + 48 * MiB); GAS bf16_t* Zg = (GAS bf16_t*)(ws + WS_R + 48 * MiB); GAS bf16_t* A2 = (GAS bf16_t*)(ws + WS_R2); \
    (void)X; (void)XN; (void)mods; (void)gsA; (void)gsB; (void)swA; (void)swB; (void)rowss; (void)vstat; (void)Hb; (void)UgS; (void)Sloc; (void)Zg; (void)A2;
#define PH_LAYER() const GAS float* rs_mix = rowss + (size_t)(2 * layer) * M * 32; GAS float* rs_ffn = rowss + (size_t)(2 * layer + 1) * M * 32; GAS float* rs_next = rowss + (size_t)((2 * layer + 2) & 7) * M * 32; \
    const GAS float* modl = mods + (size_t)layer * 5 * 6144; (void)rs_mix; (void)rs_ffn; (void)rs_next; (void)modl;

#define SIDE_IDS() const int swv = (bx - 192) * 8 + wave, snw = (G - 192) * 8; LAS float* scr = (LAS float*)(lds + wave * 16384); (void)scr; (void)swv; (void)snw
    if (IN_PH) { PH_PTRS();
#ifdef MK_RANGE
        const int pm_ = args.mode;
#else
        constexpr int pm_ = 0;
#endif
        if (bx < 128) { if (pm_ != 2) ssm_build(args, 0, bx & 63, bx >> 6, lds, ws, tid); } else { if (pm_ != 3) for (int t = bx - 128; t < 192; t += 128) mods_task(args, mods, lds, t, tid); }
        __syncthreads();
        if (bx >= 128 && pm_ != 4) { LAS float* scr = (LAS float*)(lds + wave * 16384); const int wv = (bx - 128) * 8 + wave, nw = (G - 128) * 8;
            convert_items(lds, ws, scr, IT_W1, I_W1, wv, nw, lane); convert_items(lds, ws, scr, IT_W2, I_W2, wv, nw, lane);
            convert_items(lds, ws, scr, IT_SI, I_SI, wv, nw, lane); convert_items(lds, ws, scr, IT_SO, I_SO, wv, nw, lane); }
        if (pm_ != 5 && bx >= 64) for (int row = (bx - 64) * 8 + wave; row < M; row += (G - 64) * 8) xinit_row(lds, X, row, lane);
    }
    SEAM();
    if (IN_PH) { PH_PTRS();
        for (int i = gw * 64 + lane; i < 4 * 5 * 1024; i += NGW * 64) { const int l = i / 5120, ci = (i / 1024) % 5, c = i & 1023;
            const GAS float* md = mods + ((size_t)l * 5 + ci) * 6144;
            gsA[i] = inp(lds, 8)[l * 1024 + c] * (1.0f + md[1024 + c]); gsB[i] = inp(lds, 9)[l * 1024 + c] * (1.0f + md[4 * 1024 + c]); }
        sw_mix_job(ws, mods, 0, gw, NGW, lane);
        for (int row = gw; row < M; row += 3 * NGW) {
            const GAS float* gm = inp(lds, 8);
            f32x4 v[3][4];
#pragma unroll
            for (int rr = 0; rr < 3; ++rr)
#pragma unroll
                for (int q = 0; q < 4; ++q) v[rr][q] = ((const GAS f32x4*)(X + (size_t)(row + rr * NGW) * D) + lane)[64 * q];
#pragma unroll
            for (int rr = 0; rr < 3; ++rr) {
                const int r = row + rr * NGW, ci = cond_of_row(r); const GAS float* md = mods + ((size_t)0 * 5 + ci) * 6144;
                float t = 0.f;
#pragma unroll
                for (int q = 0; q < 4; ++q) t += (v[rr][q][0] * v[rr][q][0] + v[rr][q][1] * v[rr][q][1]) + (v[rr][q][2] * v[rr][q][2] + v[rr][q][3] * v[rr][q][3]);
                t = wave_sum(t);
                if (lane < 32) rowss[(size_t)r * 32 + lane] = lane == 0 ? t : 0.f;
                GAS u32x2* o = (GAS u32x2*)(XN + (size_t)r * D) + lane;
#pragma unroll
                for (int q = 0; q < 4; ++q) { const int c = 256 * q + 4 * lane; const f32x4 gg = *(const GAS f32x4*)(gm + c), sc = *(const GAS f32x4*)(md + 1024 + c);
                    const f32x4 y = v[rr][q] * gg * (sc + 1.0f); u32x2 w; w.x = cvt_pk_bf16(y[0], y[1]); w.y = cvt_pk_bf16(y[2], y[3]); o[64 * q] = w; }
            }
        }
    }
    SEAM();
#pragma unroll 1
    for (int layer = 0; layer < 4; ++layer) {
        const int kind = layer % 3, j = layer / 3;
        if (kind == 0) {
            if (IN_PH) { PH_PTRS(); PH_LAYER(); Gemm g = gemm_rowmajor(XN, D, (const GAS bf16_t*)(ws + WS_SWIN) + (size_t)j * D * D, D, D); GMODE(g); StaticOrder S; S.init(M, D, G, bx);
                fill_tables_in(lds, S, rs_mix, swA + layer * 5 * 4096, 1024, tid); EpiU E{UgS}; gemm_phase<EpiU, ARowMajor, StaticOrder>(lds, g, S, E, wave);
                if (bx >= 192) { SIDE_IDS(); sw_ffn_job(ws, mods, layer, swv, snw, lane); if (layer == 0) convert_items(lds, ws, scr, IT_GI, I_GI, swv, snw, lane); } }
            SEAM();
            if (IN_PH) { PH_PTRS(); PH_LAYER(); SsmOrder S{G, bx};
                { Gemm g = gemm_rowmajor(UgS, 512, (const GAS bf16_t*)(ws + WS_BTS) + (size_t)j * 64 * 256 * 256, 256, 256); GMODE(g);
                  EpiScan E{UgS, (const GAS float*)(ws + TAB_LAMT), inp(lds, 2), inp(lds, 3), (GAS float*)ldsptr(lds, 30) + (size_t)M * D, (GAS float*)ldsptr(lds, 30) + (size_t)M * D + 32 * 2 * 2 * 64 * 64, j};
                  gemm_phase<EpiScan, ARowMajor, SsmOrder>(lds, g, S, E, wave); }
                asm volatile("s_waitcnt vmcnt(0)" ::: "memory"); __syncthreads(); __builtin_amdgcn_fence(__ATOMIC_ACQUIRE, "agent"); asm volatile("s_waitcnt vmcnt(0)" ::: "memory"); __syncthreads();
                { Gemm g = gemm_rowmajor(UgS, 512, (const GAS bf16_t*)(ws + WS_BTY) + (size_t)j * 64 * 256 * 512, 512, 512); GMODE(g);
                  EpiY E{Zg}; gemm_phase<EpiY, ARowMajor, SsmOrder>(lds, g, S, E, wave); }
                if (layer == 0 && bx >= 192) { SIDE_IDS(); convert_items(lds, ws, scr, IT_GO, I_GO + I_CI + I_CO, swv, snw, lane);
                    const GAS float* s_ = inp(lds, 23); GAS bf16_t* d_ = (GAS bf16_t*)(ws + WS_GWS);
                    for (int i = (swv * 64 + lane) * 8; i < 16 * 128 * 128; i += snw * 64 * 8) { const f32x4 a0 = *(const GAS f32x4*)(s_ + i), a1 = *(const GAS f32x4*)(s_ + i + 4);
                        u32x4 o; o.x = pk2(a0[0], a0[1]); o.y = pk2(a0[2], a0[3]); o.z = pk2(a1[0], a1[1]); o.w = pk2(a1[2], a1[3]); *(GAS u32x4*)(d_ + i) = o; } } }
            SEAM();
            if (IN_PH) { PH_PTRS(); PH_LAYER(); Gemm g = gemm_groupchunk(Zg, (const GAS bf16_t*)(ws + WS_SWOUT) + (size_t)j * D * 2048, D, D); GMODE(g); StaticOrder S; S.init(M, 2048, G, bx);
                fill_tables_res<128>(lds, S, modl + 2 * 1024, gsB + layer * 5 * 1024, tid); EpiRes<true> E{X, XN, rs_ffn, true}; gemm_phase<EpiRes<true>, AGroupChunk, StaticOrder>(lds, g, S, E, wave); }
            SEAM();
        } else if (kind == 1) {
            if (IN_PH) { PH_PTRS(); PH_LAYER(); Gemm g = gemm_rowmajor(XN, D, (const GAS bf16_t*)(ws + WS_GWIN), D, D); GMODE(g); StaticOrder S; S.init(M, 4096, G, bx);
                fill_tables_in(lds, S, rs_mix, swA + layer * 5 * 4096, 4096, tid); EpiIn<2, 4096> E{Hb, vstat}; gemm_phase<EpiIn<2, 4096>, ARowMajor, StaticOrder>(lds, g, S, E, wave); }
            SEAM();
            if (IN_PH) { PH_PTRS(); PH_LAYER();
                const GAS bf16_t* Wsb = (const GAS bf16_t*)(ws + WS_GWS); const GAS float* b_s = inp(lds, 24);
                constexpr int VST = 288;
                for (int unit = vcu; unit < 96 * 16; unit += G) {
                    const int c = unit >> 4, g = unit & 15, row0 = c * 128;
                    __syncthreads();
                    LAS f32x2* mr = (LAS f32x2*)(lds + 128 * VST);
                    if (tid < 128) { const GAS f32x4* p = (const GAS f32x4*)(vstat + (size_t)(row0 + tid) * 128); float s1 = 0.f, s2 = 0.f;
#pragma unroll
                        for (int q = 0; q < 32; ++q) { const f32x4 v = p[q]; s1 += v[0] + v[2]; s2 += v[1] + v[3]; }
                        const float mu = s1 * (1.0f / 2048.0f), var = s2 * (1.0f / 2048.0f) - mu * mu; mr[tid] = (f32x2){mu, rsq_f(fmaxf(var, 0.f) + EPS)}; }
                    __syncthreads();
#pragma unroll
                    for (int i = 0; i < 4; ++i) { const int pc = tid + 512 * i, q = pc >> 4, d8 = pc & 15;
                        const u32x4 w = *(const GAS u32x4*)(Hb + (size_t)(row0 + q) * 4096 + 2048 + g * 128 + d8 * 8);
                        const f32x2 st = mr[q]; const float mu = st[0], rstd = st[1];
                        u32x4 o; o.x = cvt_pk_bf16((bf_lo(w.x) - mu) * rstd, (bf_hi(w.x) - mu) * rstd); o.y = cvt_pk_bf16((bf_lo(w.y) - mu) * rstd, (bf_hi(w.y) - mu) * rstd);
                        o.z = cvt_pk_bf16((bf_lo(w.z) - mu) * rstd, (bf_hi(w.z) - mu) * rstd); o.w = cvt_pk_bf16((bf_lo(w.w) - mu) * rstd, (bf_hi(w.w) - mu) * rstd);
                        *(LAS u32x4*)(lds + q * VST + d8 * 16) = o; }
                    __syncthreads();
                    f32x4 acc[8];
#pragma unroll
                    for (int nt = 0; nt < 8; ++nt) acc[nt] = (f32x4){0.f, 0.f, 0.f, 0.f};
                    const int fr = lane & 15, fq = lane >> 4;
#pragma unroll
                    for (int kk = 0; kk < 4; ++kk) {
                        const bf16x8 wf = *(const GAS bf16x8*)(Wsb + ((size_t)g * 128 + wave * 16 + fr) * 128 + kk * 32 + fq * 8);
#pragma unroll
                        for (int nt = 0; nt < 8; ++nt) {
                            const LAS unsigned char* p0 = lds + (kk * 32 + fq * 8 + (fr >> 2)) * VST + (nt * 16 + 4 * (fr & 3)) * 2;
                            const s16x4 lo4 = __builtin_bit_cast(s16x4, __builtin_amdgcn_ds_read_tr16_b64_v4i16((LAS s16x4*)p0));
                            const s16x4 hi4 = __builtin_bit_cast(s16x4, __builtin_amdgcn_ds_read_tr16_b64_v4i16((LAS s16x4*)(p0 + 4 * VST)));
                            const bf16x8 vf = {lo4[0], lo4[1], lo4[2], lo4[3], hi4[0], hi4[1], hi4[2], hi4[3]};
                            acc[nt] = __builtin_amdgcn_mfma_f32_16x16x32_bf16(vf, wf, acc[nt], 0, 0, 0);
                        }
                    }
                    const int p = wave * 16 + fr, row = row0 + p; const float bs = b_s[g * 128 + p];
#pragma unroll
                    for (int nt = 0; nt < 8; ++nt) { const int ch = g * 128 + nt * 16 + 4 * fq;
                        const u32x2 uu = *(const GAS u32x2*)(Hb + (size_t)row * 4096 + ch);
                        u32x2 o; o.x = cvt_pk_bf16(bf_lo(uu.x) * (acc[nt][0] + bs), bf_hi(uu.x) * (acc[nt][1] + bs)); o.y = cvt_pk_bf16(bf_lo(uu.y) * (acc[nt][2] + bs), bf_hi(uu.y) * (acc[nt][3] + bs));
                        *(GAS u32x2*)(A2 + (size_t)row * 2048 + ch) = o; }
                }
                __syncthreads();
            }
            SEAM();
            if (IN_PH) { PH_PTRS(); PH_LAYER(); Gemm g = gemm_rowmajor(A2, 2048, (const GAS bf16_t*)(ws + WS_GWOUT), 2048, 2048); GMODE(g); StaticOrder S; S.init(M, D, G, bx);
                fill_tables_res<256>(lds, S, modl + 2 * 1024, gsB + layer * 5 * 1024, tid); EpiRes<false> E{X, XN, rs_ffn, true}; gemm_phase<EpiRes<false>, ARowMajor, StaticOrder>(lds, g, S, E, wave);
                if (bx >= 192) { SIDE_IDS(); sw_ffn_job(ws, mods, 1, swv, snw, lane); convert_items(lds, ws, scr, IT_W1 + 2 * I_W1, I_W1, swv, snw, lane); ssm_build(args, 1, bx - 192, 1, lds, ws, tid); } }
            SEAM();
        } else {
            if (IN_PH) { PH_PTRS(); PH_LAYER(); Gemm g = gemm_rowmajor(XN, D, (const GAS bf16_t*)(ws + WS_CWIN), D, D); GMODE(g); StaticOrder S; S.init(M, 3072, G, bx);
                fill_tables_in(lds, S, rs_mix, swA + layer * 5 * 4096, 3072, tid); EpiIn<0, 3072> E{Hb, nullptr}; gemm_phase<EpiIn<0, 3072>, ARowMajor, StaticOrder>(lds, g, S, E, wave); }
            SEAM();
            if (IN_PH) { PH_PTRS(); PH_LAYER();
                const GAS float* cw = inp(lds, 27);
                for (int it = gw * 64 + lane; it < M * 128; it += NGW * 64) {
                    const int row = it >> 7, c8 = (it & 127) * 8;
                    const int L = row < MP ? 256 : 1024, t = row < MP ? (row & 255) : ((row - MP) & 1023);
                    const GAS bf16_t* pr = Hb + (size_t)row * 3072 + c8;
                    float y[8];
#pragma unroll
                    for (int q = 0; q < 8; ++q) y[q] = 0.f;
#pragma unroll
                    for (int w = 0; w < 3; ++w) { const int tt = t + w - 1; if (tt < 0 || tt >= L) continue;
                        const u32x4 gc = *(const GAS u32x4*)(pr + (ptrdiff_t)(w - 1) * 3072 + 1024), xh = *(const GAS u32x4*)(pr + (ptrdiff_t)(w - 1) * 3072 + 2048);
                        const f32x4 k0 = *(const GAS f32x4*)(cw + w * 1024 + c8), k1 = *(const GAS f32x4*)(cw + w * 1024 + c8 + 4);
                        y[0] += k0[0] * bf_lo(gc.x) * bf_lo(xh.x); y[1] += k0[1] * bf_hi(gc.x) * bf_hi(xh.x); y[2] += k0[2] * bf_lo(gc.y) * bf_lo(xh.y); y[3] += k0[3] * bf_hi(gc.y) * bf_hi(xh.y);
                        y[4] += k1[0] * bf_lo(gc.z) * bf_lo(xh.z); y[5] += k1[1] * bf_hi(gc.z) * bf_hi(xh.z); y[6] += k1[2] * bf_lo(gc.w) * bf_lo(xh.w); y[7] += k1[3] * bf_hi(gc.w) * bf_hi(xh.w); }
                    const u32x4 gb = *(const GAS u32x4*)pr;
                    u32x4 o; o.x = cvt_pk_bf16(bf_lo(gb.x) * y[0], bf_hi(gb.x) * y[1]); o.y = cvt_pk_bf16(bf_lo(gb.y) * y[2], bf_hi(gb.y) * y[3]);
                    o.z = cvt_pk_bf16(bf_lo(gb.z) * y[4], bf_hi(gb.z) * y[5]); o.w = cvt_pk_bf16(bf_lo(gb.w) * y[6], bf_hi(gb.w) * y[7]);
                    *(GAS u32x4*)(A2 + (size_t)row * D + c8) = o;
                }
            }
            SEAM();
            if (IN_PH) { PH_PTRS(); PH_LAYER(); Gemm g = gemm_rowmajor(A2, D, (const GAS bf16_t*)(ws + WS_CWOUT), D, D); GMODE(g); StaticOrder S; S.init(M, D, G, bx);
                fill_tables_res<256>(lds, S, modl + 2 * 1024, gsB + layer * 5 * 1024, tid); EpiRes<false> E{X, XN, rs_ffn, true}; gemm_phase<EpiRes<false>, ARowMajor, StaticOrder>(lds, g, S, E, wave); }
            SEAM();
        }
        if (IN_PH) { PH_PTRS(); PH_LAYER(); Gemm g = gemm_rowmajor(XN, D, (const GAS bf16_t*)(ws + WS_W1) + (size_t)layer * D * FF, D, D); GMODE(g); StaticOrder S; S.init(M, FF, G, bx);
            fill_tables_in(lds, S, rs_ffn, swB + layer * 5 * 4096, 4096, tid); EpiIn<1, 4096> E{Hb, nullptr}; gemm_phase<EpiIn<1, 4096>, ARowMajor, StaticOrder>(lds, g, S, E, wave); }
        SEAM();
        if (IN_PH) { PH_PTRS(); PH_LAYER(); Gemm g = gemm_rowmajor(Hb, FF, (const GAS bf16_t*)(ws + WS_W2) + (size_t)layer * D * FF, FF, FF); GMODE(g); StaticOrder S; S.init(M, D, G, bx);
            fill_tables_res<256>(lds, S, modl + 5 * 1024, layer < 3 ? gsA + (layer + 1) * 5 * 1024 : (const GAS float*)nullptr, tid); EpiRes<false> E{X, XN, rs_next, layer < 3}; gemm_phase<EpiRes<false>, ARowMajor, StaticOrder>(lds, g, S, E, wave);
            if (layer < 3 && bx >= 192) { SIDE_IDS();
                if (layer == 0) { convert_items(lds, ws, scr, IT_W1 + 1 * I_W1, I_W1, swv, snw, lane); convert_items(lds, ws, scr, IT_W2 + 1 * I_W2, I_W2, swv, snw, lane); sw_mix_job(ws, mods, 1, swv, snw, lane); }
                else if (layer == 1) { convert_items(lds, ws, scr, IT_W2 + 2 * I_W2, I_W2, swv, snw, lane); convert_items(lds, ws, scr, IT_SI + I_SI, I_SI, swv, snw, lane); convert_items(lds, ws, scr, IT_SO + I_SO, I_SO, swv, snw, lane);
                    sw_mix_job(ws, mods, 2, swv, snw, lane); sw_ffn_job(ws, mods, 2, swv, snw, lane); }
                else { ssm_build(args, 1, bx - 192, 0, lds, ws, tid);
                    convert_items(lds, ws, scr, IT_W1 + 3 * I_W1, I_W1, swv, snw, lane); convert_items(lds, ws, scr, IT_W2 + 3 * I_W2, I_W2, swv, snw, lane); sw_mix_job(ws, mods, 3, swv, snw, lane); } } }
        SEAM();
    }
    if (IN_PH) { PH_PTRS();
        const GAS float* gf = inp(lds, 29);
        for (int row = gw; row < M; row += 3 * NGW) {
            f32x4 v[3][4];
#pragma unroll
            for (int rr = 0; rr < 3; ++rr)
#pragma unroll
                for (int q = 0; q < 4; ++q) v[rr][q] = ((const GAS f32x4*)(X + (size_t)(row + rr * NGW) * D) + lane)[64 * q];
            f32x4 gq[4];
#pragma unroll
            for (int q = 0; q < 4; ++q) gq[q] = *(const GAS f32x4*)(gf + 256 * q + 4 * lane);
#pragma unroll
            for (int rr = 0; rr < 3; ++rr) { float t = 0.f;
#pragma unroll
                for (int q = 0; q < 4; ++q) t += (v[rr][q][0] * v[rr][q][0] + v[rr][q][1] * v[rr][q][1]) + (v[rr][q][2] * v[rr][q][2] + v[rr][q][3] * v[rr][q][3]);
                t = wave_sum(t); const float r0 = rsq_f(t * (1.0f / D) + EPS);
                GAS f32x4* xr = (GAS f32x4*)(X + (size_t)(row + rr * NGW) * D) + lane;
#pragma unroll
                for (int q = 0; q < 4; ++q) xr[64 * q] = v[rr][q] * r0 * gq[q]; }
        }
    }
    ++ph;
#undef IN_PH
#undef SEAM
}

static bool launch(void* const* d_in, float* out, unsigned char* ws, int lo, int hi, hipStream_t stream, int mode = 0) {
    static int grid = 0;
    if (grid == 0) {
        int dev = 0, cus = 0, per_cu = 0;
        if (hipGetDevice(&dev) != hipSuccess || hipDeviceGetAttribute(&cus, hipDeviceAttributeMultiprocessorCount, dev) != hipSuccess) { grid = -1; return false; }
        if (hipFuncSetAttribute((const void*)fwd, hipFuncAttributeMaxDynamicSharedMemorySize, LDS_BYTES) != hipSuccess) { fprintf(stderr, "hipFuncSetAttribute failed\n"); grid = -1; return false; }
        if (hipOccupancyMaxActiveBlocksPerMultiprocessor(&per_cu, (const void*)fwd, 512, LDS_BYTES) != hipSuccess || per_cu < 1) { fprintf(stderr, "occupancy query: %d\n", per_cu); (void)hipGetLastError(); per_cu = 1; }
        grid = cus;
    }
    if (grid < 0) return false;
    Args a{};
    for (int i = 0; i < 30; ++i) a.in[i] = (const float*)d_in[i];
    a.out = out; a.ws = ws; a.ph_lo = lo; a.ph_hi = hi; a.mode = mode;
    void* kargs[] = {&a};
    const hipError_t e = hipLaunchCooperativeKernel((const void*)fwd, dim3(grid), dim3(512), kargs, LDS_BYTES, stream);
    if (e != hipSuccess) { fprintf(stderr, "cooperative launch failed: %s (grid %d)\n", hipGetErrorString(e), grid); return false; }
    return true;
}
}
extern "C" void kernel_launch(void* const* d_in, const int* in_sizes, int n_in, void* d_out, int out_size, void* d_ws, size_t ws_size, hipStream_t stream) {
    if (n_in != 30 || ws_size < mk::WS_END) { fprintf(stderr, "kernel_launch: unexpected n_in %d / ws %zu\n", n_in, ws_size); return; }
    (void)hipMemsetAsync((char*)d_ws + mk::WS_CTL, 0, mk::CTL_BYTES, stream);
    mk::launch(d_in, (float*)d_out, (unsigned char*)d_ws, 0, 23, stream);
}
```

```cpp
#include <hip/hip_runtime.h>
#include <cstdio>
#include <cstdint>
#include <hip/hip_cooperative_groups.h>
namespace mk {
namespace cg = cooperative_groups;
#define LAS __attribute__((address_space(3)))
#define GAS __attribute__((address_space(1)))
typedef unsigned short bf16_t;
typedef short bf16x8 __attribute__((ext_vector_type(8)));
typedef short s16x4 __attribute__((ext_vector_type(4)));
typedef float f32x4 __attribute__((ext_vector_type(4)));
typedef float f32x2 __attribute__((ext_vector_type(2)));
typedef unsigned u32x4 __attribute__((ext_vector_type(4)));
typedef unsigned u32x2 __attribute__((ext_vector_type(2)));
typedef _Float16 h16_t;
typedef _Float16 h16x4 __attribute__((ext_vector_type(4)));
typedef _Float16 h16x8 __attribute__((ext_vector_type(8)));
typedef float f32x8 __attribute__((ext_vector_type(8)));

constexpr int D = 1024, M = 12288, MP = 8192, FF = 4096, NCH = 768;
constexpr float EPS = 1e-6f;
constexpr int BM = 256, BK = 64, HALF = 128, HTB = HALF * BK * 2, STAGE_BYTES = 8 * HTB, NXCD = 8, WGM = 8;

typedef __bf16 bf16x2_t __attribute__((ext_vector_type(2)));
__device__ __forceinline__ unsigned cvt_pk_bf16(float lo, float hi) { const f32x2 v = {lo, hi}; const bf16x2_t b = __builtin_convertvector(v, bf16x2_t); return __builtin_bit_cast(unsigned, b); }
__device__ __forceinline__ unsigned f2bf(float f) { unsigned u = __builtin_bit_cast(unsigned, f); return (u + 0x7fffu + ((u >> 16) & 1u)) >> 16; }
__device__ __forceinline__ float bf_lo(unsigned w) { return __uint_as_float(w << 16); }
__device__ __forceinline__ float bf_hi(unsigned w) { return __uint_as_float(w & 0xffff0000u); }
__device__ __forceinline__ float rcp_f(float x) { return __builtin_amdgcn_rcpf(x); }
__device__ __forceinline__ float rsq_f(float x) { return __builtin_amdgcn_rsqf(x); }
__device__ __forceinline__ float gelu_tanh(float x) {
    const float t = x * x * (0.044715f * -2.0f * 0.7978845608028654f * 1.4426950408889634f) + (-2.0f * 0.7978845608028654f * 1.4426950408889634f);
    return x * rcp_f(1.0f + __builtin_amdgcn_exp2f(x * t));
}
__device__ __forceinline__ float sigmoid_f(float x) { return rcp_f(1.0f + __builtin_amdgcn_exp2f(x * -1.4426950408889634f)); }
__device__ __forceinline__ int lane_id() { int r; asm volatile("v_mbcnt_lo_u32_b32 %0, -1, 0\n\tv_mbcnt_hi_u32_b32 %0, -1, %0" : "=v"(r)); return r; }
__device__ __forceinline__ int cond_of_pm(int pm) { return pm < 32 ? 0 : 1 + ((pm - 32) >> 2); }
__device__ __forceinline__ int cond_of_row(int row) { return row < MP ? 0 : 1 + ((row - MP) >> 10); }

__host__ __device__ __forceinline__ int lds_byte(int r, int c) { const int st = (r >> 4) * 2 + (c >> 5), rr = r & 15, cc = c & 31, ob = rr * 64 + cc * 2; return st * 1024 + (ob ^ (((ob >> 9) & 1) << 5)); }
__host__ __device__ __forceinline__ void stage_rc(int b, int& R, int& C) { const int st = b / 1024, sb = b % 1024, swz = sb ^ (((sb >> 9) & 1) << 5); R = (st >> 1) * 16 + swz / 64; C = (st & 1) * 32 + (swz % 64) / 2; }
__host__ __device__ __forceinline__ int perm32(int rho) { const int n = rho >> 4, i = rho & 15; return 8 * (i >> 2) + 4 * n + (i & 3); }

struct Unit { int pm, pn; };
struct Gemm { const GAS char* A; const GAS char* Bt; int K; int lda; int ldb; size_t kstepA, hstepA, tstepA; int mode; };
struct ARowMajor { static __device__ __forceinline__ unsigned voff(int R, int C, int lda) { return (unsigned)(R * lda + C) * 2u; } };
struct AGroupChunk { static __device__ __forceinline__ unsigned voff(int R, int C, int) { return (unsigned)((((C >> 4) * NCH + (R >> 4)) * 256) + (R & 15) * 16 + (C & 15)) * 2u; } };
__device__ inline Gemm gemm_rowmajor(const GAS void* A, int lda, const GAS void* Bt, int ldb, int K) {
    Gemm g; g.A = (const GAS char*)A; g.Bt = (const GAS char*)Bt; g.K = K; g.lda = lda; g.ldb = ldb; g.kstepA = BK * 2; g.hstepA = (size_t)HALF * lda * 2; g.tstepA = 2 * g.hstepA; g.mode = 0; return g; }
__device__ inline Gemm gemm_groupchunk(const GAS void* A, const GAS void* Bt, int ldb, int K) {
    Gemm g; g.A = (const GAS char*)A; g.Bt = (const GAS char*)Bt; g.K = K; g.lda = 0; g.ldb = ldb; g.kstepA = (size_t)4 * NCH * 256 * 2; g.hstepA = 8 * 256 * 2; g.tstepA = 16 * 256 * 2; g.mode = 0; return g; }

struct StaticOrder {
    int nM, nN, nwg, G, c;
    __host__ __device__ void init(int M_, int N_, int G_, int c_) { nM = M_ / BM; nN = N_ / BM; nwg = nM * nN; G = G_; c = c_; }
    __host__ __device__ bool next(int i, Unit& u) const {
        const long L = (long)i * G + c; if (L >= nwg) return false;
        int wgid = (int)L; { const int q = nwg / NXCD, r = nwg % NXCD, xcd = wgid % NXCD, off = wgid / NXCD; wgid = (xcd < r ? xcd * (q + 1) : r * (q + 1) + (xcd - r) * q) + off; }
        const int nig = WGM * nN, gid = wgid / nig, fm = gid * WGM, gsz = (nM - fm) < WGM ? (nM - fm) : WGM;
        u.pm = fm + ((wgid % nig) % gsz); u.pn = (wgid % nig) / gsz; return true;
    }
};
struct SsmOrder {
    int G, c;
    __host__ __device__ bool next(int i, Unit& u) const { const int L = i * G + c; if (L >= 192) return false; u.pm = L; u.pn = L / 3; return true; }
};

template <class Epi, class AL, class Sched>
__device__ __forceinline__ void gemm_phase(LAS unsigned char* lds, const Gemm g, const Sched& S, const Epi& E, int wave_) {
    int tid = wave_ * 64 + lane_id(); asm volatile("" : "+v"(tid));
    const int wid = __builtin_amdgcn_readfirstlane(tid >> 6), lane = tid & 63, wr = wid >> 2, wc = wid & 3, fr = lane & 15, fq = lane >> 4;
    const int K = g.K, nt = K / BK;
    unsigned voffA[2], voffB[2];
#pragma unroll
    for (int i = 0; i < 2; ++i) { int R, C; stage_rc(tid * 16 + i * 8192, R, C); const int Rb = Epi::PERM ? ((R & ~31) + perm32(R & 31)) : R;
        voffA[i] = AL::voff(R, C, g.lda); voffB[i] = (unsigned)(Rb * g.ldb + C) * 2u; }
    const size_t kstepA = g.kstepA, hstepA = g.hstepA, tstepA = g.tstepA;
    const size_t kstepB = (size_t)(BK * 2), hstepB = (size_t)HALF * g.ldb * 2, tstepB = 2 * hstepB;
    const unsigned ldsw = (unsigned)wid * 1024u;
    const int aoff = lds_byte(wr * 64 + fr, fq * 8), boff = lds_byte(wc * 32 + fr, fq * 8);
#define PG8_SA(b, h) (((b) * 2 + (h)) * HTB)
#define PG8_SB(b, h) ((4 + (b) * 2 + (h)) * HTB)
#define PG8_STAGE(bufoff, gbase, voff) do { _Pragma("unroll") for (int _i = 0; _i < 2; ++_i) \
        __builtin_amdgcn_global_load_lds((const GAS unsigned*)((const GAS char*)(gbase) + (voff)[_i]), (LAS unsigned*)(lds + (bufoff) + ldsw + _i * 8192), 16, 0, 0); } while (0)
#define PG8_LDA(dst, b, h) do { _Pragma("unroll") for (int m = 0; m < 4; ++m) _Pragma("unroll") for (int k = 0; k < 2; ++k) dst[m][k] = *(const LAS bf16x8*)(lds + PG8_SA(b, h) + aoff + m * 2048 + k * 1024); } while (0)
#define PG8_LDB(dst, b, h) do { _Pragma("unroll") for (int n = 0; n < 2; ++n) _Pragma("unroll") for (int k = 0; k < 2; ++k) dst[n][k] = *(const LAS bf16x8*)(lds + PG8_SB(b, h) + boff + n * 2048 + k * 1024); } while (0)
#define PG8_MMA(ai, bj, At, Bt) do { __builtin_amdgcn_s_setprio(1); _Pragma("unroll") for (int m = 0; m < 4; ++m) _Pragma("unroll") for (int n = 0; n < 2; ++n) _Pragma("unroll") for (int k = 0; k < 2; ++k) \
        acc[ai][bj][m][n] = __builtin_amdgcn_mfma_f32_16x16x32_bf16(Bt[n][k], At[m][k], acc[ai][bj][m][n], 0, 0, 0); __builtin_amdgcn_s_setprio(0); } while (0)
#define PG8_WAIT_V(n) asm volatile("s_waitcnt vmcnt(" #n ")" ::: "memory")
#define PG8_WAIT_L(n) asm volatile("s_waitcnt lgkmcnt(" #n ")" ::: "memory")
#define PG8_BAR __builtin_amdgcn_s_barrier()
#define PG8_SCHED __builtin_amdgcn_sched_barrier(0)
    Unit cur, nxt; int ui = 0;
    if (!S.next(0, cur)) return;
    f32x4 acc[2][2][4][2];
#pragma unroll
    for (int a = 0; a < 2; ++a)
#pragma unroll
        for (int b = 0; b < 2; ++b)
#pragma unroll
            for (int m = 0; m < 4; ++m)
#pragma unroll
                for (int n = 0; n < 2; ++n) acc[a][b][m][n] = (f32x4){0.f, 0.f, 0.f, 0.f};
    bf16x8 At[4][2], B0[2][2], B1[2][2];
    const GAS char* cA = g.A + (size_t)cur.pm * tstepA; const GAS char* cB = g.Bt + (size_t)cur.pn * tstepB;
    PG8_STAGE(PG8_SB(0, 0), cB, voffB); PG8_STAGE(PG8_SB(0, 1), cB + hstepB, voffB); PG8_STAGE(PG8_SA(0, 0), cA, voffA); PG8_STAGE(PG8_SA(0, 1), cA + hstepA, voffA);
    if (wr == 1) PG8_BAR;
    PG8_WAIT_V(2); PG8_BAR;
    PG8_STAGE(PG8_SB(1, 0), cB + kstepB, voffB); PG8_STAGE(PG8_SA(1, 0), cA + kstepA, voffA); PG8_STAGE(PG8_SB(1, 1), cB + hstepB + kstepB, voffB);
    PG8_WAIT_V(6); PG8_BAR;
    for (;;) {
        const bool has_next = S.next(ui + 1, nxt);
        const GAS char* nA = has_next ? g.A + (size_t)nxt.pm * tstepA : cA; const GAS char* nB = has_next ? g.Bt + (size_t)nxt.pn * tstepB : cB;
        for (int t = 0; t < nt; t += 2) {
            const bool last = (t == nt - 2);
            const GAS char* a1 = cA + (size_t)(t + 1) * kstepA;
            const GAS char* a2 = last ? nA : cA + (size_t)(t + 2) * kstepA; const GAS char* b2 = last ? nB : cB + (size_t)(t + 2) * kstepB;
            const GAS char* a3 = a2 + kstepA; const GAS char* b3 = b2 + kstepB;
            PG8_LDB(B0, 0, 0); PG8_LDB(B1, 0, 1); PG8_SCHED; PG8_LDA(At, 0, 0); PG8_STAGE(PG8_SA(1, 1), a1 + hstepA, voffA);
            PG8_WAIT_V(8); PG8_WAIT_L(0); PG8_BAR; PG8_MMA(0, 0, At, B0); PG8_MMA(0, 1, At, B1); PG8_BAR; PG8_SCHED;
            PG8_LDA(At, 0, 1); PG8_STAGE(PG8_SB(0, 0), b2, voffB); PG8_STAGE(PG8_SB(0, 1), b2 + hstepB, voffB); PG8_STAGE(PG8_SA(0, 0), a2, voffA);
            PG8_WAIT_V(8); PG8_WAIT_L(0); PG8_BAR; PG8_MMA(1, 0, At, B0); PG8_MMA(1, 1, At, B1); PG8_BAR; PG8_SCHED;
            PG8_LDB(B0, 1, 0); PG8_LDB(B1, 1, 1); PG8_SCHED; PG8_LDA(At, 1, 0); PG8_STAGE(PG8_SA(0, 1), a2 + hstepA, voffA);
            PG8_WAIT_V(8); PG8_WAIT_L(0); PG8_BAR; PG8_MMA(0, 0, At, B0); PG8_MMA(0, 1, At, B1); PG8_BAR; PG8_SCHED;
            PG8_LDA(At, 1, 1); PG8_STAGE(PG8_SB(1, 0), b3, voffB); PG8_STAGE(PG8_SB(1, 1), b3 + hstepB, voffB); PG8_STAGE(PG8_SA(1, 0), a3, voffA);
            PG8_WAIT_V(8); PG8_WAIT_L(0); PG8_BAR; PG8_MMA(1, 0, At, B0); PG8_MMA(1, 1, At, B1); PG8_BAR; PG8_SCHED;
        }
        if (wr == 0) PG8_BAR;
        int el_ = lane_id(); asm volatile("" : "+v"(el_));
        const int efr = el_ & 15, efq = el_ >> 4;
#ifdef MK_RANGE
        if constexpr (!Epi::AFTER_DRAIN) { if (g.mode != 1) E(acc, cur, ui, lds, wr, wc, efr, efq); else { asm volatile("" :: "v"(acc[0][0][0][0]), "v"(acc[1][1][3][1])); } }
#else
        if constexpr (!Epi::AFTER_DRAIN) E(acc, cur, ui, lds, wr, wc, efr, efq);
#endif
        if (!has_next) break;
#pragma unroll
        for (int a = 0; a < 2; ++a)
#pragma unroll
            for (int b = 0; b < 2; ++b)
#pragma unroll
                for (int m = 0; m < 4; ++m)
#pragma unroll
                    for (int n = 0; n < 2; ++n) acc[a][b][m][n] = (f32x4){0.f, 0.f, 0.f, 0.f};
        cur = nxt; cA = nA; cB = nB; ++ui;
        if (wr == 1) PG8_BAR;
    }
    PG8_WAIT_V(0);
    PG8_BAR;
    if constexpr (Epi::AFTER_DRAIN) E.fused(acc, cur, wr, wc, fr, fq, lds, tid);
#undef PG8_SA
#undef PG8_SB
#undef PG8_STAGE
#undef PG8_LDA
#undef PG8_LDB
#undef PG8_MMA
#undef PG8_WAIT_V
#undef PG8_WAIT_L
#undef PG8_BAR
#undef PG8_SCHED
}

typedef const f32x4 (&AccRef)[2][2][4][2];

constexpr int PTR_OFF = STAGE_BYTES + 256 + 10240;
__device__ __forceinline__ unsigned long long ldsptr(const LAS unsigned char* lds, int k) { const unsigned long long v = ((const LAS unsigned long long*)(lds + PTR_OFF))[k];
    return ((unsigned long long)(unsigned)__builtin_amdgcn_readfirstlane((int)(unsigned)(v >> 32)) << 32) | (unsigned)__builtin_amdgcn_readfirstlane((int)(unsigned)v); }
__device__ __forceinline__ const GAS float* inp(const LAS unsigned char* lds, int k) { return (const GAS float*)ldsptr(lds, k); }
constexpr int TAB_OFF = STAGE_BYTES + 256, T_RS = TAB_OFF, T_SW = T_RS + 3072, T_GATE = T_SW + 3072, T_GSN = T_GATE + 2048;
template <class Sched> __device__ __forceinline__ void fill_tables_in(LAS unsigned char* lds, const Sched& S, const GAS float* rowss, const GAS float* sw, int swld, int tid) {
    LAS float* trs = (LAS float*)(lds + T_RS); LAS float* tsw = (LAS float*)(lds + T_SW);
#pragma unroll 1
    for (int i = 0; i < 3; ++i) { Unit u; if (!S.next(i, u)) break;
        if (tid < 256) { const GAS f32x4* p = (const GAS f32x4*)(rowss + (size_t)(u.pm * BM + tid) * 32);
            const f32x4 a = ((p[0] + p[1]) + (p[2] + p[3])) + ((p[4] + p[5]) + (p[6] + p[7]));
            trs[i * 256 + tid] = rsq_f(((a[0] + a[1]) + (a[2] + a[3])) * (1.0f / D) + EPS); }
        else tsw[i * 256 + tid - 256] = sw[(unsigned)(cond_of_pm(u.pm) * swld + u.pn * BM + tid - 256)];
    }
    __syncthreads();
}
template <int NCOL, class Sched> __device__ __forceinline__ void fill_tables_res(LAS unsigned char* lds, const Sched& S, const GAS float* gate, const GAS float* gsn, int tid) {
    LAS float* tg = (LAS float*)(lds + T_GATE); LAS float* tn = (LAS float*)(lds + T_GSN);
#pragma unroll 1
    for (int i = 0; i < 2; ++i) { Unit u; if (!S.next(i, u)) break; const int ci = cond_of_pm(u.pm);
        if (tid < NCOL) tg[i * 256 + tid] = gate[(unsigned)(ci * 6144 + u.pn * NCOL + tid)];
        else if (tid >= 256 && tid < 256 + NCOL) tn[i * 256 + tid - 256] = gsn ? gsn[(unsigned)(ci * 1024 + u.pn * NCOL + tid - 256)] : 0.f;
    }
    __syncthreads();
}
__device__ __forceinline__ void load_rstd(const LAS unsigned char* lds, int ui, int wr, int fr, float (&rs)[2][4]) {
    const LAS float* trs = (const LAS float*)(lds + T_RS) + ui * 256 + wr * 64 + fr;
#pragma unroll
    for (int ai = 0; ai < 2; ++ai)
#pragma unroll
        for (int m = 0; m < 4; ++m) rs[ai][m] = trs[ai * HALF + m * 16];
}

template <int ACT, int LDC> struct EpiIn {
    static constexpr bool PERM = true, AFTER_DRAIN = false;
    GAS bf16_t* O; GAS float* vstat;
    __device__ __forceinline__ void operator()(AccRef acc, const Unit& u, int ui, const LAS unsigned char* lds, int wr, int wc, int fr, int fq) const {
        const int row0 = u.pm * BM + wr * 64 + fr, col0 = u.pn * BM + wc * 32 + 8 * fq;
        float rs[2][4]; load_rstd(lds, ui, wr, fr, rs);
        const LAS float* swp = (const LAS float*)(lds + T_SW) + ui * 256 + wc * 32 + 8 * fq;
        const bool stats = ACT == 2 && u.pn >= 8;
#pragma unroll
        for (int bj = 0; bj < 2; ++bj) {
            const f32x4 b0 = *(const LAS f32x4*)(swp + bj * HALF), b1 = *(const LAS f32x4*)(swp + bj * HALF + 4);
#pragma unroll
            for (int ai = 0; ai < 2; ++ai)
#pragma unroll
                for (int m = 0; m < 4; ++m) {
                    const unsigned r = (unsigned)(row0 + ai * HALF + m * 16);
                    f32x4 v0 = acc[ai][bj][m][0] * rs[ai][m] + b0, v1 = acc[ai][bj][m][1] * rs[ai][m] + b1;
                    if (ACT == 1) {
#pragma unroll
                        for (int j = 0; j < 4; ++j) { const float a = fmaxf(v0[j], 0.f), b = fmaxf(v1[j], 0.f); v0[j] = a * a; v1[j] = b * b; } }
                    if (ACT == 2) {
#pragma unroll
                        for (int j = 0; j < 4; ++j) { v0[j] = gelu_tanh(v0[j]); v1[j] = gelu_tanh(v1[j]); } }
                    u32x4 w; w.x = cvt_pk_bf16(v0[0], v0[1]); w.y = cvt_pk_bf16(v0[2], v0[3]); w.z = cvt_pk_bf16(v1[0], v1[1]); w.w = cvt_pk_bf16(v1[2], v1[3]);
                    *(GAS u32x4*)(O + (r * (unsigned)LDC + (unsigned)(col0 + bj * HALF))) = w;
                    if (ACT == 2) { if (stats) {
                        float a = (v0[0] + v0[1]) + (v0[2] + v0[3]) + (v1[0] + v1[1]) + (v1[2] + v1[3]);
                        float b = (v0[0] * v0[0] + v0[1] * v0[1]) + (v0[2] * v0[2] + v0[3] * v0[3]) + (v1[0] * v1[0] + v1[1] * v1[1]) + (v1[2] * v1[2] + v1[3] * v1[3]);
                        a += __shfl_xor(a, 16); a += __shfl_xor(a, 32); b += __shfl_xor(b, 16); b += __shfl_xor(b, 32);
                        if (fq == 0) *(GAS f32x2*)(vstat + (r * 64u + (unsigned)(((u.pn - 8) * 2 + bj) * 4 + wc)) * 2u) = (f32x2){a, b}; } }
                }
        }
    }
};
struct EpiU {
    static constexpr bool PERM = true, AFTER_DRAIN = false;
    GAS bf16_t* UgS;
    __device__ __forceinline__ void operator()(AccRef acc, const Unit& u, int ui, const LAS unsigned char* lds, int wr, int wc, int fr, int fq) const {
        const int col0 = u.pn * BM + wc * 32 + 8 * fq;
        float rs[2][4]; load_rstd(lds, ui, wr, fr, rs);
        const LAS float* swp = (const LAS float*)(lds + T_SW) + ui * 256 + wc * 32 + 8 * fq;
#pragma unroll
        for (int bj = 0; bj < 2; ++bj) {
            const f32x4 b0 = *(const LAS f32x4*)(swp + bj * HALF), b1 = *(const LAS f32x4*)(swp + bj * HALF + 4);
            const int g = (col0 + bj * HALF) >> 4, p0 = (col0 & 15);
#pragma unroll
            for (int ai = 0; ai < 2; ++ai)
#pragma unroll
                for (int m = 0; m < 4; ++m) {
                    const f32x4 v0 = acc[ai][bj][m][0] * rs[ai][m] + b0, v1 = acc[ai][bj][m][1] * rs[ai][m] + b1;
                    u32x4 w; w.x = cvt_pk_bf16(v0[0], v0[1]); w.y = cvt_pk_bf16(v0[2], v0[3]); w.z = cvt_pk_bf16(v1[0], v1[1]); w.w = cvt_pk_bf16(v1[2], v1[3]);
                    const int chunk = u.pm * 16 + ai * 8 + wr * 4 + m;
                    *(GAS u32x4*)(UgS + ((unsigned)(g * NCH + chunk) * 512u + (unsigned)(fr * 16 + p0))) = w;
                }
        }
    }
};
struct EpiScan {
    static constexpr bool PERM = true, AFTER_DRAIN = true;
    GAS bf16_t* UgS; const GAS float* lamT; const GAS float* h0_re; const GAS float* h0_im; GAS float* new_re; GAS float* new_im; int j;
    static __device__ __forceinline__ int lidx(int row, int col) { return row * 128 + ((((col >> 2) ^ row) & 31) << 2) + (col & 3); }
    __device__ __forceinline__ void fused(AccRef acc, const Unit& u, int wr, int wc, int fr, int fq, LAS unsigned char* lds, int tid) const {
        LAS float* T = (LAS float*)lds;
        const int g = u.pn, mt = u.pm - 3 * g, n = tid & 63, slot = __builtin_amdgcn_readfirstlane(tid >> 6);
        const int len = mt < 2 ? 16 : 64, nsq = mt < 2 ? 2 : (slot < 4 ? 1 : 0), sl0 = mt < 2 ? slot * 2 : slot;
#pragma unroll 1
        for (int k = 0; k < 2; ++k) {
#pragma unroll
            for (int ai = 0; ai < 2; ++ai)
#pragma unroll
                for (int m = 0; m < 4; ++m) { const int row = ai * HALF + wr * 64 + m * 16 + fr;
#pragma unroll
                    for (int nn = 0; nn < 2; ++nn) { const int col = wc * 32 + 8 * fq + 4 * nn; *(LAS f32x4*)(T + lidx(row, col)) = k == 0 ? acc[ai][0][m][nn] : acc[ai][1][m][nn]; } }
            __syncthreads();
            const float lr = lamT[(((unsigned)j * 64 + g) * 2 + k) * 128 + 2 * n], li = lamT[(((unsigned)j * 64 + g) * 2 + k) * 128 + 2 * n + 1];
            for (int q = 0; q < nsq; ++q) {
                const int sl = sl0 + q, r0 = sl * len;
                float sr = 0.f, si = 0.f;
                if (mt == 2) { const unsigned o = ((((unsigned)sl * 2 + j) * 2 + k) * 64 + g) * 64 + n; sr = h0_re[o]; si = h0_im[o]; }
                GAS bf16_t* so = UgS + ((size_t)g * NCH + mt * 256) * 512 + 256 + k * 128 + n;
                for (int i = 0; i < len; ++i) {
                    const int row = k == 0 ? r0 + i : r0 + len - 1 - i;
                    so[(unsigned)row * 512u] = (bf16_t)f2bf(sr); so[(unsigned)row * 512u + 64u] = (bf16_t)f2bf(si);
                    const float ar = T[lidx(row, n)], ai2 = T[lidx(row, 64 + n)];
                    const float nr = lr * sr - li * si + ar, ni = lr * si + li * sr + ai2; sr = nr; si = ni;
                }
                if (mt < 2) { const unsigned o = ((((unsigned)(mt * 16 + sl) * 2 + j) * 2 + k) * 64 + g) * 64 + n; new_re[o] = sr; new_im[o] = si; }
            }
            __syncthreads();
        }
    }
};
struct EpiY {
    static constexpr bool PERM = true, AFTER_DRAIN = false;
    GAS bf16_t* Zg;
    __device__ __forceinline__ void operator()(AccRef acc, const Unit& u, int ui, const LAS unsigned char* lds, int wr, int wc, int fr, int fq) const {
        const int row0 = u.pm * BM + wr * 64 + fr, col0 = wc * 32 + 8 * fq;
#pragma unroll
        for (int ai = 0; ai < 2; ++ai)
#pragma unroll
            for (int m = 0; m < 4; ++m) { GAS bf16_t* rp = Zg + (size_t)(row0 + ai * HALF + m * 16) * 256 + col0;
#pragma unroll
                for (int bj = 0; bj < 2; ++bj) { const f32x4 v0 = acc[ai][bj][m][0], v1 = acc[ai][bj][m][1];
                    u32x4 w; w.x = cvt_pk_bf16(gelu_tanh(v0[0]), gelu_tanh(v0[1])); w.y = cvt_pk_bf16(gelu_tanh(v0[2]), gelu_tanh(v0[3]));
                    w.z = cvt_pk_bf16(gelu_tanh(v1[0]), gelu_tanh(v1[1])); w.w = cvt_pk_bf16(gelu_tanh(v1[2]), gelu_tanh(v1[3]));
                    *(GAS u32x4*)(rp + bj * HALF) = w; } }
    }
};
template <bool GATED> struct EpiRes {
    static constexpr bool PERM = true, AFTER_DRAIN = false;
    GAS h16_t* X; GAS bf16_t* XN; GAS float* rowss_next; bool has_next;
    __device__ __forceinline__ void operator()(AccRef acc, const Unit& u, int ui, const LAS unsigned char* lds, int wr, int wc, int fr, int fq) const {
        constexpr int NB = GATED ? 1 : 2;
        const int row0 = u.pm * BM + wr * 64 + fr, col0 = u.pn * (GATED ? HALF : BM) + wc * 32 + 8 * fq;
        const LAS float* tg = (const LAS float*)(lds + T_GATE) + ui * 256 + wc * 32 + 8 * fq; const LAS float* tn = (const LAS float*)(lds + T_GSN) + ui * 256 + wc * 32 + 8 * fq;
        h16x8 xa[4], xb[4];
#define RES_LOAD(dst, b_) do { const int bj_ = (b_) / 2, ai_ = (b_) % 2; _Pragma("unroll") for (int m = 0; m < 4; ++m) \
            dst[m] = *(const GAS h16x8*)(X + ((unsigned)(row0 + ai_ * HALF + m * 16) * (unsigned)D + (unsigned)(col0 + bj_ * HALF))); } while (0)
#define RES_PROC(src, b_) do { const int bj = (b_) / 2, ai = (b_) % 2; \
            const f32x4 g0 = *(const LAS f32x4*)(tg + bj * HALF), g1 = *(const LAS f32x4*)(tg + bj * HALF + 4), n0 = *(const LAS f32x4*)(tn + bj * HALF), n1 = *(const LAS f32x4*)(tn + bj * HALF + 4); \
            _Pragma("unroll") for (int m = 0; m < 4; ++m) { \
                const unsigned r = (unsigned)(row0 + ai * HALF + m * 16), off = r * (unsigned)D + (unsigned)(col0 + bj * HALF); \
                f32x4 v0 = acc[ai][bj][m][0], v1 = acc[ai][bj][m][1]; \
                if (GATED) { const f32x4 q0 = acc[ai][1][m][0], q1 = acc[ai][1][m][1]; \
                    _Pragma("unroll") for (int j = 0; j < 4; ++j) { v0[j] *= sigmoid_f(q0[j]); v1[j] *= sigmoid_f(q1[j]); } } \
                const f32x8 xo = __builtin_convertvector(src[m], f32x8); \
                const f32x4 x0 = (f32x4){xo[0], xo[1], xo[2], xo[3]} + g0 * v0, x1 = (f32x4){xo[4], xo[5], xo[6], xo[7]} + g1 * v1; \
                *(GAS h16x8*)(X + off) = __builtin_convertvector(((f32x8){x0[0], x0[1], x0[2], x0[3], x1[0], x1[1], x1[2], x1[3]}), h16x8); \
                if (has_next) { \
                    float a = (x0[0] * x0[0] + x0[1] * x0[1]) + (x0[2] * x0[2] + x0[3] * x0[3]) + (x1[0] * x1[0] + x1[1] * x1[1]) + (x1[2] * x1[2] + x1[3] * x1[3]); \
                    const f32x4 y0 = x0 * n0, y1 = x1 * n1; \
                    u32x4 w; w.x = cvt_pk_bf16(y0[0], y0[1]); w.y = cvt_pk_bf16(y0[2], y0[3]); w.z = cvt_pk_bf16(y1[0], y1[1]); w.w = cvt_pk_bf16(y1[2], y1[3]); \
                    *(GAS u32x4*)(XN + off) = w; \
                    a += __shfl_xor(a, 16); a += __shfl_xor(a, 32); \
                    if (fq == 0) rowss_next[r * 32u + (unsigned)(GATED ? u.pn * 4 + wc : (u.pn * 2 + bj) * 4 + wc)] = a; } } } while (0)
        RES_LOAD(xa, 0); RES_LOAD(xb, 1);
        RES_PROC(xa, 0);
        if (NB > 1) RES_LOAD(xa, 2);
        RES_PROC(xb, 1);
        if (NB > 1) { RES_LOAD(xb, 3); RES_PROC(xa, 2); RES_PROC(xb, 3); }
#undef RES_LOAD
#undef RES_PROC
    }
};

#define XB_TMO      128
#define XB_XCNT(j)  (256  + 64 * (j))
#define XB_XSUB(j)  (1280 + 64 * (j))
#define XB_XGEN(j)  (2304 + 64 * (j))
#define XB_TOP      3328
#define XB_TOPGEN   3392
#define XCD_BAR_WORDS 3456
#define XB_SPIN_CAP (1u << 18)
__device__ __forceinline__ unsigned xb_ld(GAS unsigned* p)              { return __hip_atomic_load(p, __ATOMIC_RELAXED, __HIP_MEMORY_SCOPE_AGENT); }
__device__ __forceinline__ unsigned xb_add(GAS unsigned* p, unsigned v) { return __hip_atomic_fetch_add(p, v, __ATOMIC_RELAXED, __HIP_MEMORY_SCOPE_AGENT); }
__device__ __forceinline__ unsigned xb_xcc_id() { return (unsigned)__builtin_amdgcn_s_getreg((3 << 11) | 20) & 0xFu; }
#define XB_SPIN(cond, bar) do { unsigned _sp = 0; while (cond) { __builtin_amdgcn_s_sleep(1); \
    if ((++_sp & 255u) == 0u) { if (xb_ld(&(bar)[XB_TMO])) break; if (_sp > XB_SPIN_CAP) { (void)xb_add(&(bar)[XB_TMO], 1u); break; } } } } while (0)
struct XcdBarrier { GAS unsigned* bar; unsigned x; volatile LAS unsigned* st; };
__device__ __forceinline__ XcdBarrier xcd_barrier_post(GAS unsigned* bar, volatile LAS unsigned* st) {
    XcdBarrier b; b.bar = bar; b.x = xb_xcc_id(); b.st = st;
    if (threadIdx.x == 0) (void)xb_add(&bar[XB_XCNT(b.x)], 1u);
    return b;
}
__device__ __forceinline__ void xcd_barrier_complete(GAS unsigned* bar, unsigned x, unsigned& nloc, unsigned& nx) {
    const unsigned G = gridDim.x * gridDim.y * gridDim.z;
    unsigned sum, cnt, mine, sp = 0u;
    for (;;) {
        sum = 0u; cnt = 0u;
#pragma unroll 1
        for (unsigned j = 0; j < 16; ++j) { const unsigned c = xb_ld(&bar[XB_XCNT(j)]); sum += c; cnt += (c > 0u) ? 1u : 0u; }
        mine = xb_ld(&bar[XB_XCNT(x)]);
        if (sum == G) break;
        __builtin_amdgcn_s_sleep(1);
        if ((++sp & 255u) == 0u) { if (xb_ld(&bar[XB_TMO])) break; if (sp > XB_SPIN_CAP) { (void)xb_add(&bar[XB_TMO], 1u); break; } }
    }
    nloc = mine > 0u ? mine : 1u; nx = cnt > 0u ? cnt : 1u;
}
__device__ __forceinline__ void xcd_barrier(const XcdBarrier& b, bool leader) {
    asm volatile("s_waitcnt vmcnt(0)" ::: "memory");
    __syncthreads();
    if (leader) {
        GAS unsigned* bar = b.bar; unsigned bx_ = b.x;
        asm volatile("" : "+s"(bar), "+s"(bx_));
        __builtin_amdgcn_s_waitcnt(0);
        unsigned nloc = b.st[0], nx = b.st[1];
        if (nloc == 0u) { xcd_barrier_complete(bar, bx_, nloc, nx); b.st[0] = nloc; b.st[1] = nx; }
        const unsigned old = xb_add(&bar[XB_XSUB(bx_)], 1u);
        const unsigned gen = old / nloc;
        if (old + 1u == (gen + 1u) * nloc) {
            __builtin_amdgcn_fence(__ATOMIC_RELEASE, "agent");
            asm volatile("s_waitcnt vmcnt(0)" ::: "memory");
            const unsigned og = xb_add(&bar[XB_TOP], 1u);
            const unsigned tg = og / nx;
            if (og + 1u == (tg + 1u) * nx) xb_add(&bar[XB_TOPGEN], 1u);
            else XB_SPIN(xb_ld(&bar[XB_TOPGEN]) == tg, bar);
            __builtin_amdgcn_fence(__ATOMIC_ACQUIRE, "agent");
            xb_add(&bar[XB_XGEN(bx_)], 1u);
            asm volatile("s_waitcnt vmcnt(0)" ::: "memory");
        } else {
            XB_SPIN(xb_ld(&bar[XB_XGEN(bx_)]) == gen, bar);
            __builtin_amdgcn_fence(__ATOMIC_ACQUIRE, "agent");
            asm volatile("s_waitcnt vmcnt(0)" ::: "memory");
        }
    }
    __syncthreads();
}

constexpr size_t MiB = 1u << 20;
constexpr size_t WS_CTL = 0, CTL_BYTES = 2 * MiB;
constexpr int CW_BAR = 4096;
constexpr size_t WS_TAB = 2 * MiB;
constexpr size_t TAB_GSA = WS_TAB, TAB_GSB = TAB_GSA + 4 * 5 * 1024 * 4, TAB_SWA = TAB_GSB + 4 * 5 * 1024 * 4, TAB_SWB = TAB_SWA + 4 * 5 * 4096 * 4, TAB_LAMT = TAB_SWB + 4 * 5 * 4096 * 4;
static_assert(TAB_LAMT + 2 * 64 * 2 * 64 * 2 * 4 <= 4 * MiB, "tables");
constexpr size_t WS_W1 = 4 * MiB, WS_W2 = 36 * MiB, WS_SWIN = 68 * MiB, WS_SWOUT = 72 * MiB, WS_GWIN = 80 * MiB, WS_GWOUT = 88 * MiB, WS_GWS = 92 * MiB,
                 WS_CWIN = 93 * MiB, WS_CWOUT = 99 * MiB, WS_BTY = 101 * MiB, WS_BTS = 133 * MiB;
constexpr size_t WS_XN = 149 * MiB;
constexpr size_t WS_R = 173 * MiB;
constexpr size_t WS_R2 = 269 * MiB;
constexpr size_t WS_ROWSS = 317 * MiB;
constexpr size_t WS_VSTAT = 329 * MiB;
constexpr size_t WS_MODS = 335 * MiB;
constexpr size_t WS_X16 = 336 * MiB;
constexpr size_t WS_END = 360 * MiB;

constexpr int LDS_BYTES = 147456;
constexpr int MISC_OFF = STAGE_BYTES;

struct Args { const float* in[30]; float* out; unsigned char* ws; int ph_lo, ph_hi; int mode, pad; };

__device__ __forceinline__ unsigned pk2(float lo, float hi) { return f2bf(lo) | (f2bf(hi) << 16); }
__device__ __forceinline__ float wave_sum(float v) {
#pragma unroll
    for (int o = 1; o < 64; o <<= 1) v += __shfl_xor(v, o);
    return v;
}
template <int MAP> __device__ __forceinline__ int rowmap(int n) {
    if (MAP == 1) { const int half = n >> 10, c = n & 1023; return (c >> 7) * 256 + half * 128 + (c & 127); }
    return n;
}
template <int MAP> __device__ __forceinline__ void transpose_item(const GAS float* W, int K, int N, GAS bf16_t* WT, LAS float* scr, int item, int lane) {
    const int nblk = N / 32, kb = item / nblk, nb = item % nblk, k0 = 64 * kb, n0 = 32 * nb;
    float wv[32];
#pragma unroll
    for (int i = 0; i < 32; ++i) wv[i] = W[(size_t)(k0 + 2 * i + (lane >> 5)) * N + n0 + (lane & 31)];
#pragma unroll
    for (int i = 0; i < 32; ++i) scr[(2 * i + (lane >> 5)) * 33 + (lane & 31)] = wv[i];
    asm volatile("s_waitcnt lgkmcnt(0)" ::: "memory");
    const int c = lane & 7;
#pragma unroll
    for (int j = 0; j < 4; ++j) { const int n = (lane >> 3) + 8 * j; const LAS float* s = scr + (8 * c) * 33 + n;
        u32x4 o; o.x = pk2(s[0 * 33], s[1 * 33]); o.y = pk2(s[2 * 33], s[3 * 33]); o.z = pk2(s[4 * 33], s[5 * 33]); o.w = pk2(s[6 * 33], s[7 * 33]);
        *(GAS u32x4*)(WT + (size_t)rowmap<MAP>(n0 + n) * K + k0 + 8 * c) = o; }
    asm volatile("s_waitcnt lgkmcnt(0)" ::: "memory");
}

__device__ __forceinline__ void ssm_build(const Args& a, int j, int g, int part, LAS unsigned char* lds, GAS unsigned char* ws, int tid) {
#ifdef MK_RANGE
    const int PMODE = a.mode;
#else
    constexpr int PMODE = 0;
#endif
    LAS float* PR = (LAS float*)lds;
    LAS float* PI = PR + 2 * 17 * 64;
    LAS float* BR = PI + 2 * 17 * 64;
    LAS float* BI = BR + 2 * 64 * 16;
    LAS float* CR = BI + 2 * 64 * 16;
    LAS float* CI = CR + 2 * 16 * 64;
    LAS float* WR = CI + 2 * 16 * 64;
    LAS float* WI = WR + 2 * 64 * 16;
    LAS float* KT = WI + 2 * 64 * 16;
    const GAS float* lam_re = inp(lds, 13); const GAS float* lam_im = inp(lds, 14); const GAS float* log_dt = inp(lds, 15);
    const GAS float* b_re = inp(lds, 16); const GAS float* b_im = inp(lds, 17); const GAS float* c_re = inp(lds, 18); const GAS float* c_im = inp(lds, 19); const GAS float* dsk = inp(lds, 20);
    __syncthreads();
    LAS float* FR = WR; LAS float* FI = WR + 128; LAS float* DSK = WR + 256;
    if (tid >= 128 && tid < 144) DSK[tid - 128] = dsk[j * 1024 + g * 16 + tid - 128];
    if (tid < 128) {
        const int k = tid >> 6, n = tid & 63, pidx = (j * 2 + k) * 64 + g;
        const float dt = expf(log_dt[pidx]);
        const float lr = lam_re[pidx * 64 + n], li = lam_im[pidx * 64 + n];
        const float mag = expf(lr * dt); float sn, cs; sincosf(li * dt, &sn, &cs); const float abr = mag * cs, abi = mag * sn;
        const float den = lr * lr + li * li;
        const float nr = (abr - 1.0f) * lr + abi * li, ni = -(abr - 1.0f) * li + abi * lr;
        FR[tid] = nr / den; FI[tid] = ni / den;
    }
#pragma unroll 1
    for (int i = tid; i < 2 * 17 * 64; i += 512) {
        const int k = i / (17 * 64), e = (i >> 6) % 17, n = i & 63, pidx = (j * 2 + k) * 64 + g;
        const float dt = expf(log_dt[pidx]); const float lr = lam_re[pidx * 64 + n], li = lam_im[pidx * 64 + n];
        const float mag = expf((float)e * lr * dt); float sn, cs; sincosf((float)e * (li * dt), &sn, &cs); PR[i] = mag * cs; PI[i] = mag * sn; }
    for (int i = tid; i < 2048; i += 512) { const int k = i >> 10, po = (i >> 6) & 15, n = i & 63; const size_t o = ((size_t)(j * 2 + k) * 64 + g) * 1024 + (i & 1023);
        CR[(k * 64 + n) * 16 + po] = c_re[o]; CI[(k * 64 + n) * 16 + po] = c_im[o]; }
    __syncthreads();
    for (int i = tid; i < 2048; i += 512) { const int kn = i >> 4; const size_t o = ((size_t)(j * 2 + (kn >> 6)) * 64 + g) * 1024 + (i & 1023);
        const float br = b_re[o], bi = b_im[o], fr = FR[kn], fi = FI[kn]; BR[i] = fr * br - fi * bi; BI[i] = fr * bi + fi * br; }
    if (part == 1 && tid < 128) { const int k = tid >> 6, n = tid & 63; GAS float* lamT = (GAS float*)(ws + TAB_LAMT) + (((size_t)j * 64 + g) * 2 + k) * 128;
        lamT[2 * n] = PR[(k * 17 + 16) * 64 + n]; lamT[2 * n + 1] = PI[(k * 17 + 16) * 64 + n]; }
    __syncthreads();
    if (part == 0 && PMODE != 6) {
        const int e = tid >> 5, k = (tid >> 4) & 1, po4 = (tid >> 2) & 3, pi4 = tid & 3;
        float acc[4][4];
#pragma unroll
        for (int x = 0; x < 4; ++x)
#pragma unroll
            for (int y = 0; y < 4; ++y) acc[x][y] = 0.f;
#pragma unroll 2
        for (int n = 0; n < 64; ++n) {
            const float pr = PR[(k * 17 + e) * 64 + n], pim = PI[(k * 17 + e) * 64 + n];
            const f32x4 br = *(const LAS f32x4*)(BR + (k * 64 + n) * 16 + 4 * pi4), bi = *(const LAS f32x4*)(BI + (k * 64 + n) * 16 + 4 * pi4);
            const f32x4 cr = *(const LAS f32x4*)(CR + (k * 64 + n) * 16 + 4 * po4), ci = *(const LAS f32x4*)(CI + (k * 64 + n) * 16 + 4 * po4);
            const f32x4 wr = br * pr - bi * pim, wi = bi * pr + br * pim;
#pragma unroll
            for (int x = 0; x < 4; ++x)
#pragma unroll
                for (int y = 0; y < 4; ++y) acc[x][y] += cr[x] * wr[y] - ci[x] * wi[y];
        }
#pragma unroll
        for (int x = 0; x < 4; ++x) *(LAS f32x4*)(KT + ((k * 16 + e) * 16 + 4 * po4 + x) * 16 + 4 * pi4) = (f32x4){acc[x][0], acc[x][1], acc[x][2], acc[x][3]};
    }
    __syncthreads();
    GAS bf16_t* BtY = (GAS bf16_t*)(ws + WS_BTY) + ((size_t)j * 64 + g) * 256 * 512;
    GAS bf16_t* BtS = (GAS bf16_t*)(ws + WS_BTS) + ((size_t)j * 64 + g) * 256 * 256;
    if (part == 0) {
    if (PMODE != 7)
#pragma unroll 1
    for (int pc = tid; pc < 256 * 32; pc += 512) {
        const int row = pc >> 5, kc = (pc & 31) * 8, t = row >> 4, po = row & 15, s = kc >> 4, pi0 = kc & 15;
        float v[8];
#pragma unroll
        for (int q = 0; q < 8; ++q) { const int pi = pi0 + q; float x = 0.f;
            if (s <= t) x += KT[((0 * 16 + (t - s)) * 16 + po) * 16 + pi];
            if (s >= t) x += KT[((1 * 16 + (s - t)) * 16 + po) * 16 + pi];
            if (s == t && pi == po) x += DSK[po];
            v[q] = x; }
        u32x4 o; o.x = pk2(v[0], v[1]); o.y = pk2(v[2], v[3]); o.z = pk2(v[4], v[5]); o.w = pk2(v[6], v[7]);
        *(GAS u32x4*)(BtY + (size_t)row * 512 + kc) = o;
    }
    if (PMODE != 8)
#pragma unroll 1
    for (int pc = tid; pc < 256 * 32; pc += 512) {
        const int row = pc >> 5, kc = (pc & 31) * 8, t = row >> 4, po = row & 15, k = kc >> 7, ri = (kc >> 6) & 1, n0 = kc & 63;
        const int e = k == 0 ? t + 1 : 16 - t;
        float v[8];
#pragma unroll
        for (int q = 0; q < 8; ++q) { const int n = n0 + q; const float cr = CR[(k * 64 + n) * 16 + po], cim = CI[(k * 64 + n) * 16 + po], pr = PR[(k * 17 + e) * 64 + n], pim = PI[(k * 17 + e) * 64 + n];
            v[q] = ri == 0 ? (cr * pr - cim * pim) : -(cr * pim + cim * pr); }
        u32x4 o; o.x = pk2(v[0], v[1]); o.y = pk2(v[2], v[3]); o.z = pk2(v[4], v[5]); o.w = pk2(v[6], v[7]);
        *(GAS u32x4*)(BtY + (size_t)row * 512 + 256 + kc) = o;
    }
    } else {
    for (int pc = tid; pc < 256 * 32; pc += 512) {
        const int row = pc >> 5, kc = (pc & 31) * 8, k = row >> 7, ri = (row >> 6) & 1, n = row & 63, s = kc >> 4, pi0 = kc & 15;
        const int e = k == 0 ? 15 - s : s;
        const float pr = PR[(k * 17 + e) * 64 + n], pim = PI[(k * 17 + e) * 64 + n];
        float v[8];
#pragma unroll
        for (int q = 0; q < 8; ++q) { const float br = BR[(k * 64 + n) * 16 + pi0 + q], bi = BI[(k * 64 + n) * 16 + pi0 + q]; v[q] = ri == 0 ? (pr * br - pim * bi) : (pr * bi + pim * br); }
        u32x4 o; o.x = pk2(v[0], v[1]); o.y = pk2(v[2], v[3]); o.z = pk2(v[4], v[5]); o.w = pk2(v[6], v[7]);
        *(GAS u32x4*)(BtS + (size_t)row * 256 + kc) = o;
    }
    }
    __syncthreads();
}

__device__ __forceinline__ void mods_task(const Args& a, GAS float* mods, LAS unsigned char* lds, int task, int tid) {
    const int cg = task % 48, l = task / 48, wave = tid >> 6, lane = tid & 63, half = lane >> 5, c4 = lane & 31;
    const GAS float* c = inp(lds, 4); const GAS float* c_ctx = inp(lds, 5); const GAS float* w_mod = inp(lds, 6); const GAS float* b_mod = inp(lds, 7);
    LAS float* sil = (LAS float*)lds;
    LAS float* red = sil + 5 * 1024;
    __syncthreads();
    for (int i = tid; i < 5 * 1024; i += 512) { const int ci = i >> 10, k = i & 1023; const float v = ci == 0 ? c_ctx[k] : c[(ci - 1) * 1024 + k]; sil[i] = v / (1.0f + expf(-v)); }
    __syncthreads();
    const GAS float* w = w_mod + ((size_t)l * 1024 + wave * 128 + half) * 6144 + cg * 128 + c4 * 4;
    f32x4 acc[5];
#pragma unroll
    for (int ci = 0; ci < 5; ++ci) acc[ci] = (f32x4){0.f, 0.f, 0.f, 0.f};
#pragma unroll 1
    for (int b = 0; b < 2; ++b) {
        f32x4 wv[32];
#pragma unroll
        for (int i = 0; i < 32; ++i) wv[i] = *(const GAS f32x4*)(w + (size_t)(b * 64 + 2 * i) * 6144);
#pragma unroll
        for (int i = 0; i < 32; ++i) { const int k = wave * 128 + b * 64 + 2 * i + half;
#pragma unroll
            for (int ci = 0; ci < 5; ++ci) acc[ci] += wv[i] * sil[ci * 1024 + k]; }
    }
#pragma unroll
    for (int ci = 0; ci < 5; ++ci) {
#pragma unroll
        for (int q = 0; q < 4; ++q) acc[ci][q] += __shfl_xor(acc[ci][q], 32);
        if (half == 0) *(LAS f32x4*)(red + (wave * 5 + ci) * 128 + c4 * 4) = acc[ci]; }
    __syncthreads();
    for (int i = tid; i < 5 * 128; i += 512) { const int ci = i >> 7, cc = i & 127; float t = 0.f;
#pragma unroll
        for (int wv2 = 0; wv2 < 8; ++wv2) t += red[(wv2 * 5 + ci) * 128 + cc];
        mods[((size_t)l * 5 + ci) * 6144 + cg * 128 + cc] = t + b_mod[l * 6144 + cg * 128 + cc]; }
}

__device__ __forceinline__ void xinit_row(const LAS unsigned char* lds, GAS h16_t* X, int row, int lane) {
    GAS h16x4* o = (GAS h16x4*)(X + (size_t)row * D) + lane;
    if (row < MP) { const GAS f32x4* s = (const GAS f32x4*)(inp(lds, 0) + (size_t)row * D) + lane;
#pragma unroll
        for (int q = 0; q < 4; ++q) o[64 * q] = __builtin_convertvector(s[64 * q], h16x4);
        return; }
    const GAS f32x4* s = (const GAS f32x4*)(inp(lds, 1) + (size_t)(row - MP) * D) + lane;
    const int t = (row - MP) & 1023; const float rr = (float)(t >> 6), cc = (float)(t & 63);
    float freq[4];
#pragma unroll
    for (int e = 0; e < 4; ++e) freq[e] = expf(-(float)(4 * lane + e) * (9.210340371976184f / 256.0f));
    f32x4 v[4];
#pragma unroll
    for (int q = 0; q < 4; ++q) v[q] = s[64 * q];
#pragma unroll
    for (int e = 0; e < 4; ++e) { float sr, cr, sc, cc2; sincosf(rr * freq[e], &sr, &cr); sincosf(cc * freq[e], &sc, &cc2); v[0][e] += sr; v[1][e] += cr; v[2][e] += sc; v[3][e] += cc2; }
#pragma unroll
    for (int q = 0; q < 4; ++q) o[64 * q] = __builtin_convertvector(v[q], h16x4);
}


__device__ __forceinline__ void sw_job(const GAS float* mods, int l, int sidx, const GAS bf16_t* WT, int N, GAS float* dst, int dld, int wv, int nw, int lane) {
    float sh[5][16];
#pragma unroll
    for (int ci = 0; ci < 5; ++ci) { const GAS float* sp = mods + ((size_t)l * 5 + ci) * 6144 + sidx * 1024 + lane * 16;
#pragma unroll
        for (int q = 0; q < 4; ++q) { const f32x4 v = *(const GAS f32x4*)(sp + 4 * q); sh[ci][4 * q] = v[0]; sh[ci][4 * q + 1] = v[1]; sh[ci][4 * q + 2] = v[2]; sh[ci][4 * q + 3] = v[3]; } }
    for (int r = wv * 8; r < N; r += nw * 8) {
        u32x4 w0[8], w1[8];
#pragma unroll
        for (int nn = 0; nn < 8; ++nn) { w0[nn] = *(const GAS u32x4*)(WT + (size_t)(r + nn) * D + lane * 16); w1[nn] = *(const GAS u32x4*)(WT + (size_t)(r + nn) * D + lane * 16 + 8); }
#pragma unroll
        for (int nn = 0; nn < 8; ++nn) {
            const float wf[16] = {bf_lo(w0[nn].x), bf_hi(w0[nn].x), bf_lo(w0[nn].y), bf_hi(w0[nn].y), bf_lo(w0[nn].z), bf_hi(w0[nn].z), bf_lo(w0[nn].w), bf_hi(w0[nn].w),
                                  bf_lo(w1[nn].x), bf_hi(w1[nn].x), bf_lo(w1[nn].y), bf_hi(w1[nn].y), bf_lo(w1[nn].z), bf_hi(w1[nn].z), bf_lo(w1[nn].w), bf_hi(w1[nn].w)};
#pragma unroll
            for (int ci = 0; ci < 5; ++ci) { float t = 0.f;
#pragma unroll
                for (int q = 0; q < 16; ++q) t += wf[q] * sh[ci][q];
                t = wave_sum(t);
                if (lane == 0) dst[ci * dld + r + nn] = t; }
        }
    }
}
__device__ __forceinline__ void sw_mix_job(GAS unsigned char* ws, const GAS float* mods, int l, int wv, int nw, int lane) {
    GAS float* swA = (GAS float*)(ws + TAB_SWA);
    if (l == 0) sw_job(mods, 0, 0, (const GAS bf16_t*)(ws + WS_SWIN), 1024, swA, 1024, wv, nw, lane);
    else if (l == 1) sw_job(mods, 1, 0, (const GAS bf16_t*)(ws + WS_GWIN), 4096, swA + 1 * 5 * 4096, 4096, wv, nw, lane);
    else if (l == 2) sw_job(mods, 2, 0, (const GAS bf16_t*)(ws + WS_CWIN), 3072, swA + 2 * 5 * 4096, 3072, wv, nw, lane);
    else sw_job(mods, 3, 0, (const GAS bf16_t*)(ws + WS_SWIN) + (size_t)D * D, 1024, swA + 3 * 5 * 4096, 1024, wv, nw, lane);
}
__device__ __forceinline__ void sw_ffn_job(GAS unsigned char* ws, const GAS float* mods, int l, int wv, int nw, int lane) {
    sw_job(mods, l, 3, (const GAS bf16_t*)(ws + WS_W1) + (size_t)l * D * FF, 4096, (GAS float*)(ws + TAB_SWB) + l * 5 * 4096, 4096, wv, nw, lane);
}


constexpr int I_W1 = 2048, I_W2 = 2048, I_SI = 512, I_SO = 1024, I_GI = 2048, I_GO = 1024, I_CI = 1536, I_CO = 512;
constexpr int IT_W1 = 0, IT_W2 = 4 * I_W1, IT_SI = IT_W2 + 4 * I_W2, IT_SO = IT_SI + 2 * I_SI, IT_GI = IT_SO + 2 * I_SO, IT_GO = IT_GI + I_GI, IT_CI = IT_GO + I_GO, IT_CO = IT_CI + I_CI, IT_END = IT_CO + I_CO;
__device__ __forceinline__ void convert_items(const LAS unsigned char* lds, GAS unsigned char* ws, LAS float* scr, int first, int count, int wv, int nw, int lane) {
    for (int it = first + wv; it < first + count; it += nw) {
        int r = it;
        if (r < IT_W2) { const int l = r / I_W1; transpose_item<0>(inp(lds, 10) + (size_t)l * D * FF, D, FF, (GAS bf16_t*)(ws + WS_W1) + (size_t)l * D * FF, scr, r % I_W1, lane); continue; } r -= IT_W2;
        if (r < 4 * I_W2) { const int l = r / I_W2; transpose_item<0>(inp(lds, 11) + (size_t)l * D * FF, FF, D, (GAS bf16_t*)(ws + WS_W2) + (size_t)l * D * FF, scr, r % I_W2, lane); continue; } r -= 4 * I_W2;
        if (r < 2 * I_SI) { const int l = r / I_SI; transpose_item<0>(inp(lds, 12) + (size_t)l * D * D, D, D, (GAS bf16_t*)(ws + WS_SWIN) + (size_t)l * D * D, scr, r % I_SI, lane); continue; } r -= 2 * I_SI;
        if (r < 2 * I_SO) { const int l = r / I_SO; transpose_item<1>(inp(lds, 21) + (size_t)l * D * 2048, D, 2048, (GAS bf16_t*)(ws + WS_SWOUT) + (size_t)l * D * 2048, scr, r % I_SO, lane); continue; } r -= 2 * I_SO;
        if (r < I_GI) { transpose_item<0>(inp(lds, 22), D, 4096, (GAS bf16_t*)(ws + WS_GWIN), scr, r, lane); continue; } r -= I_GI;
        if (r < I_GO) { transpose_item<0>(inp(lds, 25), 2048, D, (GAS bf16_t*)(ws + WS_GWOUT), scr, r, lane); continue; } r -= I_GO;
        if (r < I_CI) { transpose_item<0>(inp(lds, 26), D, 3072, (GAS bf16_t*)(ws + WS_CWIN), scr, r, lane); continue; } r -= I_CI;
        transpose_item<0>(inp(lds, 28), D, D, (GAS bf16_t*)(ws + WS_CWOUT), scr, r, lane);
    }
}
constexpr int NPH = 28;
#ifdef MK_RANGE
#define GMODE(g) g.mode = args.mode
#else
#define GMODE(g)
#endif
#ifndef MK_ALLCG
#define MK_ALLCG 0
#endif
__global__ void __launch_bounds__(512, 2) fwd(Args args) {
    extern __shared__ __attribute__((aligned(16))) unsigned char lds_raw[];
    LAS unsigned char* lds_k = (LAS unsigned char*)lds_raw;
    volatile LAS unsigned* MISC = (volatile LAS unsigned*)(lds_k + MISC_OFF);
    const int tid = threadIdx.x, lane = tid & 63, wave = __builtin_amdgcn_readfirstlane(tid >> 6);
    const int G = gridDim.x, bx = blockIdx.x;
    GAS unsigned* ctl = (GAS unsigned*)((GAS unsigned char*)args.ws + WS_CTL);
    for (int u = tid; u < 64; u += 512) MISC[u] = 0u;
    if (tid == 0) { LAS unsigned long long* pt = (LAS unsigned long long*)(lds_k + PTR_OFF);
#pragma unroll
        for (int k = 0; k < 30; ++k) pt[k] = (unsigned long long)args.in[k];
        pt[30] = (unsigned long long)args.out; pt[31] = (unsigned long long)args.ws; }
    __syncthreads();
    (void)xcd_barrier_post(ctl + CW_BAR, MISC + 8);
#ifdef MK_RANGE
    const int lo = args.ph_lo, hi = args.ph_hi;
#else
    constexpr int lo = 0, hi = 23;
#endif
    int ph = 0;
#define IN_PH (lo <= ph && ph < hi)
#define SEAM() do { if (IN_PH && ph + 1 < hi) { if (ph == 0 || MK_ALLCG) cg::this_grid().sync(); else { LAS unsigned char* lds_s_ = lds_k; asm volatile("" : "+s"(lds_s_)); XcdBarrier b_; b_.bar = (GAS unsigned*)((GAS unsigned char*)ldsptr(lds_s_, 31) + WS_CTL) + CW_BAR; b_.x = xb_xcc_id(); b_.st = (volatile LAS unsigned*)(lds_s_ + MISC_OFF) + 8; xcd_barrier(b_, wave == 0 && lane_id() == 0); } } ++ph; } while (0)

#define PH_PTRS() LAS unsigned char* lds = lds_k; asm volatile("" : "+s"(lds)); GAS unsigned char* ws = (GAS unsigned char*)ldsptr(lds, 31); asm volatile("" : "+s"(ws)); \
    int tid_o_ = wave * 64 + lane_id(); asm volatile("" : "+v"(tid_o_)); const int tid = tid_o_, lane = tid_o_ & 63; (void)tid; (void)lane; \
    const int vcu = (G % 8 == 0) ? (bx % 8) * (G / 8) + bx / 8 : bx, gw = vcu * 8 + wave, NGW = G * 8; (void)vcu; (void)gw; (void)NGW; \
    GAS h16_t* X = (GAS h16_t*)(ws + WS_X16); GAS bf16_t* XN = (GAS bf16_t*)(ws + WS_XN); GAS float* mods = (GAS float*)(ws + WS_MODS); \
    GAS float* gsA = (GAS float*)(ws + TAB_GSA); GAS float* gsB = (GAS float*)(ws + TAB_GSB); GAS float* swA = (GAS float*)(ws + TAB_SWA); GAS float* swB = (GAS float*)(ws + TAB_SWB); \
    GAS float* rowss = (GAS float*)(ws + WS_ROWSS); GAS float* vstat = (GAS float*)(ws + WS_VSTAT); \
    GAS bf16_t* Hb = (GAS bf16_t*)(ws + WS_R); GAS bf16_t* UgS = (GAS bf16_t*)(ws + WS_R); GAS float* Sloc = (GAS float*)(ws + WS_R + 48 * MiB); GAS bf16_t* Zg = (GAS bf16_t*)(ws + WS_R + 48 * MiB); GAS bf16_t* A2 = (GAS bf16_t*)(ws + WS_R2); \
    (void)X; (void)XN; (void)mods; (void)gsA; (void)gsB; (void)swA; (void)swB; (void)rowss; (void)vstat; (void)Hb; (void)UgS; (void)Sloc; (void)Zg; (void)A2;
#define PH_LAYER() const GAS float* rs_mix = rowss + (size_t)(2 * layer) * M * 32; GAS float* rs_ffn = rowss + (size_t)(2 * layer + 1) * M * 32; GAS float* rs_next = rowss + (size_t)((2 * layer + 2) & 7) * M * 32; \
    const GAS float* modl = mods + (size_t)layer * 5 * 6144; (void)rs_mix; (void)rs_ffn; (void)rs_next; (void)modl;

#define SIDE_IDS() const int swv = (bx - 192) * 8 + wave, snw = (G - 192) * 8; LAS float* scr = (LAS float*)(lds + wave * 16384); (void)scr; (void)swv; (void)snw
    if (IN_PH) { PH_PTRS();
#ifdef MK_RANGE
        const int pm_ = args.mode;
#else
        constexpr int pm_ = 0;
#endif
        if (bx < 128) { if (pm_ != 2) ssm_build(args, 0, bx & 63, bx >> 6, lds, ws, tid); } else { if (pm_ != 3) for (int t = bx - 128; t < 192; t += 128) mods_task(args, mods, lds, t, tid); }
        __syncthreads();
        if (bx >= 128 && pm_ != 4) { LAS float* scr = (LAS float*)(lds + wave * 16384); const int wv = (bx - 128) * 8 + wave, nw = (G - 128) * 8;
            convert_items(lds, ws, scr, IT_W1, I_W1, wv, nw, lane); convert_items(lds, ws, scr, IT_W2, I_W2, wv, nw, lane);
            convert_items(lds, ws, scr, IT_SI, I_SI, wv, nw, lane); convert_items(lds, ws, scr, IT_SO, I_SO, wv, nw, lane); }
        if (pm_ != 5 && bx >= 64) for (int row = (bx - 64) * 8 + wave; row < M; row += (G - 64) * 8) xinit_row(lds, X, row, lane);
    }
    SEAM();
    if (IN_PH) { PH_PTRS();
        for (int i = gw * 64 + lane; i < 4 * 5 * 1024; i += NGW * 64) { const int l = i / 5120, ci = (i / 1024) % 5, c = i & 1023;
            const GAS float* md = mods + ((size_t)l * 5 + ci) * 6144;
            gsA[i] = inp(lds, 8)[l * 1024 + c] * (1.0f + md[1024 + c]); gsB[i] = inp(lds, 9)[l * 1024 + c] * (1.0f + md[4 * 1024 + c]); }
        sw_mix_job(ws, mods, 0, gw, NGW, lane);
        for (int row = gw; row < M; row += 3 * NGW) {
            const GAS float* gm = inp(lds, 8);
            f32x4 v[3][4];
#pragma unroll
            for (int rr = 0; rr < 3; ++rr)
#pragma unroll
                for (int q = 0; q < 4; ++q) v[rr][q] = __builtin_convertvector(((const GAS h16x4*)(X + (size_t)(row + rr * NGW) * D) + lane)[64 * q], f32x4);
#pragma unroll
            for (int rr = 0; rr < 3; ++rr) {
                const int r = row + rr * NGW, ci = cond_of_row(r); const GAS float* md = mods + ((size_t)0 * 5 + ci) * 6144;
                float t = 0.f;
#pragma unroll
                for (int q = 0; q < 4; ++q) t += (v[rr][q][0] * v[rr][q][0] + v[rr][q][1] * v[rr][q][1]) + (v[rr][q][2] * v[rr][q][2] + v[rr][q][3] * v[rr][q][3]);
                t = wave_sum(t);
                if (lane < 32) rowss[(size_t)r * 32 + lane] = lane == 0 ? t : 0.f;
                GAS u32x2* o = (GAS u32x2*)(XN + (size_t)r * D) + lane;
#pragma unroll
                for (int q = 0; q < 4; ++q) { const int c = 256 * q + 4 * lane; const f32x4 gg = *(const GAS f32x4*)(gm + c), sc = *(const GAS f32x4*)(md + 1024 + c);
                    const f32x4 y = v[rr][q] * gg * (sc + 1.0f); u32x2 w; w.x = cvt_pk_bf16(y[0], y[1]); w.y = cvt_pk_bf16(y[2], y[3]); o[64 * q] = w; }
            }
        }
    }
    SEAM();
#pragma unroll 1
    for (int layer = 0; layer < 4; ++layer) {
        const int kind = layer % 3, j = layer / 3;
        if (kind == 0) {
            if (IN_PH) { PH_PTRS(); PH_LAYER(); Gemm g = gemm_rowmajor(XN, D, (const GAS bf16_t*)(ws + WS_SWIN) + (size_t)j * D * D, D, D); GMODE(g); StaticOrder S; S.init(M, D, G, bx);
                fill_tables_in(lds, S, rs_mix, swA + layer * 5 * 4096, 1024, tid); EpiU E{UgS}; gemm_phase<EpiU, ARowMajor, StaticOrder>(lds, g, S, E, wave);
                if (bx >= 192) { SIDE_IDS(); sw_ffn_job(ws, mods, layer, swv, snw, lane); if (layer == 0) convert_items(lds, ws, scr, IT_GI, I_GI, swv, snw, lane); } }
            SEAM();
            if (IN_PH) { PH_PTRS(); PH_LAYER(); SsmOrder S{G, bx};
                { Gemm g = gemm_rowmajor(UgS, 512, (const GAS bf16_t*)(ws + WS_BTS) + (size_t)j * 64 * 256 * 256, 256, 256); GMODE(g);
                  EpiScan E{UgS, (const GAS float*)(ws + TAB_LAMT), inp(lds, 2), inp(lds, 3), (GAS float*)ldsptr(lds, 30) + (size_t)M * D, (GAS float*)ldsptr(lds, 30) + (size_t)M * D + 32 * 2 * 2 * 64 * 64, j};
                  gemm_phase<EpiScan, ARowMajor, SsmOrder>(lds, g, S, E, wave); }
                asm volatile("s_waitcnt vmcnt(0)" ::: "memory"); __syncthreads(); __builtin_amdgcn_fence(__ATOMIC_ACQUIRE, "agent"); asm volatile("s_waitcnt vmcnt(0)" ::: "memory"); __syncthreads();
                { Gemm g = gemm_rowmajor(UgS, 512, (const GAS bf16_t*)(ws + WS_BTY) + (size_t)j * 64 * 256 * 512, 512, 512); GMODE(g);
                  EpiY E{Zg}; gemm_phase<EpiY, ARowMajor, SsmOrder>(lds, g, S, E, wave); }
                if (layer == 0 && bx >= 192) { SIDE_IDS(); convert_items(lds, ws, scr, IT_GO, I_GO + I_CI + I_CO, swv, snw, lane);
                    const GAS float* s_ = inp(lds, 23); GAS bf16_t* d_ = (GAS bf16_t*)(ws + WS_GWS);
                    for (int i = (swv * 64 + lane) * 8; i < 16 * 128 * 128; i += snw * 64 * 8) { const f32x4 a0 = *(const GAS f32x4*)(s_ + i), a1 = *(const GAS f32x4*)(s_ + i + 4);
                        u32x4 o; o.x = pk2(a0[0], a0[1]); o.y = pk2(a0[2], a0[3]); o.z = pk2(a1[0], a1[1]); o.w = pk2(a1[2], a1[3]); *(GAS u32x4*)(d_ + i) = o; } } }
            SEAM();
            if (IN_PH) { PH_PTRS(); PH_LAYER(); Gemm g = gemm_groupchunk(Zg, (const GAS bf16_t*)(ws + WS_SWOUT) + (size_t)j * D * 2048, D, D); GMODE(g); StaticOrder S; S.init(M, 2048, G, bx);
                fill_tables_res<128>(lds, S, modl + 2 * 1024, gsB + layer * 5 * 1024, tid); EpiRes<true> E{X, XN, rs_ffn, true}; gemm_phase<EpiRes<true>, AGroupChunk, StaticOrder>(lds, g, S, E, wave); }
            SEAM();
        } else if (kind == 1) {
            if (IN_PH) { PH_PTRS(); PH_LAYER(); Gemm g = gemm_rowmajor(XN, D, (const GAS bf16_t*)(ws + WS_GWIN), D, D); GMODE(g); StaticOrder S; S.init(M, 4096, G, bx);
                fill_tables_in(lds, S, rs_mix, swA + layer * 5 * 4096, 4096, tid); EpiIn<2, 4096> E{Hb, vstat}; gemm_phase<EpiIn<2, 4096>, ARowMajor, StaticOrder>(lds, g, S, E, wave); }
            SEAM();
            if (IN_PH) { PH_PTRS(); PH_LAYER();
                const GAS bf16_t* Wsb = (const GAS bf16_t*)(ws + WS_GWS); const GAS float* b_s = inp(lds, 24);
                constexpr int VST = 288;
                for (int unit = vcu; unit < 96 * 16; unit += G) {
                    const int c = unit >> 4, g = unit & 15, row0 = c * 128;
                    __syncthreads();
                    LAS f32x2* mr = (LAS f32x2*)(lds + 128 * VST);
                    if (tid < 128) { const GAS f32x4* p = (const GAS f32x4*)(vstat + (size_t)(row0 + tid) * 128); float s1 = 0.f, s2 = 0.f;
#pragma unroll
                        for (int q = 0; q < 32; ++q) { const f32x4 v = p[q]; s1 += v[0] + v[2]; s2 += v[1] + v[3]; }
                        const float mu = s1 * (1.0f / 2048.0f), var = s2 * (1.0f / 2048.0f) - mu * mu; mr[tid] = (f32x2){mu, rsq_f(fmaxf(var, 0.f) + EPS)}; }
                    __syncthreads();
#pragma unroll
                    for (int i = 0; i < 4; ++i) { const int pc = tid + 512 * i, q = pc >> 4, d8 = pc & 15;
                        const u32x4 w = *(const GAS u32x4*)(Hb + (size_t)(row0 + q) * 4096 + 2048 + g * 128 + d8 * 8);
                        const f32x2 st = mr[q]; const float mu = st[0], rstd = st[1];
                        u32x4 o; o.x = cvt_pk_bf16((bf_lo(w.x) - mu) * rstd, (bf_hi(w.x) - mu) * rstd); o.y = cvt_pk_bf16((bf_lo(w.y) - mu) * rstd, (bf_hi(w.y) - mu) * rstd);
                        o.z = cvt_pk_bf16((bf_lo(w.z) - mu) * rstd, (bf_hi(w.z) - mu) * rstd); o.w = cvt_pk_bf16((bf_lo(w.w) - mu) * rstd, (bf_hi(w.w) - mu) * rstd);
                        *(LAS u32x4*)(lds + q * VST + d8 * 16) = o; }
                    __syncthreads();
                    f32x4 acc[8];
#pragma unroll
                    for (int nt = 0; nt < 8; ++nt) acc[nt] = (f32x4){0.f, 0.f, 0.f, 0.f};
                    const int fr = lane & 15, fq = lane >> 4;
#pragma unroll
                    for (int kk = 0; kk < 4; ++kk) {
                        const bf16x8 wf = *(const GAS bf16x8*)(Wsb + ((size_t)g * 128 + wave * 16 + fr) * 128 + kk * 32 + fq * 8);
#pragma unroll
                        for (int nt = 0; nt < 8; ++nt) {
                            const LAS unsigned char* p0 = lds + (kk * 32 + fq * 8 + (fr >> 2)) * VST + (nt * 16 + 4 * (fr & 3)) * 2;
                            const s16x4 lo4 = __builtin_bit_cast(s16x4, __builtin_amdgcn_ds_read_tr16_b64_v4i16((LAS s16x4*)p0));
                            const s16x4 hi4 = __builtin_bit_cast(s16x4, __builtin_amdgcn_ds_read_tr16_b64_v4i16((LAS s16x4*)(p0 + 4 * VST)));
                            const bf16x8 vf = {lo4[0], lo4[1], lo4[2], lo4[3], hi4[0], hi4[1], hi4[2], hi4[3]};
                            acc[nt] = __builtin_amdgcn_mfma_f32_16x16x32_bf16(vf, wf, acc[nt], 0, 0, 0);
                        }
                    }
                    const int p = wave * 16 + fr, row = row0 + p; const float bs = b_s[g * 128 + p];
#pragma unroll
                    for (int nt = 0; nt < 8; ++nt) { const int ch = g * 128 + nt * 16 + 4 * fq;
                        const u32x2 uu = *(const GAS u32x2*)(Hb + (size_t)row * 4096 + ch);
                        u32x2 o; o.x = cvt_pk_bf16(bf_lo(uu.x) * (acc[nt][0] + bs), bf_hi(uu.x) * (acc[nt][1] + bs)); o.y = cvt_pk_bf16(bf_lo(uu.y) * (acc[nt][2] + bs), bf_hi(uu.y) * (acc[nt][3] + bs));
                        *(GAS u32x2*)(A2 + (size_t)row * 2048 + ch) = o; }
                }
                __syncthreads();
            }
            SEAM();
            if (IN_PH) { PH_PTRS(); PH_LAYER(); Gemm g = gemm_rowmajor(A2, 2048, (const GAS bf16_t*)(ws + WS_GWOUT), 2048, 2048); GMODE(g); StaticOrder S; S.init(M, D, G, bx);
                fill_tables_res<256>(lds, S, modl + 2 * 1024, gsB + layer * 5 * 1024, tid); EpiRes<false> E{X, XN, rs_ffn, true}; gemm_phase<EpiRes<false>, ARowMajor, StaticOrder>(lds, g, S, E, wave);
                if (bx >= 192) { SIDE_IDS(); sw_ffn_job(ws, mods, 1, swv, snw, lane); convert_items(lds, ws, scr, IT_W1 + 2 * I_W1, I_W1, swv, snw, lane); ssm_build(args, 1, bx - 192, 1, lds, ws, tid); } }
            SEAM();
        } else {
            if (IN_PH) { PH_PTRS(); PH_LAYER(); Gemm g = gemm_rowmajor(XN, D, (const GAS bf16_t*)(ws + WS_CWIN), D, D); GMODE(g); StaticOrder S; S.init(M, 3072, G, bx);
                fill_tables_in(lds, S, rs_mix, swA + layer * 5 * 4096, 3072, tid); EpiIn<0, 3072> E{Hb, nullptr}; gemm_phase<EpiIn<0, 3072>, ARowMajor, StaticOrder>(lds, g, S, E, wave); }
            SEAM();
            if (IN_PH) { PH_PTRS(); PH_LAYER();
                const GAS float* cw = inp(lds, 27);
                for (int it = gw * 64 + lane; it < M * 128; it += NGW * 64) {
                    const int row = it >> 7, c8 = (it & 127) * 8;
                    const int L = row < MP ? 256 : 1024, t = row < MP ? (row & 255) : ((row - MP) & 1023);
                    const GAS bf16_t* pr = Hb + (size_t)row * 3072 + c8;
                    float y[8];
#pragma unroll
                    for (int q = 0; q < 8; ++q) y[q] = 0.f;
#pragma unroll
                    for (int w = 0; w < 3; ++w) { const int tt = t + w - 1; if (tt < 0 || tt >= L) continue;
                        const u32x4 gc = *(const GAS u32x4*)(pr + (ptrdiff_t)(w - 1) * 3072 + 1024), xh = *(const GAS u32x4*)(pr + (ptrdiff_t)(w - 1) * 3072 + 2048);
                        const f32x4 k0 = *(const GAS f32x4*)(cw + w * 1024 + c8), k1 = *(const GAS f32x4*)(cw + w * 1024 + c8 + 4);
                        y[0] += k0[0] * bf_lo(gc.x) * bf_lo(xh.x); y[1] += k0[1] * bf_hi(gc.x) * bf_hi(xh.x); y[2] += k0[2] * bf_lo(gc.y) * bf_lo(xh.y); y[3] += k0[3] * bf_hi(gc.y) * bf_hi(xh.y);
                        y[4] += k1[0] * bf_lo(gc.z) * bf_lo(xh.z); y[5] += k1[1] * bf_hi(gc.z) * bf_hi(xh.z); y[6] += k1[2] * bf_lo(gc.w) * bf_lo(xh.w); y[7] += k1[3] * bf_hi(gc.w) * bf_hi(xh.w); }
                    const u32x4 gb = *(const GAS u32x4*)pr;
                    u32x4 o; o.x = cvt_pk_bf16(bf_lo(gb.x) * y[0], bf_hi(gb.x) * y[1]); o.y = cvt_pk_bf16(bf_lo(gb.y) * y[2], bf_hi(gb.y) * y[3]);
                    o.z = cvt_pk_bf16(bf_lo(gb.z) * y[4], bf_hi(gb.z) * y[5]); o.w = cvt_pk_bf16(bf_lo(gb.w) * y[6], bf_hi(gb.w) * y[7]);
                    *(GAS u32x4*)(A2 + (size_t)row * D + c8) = o;
                }
            }
            SEAM();
            if (IN_PH) { PH_PTRS(); PH_LAYER(); Gemm g = gemm_rowmajor(A2, D, (const GAS bf16_t*)(ws + WS_CWOUT), D, D); GMODE(g); StaticOrder S; S.init(M, D, G, bx);
                fill_tables_res<256>(lds, S, modl + 2 * 1024, gsB + layer * 5 * 1024, tid); EpiRes<false> E{X, XN, rs_ffn, true}; gemm_phase<EpiRes<false>, ARowMajor, StaticOrder>(lds, g, S, E, wave); }
            SEAM();
        }
        if (IN_PH) { PH_PTRS(); PH_LAYER(); Gemm g = gemm_rowmajor(XN, D, (const GAS bf16_t*)(ws + WS_W1) + (size_t)layer * D * FF, D, D); GMODE(g); StaticOrder S; S.init(M, FF, G, bx);
            fill_tables_in(lds, S, rs_ffn, swB + layer * 5 * 4096, 4096, tid); EpiIn<1, 4096> E{Hb, nullptr}; gemm_phase<EpiIn<1, 4096>, ARowMajor, StaticOrder>(lds, g, S, E, wave); }
        SEAM();
        if (IN_PH) { PH_PTRS(); PH_LAYER(); Gemm g = gemm_rowmajor(Hb, FF, (const GAS bf16_t*)(ws + WS_W2) + (size_t)layer * D * FF, FF, FF); GMODE(g); StaticOrder S; S.init(M, D, G, bx);
            fill_tables_res<256>(lds, S, modl + 5 * 1024, layer < 3 ? gsA + (layer + 1) * 5 * 1024 : (const GAS float*)nullptr, tid); EpiRes<false> E{X, XN, rs_next, layer < 3}; gemm_phase<EpiRes<false>, ARowMajor, StaticOrder>(lds, g, S, E, wave);
            if (layer < 3 && bx >= 192) { SIDE_IDS();
                if (layer == 0) { convert_items(lds, ws, scr, IT_W1 + 1 * I_W1, I_W1, swv, snw, lane); convert_items(lds, ws, scr, IT_W2 + 1 * I_W2, I_W2, swv, snw, lane); sw_mix_job(ws, mods, 1, swv, snw, lane); }
                else if (layer == 1) { convert_items(lds, ws, scr, IT_W2 + 2 * I_W2, I_W2, swv, snw, lane); convert_items(lds, ws, scr, IT_SI + I_SI, I_SI, swv, snw, lane); convert_items(lds, ws, scr, IT_SO + I_SO, I_SO, swv, snw, lane);
                    sw_mix_job(ws, mods, 2, swv, snw, lane); sw_ffn_job(ws, mods, 2, swv, snw, lane); }
                else { ssm_build(args, 1, bx - 192, 0, lds, ws, tid);
                    convert_items(lds, ws, scr, IT_W1 + 3 * I_W1, I_W1, swv, snw, lane); convert_items(lds, ws, scr, IT_W2 + 3 * I_W2, I_W2, swv, snw, lane); sw_mix_job(ws, mods, 3, swv, snw, lane); } } }
        SEAM();
    }
    if (IN_PH) { PH_PTRS();
        const GAS float* gf = inp(lds, 29);
        GAS float* Y = (GAS float*)ldsptr(lds, 30);
        for (int row = gw; row < M; row += 3 * NGW) {
            f32x4 v[3][4];
#pragma unroll
            for (int rr = 0; rr < 3; ++rr)
#pragma unroll
                for (int q = 0; q < 4; ++q) v[rr][q] = __builtin_convertvector(((const GAS h16x4*)(X + (size_t)(row + rr * NGW) * D) + lane)[64 * q], f32x4);
            f32x4 gq[4];
#pragma unroll
            for (int q = 0; q < 4; ++q) gq[q] = *(const GAS f32x4*)(gf + 256 * q + 4 * lane);
#pragma unroll
            for (int rr = 0; rr < 3; ++rr) { float t = 0.f;
#pragma unroll
                for (int q = 0; q < 4; ++q) t += (v[rr][q][0] * v[rr][q][0] + v[rr][q][1] * v[rr][q][1]) + (v[rr][q][2] * v[rr][q][2] + v[rr][q][3] * v[rr][q][3]);
                t = wave_sum(t); const float r0 = rsq_f(t * (1.0f / D) + EPS);
                GAS f32x4* yr = (GAS f32x4*)(Y + (size_t)(row + rr * NGW) * D) + lane;
#pragma unroll
                for (int q = 0; q < 4; ++q) yr[64 * q] = v[rr][q] * r0 * gq[q]; }
        }
    }
    ++ph;
#undef IN_PH
#undef SEAM
}

static bool launch(void* const* d_in, float* out, unsigned char* ws, int lo, int hi, hipStream_t stream, int mode = 0) {
    static int grid = 0;
    if (grid == 0) {
        int dev = 0, cus = 0, per_cu = 0;
        if (hipGetDevice(&dev) != hipSuccess || hipDeviceGetAttribute(&cus, hipDeviceAttributeMultiprocessorCount, dev) != hipSuccess) { grid = -1; return false; }
        if (hipFuncSetAttribute((const void*)fwd, hipFuncAttributeMaxDynamicSharedMemorySize, LDS_BYTES) != hipSuccess) { fprintf(stderr, "hipFuncSetAttribute failed\n"); grid = -1; return false; }
        if (hipOccupancyMaxActiveBlocksPerMultiprocessor(&per_cu, (const void*)fwd, 512, LDS_BYTES) != hipSuccess || per_cu < 1) { fprintf(stderr, "occupancy query: %d\n", per_cu); (void)hipGetLastError(); per_cu = 1; }
        grid = cus;
    }
    if (grid < 0) return false;
    Args a{};
    for (int i = 0; i < 30; ++i) a.in[i] = (const float*)d_in[i];
    a.out = out; a.ws = ws; a.ph_lo = lo; a.ph_hi = hi; a.mode = mode;
    void* kargs[] = {&a};
    const hipError_t e = hipLaunchCooperativeKernel((const void*)fwd, dim3(grid), dim3(512), kargs, LDS_BYTES, stream);
    if (e != hipSuccess) { fprintf(stderr, "cooperative launch failed: %s (grid %d)\n", hipGetErrorString(e), grid); return false; }
    return true;
}
}
extern "C" void kernel_launch(void* const* d_in, const int* in_sizes, int n_in, void* d_out, int out_size, void* d_ws, size_t ws_size, hipStream_t stream) {
    if (n_in != 30 || ws_size < mk::WS_END) { fprintf(stderr, "kernel_launch: unexpected n_in %d / ws %zu\n", n_in, ws_size); return; }
    (void)hipMemsetAsync((char*)d_ws + mk::WS_CTL, 0, mk::CTL_BYTES, stream);
    mk::launch(d_in, (float*)d_out, (unsigned char*)d_ws, 0, 23, stream);
}
```

```cpp
#include <hip/hip_runtime.h>
#include <cstdio>
#include <cstdint>
#include <hip/hip_cooperative_groups.h>
namespace mk {
namespace cg = cooperative_groups;
#define LAS __attribute__((address_space(3)))
#define GAS __attribute__((address_space(1)))
typedef unsigned short bf16_t;
typedef short bf16x8 __attribute__((ext_vector_type(8)));
typedef short s16x4 __attribute__((ext_vector_type(4)));
typedef float f32x4 __attribute__((ext_vector_type(4)));
typedef float f32x2 __attribute__((ext_vector_type(2)));
typedef unsigned u32x4 __attribute__((ext_vector_type(4)));
typedef unsigned u32x2 __attribute__((ext_vector_type(2)));
typedef _Float16 h16_t;
typedef _Float16 h16x4 __attribute__((ext_vector_type(4)));
typedef _Float16 h16x8 __attribute__((ext_vector_type(8)));
typedef float f32x8 __attribute__((ext_vector_type(8)));

constexpr int D = 1024, M = 12288, MP = 8192, FF = 4096, NCH = 768;
constexpr float EPS = 1e-6f;
constexpr int BM = 256, BK = 64, HALF = 128, HTB = HALF * BK * 2, STAGE_BYTES = 8 * HTB, NXCD = 8, WGM = 8;

typedef __bf16 bf16x2_t __attribute__((ext_vector_type(2)));
__device__ __forceinline__ unsigned cvt_pk_bf16(float lo, float hi) { const f32x2 v = {lo, hi}; const bf16x2_t b = __builtin_convertvector(v, bf16x2_t); return __builtin_bit_cast(unsigned, b); }
__device__ __forceinline__ unsigned f2bf(float f) { unsigned u = __builtin_bit_cast(unsigned, f); return (u + 0x7fffu + ((u >> 16) & 1u)) >> 16; }
__device__ __forceinline__ float bf_lo(unsigned w) { return __uint_as_float(w << 16); }
__device__ __forceinline__ float bf_hi(unsigned w) { return __uint_as_float(w & 0xffff0000u); }
__device__ __forceinline__ float rcp_f(float x) { return __builtin_amdgcn_rcpf(x); }
__device__ __forceinline__ float rsq_f(float x) { return __builtin_amdgcn_rsqf(x); }
__device__ __forceinline__ float gelu_tanh(float x) {
    const float t = x * x * (0.044715f * -2.0f * 0.7978845608028654f * 1.4426950408889634f) + (-2.0f * 0.7978845608028654f * 1.4426950408889634f);
    return x * rcp_f(1.0f + __builtin_amdgcn_exp2f(x * t));
}
__device__ __forceinline__ float sigmoid_f(float x) { return rcp_f(1.0f + __builtin_amdgcn_exp2f(x * -1.4426950408889634f)); }
__device__ __forceinline__ int lane_id() { int r; asm volatile("v_mbcnt_lo_u32_b32 %0, -1, 0\n\tv_mbcnt_hi_u32_b32 %0, -1, %0" : "=v"(r)); return r; }
__device__ __forceinline__ int cond_of_pm(int pm) { return pm < 32 ? 0 : 1 + ((pm - 32) >> 2); }
__device__ __forceinline__ int cond_of_row(int row) { return row < MP ? 0 : 1 + ((row - MP) >> 10); }

__host__ __device__ __forceinline__ int lds_byte(int r, int c) { const int st = (r >> 4) * 2 + (c >> 5), rr = r & 15, cc = c & 31, ob = rr * 64 + cc * 2; return st * 1024 + (ob ^ (((ob >> 9) & 1) << 5)); }
__host__ __device__ __forceinline__ void stage_rc(int b, int& R, int& C) { const int st = b / 1024, sb = b % 1024, swz = sb ^ (((sb >> 9) & 1) << 5); R = (st >> 1) * 16 + swz / 64; C = (st & 1) * 32 + (swz % 64) / 2; }
__host__ __device__ __forceinline__ int perm32(int rho) { const int n = rho >> 4, i = rho & 15; return 8 * (i >> 2) + 4 * n + (i & 3); }

struct Unit { int pm, pn; };
struct Gemm { const GAS char* A; const GAS char* Bt; int K; int lda; int ldb; size_t kstepA, hstepA, tstepA; int mode; };
struct ARowMajor { static __device__ __forceinline__ unsigned voff(int R, int C, int lda) { return (unsigned)(R * lda + C) * 2u; } };
struct AGroupChunk { static __device__ __forceinline__ unsigned voff(int R, int C, int) { return (unsigned)((((C >> 4) * NCH + (R >> 4)) * 256) + (R & 15) * 16 + (C & 15)) * 2u; } };
__device__ inline Gemm gemm_rowmajor(const GAS void* A, int lda, const GAS void* Bt, int ldb, int K) {
    Gemm g; g.A = (const GAS char*)A; g.Bt = (const GAS char*)Bt; g.K = K; g.lda = lda; g.ldb = ldb; g.kstepA = BK * 2; g.hstepA = (size_t)HALF * lda * 2; g.tstepA = 2 * g.hstepA; g.mode = 0; return g; }
__device__ inline Gemm gemm_groupchunk(const GAS void* A, const GAS void* Bt, int ldb, int K) {
    Gemm g; g.A = (const GAS char*)A; g.Bt = (const GAS char*)Bt; g.K = K; g.lda = 0; g.ldb = ldb; g.kstepA = (size_t)4 * NCH * 256 * 2; g.hstepA = 8 * 256 * 2; g.tstepA = 16 * 256 * 2; g.mode = 0; return g; }

struct StaticOrder {
    int nM, nN, nwg, G, c;
    __host__ __device__ void init(int M_, int N_, int G_, int c_) { nM = M_ / BM; nN = N_ / BM; nwg = nM * nN; G = G_; c = c_; }
    __host__ __device__ bool next(int i, Unit& u) const {
        const long L = (long)i * G + c; if (L >= nwg) return false;
        int wgid = (int)L; { const int q = nwg / NXCD, r = nwg % NXCD, xcd = wgid % NXCD, off = wgid / NXCD; wgid = (xcd < r ? xcd * (q + 1) : r * (q + 1) + (xcd - r) * q) + off; }
        const int nig = WGM * nN, gid = wgid / nig, fm = gid * WGM, gsz = (nM - fm) < WGM ? (nM - fm) : WGM;
        u.pm = fm + ((wgid % nig) % gsz); u.pn = (wgid % nig) / gsz; return true;
    }
};
struct SsmOrder {
    int G, c;
    __host__ __device__ bool next(int i, Unit& u) const { const int L = i * G + c; if (L >= 192) return false; u.pm = L; u.pn = L / 3; return true; }
};

template <class Epi, class AL, class Sched>
__device__ __forceinline__ void gemm_phase(LAS unsigned char* lds, const Gemm g, const Sched& S, const Epi& E, int wave_) {
    int tid = wave_ * 64 + lane_id(); asm volatile("" : "+v"(tid));
    const int wid = __builtin_amdgcn_readfirstlane(tid >> 6), lane = tid & 63, wr = wid >> 2, wc = wid & 3, fr = lane & 15, fq = lane >> 4;
    const int K = g.K, nt = K / BK;
    unsigned voffA[2], voffB[2];
#pragma unroll
    for (int i = 0; i < 2; ++i) { int R, C; stage_rc(tid * 16 + i * 8192, R, C); const int Rb = Epi::PERM ? ((R & ~31) + perm32(R & 31)) : R;
        voffA[i] = AL::voff(R, C, g.lda); voffB[i] = (unsigned)(Rb * g.ldb + C) * 2u; }
    const size_t kstepA = g.kstepA, hstepA = g.hstepA, tstepA = g.tstepA;
    const size_t kstepB = (size_t)(BK * 2), hstepB = (size_t)HALF * g.ldb * 2, tstepB = 2 * hstepB;
    const unsigned ldsw = (unsigned)wid * 1024u;
    const int aoff = lds_byte(wr * 64 + fr, fq * 8), boff = lds_byte(wc * 32 + fr, fq * 8);
#define PG8_SA(b, h) (((b) * 2 + (h)) * HTB)
#define PG8_SB(b, h) ((4 + (b) * 2 + (h)) * HTB)
#define PG8_STAGE(bufoff, gbase, voff) do { _Pragma("unroll") for (int _i = 0; _i < 2; ++_i) \
        __builtin_amdgcn_global_load_lds((const GAS unsigned*)((const GAS char*)(gbase) + (voff)[_i]), (LAS unsigned*)(lds + (bufoff) + ldsw + _i * 8192), 16, 0, 0); } while (0)
#define PG8_LDA(dst, b, h) do { _Pragma("unroll") for (int m = 0; m < 4; ++m) _Pragma("unroll") for (int k = 0; k < 2; ++k) dst[m][k] = *(const LAS bf16x8*)(lds + PG8_SA(b, h) + aoff + m * 2048 + k * 1024); } while (0)
#define PG8_LDB(dst, b, h) do { _Pragma("unroll") for (int n = 0; n < 2; ++n) _Pragma("unroll") for (int k = 0; k < 2; ++k) dst[n][k] = *(const LAS bf16x8*)(lds + PG8_SB(b, h) + boff + n * 2048 + k * 1024); } while (0)
#define PG8_MMA(ai, bj, At, Bt) do { __builtin_amdgcn_s_setprio(1); _Pragma("unroll") for (int m = 0; m < 4; ++m) _Pragma("unroll") for (int n = 0; n < 2; ++n) _Pragma("unroll") for (int k = 0; k < 2; ++k) \
        acc[ai][bj][m][n] = __builtin_amdgcn_mfma_f32_16x16x32_bf16(Bt[n][k], At[m][k], acc[ai][bj][m][n], 0, 0, 0); __builtin_amdgcn_s_setprio(0); } while (0)
#define PG8_WAIT_V(n) asm volatile("s_waitcnt vmcnt(" #n ")" ::: "memory")
#define PG8_WAIT_L(n) asm volatile("s_waitcnt lgkmcnt(" #n ")" ::: "memory")
#define PG8_BAR __builtin_amdgcn_s_barrier()
#define PG8_SCHED __builtin_amdgcn_sched_barrier(0)
    Unit cur, nxt; int ui = 0;
    if (!S.next(0, cur)) return;
    f32x4 acc[2][2][4][2];
#pragma unroll
    for (int a = 0; a < 2; ++a)
#pragma unroll
        for (int b = 0; b < 2; ++b)
#pragma unroll
            for (int m = 0; m < 4; ++m)
#pragma unroll
                for (int n = 0; n < 2; ++n) acc[a][b][m][n] = (f32x4){0.f, 0.f, 0.f, 0.f};
    bf16x8 At[4][2], B0[2][2], B1[2][2];
    const GAS char* cA = g.A + (size_t)cur.pm * tstepA; const GAS char* cB = g.Bt + (size_t)cur.pn * tstepB;
    PG8_STAGE(PG8_SB(0, 0), cB, voffB); PG8_STAGE(PG8_SB(0, 1), cB + hstepB, voffB); PG8_STAGE(PG8_SA(0, 0), cA, voffA); PG8_STAGE(PG8_SA(0, 1), cA + hstepA, voffA);
    if (wr == 1) PG8_BAR;
    PG8_WAIT_V(2); PG8_BAR;
    PG8_STAGE(PG8_SB(1, 0), cB + kstepB, voffB); PG8_STAGE(PG8_SA(1, 0), cA + kstepA, voffA); PG8_STAGE(PG8_SB(1, 1), cB + hstepB + kstepB, voffB);
    PG8_WAIT_V(6); PG8_BAR;
    for (;;) {
        const bool has_next = S.next(ui + 1, nxt);
        const GAS char* nA = has_next ? g.A + (size_t)nxt.pm * tstepA : cA; const GAS char* nB = has_next ? g.Bt + (size_t)nxt.pn * tstepB : cB;
        for (int t = 0; t < nt; t += 2) {
            const bool last = (t == nt - 2);
            const GAS char* a1 = cA + (size_t)(t + 1) * kstepA;
            const GAS char* a2 = last ? nA : cA + (size_t)(t + 2) * kstepA; const GAS char* b2 = last ? nB : cB + (size_t)(t + 2) * kstepB;
            const GAS char* a3 = a2 + kstepA; const GAS char* b3 = b2 + kstepB;
            PG8_LDB(B0, 0, 0); PG8_LDB(B1, 0, 1); PG8_SCHED; PG8_LDA(At, 0, 0); PG8_STAGE(PG8_SA(1, 1), a1 + hstepA, voffA);
            PG8_WAIT_V(8); PG8_WAIT_L(0); PG8_BAR; PG8_MMA(0, 0, At, B0); PG8_MMA(0, 1, At, B1); PG8_BAR; PG8_SCHED;
            PG8_LDA(At, 0, 1); PG8_STAGE(PG8_SB(0, 0), b2, voffB); PG8_STAGE(PG8_SB(0, 1), b2 + hstepB, voffB); PG8_STAGE(PG8_SA(0, 0), a2, voffA);
            PG8_WAIT_V(8); PG8_WAIT_L(0); PG8_BAR; PG8_MMA(1, 0, At, B0); PG8_MMA(1, 1, At, B1); PG8_BAR; PG8_SCHED;
            PG8_LDB(B0, 1, 0); PG8_LDB(B1, 1, 1); PG8_SCHED; PG8_LDA(At, 1, 0); PG8_STAGE(PG8_SA(0, 1), a2 + hstepA, voffA);
            PG8_WAIT_V(8); PG8_WAIT_L(0); PG8_BAR; PG8_MMA(0, 0, At, B0); PG8_MMA(0, 1, At, B1); PG8_BAR; PG8_SCHED;
            PG8_LDA(At, 1, 1); PG8_STAGE(PG8_SB(1, 0), b3, voffB); PG8_STAGE(PG8_SB(1, 1), b3 + hstepB, voffB); PG8_STAGE(PG8_SA(1, 0), a3, voffA);
            PG8_WAIT_V(8); PG8_WAIT_L(0); PG8_BAR; PG8_MMA(1, 0, At, B0); PG8_MMA(1, 1, At, B1); PG8_BAR; PG8_SCHED;
        }
        if (wr == 0) PG8_BAR;
        int el_ = lane_id(); asm volatile("" : "+v"(el_));
        const int efr = el_ & 15, efq = el_ >> 4;
#ifdef MK_RANGE
        if constexpr (!Epi::AFTER_DRAIN) { if (g.mode != 1) E(acc, cur, ui, lds, wr, wc, efr, efq); else { asm volatile("" :: "v"(acc[0][0][0][0]), "v"(acc[1][1][3][1])); } }
#else
        if constexpr (!Epi::AFTER_DRAIN) E(acc, cur, ui, lds, wr, wc, efr, efq);
#endif
        if (!has_next) break;
#pragma unroll
        for (int a = 0; a < 2; ++a)
#pragma unroll
            for (int b = 0; b < 2; ++b)
#pragma unroll
                for (int m = 0; m < 4; ++m)
#pragma unroll
                    for (int n = 0; n < 2; ++n) acc[a][b][m][n] = (f32x4){0.f, 0.f, 0.f, 0.f};
        cur = nxt; cA = nA; cB = nB; ++ui;
        if (wr == 1) PG8_BAR;
    }
    PG8_WAIT_V(0);
    PG8_BAR;
    if constexpr (Epi::AFTER_DRAIN) E.fused(acc, cur, wr, wc, fr, fq, lds, tid);
#undef PG8_SA
#undef PG8_SB
#undef PG8_STAGE
#undef PG8_LDA
#undef PG8_LDB
#undef PG8_MMA
#undef PG8_WAIT_V
#undef PG8_WAIT_L
#undef PG8_BAR
#undef PG8_SCHED
}

typedef const f32x4 (&AccRef)[2][2][4][2];

constexpr int PTR_OFF = STAGE_BYTES + 256 + 10240;
__device__ __forceinline__ unsigned long long ldsptr(const LAS unsigned char* lds, int k) { const unsigned long long v = ((const LAS unsigned long long*)(lds + PTR_OFF))[k];
    return ((unsigned long long)(unsigned)__builtin_amdgcn_readfirstlane((int)(unsigned)(v >> 32)) << 32) | (unsigned)__builtin_amdgcn_readfirstlane((int)(unsigned)v); }
__device__ __forceinline__ const GAS float* inp(const LAS unsigned char* lds, int k) { return (const GAS float*)ldsptr(lds, k); }
constexpr int TAB_OFF = STAGE_BYTES + 256, T_RS = TAB_OFF, T_SW = T_RS + 3072, T_GATE = T_SW + 3072, T_GSN = T_GATE + 2048;
template <class Sched> __device__ __forceinline__ void fill_tables_in(LAS unsigned char* lds, const Sched& S, const GAS float* rowss, const GAS float* sw, int swld, int tid) {
    LAS float* trs = (LAS float*)(lds + T_RS); LAS float* tsw = (LAS float*)(lds + T_SW);
#pragma unroll 1
    for (int i = 0; i < 3; ++i) { Unit u; if (!S.next(i, u)) break;
        if (tid < 256) { const GAS f32x4* p = (const GAS f32x4*)(rowss + (size_t)(u.pm * BM + tid) * 32);
            const f32x4 a = ((p[0] + p[1]) + (p[2] + p[3])) + ((p[4] + p[5]) + (p[6] + p[7]));
            trs[i * 256 + tid] = rsq_f(((a[0] + a[1]) + (a[2] + a[3])) * (1.0f / D) + EPS); }
        else tsw[i * 256 + tid - 256] = sw[(unsigned)(cond_of_pm(u.pm) * swld + u.pn * BM + tid - 256)];
    }
    __syncthreads();
}
template <int NCOL, class Sched> __device__ __forceinline__ void fill_tables_res(LAS unsigned char* lds, const Sched& S, const GAS float* gate, const GAS float* gsn, int tid) {
    LAS float* tg = (LAS float*)(lds + T_GATE); LAS float* tn = (LAS float*)(lds + T_GSN);
#pragma unroll 1
    for (int i = 0; i < 2; ++i) { Unit u; if (!S.next(i, u)) break; const int ci = cond_of_pm(u.pm);
        if (tid < NCOL) tg[i * 256 + tid] = gate[(unsigned)(ci * 6144 + u.pn * NCOL + tid)];
        else if (tid >= 256 && tid < 256 + NCOL) tn[i * 256 + tid - 256] = gsn ? gsn[(unsigned)(ci * 1024 + u.pn * NCOL + tid - 256)] : 0.f;
    }
    __syncthreads();
}
__device__ __forceinline__ void load_rstd(const LAS unsigned char* lds, int ui, int wr, int fr, float (&rs)[2][4]) {
    const LAS float* trs = (const LAS float*)(lds + T_RS) + ui * 256 + wr * 64 + fr;
#pragma unroll
    for (int ai = 0; ai < 2; ++ai)
#pragma unroll
        for (int m = 0; m < 4; ++m) rs[ai][m] = trs[ai * HALF + m * 16];
}

template <int ACT, int LDC> struct EpiIn {
    static constexpr bool PERM = true, AFTER_DRAIN = false;
    GAS bf16_t* O; GAS float* vstat;
    __device__ __forceinline__ void operator()(AccRef acc, const Unit& u, int ui, const LAS unsigned char* lds, int wr, int wc, int fr, int fq) const {
        const int row0 = u.pm * BM + wr * 64 + fr, col0 = u.pn * BM + wc * 32 + 8 * fq;
        float rs[2][4]; load_rstd(lds, ui, wr, fr, rs);
        const LAS float* swp = (const LAS float*)(lds + T_SW) + ui * 256 + wc * 32 + 8 * fq;
        const bool stats = ACT == 2 && u.pn >= 8;
#pragma unroll
        for (int bj = 0; bj < 2; ++bj) {
            const f32x4 b0 = *(const LAS f32x4*)(swp + bj * HALF), b1 = *(const LAS f32x4*)(swp + bj * HALF + 4);
#pragma unroll
            for (int ai = 0; ai < 2; ++ai)
#pragma unroll
                for (int m = 0; m < 4; ++m) {
                    const unsigned r = (unsigned)(row0 + ai * HALF + m * 16);
                    f32x4 v0 = acc[ai][bj][m][0] * rs[ai][m] + b0, v1 = acc[ai][bj][m][1] * rs[ai][m] + b1;
                    if (ACT == 1) {
#pragma unroll
                        for (int j = 0; j < 4; ++j) { const float a = fmaxf(v0[j], 0.f), b = fmaxf(v1[j], 0.f); v0[j] = a * a; v1[j] = b * b; } }
                    if (ACT == 2) {
#pragma unroll
                        for (int j = 0; j < 4; ++j) { v0[j] = gelu_tanh(v0[j]); v1[j] = gelu_tanh(v1[j]); } }
                    u32x4 w; w.x = cvt_pk_bf16(v0[0], v0[1]); w.y = cvt_pk_bf16(v0[2], v0[3]); w.z = cvt_pk_bf16(v1[0], v1[1]); w.w = cvt_pk_bf16(v1[2], v1[3]);
                    *(GAS u32x4*)(O + (r * (unsigned)LDC + (unsigned)(col0 + bj * HALF))) = w;
                    if (ACT == 2) { if (stats) {
                        float a = (v0[0] + v0[1]) + (v0[2] + v0[3]) + (v1[0] + v1[1]) + (v1[2] + v1[3]);
                        float b = (v0[0] * v0[0] + v0[1] * v0[1]) + (v0[2] * v0[2] + v0[3] * v0[3]) + (v1[0] * v1[0] + v1[1] * v1[1]) + (v1[2] * v1[2] + v1[3] * v1[3]);
                        a += __shfl_xor(a, 16); a += __shfl_xor(a, 32); b += __shfl_xor(b, 16); b += __shfl_xor(b, 32);
                        if (fq == 0) *(GAS f32x2*)(vstat + (r * 64u + (unsigned)(((u.pn - 8) * 2 + bj) * 4 + wc)) * 2u) = (f32x2){a, b}; } }
                }
        }
    }
};
struct EpiU {
    static constexpr bool PERM = true, AFTER_DRAIN = false;
    GAS bf16_t* UgS;
    __device__ __forceinline__ void operator()(AccRef acc, const Unit& u, int ui, const LAS unsigned char* lds, int wr, int wc, int fr, int fq) const {
        const int col0 = u.pn * BM + wc * 32 + 8 * fq;
        float rs[2][4]; load_rstd(lds, ui, wr, fr, rs);
        const LAS float* swp = (const LAS float*)(lds + T_SW) + ui * 256 + wc * 32 + 8 * fq;
#pragma unroll
        for (int bj = 0; bj < 2; ++bj) {
            const f32x4 b0 = *(const LAS f32x4*)(swp + bj * HALF), b1 = *(const LAS f32x4*)(swp + bj * HALF + 4);
            const int g = (col0 + bj * HALF) >> 4, p0 = (col0 & 15);
#pragma unroll
            for (int ai = 0; ai < 2; ++ai)
#pragma unroll
                for (int m = 0; m < 4; ++m) {
                    const f32x4 v0 = acc[ai][bj][m][0] * rs[ai][m] + b0, v1 = acc[ai][bj][m][1] * rs[ai][m] + b1;
                    u32x4 w; w.x = cvt_pk_bf16(v0[0], v0[1]); w.y = cvt_pk_bf16(v0[2], v0[3]); w.z = cvt_pk_bf16(v1[0], v1[1]); w.w = cvt_pk_bf16(v1[2], v1[3]);
                    const int chunk = u.pm * 16 + ai * 8 + wr * 4 + m;
                    *(GAS u32x4*)(UgS + ((unsigned)(g * NCH + chunk) * 512u + (unsigned)(fr * 16 + p0))) = w;
                }
        }
    }
};
struct EpiScan {
    static constexpr bool PERM = true, AFTER_DRAIN = true;
    GAS bf16_t* UgS; const GAS float* lamT; const GAS float* h0_re; const GAS float* h0_im; GAS float* new_re; GAS float* new_im; int j;
    static __device__ __forceinline__ int lidx(int row, int col) { return row * 128 + ((((col >> 2) ^ row) & 31) << 2) + (col & 3); }
    __device__ __forceinline__ void fused(AccRef acc, const Unit& u, int wr, int wc, int fr, int fq, LAS unsigned char* lds, int tid) const {
        LAS float* T = (LAS float*)lds;
        const int g = u.pn, mt = u.pm - 3 * g, n = tid & 63, slot = __builtin_amdgcn_readfirstlane(tid >> 6);
        const int len = mt < 2 ? 16 : 64, nsq = mt < 2 ? 2 : (slot < 4 ? 1 : 0), sl0 = mt < 2 ? slot * 2 : slot;
#pragma unroll 1
        for (int k = 0; k < 2; ++k) {
#pragma unroll
            for (int ai = 0; ai < 2; ++ai)
#pragma unroll
                for (int m = 0; m < 4; ++m) { const int row = ai * HALF + wr * 64 + m * 16 + fr;
#pragma unroll
                    for (int nn = 0; nn < 2; ++nn) { const int col = wc * 32 + 8 * fq + 4 * nn; *(LAS f32x4*)(T + lidx(row, col)) = k == 0 ? acc[ai][0][m][nn] : acc[ai][1][m][nn]; } }
            __syncthreads();
            const float lr = lamT[(((unsigned)j * 64 + g) * 2 + k) * 128 + 2 * n], li = lamT[(((unsigned)j * 64 + g) * 2 + k) * 128 + 2 * n + 1];
            for (int q = 0; q < nsq; ++q) {
                const int sl = sl0 + q, r0 = sl * len;
                float sr = 0.f, si = 0.f;
                if (mt == 2) { const unsigned o = ((((unsigned)sl * 2 + j) * 2 + k) * 64 + g) * 64 + n; sr = h0_re[o]; si = h0_im[o]; }
                GAS bf16_t* so = UgS + ((size_t)g * NCH + mt * 256) * 512 + 256 + k * 128 + n;
                for (int i = 0; i < len; ++i) {
                    const int row = k == 0 ? r0 + i : r0 + len - 1 - i;
                    so[(unsigned)row * 512u] = (bf16_t)f2bf(sr); so[(unsigned)row * 512u + 64u] = (bf16_t)f2bf(si);
                    const float ar = T[lidx(row, n)], ai2 = T[lidx(row, 64 + n)];
                    const float nr = lr * sr - li * si + ar, ni = lr * si + li * sr + ai2; sr = nr; si = ni;
                }
                if (mt < 2) { const unsigned o = ((((unsigned)(mt * 16 + sl) * 2 + j) * 2 + k) * 64 + g) * 64 + n; new_re[o] = sr; new_im[o] = si; }
            }
            __syncthreads();
        }
    }
};
struct EpiY {
    static constexpr bool PERM = true, AFTER_DRAIN = false;
    GAS bf16_t* Zg;
    __device__ __forceinline__ void operator()(AccRef acc, const Unit& u, int ui, const LAS unsigned char* lds, int wr, int wc, int fr, int fq) const {
        const int row0 = u.pm * BM + wr * 64 + fr, col0 = wc * 32 + 8 * fq;
#pragma unroll
        for (int ai = 0; ai < 2; ++ai)
#pragma unroll
            for (int m = 0; m < 4; ++m) { GAS bf16_t* rp = Zg + (size_t)(row0 + ai * HALF + m * 16) * 256 + col0;
#pragma unroll
                for (int bj = 0; bj < 2; ++bj) { const f32x4 v0 = acc[ai][bj][m][0], v1 = acc[ai][bj][m][1];
                    u32x4 w; w.x = cvt_pk_bf16(gelu_tanh(v0[0]), gelu_tanh(v0[1])); w.y = cvt_pk_bf16(gelu_tanh(v0[2]), gelu_tanh(v0[3]));
                    w.z = cvt_pk_bf16(gelu_tanh(v1[0]), gelu_tanh(v1[1])); w.w = cvt_pk_bf16(gelu_tanh(v1[2]), gelu_tanh(v1[3]));
                    *(GAS u32x4*)(rp + bj * HALF) = w; } }
    }
};
template <bool GATED> struct EpiRes {
    static constexpr bool PERM = true, AFTER_DRAIN = false;
    GAS h16_t* X; GAS bf16_t* XN; GAS float* rowss_next; bool has_next;
    __device__ __forceinline__ void operator()(AccRef acc, const Unit& u, int ui, const LAS unsigned char* lds, int wr, int wc, int fr, int fq) const {
        constexpr int NB = GATED ? 1 : 2;
        const int row0 = u.pm * BM + wr * 64 + fr, col0 = u.pn * (GATED ? HALF : BM) + wc * 32 + 8 * fq;
        const LAS float* tg = (const LAS float*)(lds + T_GATE) + ui * 256 + wc * 32 + 8 * fq; const LAS float* tn = (const LAS float*)(lds + T_GSN) + ui * 256 + wc * 32 + 8 * fq;
        h16x8 xa[4], xb[4];
#define RES_LOAD(dst, b_) do { const int bj_ = (b_) / 2, ai_ = (b_) % 2; _Pragma("unroll") for (int m = 0; m < 4; ++m) \
            dst[m] = *(const GAS h16x8*)(X + ((unsigned)(row0 + ai_ * HALF + m * 16) * (unsigned)D + (unsigned)(col0 + bj_ * HALF))); } while (0)
#define RES_PROC(src, b_) do { const int bj = (b_) / 2, ai = (b_) % 2; \
            const f32x4 g0 = *(const LAS f32x4*)(tg + bj * HALF), g1 = *(const LAS f32x4*)(tg + bj * HALF + 4), n0 = *(const LAS f32x4*)(tn + bj * HALF), n1 = *(const LAS f32x4*)(tn + bj * HALF + 4); \
            _Pragma("unroll") for (int m = 0; m < 4; ++m) { \
                const unsigned r = (unsigned)(row0 + ai * HALF + m * 16), off = r * (unsigned)D + (unsigned)(col0 + bj * HALF); \
                f32x4 v0 = acc[ai][bj][m][0], v1 = acc[ai][bj][m][1]; \
                if (GATED) { const f32x4 q0 = acc[ai][1][m][0], q1 = acc[ai][1][m][1]; \
                    _Pragma("unroll") for (int j = 0; j < 4; ++j) { v0[j] *= sigmoid_f(q0[j]); v1[j] *= sigmoid_f(q1[j]); } } \
                const f32x8 xo = __builtin_convertvector(src[m], f32x8); \
                const f32x4 x0 = (f32x4){xo[0], xo[1], xo[2], xo[3]} + g0 * v0, x1 = (f32x4){xo[4], xo[5], xo[6], xo[7]} + g1 * v1; \
                *(GAS h16x8*)(X + off) = __builtin_convertvector(((f32x8){x0[0], x0[1], x0[2], x0[3], x1[0], x1[1], x1[2], x1[3]}), h16x8); \
                if (has_next) { \
                    float a = (x0[0] * x0[0] + x0[1] * x0[1]) + (x0[2] * x0[2] + x0[3] * x0[3]) + (x1[0] * x1[0] + x1[1] * x1[1]) + (x1[2] * x1[2] + x1[3] * x1[3]); \
                    const f32x4 y0 = x0 * n0, y1 = x1 * n1; \
                    u32x4 w; w.x = cvt_pk_bf16(y0[0], y0[1]); w.y = cvt_pk_bf16(y0[2], y0[3]); w.z = cvt_pk_bf16(y1[0], y1[1]); w.w = cvt_pk_bf16(y1[2], y1[3]); \
                    *(GAS u32x4*)(XN + off) = w; \
                    a += __shfl_xor(a, 16); a += __shfl_xor(a, 32); \
                    if (fq == 0) rowss_next[r * 32u + (unsigned)(GATED ? u.pn * 4 + wc : (u.pn * 2 + bj) * 4 + wc)] = a; } } } while (0)
        h16x8 xc[4], xd[4];
        RES_LOAD(xa, 0); RES_LOAD(xb, 1);
        if (NB > 1) { RES_LOAD(xc, 2); RES_LOAD(xd, 3); }
        RES_PROC(xa, 0); RES_PROC(xb, 1);
        if (NB > 1) { RES_PROC(xc, 2); RES_PROC(xd, 3); }
#undef RES_LOAD
#undef RES_PROC
    }
};

#define XB_TMO      128
#define XB_XCNT(j)  (256  + 64 * (j))
#define XB_XSUB(j)  (1280 + 64 * (j))
#define XB_XGEN(j)  (2304 + 64 * (j))
#define XB_TOP      3328
#define XB_TOPGEN   3392
#define XCD_BAR_WORDS 3456
#define XB_SPIN_CAP (1u << 18)
__device__ __forceinline__ unsigned xb_ld(GAS unsigned* p)              { return __hip_atomic_load(p, __ATOMIC_RELAXED, __HIP_MEMORY_SCOPE_AGENT); }
__device__ __forceinline__ unsigned xb_add(GAS unsigned* p, unsigned v) { return __hip_atomic_fetch_add(p, v, __ATOMIC_RELAXED, __HIP_MEMORY_SCOPE_AGENT); }
__device__ __forceinline__ unsigned xb_xcc_id() { return (unsigned)__builtin_amdgcn_s_getreg((3 << 11) | 20) & 0xFu; }
#define XB_SPIN(cond, bar) do { unsigned _sp = 0; while (cond) { __builtin_amdgcn_s_sleep(1); \
    if ((++_sp & 255u) == 0u) { if (xb_ld(&(bar)[XB_TMO])) break; if (_sp > XB_SPIN_CAP) { (void)xb_add(&(bar)[XB_TMO], 1u); break; } } } } while (0)
struct XcdBarrier { GAS unsigned* bar; unsigned x; volatile LAS unsigned* st; };
__device__ __forceinline__ XcdBarrier xcd_barrier_post(GAS unsigned* bar, volatile LAS unsigned* st) {
    XcdBarrier b; b.bar = bar; b.x = xb_xcc_id(); b.st = st;
    if (threadIdx.x == 0) (void)xb_add(&bar[XB_XCNT(b.x)], 1u);
    return b;
}
__device__ __forceinline__ void xcd_barrier_complete(GAS unsigned* bar, unsigned x, unsigned& nloc, unsigned& nx) {
    const unsigned G = gridDim.x * gridDim.y * gridDim.z;
    unsigned sum, cnt, mine, sp = 0u;
    for (;;) {
        sum = 0u; cnt = 0u;
#pragma unroll 1
        for (unsigned j = 0; j < 16; ++j) { const unsigned c = xb_ld(&bar[XB_XCNT(j)]); sum += c; cnt += (c > 0u) ? 1u : 0u; }
        mine = xb_ld(&bar[XB_XCNT(x)]);
        if (sum == G) break;
        __builtin_amdgcn_s_sleep(1);
        if ((++sp & 255u) == 0u) { if (xb_ld(&bar[XB_TMO])) break; if (sp > XB_SPIN_CAP) { (void)xb_add(&bar[XB_TMO], 1u); break; } }
    }
    nloc = mine > 0u ? mine : 1u; nx = cnt > 0u ? cnt : 1u;
}
__device__ __forceinline__ void xcd_barrier(const XcdBarrier& b, bool leader) {
    asm volatile("s_waitcnt vmcnt(0)" ::: "memory");
    __syncthreads();
    if (leader) {
        GAS unsigned* bar = b.bar; unsigned bx_ = b.x;
        asm volatile("" : "+s"(bar), "+s"(bx_));
        __builtin_amdgcn_s_waitcnt(0);
        unsigned nloc = b.st[0], nx = b.st[1];
        if (nloc == 0u) { xcd_barrier_complete(bar, bx_, nloc, nx); b.st[0] = nloc; b.st[1] = nx; }
        const unsigned old = xb_add(&bar[XB_XSUB(bx_)], 1u);
        const unsigned gen = old / nloc;
        if (old + 1u == (gen + 1u) * nloc) {
            __builtin_amdgcn_fence(__ATOMIC_RELEASE, "agent");
            asm volatile("s_waitcnt vmcnt(0)" ::: "memory");
            const unsigned og = xb_add(&bar[XB_TOP], 1u);
            const unsigned tg = og / nx;
            if (og + 1u == (tg + 1u) * nx) xb_add(&bar[XB_TOPGEN], 1u);
            else XB_SPIN(xb_ld(&bar[XB_TOPGEN]) == tg, bar);
            __builtin_amdgcn_fence(__ATOMIC_ACQUIRE, "agent");
            xb_add(&bar[XB_XGEN(bx_)], 1u);
            asm volatile("s_waitcnt vmcnt(0)" ::: "memory");
        } else {
            XB_SPIN(xb_ld(&bar[XB_XGEN(bx_)]) == gen, bar);
            __builtin_amdgcn_fence(__ATOMIC_ACQUIRE, "agent");
            asm volatile("s_waitcnt vmcnt(0)" ::: "memory");
        }
    }
    __syncthreads();
}

constexpr size_t MiB = 1u << 20;
constexpr size_t WS_CTL = 0, CTL_BYTES = 2 * MiB;
constexpr int CW_BAR = 4096;
constexpr size_t WS_TAB = 2 * MiB;
constexpr size_t TAB_GSA = WS_TAB, TAB_GSB = TAB_GSA + 4 * 5 * 1024 * 4, TAB_SWA = TAB_GSB + 4 * 5 * 1024 * 4, TAB_SWB = TAB_SWA + 4 * 5 * 4096 * 4, TAB_LAMT = TAB_SWB + 4 * 5 * 4096 * 4;
static_assert(TAB_LAMT + 2 * 64 * 2 * 64 * 2 * 4 <= 4 * MiB, "tables");
constexpr size_t WS_W1 = 4 * MiB, WS_W2 = 36 * MiB, WS_SWIN = 68 * MiB, WS_SWOUT = 72 * MiB, WS_GWIN = 80 * MiB, WS_GWOUT = 88 * MiB, WS_GWS = 92 * MiB,
                 WS_CWIN = 93 * MiB, WS_CWOUT = 99 * MiB, WS_BTY = 101 * MiB, WS_BTS = 133 * MiB;
constexpr size_t WS_XN = 149 * MiB;
constexpr size_t WS_R = 173 * MiB;
constexpr size_t WS_R2 = 269 * MiB;
constexpr size_t WS_ROWSS = 317 * MiB;
constexpr size_t WS_VSTAT = 329 * MiB;
constexpr size_t WS_MODS = 335 * MiB;
constexpr size_t WS_X16 = 336 * MiB;
constexpr size_t WS_END = 360 * MiB;

constexpr int LDS_BYTES = 147456;
constexpr int MISC_OFF = STAGE_BYTES;

struct Args { const float* in[30]; float* out; unsigned char* ws; int ph_lo, ph_hi; int mode, pad; };

__device__ __forceinline__ unsigned pk2(float lo, float hi) { return f2bf(lo) | (f2bf(hi) << 16); }
__device__ __forceinline__ float wave_sum(float v) {
#pragma unroll
    for (int o = 1; o < 64; o <<= 1) v += __shfl_xor(v, o);
    return v;
}
template <int MAP> __device__ __forceinline__ int rowmap(int n) {
    if (MAP == 1) { const int half = n >> 10, c = n & 1023; return (c >> 7) * 256 + half * 128 + (c & 127); }
    return n;
}
template <int MAP> __device__ __forceinline__ void transpose_item(const GAS float* W, int K, int N, GAS bf16_t* WT, LAS float* scr, int item, int lane) {
    const int nblk = N / 32, kb = item / nblk, nb = item % nblk, k0 = 64 * kb, n0 = 32 * nb;
    float wv[32];
#pragma unroll
    for (int i = 0; i < 32; ++i) wv[i] = W[(size_t)(k0 + 2 * i + (lane >> 5)) * N + n0 + (lane & 31)];
#pragma unroll
    for (int i = 0; i < 32; ++i) scr[(2 * i + (lane >> 5)) * 33 + (lane & 31)] = wv[i];
    asm volatile("s_waitcnt lgkmcnt(0)" ::: "memory");
    const int c = lane & 7;
#pragma unroll
    for (int j = 0; j < 4; ++j) { const int n = (lane >> 3) + 8 * j; const LAS float* s = scr + (8 * c) * 33 + n;
        u32x4 o; o.x = pk2(s[0 * 33], s[1 * 33]); o.y = pk2(s[2 * 33], s[3 * 33]); o.z = pk2(s[4 * 33], s[5 * 33]); o.w = pk2(s[6 * 33], s[7 * 33]);
        *(GAS u32x4*)(WT + (size_t)rowmap<MAP>(n0 + n) * K + k0 + 8 * c) = o; }
    asm volatile("s_waitcnt lgkmcnt(0)" ::: "memory");
}

__device__ __forceinline__ void ssm_build(const Args& a, int j, int g, int part, LAS unsigned char* lds, GAS unsigned char* ws, int tid) {
#ifdef MK_RANGE
    const int PMODE = a.mode;
#else
    constexpr int PMODE = 0;
#endif
    LAS float* PR = (LAS float*)lds;
    LAS float* PI = PR + 2 * 17 * 64;
    LAS float* BR = PI + 2 * 17 * 64;
    LAS float* BI = BR + 2 * 64 * 16;
    LAS float* CR = BI + 2 * 64 * 16;
    LAS float* CI = CR + 2 * 16 * 64;
    LAS float* WR = CI + 2 * 16 * 64;
    LAS float* WI = WR + 2 * 64 * 16;
    LAS float* KT = WI + 2 * 64 * 16;
    const GAS float* lam_re = inp(lds, 13); const GAS float* lam_im = inp(lds, 14); const GAS float* log_dt = inp(lds, 15);
    const GAS float* b_re = inp(lds, 16); const GAS float* b_im = inp(lds, 17); const GAS float* c_re = inp(lds, 18); const GAS float* c_im = inp(lds, 19); const GAS float* dsk = inp(lds, 20);
    __syncthreads();
    LAS float* FR = WR; LAS float* FI = WR + 128; LAS float* DSK = WR + 256;
    if (tid >= 128 && tid < 144) DSK[tid - 128] = dsk[j * 1024 + g * 16 + tid - 128];
    if (tid < 128) {
        const int k = tid >> 6, n = tid & 63, pidx = (j * 2 + k) * 64 + g;
        const float dt = expf(log_dt[pidx]);
        const float lr = lam_re[pidx * 64 + n], li = lam_im[pidx * 64 + n];
        const float mag = expf(lr * dt); float sn, cs; sincosf(li * dt, &sn, &cs); const float abr = mag * cs, abi = mag * sn;
        const float den = lr * lr + li * li;
        const float nr = (abr - 1.0f) * lr + abi * li, ni = -(abr - 1.0f) * li + abi * lr;
        FR[tid] = nr / den; FI[tid] = ni / den;
    }
#pragma unroll 1
    for (int i = tid; i < 2 * 17 * 64; i += 512) {
        const int k = i / (17 * 64), e = (i >> 6) % 17, n = i & 63, pidx = (j * 2 + k) * 64 + g;
        const float dt = expf(log_dt[pidx]); const float lr = lam_re[pidx * 64 + n], li = lam_im[pidx * 64 + n];
        const float mag = expf((float)e * lr * dt); float sn, cs; sincosf((float)e * (li * dt), &sn, &cs); PR[i] = mag * cs; PI[i] = mag * sn; }
    for (int i = tid; i < 2048; i += 512) { const int k = i >> 10, po = (i >> 6) & 15, n = i & 63; const size_t o = ((size_t)(j * 2 + k) * 64 + g) * 1024 + (i & 1023);
        CR[(k * 64 + n) * 16 + po] = c_re[o]; CI[(k * 64 + n) * 16 + po] = c_im[o]; }
    __syncthreads();
    for (int i = tid; i < 2048; i += 512) { const int kn = i >> 4; const size_t o = ((size_t)(j * 2 + (kn >> 6)) * 64 + g) * 1024 + (i & 1023);
        const float br = b_re[o], bi = b_im[o], fr = FR[kn], fi = FI[kn]; BR[i] = fr * br - fi * bi; BI[i] = fr * bi + fi * br; }
    if (part == 1 && tid < 128) { const int k = tid >> 6, n = tid & 63; GAS float* lamT = (GAS float*)(ws + TAB_LAMT) + (((size_t)j * 64 + g) * 2 + k) * 128;
        lamT[2 * n] = PR[(k * 17 + 16) * 64 + n]; lamT[2 * n + 1] = PI[(k * 17 + 16) * 64 + n]; }
    __syncthreads();
    if (part == 0 && PMODE != 6) {
        const int e = tid >> 5, k = (tid >> 4) & 1, po4 = (tid >> 2) & 3, pi4 = tid & 3;
        float acc[4][4];
#pragma unroll
        for (int x = 0; x < 4; ++x)
#pragma unroll
            for (int y = 0; y < 4; ++y) acc[x][y] = 0.f;
#pragma unroll 2
        for (int n = 0; n < 64; ++n) {
            const float pr = PR[(k * 17 + e) * 64 + n], pim = PI[(k * 17 + e) * 64 + n];
            const f32x4 br = *(const LAS f32x4*)(BR + (k * 64 + n) * 16 + 4 * pi4), bi = *(const LAS f32x4*)(BI + (k * 64 + n) * 16 + 4 * pi4);
            const f32x4 cr = *(const LAS f32x4*)(CR + (k * 64 + n) * 16 + 4 * po4), ci = *(const LAS f32x4*)(CI + (k * 64 + n) * 16 + 4 * po4);
            const f32x4 wr = br * pr - bi * pim, wi = bi * pr + br * pim;
#pragma unroll
            for (int x = 0; x < 4; ++x)
#pragma unroll
                for (int y = 0; y < 4; ++y) acc[x][y] += cr[x] * wr[y] - ci[x] * wi[y];
        }
#pragma unroll
        for (int x = 0; x < 4; ++x) *(LAS f32x4*)(KT + ((k * 16 + e) * 16 + 4 * po4 + x) * 16 + 4 * pi4) = (f32x4){acc[x][0], acc[x][1], acc[x][2], acc[x][3]};
    }
    __syncthreads();
    GAS bf16_t* BtY = (GAS bf16_t*)(ws + WS_BTY) + ((size_t)j * 64 + g) * 256 * 512;
    GAS bf16_t* BtS = (GAS bf16_t*)(ws + WS_BTS) + ((size_t)j * 64 + g) * 256 * 256;
    if (part == 0) {
    if (PMODE != 7)
#pragma unroll 1
    for (int pc = tid; pc < 256 * 32; pc += 512) {
        const int row = pc >> 5, kc = (pc & 31) * 8, t = row >> 4, po = row & 15, s = kc >> 4, pi0 = kc & 15;
        float v[8];
#pragma unroll
        for (int q = 0; q < 8; ++q) { const int pi = pi0 + q; float x = 0.f;
            if (s <= t) x += KT[((0 * 16 + (t - s)) * 16 + po) * 16 + pi];
            if (s >= t) x += KT[((1 * 16 + (s - t)) * 16 + po) * 16 + pi];
            if (s == t && pi == po) x += DSK[po];
            v[q] = x; }
        u32x4 o; o.x = pk2(v[0], v[1]); o.y = pk2(v[2], v[3]); o.z = pk2(v[4], v[5]); o.w = pk2(v[6], v[7]);
        *(GAS u32x4*)(BtY + (size_t)row * 512 + kc) = o;
    }
    if (PMODE != 8)
#pragma unroll 1
    for (int pc = tid; pc < 256 * 32; pc += 512) {
        const int row = pc >> 5, kc = (pc & 31) * 8, t = row >> 4, po = row & 15, k = kc >> 7, ri = (kc >> 6) & 1, n0 = kc & 63;
        const int e = k == 0 ? t + 1 : 16 - t;
        float v[8];
#pragma unroll
        for (int q = 0; q < 8; ++q) { const int n = n0 + q; const float cr = CR[(k * 64 + n) * 16 + po], cim = CI[(k * 64 + n) * 16 + po], pr = PR[(k * 17 + e) * 64 + n], pim = PI[(k * 17 + e) * 64 + n];
            v[q] = ri == 0 ? (cr * pr - cim * pim) : -(cr * pim + cim * pr); }
        u32x4 o; o.x = pk2(v[0], v[1]); o.y = pk2(v[2], v[3]); o.z = pk2(v[4], v[5]); o.w = pk2(v[6], v[7]);
        *(GAS u32x4*)(BtY + (size_t)row * 512 + 256 + kc) = o;
    }
    } else {
    for (int pc = tid; pc < 256 * 32; pc += 512) {
        const int row = pc >> 5, kc = (pc & 31) * 8, k = row >> 7, ri = (row >> 6) & 1, n = row & 63, s = kc >> 4, pi0 = kc & 15;
        const int e = k == 0 ? 15 - s : s;
        const float pr = PR[(k * 17 + e) * 64 + n], pim = PI[(k * 17 + e) * 64 + n];
        float v[8];
#pragma unroll
        for (int q = 0; q < 8; ++q) { const float br = BR[(k * 64 + n) * 16 + pi0 + q], bi = BI[(k * 64 + n) * 16 + pi0 + q]; v[q] = ri == 0 ? (pr * br - pim * bi) : (pr * bi + pim * br); }
        u32x4 o; o.x = pk2(v[0], v[1]); o.y = pk2(v[2], v[3]); o.z = pk2(v[4], v[5]); o.w = pk2(v[6], v[7]);
        *(GAS u32x4*)(BtS + (size_t)row * 256 + kc) = o;
    }
    }
    __syncthreads();
}

__device__ __forceinline__ void mods_task(const Args& a, GAS float* mods, LAS unsigned char* lds, int task, int tid) {
    const int cg = task % 48, l = task / 48, wave = tid >> 6, lane = tid & 63, half = lane >> 5, c4 = lane & 31;
    const GAS float* c = inp(lds, 4); const GAS float* c_ctx = inp(lds, 5); const GAS float* w_mod = inp(lds, 6); const GAS float* b_mod = inp(lds, 7);
    LAS float* sil = (LAS float*)lds;
    LAS float* red = sil + 5 * 1024;
    __syncthreads();
    for (int i = tid; i < 5 * 1024; i += 512) { const int ci = i >> 10, k = i & 1023; const float v = ci == 0 ? c_ctx[k] : c[(ci - 1) * 1024 + k]; sil[i] = v / (1.0f + expf(-v)); }
    __syncthreads();
    const GAS float* w = w_mod + ((size_t)l * 1024 + wave * 128 + half) * 6144 + cg * 128 + c4 * 4;
    f32x4 acc[5];
#pragma unroll
    for (int ci = 0; ci < 5; ++ci) acc[ci] = (f32x4){0.f, 0.f, 0.f, 0.f};
#pragma unroll 1
    for (int b = 0; b < 2; ++b) {
        f32x4 wv[32];
#pragma unroll
        for (int i = 0; i < 32; ++i) wv[i] = *(const GAS f32x4*)(w + (size_t)(b * 64 + 2 * i) * 6144);
#pragma unroll
        for (int i = 0; i < 32; ++i) { const int k = wave * 128 + b * 64 + 2 * i + half;
#pragma unroll
            for (int ci = 0; ci < 5; ++ci) acc[ci] += wv[i] * sil[ci * 1024 + k]; }
    }
#pragma unroll
    for (int ci = 0; ci < 5; ++ci) {
#pragma unroll
        for (int q = 0; q < 4; ++q) acc[ci][q] += __shfl_xor(acc[ci][q], 32);
        if (half == 0) *(LAS f32x4*)(red + (wave * 5 + ci) * 128 + c4 * 4) = acc[ci]; }
    __syncthreads();
    for (int i = tid; i < 5 * 128; i += 512) { const int ci = i >> 7, cc = i & 127; float t = 0.f;
#pragma unroll
        for (int wv2 = 0; wv2 < 8; ++wv2) t += red[(wv2 * 5 + ci) * 128 + cc];
        mods[((size_t)l * 5 + ci) * 6144 + cg * 128 + cc] = t + b_mod[l * 6144 + cg * 128 + cc]; }
}

__device__ __forceinline__ void xinit_row(const LAS unsigned char* lds, GAS h16_t* X, int row, int lane) {
    GAS h16x4* o = (GAS h16x4*)(X + (size_t)row * D) + lane;
    if (row < MP) { const GAS f32x4* s = (const GAS f32x4*)(inp(lds, 0) + (size_t)row * D) + lane;
#pragma unroll
        for (int q = 0; q < 4; ++q) o[64 * q] = __builtin_convertvector(s[64 * q], h16x4);
        return; }
    const GAS f32x4* s = (const GAS f32x4*)(inp(lds, 1) + (size_t)(row - MP) * D) + lane;
    const int t = (row - MP) & 1023; const float rr = (float)(t >> 6), cc = (float)(t & 63);
    float freq[4];
#pragma unroll
    for (int e = 0; e < 4; ++e) freq[e] = expf(-(float)(4 * lane + e) * (9.210340371976184f / 256.0f));
    f32x4 v[4];
#pragma unroll
    for (int q = 0; q < 4; ++q) v[q] = s[64 * q];
#pragma unroll
    for (int e = 0; e < 4; ++e) { float sr, cr, sc, cc2; sincosf(rr * freq[e], &sr, &cr); sincosf(cc * freq[e], &sc, &cc2); v[0][e] += sr; v[1][e] += cr; v[2][e] += sc; v[3][e] += cc2; }
#pragma unroll
    for (int q = 0; q < 4; ++q) o[64 * q] = __builtin_convertvector(v[q], h16x4);
}


__device__ __forceinline__ void sw_job(const GAS float* mods, int l, int sidx, const GAS bf16_t* WT, int N, GAS float* dst, int dld, int wv, int nw, int lane) {
    float sh[5][16];
#pragma unroll
    for (int ci = 0; ci < 5; ++ci) { const GAS float* sp = mods + ((size_t)l * 5 + ci) * 6144 + sidx * 1024 + lane * 16;
#pragma unroll
        for (int q = 0; q < 4; ++q) { const f32x4 v = *(const GAS f32x4*)(sp + 4 * q); sh[ci][4 * q] = v[0]; sh[ci][4 * q + 1] = v[1]; sh[ci][4 * q + 2] = v[2]; sh[ci][4 * q + 3] = v[3]; } }
    for (int r = wv * 8; r < N; r += nw * 8) {
        u32x4 w0[8], w1[8];
#pragma unroll
        for (int nn = 0; nn < 8; ++nn) { w0[nn] = *(const GAS u32x4*)(WT + (size_t)(r + nn) * D + lane * 16); w1[nn] = *(const GAS u32x4*)(WT + (size_t)(r + nn) * D + lane * 16 + 8); }
#pragma unroll
        for (int nn = 0; nn < 8; ++nn) {
            const float wf[16] = {bf_lo(w0[nn].x), bf_hi(w0[nn].x), bf_lo(w0[nn].y), bf_hi(w0[nn].y), bf_lo(w0[nn].z), bf_hi(w0[nn].z), bf_lo(w0[nn].w), bf_hi(w0[nn].w),
                                  bf_lo(w1[nn].x), bf_hi(w1[nn].x), bf_lo(w1[nn].y), bf_hi(w1[nn].y), bf_lo(w1[nn].z), bf_hi(w1[nn].z), bf_lo(w1[nn].w), bf_hi(w1[nn].w)};
#pragma unroll
            for (int ci = 0; ci < 5; ++ci) { float t = 0.f;
#pragma unroll
                for (int q = 0; q < 16; ++q) t += wf[q] * sh[ci][q];
                t = wave_sum(t);
                if (lane == 0) dst[ci * dld + r + nn] = t; }
        }
    }
}
__device__ __forceinline__ void sw_mix_job(GAS unsigned char* ws, const GAS float* mods, int l, int wv, int nw, int lane) {
    GAS float* swA = (GAS float*)(ws + TAB_SWA);
    if (l == 0) sw_job(mods, 0, 0, (const GAS bf16_t*)(ws + WS_SWIN), 1024, swA, 1024, wv, nw, lane);
    else if (l == 1) sw_job(mods, 1, 0, (const GAS bf16_t*)(ws + WS_GWIN), 4096, swA + 1 * 5 * 4096, 4096, wv, nw, lane);
    else if (l == 2) sw_job(mods, 2, 0, (const GAS bf16_t*)(ws + WS_CWIN), 3072, swA + 2 * 5 * 4096, 3072, wv, nw, lane);
    else sw_job(mods, 3, 0, (const GAS bf16_t*)(ws + WS_SWIN) + (size_t)D * D, 1024, swA + 3 * 5 * 4096, 1024, wv, nw, lane);
}
__device__ __forceinline__ void sw_ffn_job(GAS unsigned char* ws, const GAS float* mods, int l, int wv, int nw, int lane) {
    sw_job(mods, l, 3, (const GAS bf16_t*)(ws + WS_W1) + (size_t)l * D * FF, 4096, (GAS float*)(ws + TAB_SWB) + l * 5 * 4096, 4096, wv, nw, lane);
}


constexpr int I_W1 = 2048, I_W2 = 2048, I_SI = 512, I_SO = 1024, I_GI = 2048, I_GO = 1024, I_CI = 1536, I_CO = 512;
constexpr int IT_W1 = 0, IT_W2 = 4 * I_W1, IT_SI = IT_W2 + 4 * I_W2, IT_SO = IT_SI + 2 * I_SI, IT_GI = IT_SO + 2 * I_SO, IT_GO = IT_GI + I_GI, IT_CI = IT_GO + I_GO, IT_CO = IT_CI + I_CI, IT_END = IT_CO + I_CO;
__device__ __forceinline__ void convert_items(const LAS unsigned char* lds, GAS unsigned char* ws, LAS float* scr, int first, int count, int wv, int nw, int lane) {
    for (int it = first + wv; it < first + count; it += nw) {
        int r = it;
        if (r < IT_W2) { const int l = r / I_W1; transpose_item<0>(inp(lds, 10) + (size_t)l * D * FF, D, FF, (GAS bf16_t*)(ws + WS_W1) + (size_t)l * D * FF, scr, r % I_W1, lane); continue; } r -= IT_W2;
        if (r < 4 * I_W2) { const int l = r / I_W2; transpose_item<0>(inp(lds, 11) + (size_t)l * D * FF, FF, D, (GAS bf16_t*)(ws + WS_W2) + (size_t)l * D * FF, scr, r % I_W2, lane); continue; } r -= 4 * I_W2;
        if (r < 2 * I_SI) { const int l = r / I_SI; transpose_item<0>(inp(lds, 12) + (size_t)l * D * D, D, D, (GAS bf16_t*)(ws + WS_SWIN) + (size_t)l * D * D, scr, r % I_SI, lane); continue; } r -= 2 * I_SI;
        if (r < 2 * I_SO) { const int l = r / I_SO; transpose_item<1>(inp(lds, 21) + (size_t)l * D * 2048, D, 2048, (GAS bf16_t*)(ws + WS_SWOUT) + (size_t)l * D * 2048, scr, r % I_SO, lane); continue; } r -= 2 * I_SO;
        if (r < I_GI) { transpose_item<0>(inp(lds, 22), D, 4096, (GAS bf16_t*)(ws + WS_GWIN), scr, r, lane); continue; } r -= I_GI;
        if (r < I_GO) { transpose_item<0>(inp(lds, 25), 2048, D, (GAS bf16_t*)(ws + WS_GWOUT), scr, r, lane); continue; } r -= I_GO;
        if (r < I_CI) { transpose_item<0>(inp(lds, 26), D, 3072, (GAS bf16_t*)(ws + WS_CWIN), scr, r, lane); continue; } r -= I_CI;
        transpose_item<0>(inp(lds, 28), D, D, (GAS bf16_t*)(ws + WS_CWOUT), scr, r, lane);
    }
}
constexpr int NPH = 28;
#ifdef MK_RANGE
#define GMODE(g) g.mode = args.mode
#else
#define GMODE(g)
#endif
#ifndef MK_ALLCG
#define MK_ALLCG 0
#endif
__global__ void __launch_bounds__(512, 2) fwd(Args args) {
    extern __shared__ __attribute__((aligned(16))) unsigned char lds_raw[];
    LAS unsigned char* lds_k = (LAS unsigned char*)lds_raw;
    volatile LAS unsigned* MISC = (volatile LAS unsigned*)(lds_k + MISC_OFF);
    const int tid = threadIdx.x, lane = tid & 63, wave = __builtin_amdgcn_readfirstlane(tid >> 6);
    const int G = gridDim.x, bx = blockIdx.x;
    GAS unsigned* ctl = (GAS unsigned*)((GAS unsigned char*)args.ws + WS_CTL);
    for (int u = tid; u < 64; u += 512) MISC[u] = 0u;
    if (tid == 0) { LAS unsigned long long* pt = (LAS unsigned long long*)(lds_k + PTR_OFF);
#pragma unroll
        for (int k = 0; k < 30; ++k) pt[k] = (unsigned long long)args.in[k];
        pt[30] = (unsigned long long)args.out; pt[31] = (unsigned long long)args.ws; }
    __syncthreads();
    (void)xcd_barrier_post(ctl + CW_BAR, MISC + 8);
#ifdef MK_RANGE
    const int lo = args.ph_lo, hi = args.ph_hi;
#else
    constexpr int lo = 0, hi = 23;
#endif
    int ph = 0;
#define IN_PH (lo <= ph && ph < hi)
#define SEAM() do { if (IN_PH && ph + 1 < hi) { if (ph == 0 || MK_ALLCG) cg::this_grid().sync(); else { LAS unsigned char* lds_s_ = lds_k; asm volatile("" : "+s"(lds_s_)); XcdBarrier b_; b_.bar = (GAS unsigned*)((GAS unsigned char*)ldsptr(lds_s_, 31) + WS_CTL) + CW_BAR; b_.x = xb_xcc_id(); b_.st = (volatile LAS unsigned*)(lds_s_ + MISC_OFF) + 8; xcd_barrier(b_, wave == 0 && lane_id() == 0); } } ++ph; } while (0)

#define PH_PTRS() LAS unsigned char* lds = lds_k; asm volatile("" : "+s"(lds)); GAS unsigned char* ws = (GAS unsigned char*)ldsptr(lds, 31); asm volatile("" : "+s"(ws)); \
    int tid_o_ = wave * 64 + lane_id(); asm volatile("" : "+v"(tid_o_)); const int tid = tid_o_, lane = tid_o_ & 63; (void)tid; (void)lane; \
    const int vcu = (G % 8 == 0) ? (bx % 8) * (G / 8) + bx / 8 : bx, gw = vcu * 8 + wave, NGW = G * 8; (void)vcu; (void)gw; (void)NGW; \
    GAS h16_t* X = (GAS h16_t*)(ws + WS_X16); GAS bf16_t* XN = (GAS bf16_t*)(ws + WS_XN); GAS float* mods = (GAS float*)(ws + WS_MODS); \
    GAS float* gsA = (GAS float*)(ws + TAB_GSA); GAS float* gsB = (GAS float*)(ws + TAB_GSB); GAS float* swA = (GAS float*)(ws + TAB_SWA); GAS float* swB = (GAS float*)(ws + TAB_SWB); \
    GAS float* rowss = (GAS float*)(ws + WS_ROWSS); GAS float* vstat = (GAS float*)(ws + WS_VSTAT); \
    GAS bf16_t* Hb = (GAS bf16_t*)(ws + WS_R); GAS bf16_t* UgS = (GAS bf16_t*)(ws + WS_R); GAS float* Sloc = (GAS float*)(ws + WS_R + 48 * MiB); GAS bf16_t* Zg = (GAS bf16_t*)(ws + WS_R + 48 * MiB); GAS bf16_t* A2 = (GAS bf16_t*)(ws + WS_R2); \
    (void)X; (void)XN; (void)mods; (void)gsA; (void)gsB; (void)swA; (void)swB; (void)rowss; (void)vstat; (void)Hb; (void)UgS; (void)Sloc; (void)Zg; (void)A2;
#define PH_LAYER() const GAS float* rs_mix = rowss + (size_t)(2 * layer) * M * 32; GAS float* rs_ffn = rowss + (size_t)(2 * layer + 1) * M * 32; GAS float* rs_next = rowss + (size_t)((2 * layer + 2) & 7) * M * 32; \
    const GAS float* modl = mods + (size_t)layer * 5 * 6144; (void)rs_mix; (void)rs_ffn; (void)rs_next; (void)modl;

#define SIDE_IDS() const int swv = (bx - 192) * 8 + wave, snw = (G - 192) * 8; LAS float* scr = (LAS float*)(lds + wave * 16384); (void)scr; (void)swv; (void)snw
    if (IN_PH) { PH_PTRS();
#ifdef MK_RANGE
        const int pm_ = args.mode;
#else
        constexpr int pm_ = 0;
#endif
        if (bx < 128) { if (pm_ != 2) ssm_build(args, 0, bx & 63, bx >> 6, lds, ws, tid); } else { if (pm_ != 3) for (int t = bx - 128; t < 192; t += 128) mods_task(args, mods, lds, t, tid); }
        __syncthreads();
        if (bx >= 128 && pm_ != 4) { LAS float* scr = (LAS float*)(lds + wave * 16384); const int wv = (bx - 128) * 8 + wave, nw = (G - 128) * 8;
            convert_items(lds, ws, scr, IT_W1, I_W1, wv, nw, lane); convert_items(lds, ws, scr, IT_W2, I_W2, wv, nw, lane);
            convert_items(lds, ws, scr, IT_SI, I_SI, wv, nw, lane); convert_items(lds, ws, scr, IT_SO, I_SO, wv, nw, lane); }
        if (pm_ != 5 && bx >= 64) for (int row = (bx - 64) * 8 + wave; row < M; row += (G - 64) * 8) xinit_row(lds, X, row, lane);
    }
    SEAM();
    if (IN_PH) { PH_PTRS();
        for (int i = gw * 64 + lane; i < 4 * 5 * 1024; i += NGW * 64) { const int l = i / 5120, ci = (i / 1024) % 5, c = i & 1023;
            const GAS float* md = mods + ((size_t)l * 5 + ci) * 6144;
            gsA[i] = inp(lds, 8)[l * 1024 + c] * (1.0f + md[1024 + c]); gsB[i] = inp(lds, 9)[l * 1024 + c] * (1.0f + md[4 * 1024 + c]); }
        sw_mix_job(ws, mods, 0, gw, NGW, lane);
        for (int row = gw; row < M; row += 3 * NGW) {
            const GAS float* gm = inp(lds, 8);
            f32x4 v[3][4];
#pragma unroll
            for (int rr = 0; rr < 3; ++rr)
#pragma unroll
                for (int q = 0; q < 4; ++q) v[rr][q] = __builtin_convertvector(((const GAS h16x4*)(X + (size_t)(row + rr * NGW) * D) + lane)[64 * q], f32x4);
#pragma unroll
            for (int rr = 0; rr < 3; ++rr) {
                const int r = row + rr * NGW, ci = cond_of_row(r); const GAS float* md = mods + ((size_t)0 * 5 + ci) * 6144;
                float t = 0.f;
#pragma unroll
                for (int q = 0; q < 4; ++q) t += (v[rr][q][0] * v[rr][q][0] + v[rr][q][1] * v[rr][q][1]) + (v[rr][q][2] * v[rr][q][2] + v[rr][q][3] * v[rr][q][3]);
                t = wave_sum(t);
                if (lane < 32) rowss[(size_t)r * 32 + lane] = lane == 0 ? t : 0.f;
                GAS u32x2* o = (GAS u32x2*)(XN + (size_t)r * D) + lane;
#pragma unroll
                for (int q = 0; q < 4; ++q) { const int c = 256 * q + 4 * lane; const f32x4 gg = *(const GAS f32x4*)(gm + c), sc = *(const GAS f32x4*)(md + 1024 + c);
                    const f32x4 y = v[rr][q] * gg * (sc + 1.0f); u32x2 w; w.x = cvt_pk_bf16(y[0], y[1]); w.y = cvt_pk_bf16(y[2], y[3]); o[64 * q] = w; }
            }
        }
    }
    SEAM();
#pragma unroll 1
    for (int layer = 0; layer < 4; ++layer) {
        const int kind = layer % 3, j = layer / 3;
        if (kind == 0) {
            if (IN_PH) { PH_PTRS(); PH_LAYER(); Gemm g = gemm_rowmajor(XN, D, (const GAS bf16_t*)(ws + WS_SWIN) + (size_t)j * D * D, D, D); GMODE(g); StaticOrder S; S.init(M, D, G, bx);
                fill_tables_in(lds, S, rs_mix, swA + layer * 5 * 4096, 1024, tid); EpiU E{UgS}; gemm_phase<EpiU, ARowMajor, StaticOrder>(lds, g, S, E, wave);
                if (bx >= 192) { SIDE_IDS(); sw_ffn_job(ws, mods, layer, swv, snw, lane); if (layer == 0) convert_items(lds, ws, scr, IT_GI, I_GI, swv, snw, lane); } }
            SEAM();
            if (IN_PH) { PH_PTRS(); PH_LAYER(); SsmOrder S{G, bx};
                { Gemm g = gemm_rowmajor(UgS, 512, (const GAS bf16_t*)(ws + WS_BTS) + (size_t)j * 64 * 256 * 256, 256, 256); GMODE(g);
                  EpiScan E{UgS, (const GAS float*)(ws + TAB_LAMT), inp(lds, 2), inp(lds, 3), (GAS float*)ldsptr(lds, 30) + (size_t)M * D, (GAS float*)ldsptr(lds, 30) + (size_t)M * D + 32 * 2 * 2 * 64 * 64, j};
                  gemm_phase<EpiScan, ARowMajor, SsmOrder>(lds, g, S, E, wave); }
                asm volatile("s_waitcnt vmcnt(0)" ::: "memory"); __syncthreads(); __builtin_amdgcn_fence(__ATOMIC_ACQUIRE, "agent"); asm volatile("s_waitcnt vmcnt(0)" ::: "memory"); __syncthreads();
                { Gemm g = gemm_rowmajor(UgS, 512, (const GAS bf16_t*)(ws + WS_BTY) + (size_t)j * 64 * 256 * 512, 512, 512); GMODE(g);
                  EpiY E{Zg}; gemm_phase<EpiY, ARowMajor, SsmOrder>(lds, g, S, E, wave); }
                if (layer == 0 && bx >= 192) { SIDE_IDS(); convert_items(lds, ws, scr, IT_GO, I_GO + I_CI + I_CO, swv, snw, lane);
                    const GAS float* s_ = inp(lds, 23); GAS bf16_t* d_ = (GAS bf16_t*)(ws + WS_GWS);
                    for (int i = (swv * 64 + lane) * 8; i < 16 * 128 * 128; i += snw * 64 * 8) { const f32x4 a0 = *(const GAS f32x4*)(s_ + i), a1 = *(const GAS f32x4*)(s_ + i + 4);
                        u32x4 o; o.x = pk2(a0[0], a0[1]); o.y = pk2(a0[2], a0[3]); o.z = pk2(a1[0], a1[1]); o.w = pk2(a1[2], a1[3]); *(GAS u32x4*)(d_ + i) = o; } } }
            SEAM();
            if (IN_PH) { PH_PTRS(); PH_LAYER(); Gemm g = gemm_groupchunk(Zg, (const GAS bf16_t*)(ws + WS_SWOUT) + (size_t)j * D * 2048, D, D); GMODE(g); StaticOrder S; S.init(M, 2048, G, bx);
                fill_tables_res<128>(lds, S, modl + 2 * 1024, gsB + layer * 5 * 1024, tid); EpiRes<true> E{X, XN, rs_ffn, true}; gemm_phase<EpiRes<true>, AGroupChunk, StaticOrder>(lds, g, S, E, wave); }
            SEAM();
        } else if (kind == 1) {
            if (IN_PH) { PH_PTRS(); PH_LAYER(); Gemm g = gemm_rowmajor(XN, D, (const GAS bf16_t*)(ws + WS_GWIN), D, D); GMODE(g); StaticOrder S; S.init(M, 4096, G, bx);
                fill_tables_in(lds, S, rs_mix, swA + layer * 5 * 4096, 4096, tid); EpiIn<2, 4096> E{Hb, vstat}; gemm_phase<EpiIn<2, 4096>, ARowMajor, StaticOrder>(lds, g, S, E, wave); }
            SEAM();
            if (IN_PH) { PH_PTRS(); PH_LAYER();
                const GAS bf16_t* Wsb = (const GAS bf16_t*)(ws + WS_GWS); const GAS float* b_s = inp(lds, 24);
                constexpr int VST = 288;
                LAS f32x2* mr = (LAS f32x2*)(lds + 128 * VST);
                __syncthreads();
                { int ui = 0;
                  for (int unit = vcu; unit < 96 * 16; unit += G, ++ui) { const int row = tid >> 2, part = tid & 3;
                    const GAS f32x4* p = (const GAS f32x4*)(vstat + (size_t)((unit >> 4) * 128 + row) * 128) + part * 8; float s1 = 0.f, s2 = 0.f;
#pragma unroll
                    for (int q = 0; q < 8; ++q) { const f32x4 v = p[q]; s1 += v[0] + v[2]; s2 += v[1] + v[3]; }
                    s1 += __shfl_xor(s1, 1); s2 += __shfl_xor(s2, 1); s1 += __shfl_xor(s1, 2); s2 += __shfl_xor(s2, 2);
                    const float mu = s1 * (1.0f / 2048.0f), var = s2 * (1.0f / 2048.0f) - mu * mu; if (part == 0) mr[ui * 128 + row] = (f32x2){mu, rsq_f(fmaxf(var, 0.f) + EPS)}; } }
                u32x4 vr[4] = {(u32x4){0u, 0u, 0u, 0u}, (u32x4){0u, 0u, 0u, 0u}, (u32x4){0u, 0u, 0u, 0u}, (u32x4){0u, 0u, 0u, 0u}};
                if (vcu < 96 * 16) {
#pragma unroll
                    for (int i = 0; i < 4; ++i) { const int pc = tid + 512 * i, q = pc >> 4, d8 = pc & 15; vr[i] = *(const GAS u32x4*)(Hb + (size_t)((vcu >> 4) * 128 + q) * 4096 + 2048 + (vcu & 15) * 128 + d8 * 8); } }
                int ui = 0;
                for (int unit = vcu; unit < 96 * 16; unit += G, ++ui) {
                    const int c = unit >> 4, g = unit & 15, row0 = c * 128;
                    __syncthreads();
#pragma unroll
                    for (int i = 0; i < 4; ++i) { const int pc = tid + 512 * i, q = pc >> 4, d8 = pc & 15;
                        const u32x4 w = vr[i];
                        const f32x2 st = mr[ui * 128 + q]; const float mu = st[0], rstd = st[1];
                        u32x4 o; o.x = cvt_pk_bf16((bf_lo(w.x) - mu) * rstd, (bf_hi(w.x) - mu) * rstd); o.y = cvt_pk_bf16((bf_lo(w.y) - mu) * rstd, (bf_hi(w.y) - mu) * rstd);
                        o.z = cvt_pk_bf16((bf_lo(w.z) - mu) * rstd, (bf_hi(w.z) - mu) * rstd); o.w = cvt_pk_bf16((bf_lo(w.w) - mu) * rstd, (bf_hi(w.w) - mu) * rstd);
                        *(LAS u32x4*)(lds + q * VST + d8 * 16) = o; }
                    __syncthreads();
                    if (unit + G < 96 * 16) { const int un = unit + G;
#pragma unroll
                        for (int i = 0; i < 4; ++i) { const int pc = tid + 512 * i, q = pc >> 4, d8 = pc & 15; vr[i] = *(const GAS u32x4*)(Hb + (size_t)((un >> 4) * 128 + q) * 4096 + 2048 + (un & 15) * 128 + d8 * 8); } }
                    f32x4 acc[8];
#pragma unroll
                    for (int nt = 0; nt < 8; ++nt) acc[nt] = (f32x4){0.f, 0.f, 0.f, 0.f};
                    const int fr = lane & 15, fq = lane >> 4;
#pragma unroll
                    for (int kk = 0; kk < 4; ++kk) {
                        const bf16x8 wf = *(const GAS bf16x8*)(Wsb + ((size_t)g * 128 + wave * 16 + fr) * 128 + kk * 32 + fq * 8);
#pragma unroll
                        for (int nt = 0; nt < 8; ++nt) {
                            const LAS unsigned char* p0 = lds + (kk * 32 + fq * 8 + (fr >> 2)) * VST + (nt * 16 + 4 * (fr & 3)) * 2;
                            const s16x4 lo4 = __builtin_bit_cast(s16x4, __builtin_amdgcn_ds_read_tr16_b64_v4i16((LAS s16x4*)p0));
                            const s16x4 hi4 = __builtin_bit_cast(s16x4, __builtin_amdgcn_ds_read_tr16_b64_v4i16((LAS s16x4*)(p0 + 4 * VST)));
                            const bf16x8 vf = {lo4[0], lo4[1], lo4[2], lo4[3], hi4[0], hi4[1], hi4[2], hi4[3]};
                            acc[nt] = __builtin_amdgcn_mfma_f32_16x16x32_bf16(vf, wf, acc[nt], 0, 0, 0);
                        }
                    }
                    const int p = wave * 16 + fr, row = row0 + p; const float bs = b_s[g * 128 + p];
#pragma unroll
                    for (int nt = 0; nt < 8; ++nt) { const int ch = g * 128 + nt * 16 + 4 * fq;
                        const u32x2 uu = *(const GAS u32x2*)(Hb + (size_t)row * 4096 + ch);
                        u32x2 o; o.x = cvt_pk_bf16(bf_lo(uu.x) * (acc[nt][0] + bs), bf_hi(uu.x) * (acc[nt][1] + bs)); o.y = cvt_pk_bf16(bf_lo(uu.y) * (acc[nt][2] + bs), bf_hi(uu.y) * (acc[nt][3] + bs));
                        *(GAS u32x2*)(A2 + (size_t)row * 2048 + ch) = o; }
                }
                __syncthreads();
            }
            SEAM();
            if (IN_PH) { PH_PTRS(); PH_LAYER(); Gemm g = gemm_rowmajor(A2, 2048, (const GAS bf16_t*)(ws + WS_GWOUT), 2048, 2048); GMODE(g); StaticOrder S; S.init(M, D, G, bx);
                fill_tables_res<256>(lds, S, modl + 2 * 1024, gsB + layer * 5 * 1024, tid); EpiRes<false> E{X, XN, rs_ffn, true}; gemm_phase<EpiRes<false>, ARowMajor, StaticOrder>(lds, g, S, E, wave);
                if (bx >= 192) { SIDE_IDS(); sw_ffn_job(ws, mods, 1, swv, snw, lane); convert_items(lds, ws, scr, IT_W1 + 2 * I_W1, I_W1, swv, snw, lane); ssm_build(args, 1, bx - 192, 1, lds, ws, tid); } }
            SEAM();
        } else {
            if (IN_PH) { PH_PTRS(); PH_LAYER(); Gemm g = gemm_rowmajor(XN, D, (const GAS bf16_t*)(ws + WS_CWIN), D, D); GMODE(g); StaticOrder S; S.init(M, 3072, G, bx);
                fill_tables_in(lds, S, rs_mix, swA + layer * 5 * 4096, 3072, tid); EpiIn<0, 3072> E{Hb, nullptr}; gemm_phase<EpiIn<0, 3072>, ARowMajor, StaticOrder>(lds, g, S, E, wave); }
            SEAM();
            if (IN_PH) { PH_PTRS(); PH_LAYER();
                const GAS float* cw = inp(lds, 27);
                for (int it = gw * 64 + lane; it < M * 128; it += NGW * 64) {
                    const int row = it >> 7, c8 = (it & 127) * 8;
                    const int L = row < MP ? 256 : 1024, t = row < MP ? (row & 255) : ((row - MP) & 1023);
                    const GAS bf16_t* pr = Hb + (size_t)row * 3072 + c8;
                    float y[8];
#pragma unroll
                    for (int q = 0; q < 8; ++q) y[q] = 0.f;
#pragma unroll
                    for (int w = 0; w < 3; ++w) { const int tt = t + w - 1; if (tt < 0 || tt >= L) continue;
                        const u32x4 gc = *(const GAS u32x4*)(pr + (ptrdiff_t)(w - 1) * 3072 + 1024), xh = *(const GAS u32x4*)(pr + (ptrdiff_t)(w - 1) * 3072 + 2048);
                        const f32x4 k0 = *(const GAS f32x4*)(cw + w * 1024 + c8), k1 = *(const GAS f32x4*)(cw + w * 1024 + c8 + 4);
                        y[0] += k0[0] * bf_lo(gc.x) * bf_lo(xh.x); y[1] += k0[1] * bf_hi(gc.x) * bf_hi(xh.x); y[2] += k0[2] * bf_lo(gc.y) * bf_lo(xh.y); y[3] += k0[3] * bf_hi(gc.y) * bf_hi(xh.y);
                        y[4] += k1[0] * bf_lo(gc.z) * bf_lo(xh.z); y[5] += k1[1] * bf_hi(gc.z) * bf_hi(xh.z); y[6] += k1[2] * bf_lo(gc.w) * bf_lo(xh.w); y[7] += k1[3] * bf_hi(gc.w) * bf_hi(xh.w); }
                    const u32x4 gb = *(const GAS u32x4*)pr;
                    u32x4 o; o.x = cvt_pk_bf16(bf_lo(gb.x) * y[0], bf_hi(gb.x) * y[1]); o.y = cvt_pk_bf16(bf_lo(gb.y) * y[2], bf_hi(gb.y) * y[3]);
                    o.z = cvt_pk_bf16(bf_lo(gb.z) * y[4], bf_hi(gb.z) * y[5]); o.w = cvt_pk_bf16(bf_lo(gb.w) * y[6], bf_hi(gb.w) * y[7]);
                    *(GAS u32x4*)(A2 + (size_t)row * D + c8) = o;
                }
            }
            SEAM();
            if (IN_PH) { PH_PTRS(); PH_LAYER(); Gemm g = gemm_rowmajor(A2, D, (const GAS bf16_t*)(ws + WS_CWOUT), D, D); GMODE(g); StaticOrder S; S.init(M, D, G, bx);
                fill_tables_res<256>(lds, S, modl + 2 * 1024, gsB + layer * 5 * 1024, tid); EpiRes<false> E{X, XN, rs_ffn, true}; gemm_phase<EpiRes<false>, ARowMajor, StaticOrder>(lds, g, S, E, wave); }
            SEAM();
        }
        if (IN_PH) { PH_PTRS(); PH_LAYER(); Gemm g = gemm_rowmajor(XN, D, (const GAS bf16_t*)(ws + WS_W1) + (size_t)layer * D * FF, D, D); GMODE(g); StaticOrder S; S.init(M, FF, G, bx);
            fill_tables_in(lds, S, rs_ffn, swB + layer * 5 * 4096, 4096, tid); EpiIn<1, 4096> E{Hb, nullptr}; gemm_phase<EpiIn<1, 4096>, ARowMajor, StaticOrder>(lds, g, S, E, wave); }
        SEAM();
        if (IN_PH) { PH_PTRS(); PH_LAYER(); Gemm g = gemm_rowmajor(Hb, FF, (const GAS bf16_t*)(ws + WS_W2) + (size_t)layer * D * FF, FF, FF); GMODE(g); StaticOrder S; S.init(M, D, G, bx);
            fill_tables_res<256>(lds, S, modl + 5 * 1024, layer < 3 ? gsA + (layer + 1) * 5 * 1024 : (const GAS float*)nullptr, tid); EpiRes<false> E{X, XN, rs_next, layer < 3}; gemm_phase<EpiRes<false>, ARowMajor, StaticOrder>(lds, g, S, E, wave);
            if (layer < 3 && bx >= 192) { SIDE_IDS();
                if (layer == 0) { convert_items(lds, ws, scr, IT_W1 + 1 * I_W1, I_W1, swv, snw, lane); convert_items(lds, ws, scr, IT_W2 + 1 * I_W2, I_W2, swv, snw, lane); sw_mix_job(ws, mods, 1, swv, snw, lane); }
                else if (layer == 1) { convert_items(lds, ws, scr, IT_W2 + 2 * I_W2, I_W2, swv, snw, lane); convert_items(lds, ws, scr, IT_SI + I_SI, I_SI, swv, snw, lane); convert_items(lds, ws, scr, IT_SO + I_SO, I_SO, swv, snw, lane);
                    sw_mix_job(ws, mods, 2, swv, snw, lane); sw_ffn_job(ws, mods, 2, swv, snw, lane); }
                else { ssm_build(args, 1, bx - 192, 0, lds, ws, tid);
                    convert_items(lds, ws, scr, IT_W1 + 3 * I_W1, I_W1, swv, snw, lane); convert_items(lds, ws, scr, IT_W2 + 3 * I_W2, I_W2, swv, snw, lane); sw_mix_job(ws, mods, 3, swv, snw, lane); } } }
        SEAM();
    }
    if (IN_PH) { PH_PTRS();
        const GAS float* gf = inp(lds, 29);
        GAS float* Y = (GAS float*)ldsptr(lds, 30);
        for (int row = gw; row < M; row += 3 * NGW) {
            f32x4 v[3][4];
#pragma unroll
            for (int rr = 0; rr < 3; ++rr)
#pragma unroll
                for (int q = 0; q < 4; ++q) v[rr][q] = __builtin_convertvector(((const GAS h16x4*)(X + (size_t)(row + rr * NGW) * D) + lane)[64 * q], f32x4);
            f32x4 gq[4];
#pragma unroll
            for (int q = 0; q < 4; ++q) gq[q] = *(const GAS f32x4*)(gf + 256 * q + 4 * lane);
#pragma unroll
            for (int rr = 0; rr < 3; ++rr) { float t = 0.f;
#pragma unroll
                for (int q = 0; q < 4; ++q) t += (v[rr][q][0] * v[rr][q][0] + v[rr][q][1] * v[rr][q][1]) + (v[rr][q][2] * v[rr][q][2] + v[rr][q][3] * v[rr][q][3]);
                t = wave_sum(t); const float r0 = rsq_f(t * (1.0f / D) + EPS);
                GAS f32x4* yr = (GAS f32x4*)(Y + (size_t)(row + rr * NGW) * D) + lane;
#pragma unroll
                for (int q = 0; q < 4; ++q) yr[64 * q] = v[rr][q] * r0 * gq[q]; }
        }
    }
    ++ph;
#undef IN_PH
#undef SEAM
}

static bool launch(void* const* d_in, float* out, unsigned char* ws, int lo, int hi, hipStream_t stream, int mode = 0) {
    static int grid = 0;
    if (grid == 0) {
        int dev = 0, cus = 0, per_cu = 0;
        if (hipGetDevice(&dev) != hipSuccess || hipDeviceGetAttribute(&cus, hipDeviceAttributeMultiprocessorCount, dev) != hipSuccess) { grid = -1; return false; }
        if (hipFuncSetAttribute((const void*)fwd, hipFuncAttributeMaxDynamicSharedMemorySize, LDS_BYTES) != hipSuccess) { fprintf(stderr, "hipFuncSetAttribute failed\n"); grid = -1; return false; }
        if (hipOccupancyMaxActiveBlocksPerMultiprocessor(&per_cu, (const void*)fwd, 512, LDS_BYTES) != hipSuccess || per_cu < 1) { fprintf(stderr, "occupancy query: %d\n", per_cu); (void)hipGetLastError(); per_cu = 1; }
        grid = cus;
    }
    if (grid < 0) return false;
    Args a{};
    for (int i = 0; i < 30; ++i) a.in[i] = (const float*)d_in[i];
    a.out = out; a.ws = ws; a.ph_lo = lo; a.ph_hi = hi; a.mode = mode;
    void* kargs[] = {&a};
    const hipError_t e = hipLaunchCooperativeKernel((const void*)fwd, dim3(grid), dim3(512), kargs, LDS_BYTES, stream);
    if (e != hipSuccess) { fprintf(stderr, "cooperative launch failed: %s (grid %d)\n", hipGetErrorString(e), grid); return false; }
    return true;
}
}
extern "C" void kernel_launch(void* const* d_in, const int* in_sizes, int n_in, void* d_out, int out_size, void* d_ws, size_t ws_size, hipStream_t stream) {
    if (n_in != 30 || ws_size < mk::WS_END) { fprintf(stderr, "kernel_launch: unexpected n_in %d / ws %zu\n", n_in, ws_size); return; }
    (void)hipMemsetAsync((char*)d_ws + mk::WS_CTL, 0, mk::CTL_BYTES, stream);
    mk::launch(d_in, (float*)d_out, (unsigned char*)d_ws, 0, 23, stream);
}
```

```cpp
#include <hip/hip_runtime.h>
#include <cstdio>
#include <cstdint>
#include <hip/hip_cooperative_groups.h>
namespace mk {
namespace cg = cooperative_groups;
#define LAS __attribute__((address_space(3)))
#define GAS __attribute__((address_space(1)))
typedef unsigned short bf16_t;
typedef short bf16x8 __attribute__((ext_vector_type(8)));
typedef short s16x4 __attribute__((ext_vector_type(4)));
typedef float f32x4 __attribute__((ext_vector_type(4)));
typedef float f32x2 __attribute__((ext_vector_type(2)));
typedef unsigned u32x4 __attribute__((ext_vector_type(4)));
typedef unsigned u32x2 __attribute__((ext_vector_type(2)));
typedef _Float16 h16_t;
typedef _Float16 h16x4 __attribute__((ext_vector_type(4)));
typedef _Float16 h16x8 __attribute__((ext_vector_type(8)));
typedef float f32x8 __attribute__((ext_vector_type(8)));

constexpr int D = 1024, M = 12288, MP = 8192, FF = 4096, NCH = 768;
constexpr float EPS = 1e-6f;
constexpr int BM = 256, BK = 64, HALF = 128, HTB = HALF * BK * 2, STAGE_BYTES = 8 * HTB, NXCD = 8, WGM = 8;

typedef __bf16 bf16x2_t __attribute__((ext_vector_type(2)));
__device__ __forceinline__ unsigned cvt_pk_bf16(float lo, float hi) { const f32x2 v = {lo, hi}; const bf16x2_t b = __builtin_convertvector(v, bf16x2_t); return __builtin_bit_cast(unsigned, b); }
__device__ __forceinline__ unsigned f2bf(float f) { unsigned u = __builtin_bit_cast(unsigned, f); return (u + 0x7fffu + ((u >> 16) & 1u)) >> 16; }
__device__ __forceinline__ float bf_lo(unsigned w) { return __uint_as_float(w << 16); }
__device__ __forceinline__ float bf_hi(unsigned w) { return __uint_as_float(w & 0xffff0000u); }
__device__ __forceinline__ float rcp_f(float x) { return __builtin_amdgcn_rcpf(x); }
__device__ __forceinline__ float rsq_f(float x) { return __builtin_amdgcn_rsqf(x); }
__device__ __forceinline__ float gelu_tanh(float x) {
    const float t = x * x * (0.044715f * -2.0f * 0.7978845608028654f * 1.4426950408889634f) + (-2.0f * 0.7978845608028654f * 1.4426950408889634f);
    return x * rcp_f(1.0f + __builtin_amdgcn_exp2f(x * t));
}
__device__ __forceinline__ float sigmoid_f(float x) { return rcp_f(1.0f + __builtin_amdgcn_exp2f(x * -1.4426950408889634f)); }
__device__ __forceinline__ int lane_id() { int r; asm volatile("v_mbcnt_lo_u32_b32 %0, -1, 0\n\tv_mbcnt_hi_u32_b32 %0, -1, %0" : "=v"(r)); return r; }
__device__ __forceinline__ int cond_of_pm(int pm) { return pm < 32 ? 0 : 1 + ((pm - 32) >> 2); }
__device__ __forceinline__ int cond_of_row(int row) { return row < MP ? 0 : 1 + ((row - MP) >> 10); }

__host__ __device__ __forceinline__ int lds_byte(int r, int c) { const int st = (r >> 4) * 2 + (c >> 5), rr = r & 15, cc = c & 31, ob = rr * 64 + cc * 2; return st * 1024 + (ob ^ (((ob >> 9) & 1) << 5)); }
__host__ __device__ __forceinline__ void stage_rc(int b, int& R, int& C) { const int st = b / 1024, sb = b % 1024, swz = sb ^ (((sb >> 9) & 1) << 5); R = (st >> 1) * 16 + swz / 64; C = (st & 1) * 32 + (swz % 64) / 2; }
__host__ __device__ __forceinline__ int perm32(int rho) { const int n = rho >> 4, i = rho & 15; return 8 * (i >> 2) + 4 * n + (i & 3); }

struct Unit { int pm, pn; };
struct Gemm { const GAS char* A; const GAS char* Bt; int K; int lda; int ldb; size_t kstepA, hstepA, tstepA; int mode; };
struct ARowMajor { static __device__ __forceinline__ unsigned voff(int R, int C, int lda) { return (unsigned)(R * lda + C) * 2u; } };
struct AGroupChunk { static __device__ __forceinline__ unsigned voff(int R, int C, int) { return (unsigned)((((C >> 4) * NCH + (R >> 4)) * 256) + (R & 15) * 16 + (C & 15)) * 2u; } };
__device__ inline Gemm gemm_rowmajor(const GAS void* A, int lda, const GAS void* Bt, int ldb, int K) {
    Gemm g; g.A = (const GAS char*)A; g.Bt = (const GAS char*)Bt; g.K = K; g.lda = lda; g.ldb = ldb; g.kstepA = BK * 2; g.hstepA = (size_t)HALF * lda * 2; g.tstepA = 2 * g.hstepA; g.mode = 0; return g; }
__device__ inline Gemm gemm_groupchunk(const GAS void* A, const GAS void* Bt, int ldb, int K) {
    Gemm g; g.A = (const GAS char*)A; g.Bt = (const GAS char*)Bt; g.K = K; g.lda = 0; g.ldb = ldb; g.kstepA = (size_t)4 * NCH * 256 * 2; g.hstepA = 8 * 256 * 2; g.tstepA = 16 * 256 * 2; g.mode = 0; return g; }

struct StaticOrder {
    int nM, nN, nwg, G, c;
    __host__ __device__ void init(int M_, int N_, int G_, int c_) { nM = M_ / BM; nN = N_ / BM; nwg = nM * nN; G = G_; c = c_; }
    __host__ __device__ bool next(int i, Unit& u) const {
        const long L = (long)i * G + c; if (L >= nwg) return false;
        int wgid = (int)L; { const int q = nwg / NXCD, r = nwg % NXCD, xcd = wgid % NXCD, off = wgid / NXCD; wgid = (xcd < r ? xcd * (q + 1) : r * (q + 1) + (xcd - r) * q) + off; }
        const int nig = WGM * nN, gid = wgid / nig, fm = gid * WGM, gsz = (nM - fm) < WGM ? (nM - fm) : WGM;
        u.pm = fm + ((wgid % nig) % gsz); u.pn = (wgid % nig) / gsz; return true;
    }
};
__host__ __device__ __forceinline__ int panel_of(int vx, int pl) { return vx < 4 ? (pl < 4 ? 32 + 4 * vx + pl : 2 * vx + (pl - 4)) : 8 + 6 * (vx - 4) + pl; }
struct OwnerOrder {
    int nN, vx, rank;
    __host__ __device__ bool next(int i, Unit& u) const { const int L = i * 32 + rank; if (L >= 6 * nN) return false; u.pm = panel_of(vx, L % 6); u.pn = L / 6; return true; }
};
struct SsmOrder {
    int G, c;
    __host__ __device__ bool next(int i, Unit& u) const { const int L = i * G + c; if (L >= 192) return false; u.pm = L; u.pn = L / 3; return true; }
};

template <class Epi, class AL, class Sched>
__device__ __forceinline__ void gemm_phase(LAS unsigned char* lds, const Gemm g, const Sched& S, const Epi& E, int wave_) {
    int tid = wave_ * 64 + lane_id(); asm volatile("" : "+v"(tid));
    const int wid = __builtin_amdgcn_readfirstlane(tid >> 6), lane = tid & 63, wr = wid >> 2, wc = wid & 3, fr = lane & 15, fq = lane >> 4;
    const int K = g.K, nt = K / BK;
    unsigned voffA[2], voffB[2];
#pragma unroll
    for (int i = 0; i < 2; ++i) { int R, C; stage_rc(tid * 16 + i * 8192, R, C); const int Rb = Epi::PERM ? ((R & ~31) + perm32(R & 31)) : R;
        voffA[i] = AL::voff(R, C, g.lda); voffB[i] = (unsigned)(Rb * g.ldb + C) * 2u; }
    const size_t kstepA = g.kstepA, hstepA = g.hstepA, tstepA = g.tstepA;
    const size_t kstepB = (size_t)(BK * 2), hstepB = (size_t)HALF * g.ldb * 2, tstepB = 2 * hstepB;
    const unsigned ldsw = (unsigned)wid * 1024u;
    const int aoff = lds_byte(wr * 64 + fr, fq * 8), boff = lds_byte(wc * 32 + fr, fq * 8);
#define PG8_SA(b, h) (((b) * 2 + (h)) * HTB)
#define PG8_SB(b, h) ((4 + (b) * 2 + (h)) * HTB)
#define PG8_STAGE(bufoff, gbase, voff) do { _Pragma("unroll") for (int _i = 0; _i < 2; ++_i) \
        __builtin_amdgcn_global_load_lds((const GAS unsigned*)((const GAS char*)(gbase) + (voff)[_i]), (LAS unsigned*)(lds + (bufoff) + ldsw + _i * 8192), 16, 0, 0); } while (0)
#define PG8_LDA(dst, b, h) do { _Pragma("unroll") for (int m = 0; m < 4; ++m) _Pragma("unroll") for (int k = 0; k < 2; ++k) dst[m][k] = *(const LAS bf16x8*)(lds + PG8_SA(b, h) + aoff + m * 2048 + k * 1024); } while (0)
#define PG8_LDB(dst, b, h) do { _Pragma("unroll") for (int n = 0; n < 2; ++n) _Pragma("unroll") for (int k = 0; k < 2; ++k) dst[n][k] = *(const LAS bf16x8*)(lds + PG8_SB(b, h) + boff + n * 2048 + k * 1024); } while (0)
#define PG8_MMA(ai, bj, At, Bt) do { __builtin_amdgcn_s_setprio(1); _Pragma("unroll") for (int m = 0; m < 4; ++m) _Pragma("unroll") for (int n = 0; n < 2; ++n) _Pragma("unroll") for (int k = 0; k < 2; ++k) \
        acc[ai][bj][m][n] = __builtin_amdgcn_mfma_f32_16x16x32_bf16(Bt[n][k], At[m][k], acc[ai][bj][m][n], 0, 0, 0); __builtin_amdgcn_s_setprio(0); } while (0)
#define PG8_WAIT_V(n) asm volatile("s_waitcnt vmcnt(" #n ")" ::: "memory")
#define PG8_WAIT_L(n) asm volatile("s_waitcnt lgkmcnt(" #n ")" ::: "memory")
#define PG8_BAR __builtin_amdgcn_s_barrier()
#define PG8_SCHED __builtin_amdgcn_sched_barrier(0)
    Unit cur, nxt; int ui = 0;
    if (!S.next(0, cur)) return;
    f32x4 acc[2][2][4][2];
#pragma unroll
    for (int a = 0; a < 2; ++a)
#pragma unroll
        for (int b = 0; b < 2; ++b)
#pragma unroll
            for (int m = 0; m < 4; ++m)
#pragma unroll
                for (int n = 0; n < 2; ++n) acc[a][b][m][n] = (f32x4){0.f, 0.f, 0.f, 0.f};
    bf16x8 At[4][2], B0[2][2], B1[2][2];
    const GAS char* cA = g.A + (size_t)cur.pm * tstepA; const GAS char* cB = g.Bt + (size_t)cur.pn * tstepB;
    PG8_STAGE(PG8_SB(0, 0), cB, voffB); PG8_STAGE(PG8_SB(0, 1), cB + hstepB, voffB); PG8_STAGE(PG8_SA(0, 0), cA, voffA); PG8_STAGE(PG8_SA(0, 1), cA + hstepA, voffA);
    if (wr == 1) PG8_BAR;
    PG8_WAIT_V(2); PG8_BAR;
    PG8_STAGE(PG8_SB(1, 0), cB + kstepB, voffB); PG8_STAGE(PG8_SA(1, 0), cA + kstepA, voffA); PG8_STAGE(PG8_SB(1, 1), cB + hstepB + kstepB, voffB);
    PG8_WAIT_V(6); PG8_BAR;
    for (;;) {
        const bool has_next = S.next(ui + 1, nxt);
        const GAS char* nA = has_next ? g.A + (size_t)nxt.pm * tstepA : cA; const GAS char* nB = has_next ? g.Bt + (size_t)nxt.pn * tstepB : cB;
        for (int t = 0; t < nt; t += 2) {
            const bool last = (t == nt - 2);
            const GAS char* a1 = cA + (size_t)(t + 1) * kstepA;
            const GAS char* a2 = last ? nA : cA + (size_t)(t + 2) * kstepA; const GAS char* b2 = last ? nB : cB + (size_t)(t + 2) * kstepB;
            const GAS char* a3 = a2 + kstepA; const GAS char* b3 = b2 + kstepB;
            PG8_LDB(B0, 0, 0); PG8_LDB(B1, 0, 1); PG8_SCHED; PG8_LDA(At, 0, 0); PG8_STAGE(PG8_SA(1, 1), a1 + hstepA, voffA);
            PG8_WAIT_V(8); PG8_WAIT_L(0); PG8_BAR; PG8_MMA(0, 0, At, B0); PG8_MMA(0, 1, At, B1); PG8_BAR; PG8_SCHED;
            PG8_LDA(At, 0, 1); PG8_STAGE(PG8_SB(0, 0), b2, voffB); PG8_STAGE(PG8_SB(0, 1), b2 + hstepB, voffB); PG8_STAGE(PG8_SA(0, 0), a2, voffA);
            PG8_WAIT_V(8); PG8_WAIT_L(0); PG8_BAR; PG8_MMA(1, 0, At, B0); PG8_MMA(1, 1, At, B1); PG8_BAR; PG8_SCHED;
            PG8_LDB(B0, 1, 0); PG8_LDB(B1, 1, 1); PG8_SCHED; PG8_LDA(At, 1, 0); PG8_STAGE(PG8_SA(0, 1), a2 + hstepA, voffA);
            PG8_WAIT_V(8); PG8_WAIT_L(0); PG8_BAR; PG8_MMA(0, 0, At, B0); PG8_MMA(0, 1, At, B1); PG8_BAR; PG8_SCHED;
            PG8_LDA(At, 1, 1); PG8_STAGE(PG8_SB(1, 0), b3, voffB); PG8_STAGE(PG8_SB(1, 1), b3 + hstepB, voffB); PG8_STAGE(PG8_SA(1, 0), a3, voffA);
            PG8_WAIT_V(8); PG8_WAIT_L(0); PG8_BAR; PG8_MMA(1, 0, At, B0); PG8_MMA(1, 1, At, B1); PG8_BAR; PG8_SCHED;
        }
        if (wr == 0) PG8_BAR;
        int el_ = lane_id(); asm volatile("" : "+v"(el_));
        const int efr = el_ & 15, efq = el_ >> 4;
#ifdef MK_RANGE
        if constexpr (!Epi::AFTER_DRAIN) { if (g.mode != 1) E(acc, cur, ui, lds, wr, wc, efr, efq); else { asm volatile("" :: "v"(acc[0][0][0][0]), "v"(acc[1][1][3][1])); } }
#else
        if constexpr (!Epi::AFTER_DRAIN) E(acc, cur, ui, lds, wr, wc, efr, efq);
#endif
        if (!has_next) break;
#pragma unroll
        for (int a = 0; a < 2; ++a)
#pragma unroll
            for (int b = 0; b < 2; ++b)
#pragma unroll
                for (int m = 0; m < 4; ++m)
#pragma unroll
                    for (int n = 0; n < 2; ++n) acc[a][b][m][n] = (f32x4){0.f, 0.f, 0.f, 0.f};
        cur = nxt; cA = nA; cB = nB; ++ui;
        if (wr == 1) PG8_BAR;
    }
    PG8_WAIT_V(0);
    PG8_BAR;
    if constexpr (Epi::AFTER_DRAIN) E.fused(acc, cur, wr, wc, fr, fq, lds, tid);
#undef PG8_SA
#undef PG8_SB
#undef PG8_STAGE
#undef PG8_LDA
#undef PG8_LDB
#undef PG8_MMA
#undef PG8_WAIT_V
#undef PG8_WAIT_L
#undef PG8_BAR
#undef PG8_SCHED
}

typedef const f32x4 (&AccRef)[2][2][4][2];

constexpr int PTR_OFF = STAGE_BYTES + 256 + 10240;
__device__ __forceinline__ unsigned long long ldsptr(const LAS unsigned char* lds, int k) { const unsigned long long v = ((const LAS unsigned long long*)(lds + PTR_OFF))[k];
    return ((unsigned long long)(unsigned)__builtin_amdgcn_readfirstlane((int)(unsigned)(v >> 32)) << 32) | (unsigned)__builtin_amdgcn_readfirstlane((int)(unsigned)v); }
__device__ __forceinline__ const GAS float* inp(const LAS unsigned char* lds, int k) { return (const GAS float*)ldsptr(lds, k); }
constexpr int TAB_OFF = STAGE_BYTES + 256, T_RS = TAB_OFF, T_SW = T_RS + 3072, T_GATE = T_SW + 3072, T_GSN = T_GATE + 2048;
template <class Sched> __device__ __forceinline__ void fill_tables_in(LAS unsigned char* lds, const Sched& S, const GAS float* rowss, const GAS float* sw, int swld, int tid) {
    LAS float* trs = (LAS float*)(lds + T_RS); LAS float* tsw = (LAS float*)(lds + T_SW);
#pragma unroll 1
    for (int i = 0; i < 3; ++i) { Unit u; if (!S.next(i, u)) break;
        if (tid < 256) { const GAS f32x4* p = (const GAS f32x4*)(rowss + (size_t)(u.pm * BM + tid) * 32);
            const f32x4 a = ((p[0] + p[1]) + (p[2] + p[3])) + ((p[4] + p[5]) + (p[6] + p[7]));
            trs[i * 256 + tid] = rsq_f(((a[0] + a[1]) + (a[2] + a[3])) * (1.0f / D) + EPS); }
        else tsw[i * 256 + tid - 256] = sw[(unsigned)(cond_of_pm(u.pm) * swld + u.pn * BM + tid - 256)];
    }
    __syncthreads();
}
template <int NCOL, class Sched> __device__ __forceinline__ void fill_tables_res(LAS unsigned char* lds, const Sched& S, const GAS float* gate, const GAS float* gsn, int tid) {
    LAS float* tg = (LAS float*)(lds + T_GATE); LAS float* tn = (LAS float*)(lds + T_GSN);
#pragma unroll 1
    for (int i = 0; i < 2; ++i) { Unit u; if (!S.next(i, u)) break; const int ci = cond_of_pm(u.pm);
        if (tid < NCOL) tg[i * 256 + tid] = gate[(unsigned)(ci * 6144 + u.pn * NCOL + tid)];
        else if (tid >= 256 && tid < 256 + NCOL) tn[i * 256 + tid - 256] = gsn ? gsn[(unsigned)(ci * 1024 + u.pn * NCOL + tid - 256)] : 0.f;
    }
    __syncthreads();
}
__device__ __forceinline__ void load_rstd(const LAS unsigned char* lds, int ui, int wr, int fr, float (&rs)[2][4]) {
    const LAS float* trs = (const LAS float*)(lds + T_RS) + ui * 256 + wr * 64 + fr;
#pragma unroll
    for (int ai = 0; ai < 2; ++ai)
#pragma unroll
        for (int m = 0; m < 4; ++m) rs[ai][m] = trs[ai * HALF + m * 16];
}

template <int ACT, int LDC> struct EpiIn {
    static constexpr bool PERM = true, AFTER_DRAIN = false;
    GAS bf16_t* O; GAS float* vstat;
    __device__ __forceinline__ void operator()(AccRef acc, const Unit& u, int ui, const LAS unsigned char* lds, int wr, int wc, int fr, int fq) const {
        const int row0 = u.pm * BM + wr * 64 + fr, col0 = u.pn * BM + wc * 32 + 8 * fq;
        float rs[2][4]; load_rstd(lds, ui, wr, fr, rs);
        const LAS float* swp = (const LAS float*)(lds + T_SW) + ui * 256 + wc * 32 + 8 * fq;
        const bool stats = ACT == 2 && u.pn >= 8;
#pragma unroll
        for (int bj = 0; bj < 2; ++bj) {
            const f32x4 b0 = *(const LAS f32x4*)(swp + bj * HALF), b1 = *(const LAS f32x4*)(swp + bj * HALF + 4);
#pragma unroll
            for (int ai = 0; ai < 2; ++ai)
#pragma unroll
                for (int m = 0; m < 4; ++m) {
                    const unsigned r = (unsigned)(row0 + ai * HALF + m * 16);
                    f32x4 v0 = acc[ai][bj][m][0] * rs[ai][m] + b0, v1 = acc[ai][bj][m][1] * rs[ai][m] + b1;
                    if (ACT == 1) {
#pragma unroll
                        for (int j = 0; j < 4; ++j) { const float a = fmaxf(v0[j], 0.f), b = fmaxf(v1[j], 0.f); v0[j] = a * a; v1[j] = b * b; } }
                    if (ACT == 2) {
#pragma unroll
                        for (int j = 0; j < 4; ++j) { v0[j] = gelu_tanh(v0[j]); v1[j] = gelu_tanh(v1[j]); } }
                    u32x4 w; w.x = cvt_pk_bf16(v0[0], v0[1]); w.y = cvt_pk_bf16(v0[2], v0[3]); w.z = cvt_pk_bf16(v1[0], v1[1]); w.w = cvt_pk_bf16(v1[2], v1[3]);
                    *(GAS u32x4*)(O + (r * (unsigned)LDC + (unsigned)(col0 + bj * HALF))) = w;
                    if (ACT == 2) { if (stats) {
                        float a = (v0[0] + v0[1]) + (v0[2] + v0[3]) + (v1[0] + v1[1]) + (v1[2] + v1[3]);
                        float b = (v0[0] * v0[0] + v0[1] * v0[1]) + (v0[2] * v0[2] + v0[3] * v0[3]) + (v1[0] * v1[0] + v1[1] * v1[1]) + (v1[2] * v1[2] + v1[3] * v1[3]);
                        a += __shfl_xor(a, 16); a += __shfl_xor(a, 32); b += __shfl_xor(b, 16); b += __shfl_xor(b, 32);
                        if (fq == 0) *(GAS f32x2*)(vstat + (r * 64u + (unsigned)(((u.pn - 8) * 2 + bj) * 4 + wc)) * 2u) = (f32x2){a, b}; } }
                }
        }
    }
};
struct EpiU {
    static constexpr bool PERM = true, AFTER_DRAIN = false;
    GAS bf16_t* UgS;
    __device__ __forceinline__ void operator()(AccRef acc, const Unit& u, int ui, const LAS unsigned char* lds, int wr, int wc, int fr, int fq) const {
        const int col0 = u.pn * BM + wc * 32 + 8 * fq;
        float rs[2][4]; load_rstd(lds, ui, wr, fr, rs);
        const LAS float* swp = (const LAS float*)(lds + T_SW) + ui * 256 + wc * 32 + 8 * fq;
#pragma unroll
        for (int bj = 0; bj < 2; ++bj) {
            const f32x4 b0 = *(const LAS f32x4*)(swp + bj * HALF), b1 = *(const LAS f32x4*)(swp + bj * HALF + 4);
            const int g = (col0 + bj * HALF) >> 4, p0 = (col0 & 15);
#pragma unroll
            for (int ai = 0; ai < 2; ++ai)
#pragma unroll
                for (int m = 0; m < 4; ++m) {
                    const f32x4 v0 = acc[ai][bj][m][0] * rs[ai][m] + b0, v1 = acc[ai][bj][m][1] * rs[ai][m] + b1;
                    u32x4 w; w.x = cvt_pk_bf16(v0[0], v0[1]); w.y = cvt_pk_bf16(v0[2], v0[3]); w.z = cvt_pk_bf16(v1[0], v1[1]); w.w = cvt_pk_bf16(v1[2], v1[3]);
                    const int chunk = u.pm * 16 + ai * 8 + wr * 4 + m;
                    *(GAS u32x4*)(UgS + ((unsigned)(g * NCH + chunk) * 512u + (unsigned)(fr * 16 + p0))) = w;
                }
        }
    }
};
struct EpiScan {
    static constexpr bool PERM = true, AFTER_DRAIN = true;
    GAS bf16_t* UgS; const GAS float* lamT; const GAS float* h0_re; const GAS float* h0_im; GAS float* new_re; GAS float* new_im; int j;
    static __device__ __forceinline__ int lidx(int row, int col) { return row * 128 + ((((col >> 2) ^ row) & 31) << 2) + (col & 3); }
    __device__ __forceinline__ void fused(AccRef acc, const Unit& u, int wr, int wc, int fr, int fq, LAS unsigned char* lds, int tid) const {
        LAS float* T = (LAS float*)lds;
        const int g = u.pn, mt = u.pm - 3 * g, n = tid & 63, slot = __builtin_amdgcn_readfirstlane(tid >> 6);
        const int len = mt < 2 ? 16 : 64, nsq = mt < 2 ? 2 : (slot < 4 ? 1 : 0), sl0 = mt < 2 ? slot * 2 : slot;
#pragma unroll 1
        for (int k = 0; k < 2; ++k) {
#pragma unroll
            for (int ai = 0; ai < 2; ++ai)
#pragma unroll
                for (int m = 0; m < 4; ++m) { const int row = ai * HALF + wr * 64 + m * 16 + fr;
#pragma unroll
                    for (int nn = 0; nn < 2; ++nn) { const int col = wc * 32 + 8 * fq + 4 * nn; *(LAS f32x4*)(T + lidx(row, col)) = k == 0 ? acc[ai][0][m][nn] : acc[ai][1][m][nn]; } }
            __syncthreads();
            const float lr = lamT[(((unsigned)j * 64 + g) * 2 + k) * 128 + 2 * n], li = lamT[(((unsigned)j * 64 + g) * 2 + k) * 128 + 2 * n + 1];
            for (int q = 0; q < nsq; ++q) {
                const int sl = sl0 + q, r0 = sl * len;
                float sr = 0.f, si = 0.f;
                if (mt == 2) { const unsigned o = ((((unsigned)sl * 2 + j) * 2 + k) * 64 + g) * 64 + n; sr = h0_re[o]; si = h0_im[o]; }
                GAS bf16_t* so = UgS + ((size_t)g * NCH + mt * 256) * 512 + 256 + k * 128 + n;
                for (int i = 0; i < len; ++i) {
                    const int row = k == 0 ? r0 + i : r0 + len - 1 - i;
                    so[(unsigned)row * 512u] = (bf16_t)f2bf(sr); so[(unsigned)row * 512u + 64u] = (bf16_t)f2bf(si);
                    const float ar = T[lidx(row, n)], ai2 = T[lidx(row, 64 + n)];
                    const float nr = lr * sr - li * si + ar, ni = lr * si + li * sr + ai2; sr = nr; si = ni;
                }
                if (mt < 2) { const unsigned o = ((((unsigned)(mt * 16 + sl) * 2 + j) * 2 + k) * 64 + g) * 64 + n; new_re[o] = sr; new_im[o] = si; }
            }
            __syncthreads();
        }
    }
};
struct EpiY {
    static constexpr bool PERM = true, AFTER_DRAIN = false;
    GAS bf16_t* Zg;
    __device__ __forceinline__ void operator()(AccRef acc, const Unit& u, int ui, const LAS unsigned char* lds, int wr, int wc, int fr, int fq) const {
        const int row0 = u.pm * BM + wr * 64 + fr, col0 = wc * 32 + 8 * fq;
#pragma unroll
        for (int ai = 0; ai < 2; ++ai)
#pragma unroll
            for (int m = 0; m < 4; ++m) { GAS bf16_t* rp = Zg + (size_t)(row0 + ai * HALF + m * 16) * 256 + col0;
#pragma unroll
                for (int bj = 0; bj < 2; ++bj) { const f32x4 v0 = acc[ai][bj][m][0], v1 = acc[ai][bj][m][1];
                    u32x4 w; w.x = cvt_pk_bf16(gelu_tanh(v0[0]), gelu_tanh(v0[1])); w.y = cvt_pk_bf16(gelu_tanh(v0[2]), gelu_tanh(v0[3]));
                    w.z = cvt_pk_bf16(gelu_tanh(v1[0]), gelu_tanh(v1[1])); w.w = cvt_pk_bf16(gelu_tanh(v1[2]), gelu_tanh(v1[3]));
                    *(GAS u32x4*)(rp + bj * HALF) = w; } }
    }
};
template <bool GATED> struct EpiRes {
    static constexpr bool PERM = true, AFTER_DRAIN = false;
    GAS h16_t* X; GAS bf16_t* XN; GAS float* rowss_next; bool has_next;
    __device__ __forceinline__ void operator()(AccRef acc, const Unit& u, int ui, const LAS unsigned char* lds, int wr, int wc, int fr, int fq) const {
        constexpr int NB = GATED ? 1 : 2;
        const int row0 = u.pm * BM + wr * 64 + fr, col0 = u.pn * (GATED ? HALF : BM) + wc * 32 + 8 * fq;
        const LAS float* tg = (const LAS float*)(lds + T_GATE) + ui * 256 + wc * 32 + 8 * fq; const LAS float* tn = (const LAS float*)(lds + T_GSN) + ui * 256 + wc * 32 + 8 * fq;
        h16x8 xa[4], xb[4];
#define RES_LOAD(dst, b_) do { const int bj_ = (b_) / 2, ai_ = (b_) % 2; _Pragma("unroll") for (int m = 0; m < 4; ++m) \
            dst[m] = *(const GAS h16x8*)(X + ((unsigned)(row0 + ai_ * HALF + m * 16) * (unsigned)D + (unsigned)(col0 + bj_ * HALF))); } while (0)
#define RES_PROC(src, b_) do { const int bj = (b_) / 2, ai = (b_) % 2; \
            const f32x4 g0 = *(const LAS f32x4*)(tg + bj * HALF), g1 = *(const LAS f32x4*)(tg + bj * HALF + 4), n0 = *(const LAS f32x4*)(tn + bj * HALF), n1 = *(const LAS f32x4*)(tn + bj * HALF + 4); \
            _Pragma("unroll") for (int m = 0; m < 4; ++m) { \
                const unsigned r = (unsigned)(row0 + ai * HALF + m * 16), off = r * (unsigned)D + (unsigned)(col0 + bj * HALF); \
                f32x4 v0 = acc[ai][bj][m][0], v1 = acc[ai][bj][m][1]; \
                if (GATED) { const f32x4 q0 = acc[ai][1][m][0], q1 = acc[ai][1][m][1]; \
                    _Pragma("unroll") for (int j = 0; j < 4; ++j) { v0[j] *= sigmoid_f(q0[j]); v1[j] *= sigmoid_f(q1[j]); } } \
                const f32x8 xo = __builtin_convertvector(src[m], f32x8); \
                const f32x4 x0 = (f32x4){xo[0], xo[1], xo[2], xo[3]} + g0 * v0, x1 = (f32x4){xo[4], xo[5], xo[6], xo[7]} + g1 * v1; \
                *(GAS h16x8*)(X + off) = __builtin_convertvector(((f32x8){x0[0], x0[1], x0[2], x0[3], x1[0], x1[1], x1[2], x1[3]}), h16x8); \
                if (has_next) { \
                    float a = (x0[0] * x0[0] + x0[1] * x0[1]) + (x0[2] * x0[2] + x0[3] * x0[3]) + (x1[0] * x1[0] + x1[1] * x1[1]) + (x1[2] * x1[2] + x1[3] * x1[3]); \
                    const f32x4 y0 = x0 * n0, y1 = x1 * n1; \
                    u32x4 w; w.x = cvt_pk_bf16(y0[0], y0[1]); w.y = cvt_pk_bf16(y0[2], y0[3]); w.z = cvt_pk_bf16(y1[0], y1[1]); w.w = cvt_pk_bf16(y1[2], y1[3]); \
                    *(GAS u32x4*)(XN + off) = w; \
                    a += __shfl_xor(a, 16); a += __shfl_xor(a, 32); \
                    if (fq == 0) rowss_next[r * 32u + (unsigned)(GATED ? u.pn * 4 + wc : (u.pn * 2 + bj) * 4 + wc)] = a; } } } while (0)
        h16x8 xc[4], xd[4];
        RES_LOAD(xa, 0); RES_LOAD(xb, 1);
        if (NB > 1) { RES_LOAD(xc, 2); RES_LOAD(xd, 3); }
        RES_PROC(xa, 0); RES_PROC(xb, 1);
        if (NB > 1) { RES_PROC(xc, 2); RES_PROC(xd, 3); }
#undef RES_LOAD
#undef RES_PROC
    }
};

#define XB_TMO      128
#define XB_XCNT(j)  (256  + 64 * (j))
#define XB_XSUB(j)  (1280 + 64 * (j))
#define XB_XGEN(j)  (2304 + 64 * (j))
#define XB_TOP      3328
#define XB_TOPGEN   3392
#define XCD_BAR_WORDS 3456
#define XB_SPIN_CAP (1u << 18)
__device__ __forceinline__ unsigned xb_ld(GAS unsigned* p)              { return __hip_atomic_load(p, __ATOMIC_RELAXED, __HIP_MEMORY_SCOPE_AGENT); }
__device__ __forceinline__ unsigned xb_add(GAS unsigned* p, unsigned v) { return __hip_atomic_fetch_add(p, v, __ATOMIC_RELAXED, __HIP_MEMORY_SCOPE_AGENT); }
__device__ __forceinline__ unsigned xb_xcc_id() { return (unsigned)__builtin_amdgcn_s_getreg((3 << 11) | 20) & 0xFu; }
#define XB_SPIN(cond, bar) do { unsigned _sp = 0; while (cond) { __builtin_amdgcn_s_sleep(1); \
    if ((++_sp & 255u) == 0u) { if (xb_ld(&(bar)[XB_TMO])) break; if (_sp > XB_SPIN_CAP) { (void)xb_add(&(bar)[XB_TMO], 1u); break; } } } } while (0)
struct XcdBarrier { GAS unsigned* bar; unsigned x; volatile LAS unsigned* st; };
__device__ __forceinline__ XcdBarrier xcd_barrier_post(GAS unsigned* bar, volatile LAS unsigned* st) {
    XcdBarrier b; b.bar = bar; b.x = xb_xcc_id(); b.st = st;
    if (threadIdx.x == 0) st[2] = xb_add(&bar[XB_XCNT(b.x)], 1u);
    return b;
}
__device__ __forceinline__ void xcd_barrier_complete(GAS unsigned* bar, unsigned x, unsigned& nloc, unsigned& nx, unsigned& dense, unsigned& uni) {
    const unsigned G = gridDim.x * gridDim.y * gridDim.z;
    unsigned sum, cnt, mine, sp = 0u;
    for (;;) {
        sum = 0u; cnt = 0u; dense = 0u; uni = 1u;
#pragma unroll 1
        for (unsigned j = 0; j < 16; ++j) { const unsigned c = xb_ld(&bar[XB_XCNT(j)]); sum += c; cnt += (c > 0u) ? 1u : 0u; dense += (j < x && c > 0u) ? 1u : 0u; uni &= (c == 0u || c == 32u) ? 1u : 0u; }
        mine = xb_ld(&bar[XB_XCNT(x)]);
        if (sum == G) break;
        __builtin_amdgcn_s_sleep(1);
        if ((++sp & 255u) == 0u) { if (xb_ld(&bar[XB_TMO])) break; if (sp > XB_SPIN_CAP) { (void)xb_add(&bar[XB_TMO], 1u); break; } }
    }
    nloc = mine > 0u ? mine : 1u; nx = cnt > 0u ? cnt : 1u;
}
__device__ __forceinline__ void xcd_barrier(const XcdBarrier& b, bool leader) {
    asm volatile("s_waitcnt vmcnt(0)" ::: "memory");
    __syncthreads();
    if (leader) {
        GAS unsigned* bar = b.bar; unsigned bx_ = b.x;
        asm volatile("" : "+s"(bar), "+s"(bx_));
        __builtin_amdgcn_s_waitcnt(0);
        unsigned nloc = b.st[0], nx = b.st[1];
        if (nloc == 0u) { unsigned dense, uni; xcd_barrier_complete(bar, bx_, nloc, nx, dense, uni); b.st[0] = nloc; b.st[1] = nx; b.st[3] = dense;
            b.st[4] = (nx == 8u && uni != 0u && gridDim.x == 256u) ? 1u : 0u; }
        const unsigned old = xb_add(&bar[XB_XSUB(bx_)], 1u);
        const unsigned gen = old / nloc;
        if (old + 1u == (gen + 1u) * nloc) {
            __builtin_amdgcn_fence(__ATOMIC_RELEASE, "agent");
            asm volatile("s_waitcnt vmcnt(0)" ::: "memory");
            const unsigned og = xb_add(&bar[XB_TOP], 1u);
            const unsigned tg = og / nx;
            if (og + 1u == (tg + 1u) * nx) xb_add(&bar[XB_TOPGEN], 1u);
            else XB_SPIN(xb_ld(&bar[XB_TOPGEN]) == tg, bar);
            __builtin_amdgcn_fence(__ATOMIC_ACQUIRE, "agent");
            xb_add(&bar[XB_XGEN(bx_)], 1u);
            asm volatile("s_waitcnt vmcnt(0)" ::: "memory");
        } else {
            XB_SPIN(xb_ld(&bar[XB_XGEN(bx_)]) == gen, bar);
            __builtin_amdgcn_fence(__ATOMIC_ACQUIRE, "agent");
            asm volatile("s_waitcnt vmcnt(0)" ::: "memory");
        }
    }
    __syncthreads();
}

__device__ __forceinline__ void xcc_barrier(const XcdBarrier& b, bool leader) {
    asm volatile("s_waitcnt vmcnt(0)" ::: "memory");
    __syncthreads();
    if (leader) {
        GAS unsigned* bar = b.bar; unsigned bx_ = b.x;
        asm volatile("" : "+s"(bar), "+s"(bx_));
        __builtin_amdgcn_s_waitcnt(0);
        const unsigned nloc = b.st[0];
        const unsigned old = xb_add(&bar[XB_XSUB(bx_)], 1u);
        const unsigned gen = old / nloc;
        if (old + 1u == (gen + 1u) * nloc) xb_add(&bar[XB_XGEN(bx_)], 1u);
        else XB_SPIN(xb_ld(&bar[XB_XGEN(bx_)]) == gen, bar);
        __builtin_amdgcn_fence(__ATOMIC_ACQUIRE, "agent");
        asm volatile("s_waitcnt vmcnt(0)" ::: "memory");
    }
    __syncthreads();
}

constexpr size_t MiB = 1u << 20;
constexpr size_t WS_CTL = 0, CTL_BYTES = 2 * MiB;
constexpr int CW_BAR = 4096;
constexpr size_t WS_TAB = 2 * MiB;
constexpr size_t TAB_GSA = WS_TAB, TAB_GSB = TAB_GSA + 4 * 5 * 1024 * 4, TAB_SWA = TAB_GSB + 4 * 5 * 1024 * 4, TAB_SWB = TAB_SWA + 4 * 5 * 4096 * 4, TAB_LAMT = TAB_SWB + 4 * 5 * 4096 * 4;
static_assert(TAB_LAMT + 2 * 64 * 2 * 64 * 2 * 4 <= 4 * MiB, "tables");
constexpr size_t WS_W1 = 4 * MiB, WS_W2 = 36 * MiB, WS_SWIN = 68 * MiB, WS_SWOUT = 72 * MiB, WS_GWIN = 80 * MiB, WS_GWOUT = 88 * MiB, WS_GWS = 92 * MiB,
                 WS_CWIN = 93 * MiB, WS_CWOUT = 99 * MiB, WS_BTY = 101 * MiB, WS_BTS = 133 * MiB;
constexpr size_t WS_XN = 149 * MiB;
constexpr size_t WS_R = 173 * MiB;
constexpr size_t WS_R2 = 269 * MiB;
constexpr size_t WS_ROWSS = 317 * MiB;
constexpr size_t WS_VSTAT = 329 * MiB;
constexpr size_t WS_MODS = 335 * MiB;
constexpr size_t WS_X16 = 336 * MiB;
constexpr size_t WS_END = 360 * MiB;

constexpr int LDS_BYTES = 147456;
constexpr int MISC_OFF = STAGE_BYTES;

struct Args { const float* in[30]; float* out; unsigned char* ws; int ph_lo, ph_hi; int mode, pad; };

__device__ __forceinline__ unsigned pk2(float lo, float hi) { return f2bf(lo) | (f2bf(hi) << 16); }
__device__ __forceinline__ float wave_sum(float v) {
#pragma unroll
    for (int o = 1; o < 64; o <<= 1) v += __shfl_xor(v, o);
    return v;
}
template <int MAP> __device__ __forceinline__ int rowmap(int n) {
    if (MAP == 1) { const int half = n >> 10, c = n & 1023; return (c >> 7) * 256 + half * 128 + (c & 127); }
    return n;
}
template <int MAP> __device__ __forceinline__ void transpose_item(const GAS float* W, int K, int N, GAS bf16_t* WT, LAS float* scr, int item, int lane) {
    const int nblk = N / 32, kb = item / nblk, nb = item % nblk, k0 = 64 * kb, n0 = 32 * nb;
    float wv[32];
#pragma unroll
    for (int i = 0; i < 32; ++i) wv[i] = W[(size_t)(k0 + 2 * i + (lane >> 5)) * N + n0 + (lane & 31)];
#pragma unroll
    for (int i = 0; i < 32; ++i) scr[(2 * i + (lane >> 5)) * 33 + (lane & 31)] = wv[i];
    asm volatile("s_waitcnt lgkmcnt(0)" ::: "memory");
    const int c = lane & 7;
#pragma unroll
    for (int j = 0; j < 4; ++j) { const int n = (lane >> 3) + 8 * j; const LAS float* s = scr + (8 * c) * 33 + n;
        u32x4 o; o.x = pk2(s[0 * 33], s[1 * 33]); o.y = pk2(s[2 * 33], s[3 * 33]); o.z = pk2(s[4 * 33], s[5 * 33]); o.w = pk2(s[6 * 33], s[7 * 33]);
        *(GAS u32x4*)(WT + (size_t)rowmap<MAP>(n0 + n) * K + k0 + 8 * c) = o; }
    asm volatile("s_waitcnt lgkmcnt(0)" ::: "memory");
}

__device__ __forceinline__ void ssm_build(const Args& a, int j, int g, int part, LAS unsigned char* lds, GAS unsigned char* ws, int tid) {
#ifdef MK_RANGE
    const int PMODE = a.mode;
#else
    constexpr int PMODE = 0;
#endif
    LAS float* PR = (LAS float*)lds;
    LAS float* PI = PR + 2 * 17 * 64;
    LAS float* BR = PI + 2 * 17 * 64;
    LAS float* BI = BR + 2 * 64 * 16;
    LAS float* CR = BI + 2 * 64 * 16;
    LAS float* CI = CR + 2 * 16 * 64;
    LAS float* WR = CI + 2 * 16 * 64;
    LAS float* WI = WR + 2 * 64 * 16;
    LAS float* KT = WI + 2 * 64 * 16;
    const GAS float* lam_re = inp(lds, 13); const GAS float* lam_im = inp(lds, 14); const GAS float* log_dt = inp(lds, 15);
    const GAS float* b_re = inp(lds, 16); const GAS float* b_im = inp(lds, 17); const GAS float* c_re = inp(lds, 18); const GAS float* c_im = inp(lds, 19); const GAS float* dsk = inp(lds, 20);
    __syncthreads();
    LAS float* FR = WR; LAS float* FI = WR + 128; LAS float* DSK = WR + 256;
    if (tid >= 128 && tid < 144) DSK[tid - 128] = dsk[j * 1024 + g * 16 + tid - 128];
    if (tid < 128) {
        const int k = tid >> 6, n = tid & 63, pidx = (j * 2 + k) * 64 + g;
        const float dt = expf(log_dt[pidx]);
        const float lr = lam_re[pidx * 64 + n], li = lam_im[pidx * 64 + n];
        const float mag = expf(lr * dt); float sn, cs; sincosf(li * dt, &sn, &cs); const float abr = mag * cs, abi = mag * sn;
        const float den = lr * lr + li * li;
        const float nr = (abr - 1.0f) * lr + abi * li, ni = -(abr - 1.0f) * li + abi * lr;
        FR[tid] = nr / den; FI[tid] = ni / den;
    }
#pragma unroll 1
    for (int i = tid; i < 2 * 17 * 64; i += 512) {
        const int k = i / (17 * 64), e = (i >> 6) % 17, n = i & 63, pidx = (j * 2 + k) * 64 + g;
        const float dt = expf(log_dt[pidx]); const float lr = lam_re[pidx * 64 + n], li = lam_im[pidx * 64 + n];
        const float mag = expf((float)e * lr * dt); float sn, cs; sincosf((float)e * (li * dt), &sn, &cs); PR[i] = mag * cs; PI[i] = mag * sn; }
    for (int i = tid; i < 2048; i += 512) { const int k = i >> 10, po = (i >> 6) & 15, n = i & 63; const size_t o = ((size_t)(j * 2 + k) * 64 + g) * 1024 + (i & 1023);
        CR[(k * 64 + n) * 16 + po] = c_re[o]; CI[(k * 64 + n) * 16 + po] = c_im[o]; }
    __syncthreads();
    for (int i = tid; i < 2048; i += 512) { const int kn = i >> 4; const size_t o = ((size_t)(j * 2 + (kn >> 6)) * 64 + g) * 1024 + (i & 1023);
        const float br = b_re[o], bi = b_im[o], fr = FR[kn], fi = FI[kn]; BR[i] = fr * br - fi * bi; BI[i] = fr * bi + fi * br; }
    if (part == 1 && tid < 128) { const int k = tid >> 6, n = tid & 63; GAS float* lamT = (GAS float*)(ws + TAB_LAMT) + (((size_t)j * 64 + g) * 2 + k) * 128;
        lamT[2 * n] = PR[(k * 17 + 16) * 64 + n]; lamT[2 * n + 1] = PI[(k * 17 + 16) * 64 + n]; }
    __syncthreads();
    if (part == 0 && PMODE != 6) {
        const int e = tid >> 5, k = (tid >> 4) & 1, po4 = (tid >> 2) & 3, pi4 = tid & 3;
        float acc[4][4];
#pragma unroll
        for (int x = 0; x < 4; ++x)
#pragma unroll
            for (int y = 0; y < 4; ++y) acc[x][y] = 0.f;
#pragma unroll 2
        for (int n = 0; n < 64; ++n) {
            const float pr = PR[(k * 17 + e) * 64 + n], pim = PI[(k * 17 + e) * 64 + n];
            const f32x4 br = *(const LAS f32x4*)(BR + (k * 64 + n) * 16 + 4 * pi4), bi = *(const LAS f32x4*)(BI + (k * 64 + n) * 16 + 4 * pi4);
            const f32x4 cr = *(const LAS f32x4*)(CR + (k * 64 + n) * 16 + 4 * po4), ci = *(const LAS f32x4*)(CI + (k * 64 + n) * 16 + 4 * po4);
            const f32x4 wr = br * pr - bi * pim, wi = bi * pr + br * pim;
#pragma unroll
            for (int x = 0; x < 4; ++x)
#pragma unroll
                for (int y = 0; y < 4; ++y) acc[x][y] += cr[x] * wr[y] - ci[x] * wi[y];
        }
#pragma unroll
        for (int x = 0; x < 4; ++x) *(LAS f32x4*)(KT + ((k * 16 + e) * 16 + 4 * po4 + x) * 16 + 4 * pi4) = (f32x4){acc[x][0], acc[x][1], acc[x][2], acc[x][3]};
    }
    __syncthreads();
    GAS bf16_t* BtY = (GAS bf16_t*)(ws + WS_BTY) + ((size_t)j * 64 + g) * 256 * 512;
    GAS bf16_t* BtS = (GAS bf16_t*)(ws + WS_BTS) + ((size_t)j * 64 + g) * 256 * 256;
    if (part == 0) {
    if (PMODE != 7)
#pragma unroll 1
    for (int pc = tid; pc < 256 * 32; pc += 512) {
        const int row = pc >> 5, kc = (pc & 31) * 8, t = row >> 4, po = row & 15, s = kc >> 4, pi0 = kc & 15;
        float v[8];
#pragma unroll
        for (int q = 0; q < 8; ++q) { const int pi = pi0 + q; float x = 0.f;
            if (s <= t) x += KT[((0 * 16 + (t - s)) * 16 + po) * 16 + pi];
            if (s >= t) x += KT[((1 * 16 + (s - t)) * 16 + po) * 16 + pi];
            if (s == t && pi == po) x += DSK[po];
            v[q] = x; }
        u32x4 o; o.x = pk2(v[0], v[1]); o.y = pk2(v[2], v[3]); o.z = pk2(v[4], v[5]); o.w = pk2(v[6], v[7]);
        *(GAS u32x4*)(BtY + (size_t)row * 512 + kc) = o;
    }
    if (PMODE != 8)
#pragma unroll 1
    for (int pc = tid; pc < 256 * 32; pc += 512) {
        const int row = pc >> 5, kc = (pc & 31) * 8, t = row >> 4, po = row & 15, k = kc >> 7, ri = (kc >> 6) & 1, n0 = kc & 63;
        const int e = k == 0 ? t + 1 : 16 - t;
        float v[8];
#pragma unroll
        for (int q = 0; q < 8; ++q) { const int n = n0 + q; const float cr = CR[(k * 64 + n) * 16 + po], cim = CI[(k * 64 + n) * 16 + po], pr = PR[(k * 17 + e) * 64 + n], pim = PI[(k * 17 + e) * 64 + n];
            v[q] = ri == 0 ? (cr * pr - cim * pim) : -(cr * pim + cim * pr); }
        u32x4 o; o.x = pk2(v[0], v[1]); o.y = pk2(v[2], v[3]); o.z = pk2(v[4], v[5]); o.w = pk2(v[6], v[7]);
        *(GAS u32x4*)(BtY + (size_t)row * 512 + 256 + kc) = o;
    }
    } else {
    for (int pc = tid; pc < 256 * 32; pc += 512) {
        const int row = pc >> 5, kc = (pc & 31) * 8, k = row >> 7, ri = (row >> 6) & 1, n = row & 63, s = kc >> 4, pi0 = kc & 15;
        const int e = k == 0 ? 15 - s : s;
        const float pr = PR[(k * 17 + e) * 64 + n], pim = PI[(k * 17 + e) * 64 + n];
        float v[8];
#pragma unroll
        for (int q = 0; q < 8; ++q) { const float br = BR[(k * 64 + n) * 16 + pi0 + q], bi = BI[(k * 64 + n) * 16 + pi0 + q]; v[q] = ri == 0 ? (pr * br - pim * bi) : (pr * bi + pim * br); }
        u32x4 o; o.x = pk2(v[0], v[1]); o.y = pk2(v[2], v[3]); o.z = pk2(v[4], v[5]); o.w = pk2(v[6], v[7]);
        *(GAS u32x4*)(BtS + (size_t)row * 256 + kc) = o;
    }
    }
    __syncthreads();
}

__device__ __forceinline__ void mods_task(const Args& a, GAS float* mods, LAS unsigned char* lds, int task, int tid) {
    const int cg = task % 48, l = task / 48, wave = tid >> 6, lane = tid & 63, half = lane >> 5, c4 = lane & 31;
    const GAS float* c = inp(lds, 4); const GAS float* c_ctx = inp(lds, 5); const GAS float* w_mod = inp(lds, 6); const GAS float* b_mod = inp(lds, 7);
    LAS float* sil = (LAS float*)lds;
    LAS float* red = sil + 5 * 1024;
    __syncthreads();
    for (int i = tid; i < 5 * 1024; i += 512) { const int ci = i >> 10, k = i & 1023; const float v = ci == 0 ? c_ctx[k] : c[(ci - 1) * 1024 + k]; sil[i] = v / (1.0f + expf(-v)); }
    __syncthreads();
    const GAS float* w = w_mod + ((size_t)l * 1024 + wave * 128 + half) * 6144 + cg * 128 + c4 * 4;
    f32x4 acc[5];
#pragma unroll
    for (int ci = 0; ci < 5; ++ci) acc[ci] = (f32x4){0.f, 0.f, 0.f, 0.f};
#pragma unroll 1
    for (int b = 0; b < 2; ++b) {
        f32x4 wv[32];
#pragma unroll
        for (int i = 0; i < 32; ++i) wv[i] = *(const GAS f32x4*)(w + (size_t)(b * 64 + 2 * i) * 6144);
#pragma unroll
        for (int i = 0; i < 32; ++i) { const int k = wave * 128 + b * 64 + 2 * i + half;
#pragma unroll
            for (int ci = 0; ci < 5; ++ci) acc[ci] += wv[i] * sil[ci * 1024 + k]; }
    }
#pragma unroll
    for (int ci = 0; ci < 5; ++ci) {
#pragma unroll
        for (int q = 0; q < 4; ++q) acc[ci][q] += __shfl_xor(acc[ci][q], 32);
        if (half == 0) *(LAS f32x4*)(red + (wave * 5 + ci) * 128 + c4 * 4) = acc[ci]; }
    __syncthreads();
    for (int i = tid; i < 5 * 128; i += 512) { const int ci = i >> 7, cc = i & 127; float t = 0.f;
#pragma unroll
        for (int wv2 = 0; wv2 < 8; ++wv2) t += red[(wv2 * 5 + ci) * 128 + cc];
        mods[((size_t)l * 5 + ci) * 6144 + cg * 128 + cc] = t + b_mod[l * 6144 + cg * 128 + cc]; }
}

__device__ __forceinline__ void xinit_row(const LAS unsigned char* lds, GAS h16_t* X, int row, int lane) {
    GAS h16x4* o = (GAS h16x4*)(X + (size_t)row * D) + lane;
    if (row < MP) { const GAS f32x4* s = (const GAS f32x4*)(inp(lds, 0) + (size_t)row * D) + lane;
#pragma unroll
        for (int q = 0; q < 4; ++q) o[64 * q] = __builtin_convertvector(s[64 * q], h16x4);
        return; }
    const GAS f32x4* s = (const GAS f32x4*)(inp(lds, 1) + (size_t)(row - MP) * D) + lane;
    const int t = (row - MP) & 1023; const float rr = (float)(t >> 6), cc = (float)(t & 63);
    float freq[4];
#pragma unroll
    for (int e = 0; e < 4; ++e) freq[e] = expf(-(float)(4 * lane + e) * (9.210340371976184f / 256.0f));
    f32x4 v[4];
#pragma unroll
    for (int q = 0; q < 4; ++q) v[q] = s[64 * q];
#pragma unroll
    for (int e = 0; e < 4; ++e) { float sr, cr, sc, cc2; sincosf(rr * freq[e], &sr, &cr); sincosf(cc * freq[e], &sc, &cc2); v[0][e] += sr; v[1][e] += cr; v[2][e] += sc; v[3][e] += cc2; }
#pragma unroll
    for (int q = 0; q < 4; ++q) o[64 * q] = __builtin_convertvector(v[q], h16x4);
}


__device__ __forceinline__ void sw_job(const GAS float* mods, int l, int sidx, const GAS bf16_t* WT, int N, GAS float* dst, int dld, int wv, int nw, int lane) {
    float sh[5][16];
#pragma unroll
    for (int ci = 0; ci < 5; ++ci) { const GAS float* sp = mods + ((size_t)l * 5 + ci) * 6144 + sidx * 1024 + lane * 16;
#pragma unroll
        for (int q = 0; q < 4; ++q) { const f32x4 v = *(const GAS f32x4*)(sp + 4 * q); sh[ci][4 * q] = v[0]; sh[ci][4 * q + 1] = v[1]; sh[ci][4 * q + 2] = v[2]; sh[ci][4 * q + 3] = v[3]; } }
    for (int r = wv * 8; r < N; r += nw * 8) {
        u32x4 w0[8], w1[8];
#pragma unroll
        for (int nn = 0; nn < 8; ++nn) { w0[nn] = *(const GAS u32x4*)(WT + (size_t)(r + nn) * D + lane * 16); w1[nn] = *(const GAS u32x4*)(WT + (size_t)(r + nn) * D + lane * 16 + 8); }
#pragma unroll
        for (int nn = 0; nn < 8; ++nn) {
            const float wf[16] = {bf_lo(w0[nn].x), bf_hi(w0[nn].x), bf_lo(w0[nn].y), bf_hi(w0[nn].y), bf_lo(w0[nn].z), bf_hi(w0[nn].z), bf_lo(w0[nn].w), bf_hi(w0[nn].w),
                                  bf_lo(w1[nn].x), bf_hi(w1[nn].x), bf_lo(w1[nn].y), bf_hi(w1[nn].y), bf_lo(w1[nn].z), bf_hi(w1[nn].z), bf_lo(w1[nn].w), bf_hi(w1[nn].w)};
#pragma unroll
            for (int ci = 0; ci < 5; ++ci) { float t = 0.f;
#pragma unroll
                for (int q = 0; q < 16; ++q) t += wf[q] * sh[ci][q];
                t = wave_sum(t);
                if (lane == 0) dst[ci * dld + r + nn] = t; }
        }
    }
}
__device__ __forceinline__ void sw_mix_job(GAS unsigned char* ws, const GAS float* mods, int l, int wv, int nw, int lane) {
    GAS float* swA = (GAS float*)(ws + TAB_SWA);
    if (l == 0) sw_job(mods, 0, 0, (const GAS bf16_t*)(ws + WS_SWIN), 1024, swA, 1024, wv, nw, lane);
    else if (l == 1) sw_job(mods, 1, 0, (const GAS bf16_t*)(ws + WS_GWIN), 4096, swA + 1 * 5 * 4096, 4096, wv, nw, lane);
    else if (l == 2) sw_job(mods, 2, 0, (const GAS bf16_t*)(ws + WS_CWIN), 3072, swA + 2 * 5 * 4096, 3072, wv, nw, lane);
    else sw_job(mods, 3, 0, (const GAS bf16_t*)(ws + WS_SWIN) + (size_t)D * D, 1024, swA + 3 * 5 * 4096, 1024, wv, nw, lane);
}
__device__ __forceinline__ void sw_ffn_job(GAS unsigned char* ws, const GAS float* mods, int l, int wv, int nw, int lane) {
    sw_job(mods, l, 3, (const GAS bf16_t*)(ws + WS_W1) + (size_t)l * D * FF, 4096, (GAS float*)(ws + TAB_SWB) + l * 5 * 4096, 4096, wv, nw, lane);
}


constexpr int I_W1 = 2048, I_W2 = 2048, I_SI = 512, I_SO = 1024, I_GI = 2048, I_GO = 1024, I_CI = 1536, I_CO = 512;
constexpr int IT_W1 = 0, IT_W2 = 4 * I_W1, IT_SI = IT_W2 + 4 * I_W2, IT_SO = IT_SI + 2 * I_SI, IT_GI = IT_SO + 2 * I_SO, IT_GO = IT_GI + I_GI, IT_CI = IT_GO + I_GO, IT_CO = IT_CI + I_CI, IT_END = IT_CO + I_CO;
__device__ __forceinline__ void convert_items(const LAS unsigned char* lds, GAS unsigned char* ws, LAS float* scr, int first, int count, int wv, int nw, int lane) {
    for (int it = first + wv; it < first + count; it += nw) {
        int r = it;
        if (r < IT_W2) { const int l = r / I_W1; transpose_item<0>(inp(lds, 10) + (size_t)l * D * FF, D, FF, (GAS bf16_t*)(ws + WS_W1) + (size_t)l * D * FF, scr, r % I_W1, lane); continue; } r -= IT_W2;
        if (r < 4 * I_W2) { const int l = r / I_W2; transpose_item<0>(inp(lds, 11) + (size_t)l * D * FF, FF, D, (GAS bf16_t*)(ws + WS_W2) + (size_t)l * D * FF, scr, r % I_W2, lane); continue; } r -= 4 * I_W2;
        if (r < 2 * I_SI) { const int l = r / I_SI; transpose_item<0>(inp(lds, 12) + (size_t)l * D * D, D, D, (GAS bf16_t*)(ws + WS_SWIN) + (size_t)l * D * D, scr, r % I_SI, lane); continue; } r -= 2 * I_SI;
        if (r < 2 * I_SO) { const int l = r / I_SO; transpose_item<1>(inp(lds, 21) + (size_t)l * D * 2048, D, 2048, (GAS bf16_t*)(ws + WS_SWOUT) + (size_t)l * D * 2048, scr, r % I_SO, lane); continue; } r -= 2 * I_SO;
        if (r < I_GI) { transpose_item<0>(inp(lds, 22), D, 4096, (GAS bf16_t*)(ws + WS_GWIN), scr, r, lane); continue; } r -= I_GI;
        if (r < I_GO) { transpose_item<0>(inp(lds, 25), 2048, D, (GAS bf16_t*)(ws + WS_GWOUT), scr, r, lane); continue; } r -= I_GO;
        if (r < I_CI) { transpose_item<0>(inp(lds, 26), D, 3072, (GAS bf16_t*)(ws + WS_CWIN), scr, r, lane); continue; } r -= I_CI;
        transpose_item<0>(inp(lds, 28), D, D, (GAS bf16_t*)(ws + WS_CWOUT), scr, r, lane);
    }
}
constexpr int NPH = 28;
#ifdef MK_RANGE
#define GMODE(g) g.mode = args.mode
#else
#define GMODE(g)
#endif
#ifndef MK_ALLCG
#define MK_ALLCG 0
#endif
#ifndef MK_NOLOCAL
#define MK_NOLOCAL 0
#endif
__global__ void __launch_bounds__(512, 2) fwd(Args args) {
    extern __shared__ __attribute__((aligned(16))) unsigned char lds_raw[];
    LAS unsigned char* lds_k = (LAS unsigned char*)lds_raw;
    volatile LAS unsigned* MISC = (volatile LAS unsigned*)(lds_k + MISC_OFF);
    const int tid = threadIdx.x, lane = tid & 63, wave = __builtin_amdgcn_readfirstlane(tid >> 6);
    const int G = gridDim.x, bx = blockIdx.x;
    GAS unsigned* ctl = (GAS unsigned*)((GAS unsigned char*)args.ws + WS_CTL);
    for (int u = tid; u < 64; u += 512) MISC[u] = 0u;
    if (tid == 0) { LAS unsigned long long* pt = (LAS unsigned long long*)(lds_k + PTR_OFF);
#pragma unroll
        for (int k = 0; k < 30; ++k) pt[k] = (unsigned long long)args.in[k];
        pt[30] = (unsigned long long)args.out; pt[31] = (unsigned long long)args.ws; }
    __syncthreads();
    (void)xcd_barrier_post(ctl + CW_BAR, MISC + 8);
#ifdef MK_RANGE
    const int lo = args.ph_lo, hi = args.ph_hi;
#else
    constexpr int lo = 0, hi = 23;
#endif
    int ph = 0;
#define IN_PH (lo <= ph && ph < hi)
#define SEAM_GLOBAL(p) ((p) <= 3 || (p) == 6 || (p) == 11 || (p) == 16 || (p) == 17 || (p) == 18)
#define SEAM() do { if (IN_PH && ph + 1 < hi) { if (ph == 0 || MK_ALLCG) cg::this_grid().sync(); else { LAS unsigned char* lds_s_ = lds_k; asm volatile("" : "+s"(lds_s_)); XcdBarrier b_; b_.bar = (GAS unsigned*)((GAS unsigned char*)ldsptr(lds_s_, 31) + WS_CTL) + CW_BAR; b_.x = xb_xcc_id(); b_.st = (volatile LAS unsigned*)(lds_s_ + MISC_OFF) + 8; \
        const bool ldr_ = wave == 0 && lane_id() == 0; if (SEAM_GLOBAL(ph) || MK_NOLOCAL || b_.st[4] == 0u) xcd_barrier(b_, ldr_); else xcc_barrier(b_, ldr_); } } ++ph; } while (0)

#define PH_PTRS() LAS unsigned char* lds = lds_k; asm volatile("" : "+s"(lds)); GAS unsigned char* ws = (GAS unsigned char*)ldsptr(lds, 31); asm volatile("" : "+s"(ws)); \
    int tid_o_ = wave * 64 + lane_id(); asm volatile("" : "+v"(tid_o_)); const int tid = tid_o_, lane = tid_o_ & 63; (void)tid; (void)lane; \
    const int vcu = (G % 8 == 0) ? (bx % 8) * (G / 8) + bx / 8 : bx, gw = vcu * 8 + wave, NGW = G * 8; (void)vcu; (void)gw; (void)NGW; \
    const int o_mode = __builtin_amdgcn_readfirstlane((int)((volatile LAS unsigned*)(lds + MISC_OFF))[12]); \
    const int o_vx = o_mode ? __builtin_amdgcn_readfirstlane((int)((volatile LAS unsigned*)(lds + MISC_OFF))[11]) : (bx & 7), o_rank = o_mode ? __builtin_amdgcn_readfirstlane((int)((volatile LAS unsigned*)(lds + MISC_OFF))[10]) : (bx >> 3); (void)o_vx; (void)o_rank; \
    GAS h16_t* X = (GAS h16_t*)(ws + WS_X16); GAS bf16_t* XN = (GAS bf16_t*)(ws + WS_XN); GAS float* mods = (GAS float*)(ws + WS_MODS); \
    GAS float* gsA = (GAS float*)(ws + TAB_GSA); GAS float* gsB = (GAS float*)(ws + TAB_GSB); GAS float* swA = (GAS float*)(ws + TAB_SWA); GAS float* swB = (GAS float*)(ws + TAB_SWB); \
    GAS float* rowss = (GAS float*)(ws + WS_ROWSS); GAS float* vstat = (GAS float*)(ws + WS_VSTAT); \
    GAS bf16_t* Hb = (GAS bf16_t*)(ws + WS_R); GAS bf16_t* UgS = (GAS bf16_t*)(ws + WS_R); GAS float* Sloc = (GAS float*)(ws + WS_R + 48 * MiB); GAS bf16_t* Zg = (GAS bf16_t*)(ws + WS_R2); GAS bf16_t* A2 = (GAS bf16_t*)(ws + WS_R2); \
    (void)X; (void)XN; (void)mods; (void)gsA; (void)gsB; (void)swA; (void)swB; (void)rowss; (void)vstat; (void)Hb; (void)UgS; (void)Sloc; (void)Zg; (void)A2;
#define PH_LAYER() const GAS float* rs_mix = rowss + (size_t)(2 * layer) * M * 32; GAS float* rs_ffn = rowss + (size_t)(2 * layer + 1) * M * 32; GAS float* rs_next = rowss + (size_t)((2 * layer + 2) & 7) * M * 32; \
    const GAS float* modl = mods + (size_t)layer * 5 * 6144; (void)rs_mix; (void)rs_ffn; (void)rs_next; (void)modl;

#define SIDE_IDS() const int sidle = o_vx * 8 + o_rank - 24, swv = sidle * 8 + wave, snw = 512; (void)sidle; LAS float* scr = (LAS float*)(lds + wave * 16384); (void)scr; (void)swv; (void)snw
    if (IN_PH) { PH_PTRS();
#ifdef MK_RANGE
        const int pm_ = args.mode;
#else
        constexpr int pm_ = 0;
#endif
        if (bx < 128) { if (pm_ != 2) ssm_build(args, 0, bx & 63, bx >> 6, lds, ws, tid); } else { if (pm_ != 3) for (int t = bx - 128; t < 192; t += 128) mods_task(args, mods, lds, t, tid); }
        __syncthreads();
        if (bx >= 128 && pm_ != 4) { LAS float* scr = (LAS float*)(lds + wave * 16384); const int wv = (bx - 128) * 8 + wave, nw = (G - 128) * 8;
            convert_items(lds, ws, scr, IT_W1, I_W1, wv, nw, lane); convert_items(lds, ws, scr, IT_W2, I_W2, wv, nw, lane);
            convert_items(lds, ws, scr, IT_SI, I_SI, wv, nw, lane); convert_items(lds, ws, scr, IT_SO, I_SO, wv, nw, lane); }
        if (pm_ != 5 && bx >= 64) for (int row = (bx - 64) * 8 + wave; row < M; row += (G - 64) * 8) xinit_row(lds, X, row, lane);
    }
    SEAM();
    if (IN_PH) { PH_PTRS();
        for (int i = gw * 64 + lane; i < 4 * 5 * 1024; i += NGW * 64) { const int l = i / 5120, ci = (i / 1024) % 5, c = i & 1023;
            const GAS float* md = mods + ((size_t)l * 5 + ci) * 6144;
            gsA[i] = inp(lds, 8)[l * 1024 + c] * (1.0f + md[1024 + c]); gsB[i] = inp(lds, 9)[l * 1024 + c] * (1.0f + md[4 * 1024 + c]); }
        sw_mix_job(ws, mods, 0, gw, NGW, lane);
        for (int row = gw; row < M; row += 3 * NGW) {
            const GAS float* gm = inp(lds, 8);
            f32x4 v[3][4];
#pragma unroll
            for (int rr = 0; rr < 3; ++rr)
#pragma unroll
                for (int q = 0; q < 4; ++q) v[rr][q] = __builtin_convertvector(((const GAS h16x4*)(X + (size_t)(row + rr * NGW) * D) + lane)[64 * q], f32x4);
#pragma unroll
            for (int rr = 0; rr < 3; ++rr) {
                const int r = row + rr * NGW, ci = cond_of_row(r); const GAS float* md = mods + ((size_t)0 * 5 + ci) * 6144;
                float t = 0.f;
#pragma unroll
                for (int q = 0; q < 4; ++q) t += (v[rr][q][0] * v[rr][q][0] + v[rr][q][1] * v[rr][q][1]) + (v[rr][q][2] * v[rr][q][2] + v[rr][q][3] * v[rr][q][3]);
                t = wave_sum(t);
                if (lane < 32) rowss[(size_t)r * 32 + lane] = lane == 0 ? t : 0.f;
                GAS u32x2* o = (GAS u32x2*)(XN + (size_t)r * D) + lane;
#pragma unroll
                for (int q = 0; q < 4; ++q) { const int c = 256 * q + 4 * lane; const f32x4 gg = *(const GAS f32x4*)(gm + c), sc = *(const GAS f32x4*)(md + 1024 + c);
                    const f32x4 y = v[rr][q] * gg * (sc + 1.0f); u32x2 w; w.x = cvt_pk_bf16(y[0], y[1]); w.y = cvt_pk_bf16(y[2], y[3]); o[64 * q] = w; }
            }
        }
    }
    SEAM();
#pragma unroll 1
    for (int layer = 0; layer < 4; ++layer) {
        const int kind = layer % 3, j = layer / 3;
        if (kind == 0) {
            if (IN_PH) { PH_PTRS(); PH_LAYER(); Gemm g = gemm_rowmajor(XN, D, (const GAS bf16_t*)(ws + WS_SWIN) + (size_t)j * D * D, D, D); GMODE(g); OwnerOrder S{(D) / BM, o_vx, o_rank};
                fill_tables_in(lds, S, rs_mix, swA + layer * 5 * 4096, 1024, tid); EpiU E{UgS}; gemm_phase<EpiU, ARowMajor, OwnerOrder>(lds, g, S, E, wave);
                if (o_rank >= 24) { SIDE_IDS(); sw_ffn_job(ws, mods, layer, swv, snw, lane); if (layer == 0) convert_items(lds, ws, scr, IT_GI, I_GI, swv, snw, lane); } }
            SEAM();
            if (IN_PH) { PH_PTRS(); PH_LAYER(); SsmOrder S{G, bx};
                { Gemm g = gemm_rowmajor(UgS, 512, (const GAS bf16_t*)(ws + WS_BTS) + (size_t)j * 64 * 256 * 256, 256, 256); GMODE(g);
                  EpiScan E{UgS, (const GAS float*)(ws + TAB_LAMT), inp(lds, 2), inp(lds, 3), (GAS float*)ldsptr(lds, 30) + (size_t)M * D, (GAS float*)ldsptr(lds, 30) + (size_t)M * D + 32 * 2 * 2 * 64 * 64, j};
                  gemm_phase<EpiScan, ARowMajor, SsmOrder>(lds, g, S, E, wave); }
                asm volatile("s_waitcnt vmcnt(0)" ::: "memory"); __syncthreads(); __builtin_amdgcn_fence(__ATOMIC_ACQUIRE, "agent"); asm volatile("s_waitcnt vmcnt(0)" ::: "memory"); __syncthreads();
                { Gemm g = gemm_rowmajor(UgS, 512, (const GAS bf16_t*)(ws + WS_BTY) + (size_t)j * 64 * 256 * 512, 512, 512); GMODE(g);
                  EpiY E{Zg}; gemm_phase<EpiY, ARowMajor, SsmOrder>(lds, g, S, E, wave); }
                if (layer == 0 && bx >= 192) { const int swv = (bx - 192) * 8 + wave, snw = 512; LAS float* scr = (LAS float*)(lds + wave * 16384); convert_items(lds, ws, scr, IT_GO, I_GO + I_CI + I_CO, swv, snw, lane); convert_items(lds, ws, scr, IT_W1 + 1 * I_W1, I_W1, swv, snw, lane);
                    const GAS float* s_ = inp(lds, 23); GAS bf16_t* d_ = (GAS bf16_t*)(ws + WS_GWS);
                    for (int i = (swv * 64 + lane) * 8; i < 16 * 128 * 128; i += snw * 64 * 8) { const f32x4 a0 = *(const GAS f32x4*)(s_ + i), a1 = *(const GAS f32x4*)(s_ + i + 4);
                        u32x4 o; o.x = pk2(a0[0], a0[1]); o.y = pk2(a0[2], a0[3]); o.z = pk2(a1[0], a1[1]); o.w = pk2(a1[2], a1[3]); *(GAS u32x4*)(d_ + i) = o; } } }
            SEAM();
            if (IN_PH) { PH_PTRS(); PH_LAYER(); Gemm g = gemm_groupchunk(Zg, (const GAS bf16_t*)(ws + WS_SWOUT) + (size_t)j * D * 2048, D, D); GMODE(g); OwnerOrder S{(2048) / BM, o_vx, o_rank};
                fill_tables_res<128>(lds, S, modl + 2 * 1024, gsB + layer * 5 * 1024, tid); EpiRes<true> E{X, XN, rs_ffn, true}; gemm_phase<EpiRes<true>, AGroupChunk, OwnerOrder>(lds, g, S, E, wave); }
            SEAM();
        } else if (kind == 1) {
            if (IN_PH) { PH_PTRS(); PH_LAYER(); Gemm g = gemm_rowmajor(XN, D, (const GAS bf16_t*)(ws + WS_GWIN), D, D); GMODE(g); OwnerOrder S{(4096) / BM, o_vx, o_rank};
                fill_tables_in(lds, S, rs_mix, swA + layer * 5 * 4096, 4096, tid); EpiIn<2, 4096> E{Hb, vstat}; gemm_phase<EpiIn<2, 4096>, ARowMajor, OwnerOrder>(lds, g, S, E, wave); }
            SEAM();
            if (IN_PH) { PH_PTRS(); PH_LAYER();
                const GAS bf16_t* Wsb = (const GAS bf16_t*)(ws + WS_GWS); const GAS float* b_s = inp(lds, 24);
                constexpr int VST = 288;
                LAS f32x2* mr = (LAS f32x2*)(lds + 128 * VST);
                __syncthreads();
#define G2_UNIT(L_) (((2 * panel_of(o_vx, ((L_) >> 4) >> 1) + (((L_) >> 4) & 1)) << 4) | ((L_) & 15))
                { int ui = 0;
                  for (int L = o_rank; L < 192; L += 32, ++ui) { const int unit = G2_UNIT(L); const int row = tid >> 2, part = tid & 3;
                    const GAS f32x4* p = (const GAS f32x4*)(vstat + (size_t)((unit >> 4) * 128 + row) * 128) + part * 8; float s1 = 0.f, s2 = 0.f;
#pragma unroll
                    for (int q = 0; q < 8; ++q) { const f32x4 v = p[q]; s1 += v[0] + v[2]; s2 += v[1] + v[3]; }
                    s1 += __shfl_xor(s1, 1); s2 += __shfl_xor(s2, 1); s1 += __shfl_xor(s1, 2); s2 += __shfl_xor(s2, 2);
                    const float mu = s1 * (1.0f / 2048.0f), var = s2 * (1.0f / 2048.0f) - mu * mu; if (part == 0) mr[ui * 128 + row] = (f32x2){mu, rsq_f(fmaxf(var, 0.f) + EPS)}; } }
                u32x4 vr[4] = {(u32x4){0u, 0u, 0u, 0u}, (u32x4){0u, 0u, 0u, 0u}, (u32x4){0u, 0u, 0u, 0u}, (u32x4){0u, 0u, 0u, 0u}};
                { const int u0 = G2_UNIT(o_rank);
#pragma unroll
                    for (int i = 0; i < 4; ++i) { const int pc = tid + 512 * i, q = pc >> 4, d8 = pc & 15; vr[i] = *(const GAS u32x4*)(Hb + (size_t)((u0 >> 4) * 128 + q) * 4096 + 2048 + (u0 & 15) * 128 + d8 * 8); } }
                int ui = 0;
                for (int L = o_rank; L < 192; L += 32, ++ui) {
                    const int unit = G2_UNIT(L); const int c = unit >> 4, g = unit & 15, row0 = c * 128;
                    __syncthreads();
#pragma unroll
                    for (int i = 0; i < 4; ++i) { const int pc = tid + 512 * i, q = pc >> 4, d8 = pc & 15;
                        const u32x4 w = vr[i];
                        const f32x2 st = mr[ui * 128 + q]; const float mu = st[0], rstd = st[1];
                        u32x4 o; o.x = cvt_pk_bf16((bf_lo(w.x) - mu) * rstd, (bf_hi(w.x) - mu) * rstd); o.y = cvt_pk_bf16((bf_lo(w.y) - mu) * rstd, (bf_hi(w.y) - mu) * rstd);
                        o.z = cvt_pk_bf16((bf_lo(w.z) - mu) * rstd, (bf_hi(w.z) - mu) * rstd); o.w = cvt_pk_bf16((bf_lo(w.w) - mu) * rstd, (bf_hi(w.w) - mu) * rstd);
                        *(LAS u32x4*)(lds + q * VST + d8 * 16) = o; }
                    __syncthreads();
                    if (L + 32 < 192) { const int un = G2_UNIT(L + 32);
#pragma unroll
                        for (int i = 0; i < 4; ++i) { const int pc = tid + 512 * i, q = pc >> 4, d8 = pc & 15; vr[i] = *(const GAS u32x4*)(Hb + (size_t)((un >> 4) * 128 + q) * 4096 + 2048 + (un & 15) * 128 + d8 * 8); } }
                    f32x4 acc[8];
#pragma unroll
                    for (int nt = 0; nt < 8; ++nt) acc[nt] = (f32x4){0.f, 0.f, 0.f, 0.f};
                    const int fr = lane & 15, fq = lane >> 4;
#pragma unroll
                    for (int kk = 0; kk < 4; ++kk) {
                        const bf16x8 wf = *(const GAS bf16x8*)(Wsb + ((size_t)g * 128 + wave * 16 + fr) * 128 + kk * 32 + fq * 8);
#pragma unroll
                        for (int nt = 0; nt < 8; ++nt) {
                            const LAS unsigned char* p0 = lds + (kk * 32 + fq * 8 + (fr >> 2)) * VST + (nt * 16 + 4 * (fr & 3)) * 2;
                            const s16x4 lo4 = __builtin_bit_cast(s16x4, __builtin_amdgcn_ds_read_tr16_b64_v4i16((LAS s16x4*)p0));
                            const s16x4 hi4 = __builtin_bit_cast(s16x4, __builtin_amdgcn_ds_read_tr16_b64_v4i16((LAS s16x4*)(p0 + 4 * VST)));
                            const bf16x8 vf = {lo4[0], lo4[1], lo4[2], lo4[3], hi4[0], hi4[1], hi4[2], hi4[3]};
                            acc[nt] = __builtin_amdgcn_mfma_f32_16x16x32_bf16(vf, wf, acc[nt], 0, 0, 0);
                        }
                    }
                    const int p = wave * 16 + fr, row = row0 + p; const float bs = b_s[g * 128 + p];
#pragma unroll
                    for (int nt = 0; nt < 8; ++nt) { const int ch = g * 128 + nt * 16 + 4 * fq;
                        const u32x2 uu = *(const GAS u32x2*)(Hb + (size_t)row * 4096 + ch);
                        u32x2 o; o.x = cvt_pk_bf16(bf_lo(uu.x) * (acc[nt][0] + bs), bf_hi(uu.x) * (acc[nt][1] + bs)); o.y = cvt_pk_bf16(bf_lo(uu.y) * (acc[nt][2] + bs), bf_hi(uu.y) * (acc[nt][3] + bs));
                        *(GAS u32x2*)(A2 + (size_t)row * 2048 + ch) = o; }
                }
                __syncthreads();
            }
            SEAM();
            if (IN_PH) { PH_PTRS(); PH_LAYER(); Gemm g = gemm_rowmajor(A2, 2048, (const GAS bf16_t*)(ws + WS_GWOUT), 2048, 2048); GMODE(g); OwnerOrder S{(D) / BM, o_vx, o_rank};
                fill_tables_res<256>(lds, S, modl + 2 * 1024, gsB + layer * 5 * 1024, tid); EpiRes<false> E{X, XN, rs_ffn, true}; gemm_phase<EpiRes<false>, ARowMajor, OwnerOrder>(lds, g, S, E, wave);
                if (o_rank >= 24) { SIDE_IDS(); ssm_build(args, 1, sidle, 1, lds, ws, tid); } }
            SEAM();
        } else {
            if (IN_PH) { PH_PTRS(); PH_LAYER(); Gemm g = gemm_rowmajor(XN, D, (const GAS bf16_t*)(ws + WS_CWIN), D, D); GMODE(g); OwnerOrder S{(3072) / BM, o_vx, o_rank};
                fill_tables_in(lds, S, rs_mix, swA + layer * 5 * 4096, 3072, tid); EpiIn<0, 3072> E{Hb, nullptr}; gemm_phase<EpiIn<0, 3072>, ARowMajor, OwnerOrder>(lds, g, S, E, wave); }
            SEAM();
            if (IN_PH) { PH_PTRS(); PH_LAYER();
                const GAS float* cw = inp(lds, 27);
                for (int it = o_rank * 512 + tid; it < 6 * 256 * 128; it += 32 * 512) {
                    const int row = panel_of(o_vx, it >> 15) * 256 + ((it >> 7) & 255), c8 = (it & 127) * 8;
                    const int L = row < MP ? 256 : 1024, t = row < MP ? (row & 255) : ((row - MP) & 1023);
                    const GAS bf16_t* pr = Hb + (size_t)row * 3072 + c8;
                    float y[8];
#pragma unroll
                    for (int q = 0; q < 8; ++q) y[q] = 0.f;
#pragma unroll
                    for (int w = 0; w < 3; ++w) { const int tt = t + w - 1; if (tt < 0 || tt >= L) continue;
                        const u32x4 gc = *(const GAS u32x4*)(pr + (ptrdiff_t)(w - 1) * 3072 + 1024), xh = *(const GAS u32x4*)(pr + (ptrdiff_t)(w - 1) * 3072 + 2048);
                        const f32x4 k0 = *(const GAS f32x4*)(cw + w * 1024 + c8), k1 = *(const GAS f32x4*)(cw + w * 1024 + c8 + 4);
                        y[0] += k0[0] * bf_lo(gc.x) * bf_lo(xh.x); y[1] += k0[1] * bf_hi(gc.x) * bf_hi(xh.x); y[2] += k0[2] * bf_lo(gc.y) * bf_lo(xh.y); y[3] += k0[3] * bf_hi(gc.y) * bf_hi(xh.y);
                        y[4] += k1[0] * bf_lo(gc.z) * bf_lo(xh.z); y[5] += k1[1] * bf_hi(gc.z) * bf_hi(xh.z); y[6] += k1[2] * bf_lo(gc.w) * bf_lo(xh.w); y[7] += k1[3] * bf_hi(gc.w) * bf_hi(xh.w); }
                    const u32x4 gb = *(const GAS u32x4*)pr;
                    u32x4 o; o.x = cvt_pk_bf16(bf_lo(gb.x) * y[0], bf_hi(gb.x) * y[1]); o.y = cvt_pk_bf16(bf_lo(gb.y) * y[2], bf_hi(gb.y) * y[3]);
                    o.z = cvt_pk_bf16(bf_lo(gb.z) * y[4], bf_hi(gb.z) * y[5]); o.w = cvt_pk_bf16(bf_lo(gb.w) * y[6], bf_hi(gb.w) * y[7]);
                    *(GAS u32x4*)(A2 + (size_t)row * D + c8) = o;
                }
            }
            SEAM();
            if (IN_PH) { PH_PTRS(); PH_LAYER(); Gemm g = gemm_rowmajor(A2, D, (const GAS bf16_t*)(ws + WS_CWOUT), D, D); GMODE(g); OwnerOrder S{(D) / BM, o_vx, o_rank};
                fill_tables_res<256>(lds, S, modl + 2 * 1024, gsB + layer * 5 * 1024, tid); EpiRes<false> E{X, XN, rs_ffn, true}; gemm_phase<EpiRes<false>, ARowMajor, OwnerOrder>(lds, g, S, E, wave); }
            SEAM();
        }
        if (IN_PH) { PH_PTRS(); PH_LAYER(); Gemm g = gemm_rowmajor(XN, D, (const GAS bf16_t*)(ws + WS_W1) + (size_t)layer * D * FF, D, D); GMODE(g); OwnerOrder S{(FF) / BM, o_vx, o_rank};
            fill_tables_in(lds, S, rs_ffn, swB + layer * 5 * 4096, 4096, tid); EpiIn<1, 4096> E{Hb, nullptr}; gemm_phase<EpiIn<1, 4096>, ARowMajor, OwnerOrder>(lds, g, S, E, wave); }
        SEAM();
        if (IN_PH) { PH_PTRS(); PH_LAYER(); Gemm g = gemm_rowmajor(Hb, FF, (const GAS bf16_t*)(ws + WS_W2) + (size_t)layer * D * FF, FF, FF); GMODE(g); OwnerOrder S{(D) / BM, o_vx, o_rank};
            fill_tables_res<256>(lds, S, modl + 5 * 1024, layer < 3 ? gsA + (layer + 1) * 5 * 1024 : (const GAS float*)nullptr, tid); EpiRes<false> E{X, XN, rs_next, layer < 3}; gemm_phase<EpiRes<false>, ARowMajor, OwnerOrder>(lds, g, S, E, wave);
            if (layer < 3 && o_rank >= 24) { SIDE_IDS();
                if (layer == 0) { convert_items(lds, ws, scr, IT_W2 + 1 * I_W2, I_W2, swv, snw, lane); convert_items(lds, ws, scr, IT_W1 + 2 * I_W1, I_W1, swv, snw, lane); sw_mix_job(ws, mods, 1, swv, snw, lane); sw_ffn_job(ws, mods, 1, swv, snw, lane); }
                else if (layer == 1) { convert_items(lds, ws, scr, IT_W2 + 2 * I_W2, I_W2, swv, snw, lane); convert_items(lds, ws, scr, IT_SI + I_SI, I_SI, swv, snw, lane); convert_items(lds, ws, scr, IT_SO + I_SO, I_SO, swv, snw, lane);
                    sw_mix_job(ws, mods, 2, swv, snw, lane); sw_ffn_job(ws, mods, 2, swv, snw, lane); }
                else { ssm_build(args, 1, sidle, 0, lds, ws, tid);
                    convert_items(lds, ws, scr, IT_W1 + 3 * I_W1, I_W1, swv, snw, lane); convert_items(lds, ws, scr, IT_W2 + 3 * I_W2, I_W2, swv, snw, lane); sw_mix_job(ws, mods, 3, swv, snw, lane); } } }
        SEAM();
    }
    if (IN_PH) { PH_PTRS();
        const GAS float* gf = inp(lds, 29);
        GAS float* Y = (GAS float*)ldsptr(lds, 30);
        for (int t3 = 0; t3 < 2; ++t3) {
            int rws[3];
#pragma unroll
            for (int rr = 0; rr < 3; ++rr) { const int rl = o_rank * 8 + wave + 256 * (3 * t3 + rr); rws[rr] = panel_of(o_vx, rl >> 8) * 256 + (rl & 255); }
            f32x4 v[3][4];
#pragma unroll
            for (int rr = 0; rr < 3; ++rr)
#pragma unroll
                for (int q = 0; q < 4; ++q) v[rr][q] = __builtin_convertvector(((const GAS h16x4*)(X + (size_t)rws[rr] * D) + lane)[64 * q], f32x4);
            f32x4 gq[4];
#pragma unroll
            for (int q = 0; q < 4; ++q) gq[q] = *(const GAS f32x4*)(gf + 256 * q + 4 * lane);
#pragma unroll
            for (int rr = 0; rr < 3; ++rr) { float t = 0.f;
#pragma unroll
                for (int q = 0; q < 4; ++q) t += (v[rr][q][0] * v[rr][q][0] + v[rr][q][1] * v[rr][q][1]) + (v[rr][q][2] * v[rr][q][2] + v[rr][q][3] * v[rr][q][3]);
                t = wave_sum(t); const float r0 = rsq_f(t * (1.0f / D) + EPS);
                GAS f32x4* yr = (GAS f32x4*)(Y + (size_t)rws[rr] * D) + lane;
#pragma unroll
                for (int q = 0; q < 4; ++q) yr[64 * q] = v[rr][q] * r0 * gq[q]; }
        }
    }
    ++ph;
#undef IN_PH
#undef SEAM
}

static bool launch(void* const* d_in, float* out, unsigned char* ws, int lo, int hi, hipStream_t stream, int mode = 0) {
    static int grid = 0;
    if (grid == 0) {
        int dev = 0, cus = 0, per_cu = 0;
        if (hipGetDevice(&dev) != hipSuccess || hipDeviceGetAttribute(&cus, hipDeviceAttributeMultiprocessorCount, dev) != hipSuccess) { grid = -1; return false; }
        if (hipFuncSetAttribute((const void*)fwd, hipFuncAttributeMaxDynamicSharedMemorySize, LDS_BYTES) != hipSuccess) { fprintf(stderr, "hipFuncSetAttribute failed\n"); grid = -1; return false; }
        if (hipOccupancyMaxActiveBlocksPerMultiprocessor(&per_cu, (const void*)fwd, 512, LDS_BYTES) != hipSuccess || per_cu < 1) { fprintf(stderr, "occupancy query: %d\n", per_cu); (void)hipGetLastError(); per_cu = 1; }
        grid = cus;
    }
    if (grid < 0) return false;
    Args a{};
    for (int i = 0; i < 30; ++i) a.in[i] = (const float*)d_in[i];
    a.out = out; a.ws = ws; a.ph_lo = lo; a.ph_hi = hi; a.mode = mode;
    void* kargs[] = {&a};
    const hipError_t e = hipLaunchCooperativeKernel((const void*)fwd, dim3(grid), dim3(512), kargs, LDS_BYTES, stream);
    if (e != hipSuccess) { fprintf(stderr, "cooperative launch failed: %s (grid %d)\n", hipGetErrorString(e), grid); return false; }
    return true;
}
}
extern "C" void kernel_launch(void* const* d_in, const int* in_sizes, int n_in, void* d_out, int out_size, void* d_ws, size_t ws_size, hipStream_t stream) {
    if (n_in != 30 || ws_size < mk::WS_END) { fprintf(stderr, "kernel_launch: unexpected n_in %d / ws %zu\n", n_in, ws_size); return; }
    (void)hipMemsetAsync((char*)d_ws + mk::WS_CTL, 0, mk::CTL_BYTES, stream);
    mk::launch(d_in, (float*)d_out, (unsigned char*)d_ws, 0, 23, stream);
}
```

```cpp
#include <hip/hip_runtime.h>
#include <cstdio>
#include <cstdint>
#include <hip/hip_cooperative_groups.h>
namespace mk {
namespace cg = cooperative_groups;
#define LAS __attribute__((address_space(3)))
#define GAS __attribute__((address_space(1)))
typedef unsigned short bf16_t;
typedef short bf16x8 __attribute__((ext_vector_type(8)));
typedef short s16x4 __attribute__((ext_vector_type(4)));
typedef float f32x4 __attribute__((ext_vector_type(4)));
typedef float f32x2 __attribute__((ext_vector_type(2)));
typedef unsigned u32x4 __attribute__((ext_vector_type(4)));
typedef unsigned u32x2 __attribute__((ext_vector_type(2)));
typedef _Float16 h16_t;
typedef _Float16 h16x4 __attribute__((ext_vector_type(4)));
typedef _Float16 h16x8 __attribute__((ext_vector_type(8)));
typedef float f32x8 __attribute__((ext_vector_type(8)));

constexpr int D = 1024, M = 12288, MP = 8192, FF = 4096, NCH = 768;
constexpr float EPS = 1e-6f;
constexpr int BM = 256, BK = 64, HALF = 128, HTB = HALF * BK * 2, STAGE_BYTES = 8 * HTB, NXCD = 8, WGM = 8;

typedef __bf16 bf16x2_t __attribute__((ext_vector_type(2)));
__device__ __forceinline__ unsigned cvt_pk_bf16(float lo, float hi) { const f32x2 v = {lo, hi}; const bf16x2_t b = __builtin_convertvector(v, bf16x2_t); return __builtin_bit_cast(unsigned, b); }
__device__ __forceinline__ unsigned f2bf(float f) { unsigned u = __builtin_bit_cast(unsigned, f); return (u + 0x7fffu + ((u >> 16) & 1u)) >> 16; }
__device__ __forceinline__ float bf_lo(unsigned w) { return __uint_as_float(w << 16); }
__device__ __forceinline__ float bf_hi(unsigned w) { return __uint_as_float(w & 0xffff0000u); }
__device__ __forceinline__ float rcp_f(float x) { return __builtin_amdgcn_rcpf(x); }
__device__ __forceinline__ float rsq_f(float x) { return __builtin_amdgcn_rsqf(x); }
__device__ __forceinline__ float gelu_tanh(float x) {
    const float t = x * x * (0.044715f * -2.0f * 0.7978845608028654f * 1.4426950408889634f) + (-2.0f * 0.7978845608028654f * 1.4426950408889634f);
    return x * rcp_f(1.0f + __builtin_amdgcn_exp2f(x * t));
}
__device__ __forceinline__ float sigmoid_f(float x) { return rcp_f(1.0f + __builtin_amdgcn_exp2f(x * -1.4426950408889634f)); }
__device__ __forceinline__ int lane_id() { int r; asm volatile("v_mbcnt_lo_u32_b32 %0, -1, 0\n\tv_mbcnt_hi_u32_b32 %0, -1, %0" : "=v"(r)); return r; }
__device__ __forceinline__ int cond_of_pm(int pm) { return pm < 32 ? 0 : 1 + ((pm - 32) >> 2); }
__device__ __forceinline__ int cond_of_row(int row) { return row < MP ? 0 : 1 + ((row - MP) >> 10); }

__host__ __device__ __forceinline__ int lds_byte(int r, int c) { const int st = (r >> 4) * 2 + (c >> 5), rr = r & 15, cc = c & 31, ob = rr * 64 + cc * 2; return st * 1024 + (ob ^ (((ob >> 9) & 1) << 5)); }
__host__ __device__ __forceinline__ void stage_rc(int b, int& R, int& C) { const int st = b / 1024, sb = b % 1024, swz = sb ^ (((sb >> 9) & 1) << 5); R = (st >> 1) * 16 + swz / 64; C = (st & 1) * 32 + (swz % 64) / 2; }
__host__ __device__ __forceinline__ int perm32(int rho) { const int n = rho >> 4, i = rho & 15; return 8 * (i >> 2) + 4 * n + (i & 3); }

struct Unit { int pm, pn; };
struct Gemm { const GAS char* A; const GAS char* Bt; int K; int lda; int ldb; size_t kstepA, hstepA, tstepA; int mode; };
struct ARowMajor { static __device__ __forceinline__ unsigned voff(int R, int C, int lda) { return (unsigned)(R * lda + C) * 2u; } };
struct AGroupChunk { static __device__ __forceinline__ unsigned voff(int R, int C, int) { return (unsigned)((((C >> 4) * NCH + (R >> 4)) * 256) + (R & 15) * 16 + (C & 15)) * 2u; } };
__device__ inline Gemm gemm_rowmajor(const GAS void* A, int lda, const GAS void* Bt, int ldb, int K) {
    Gemm g; g.A = (const GAS char*)A; g.Bt = (const GAS char*)Bt; g.K = K; g.lda = lda; g.ldb = ldb; g.kstepA = BK * 2; g.hstepA = (size_t)HALF * lda * 2; g.tstepA = 2 * g.hstepA; g.mode = 0; return g; }
__device__ inline Gemm gemm_groupchunk(const GAS void* A, const GAS void* Bt, int ldb, int K) {
    Gemm g; g.A = (const GAS char*)A; g.Bt = (const GAS char*)Bt; g.K = K; g.lda = 0; g.ldb = ldb; g.kstepA = (size_t)4 * NCH * 256 * 2; g.hstepA = 8 * 256 * 2; g.tstepA = 16 * 256 * 2; g.mode = 0; return g; }

struct StaticOrder {
    int nM, nN, nwg, G, c;
    __host__ __device__ void init(int M_, int N_, int G_, int c_) { nM = M_ / BM; nN = N_ / BM; nwg = nM * nN; G = G_; c = c_; }
    __host__ __device__ bool next(int i, Unit& u) const {
        const long L = (long)i * G + c; if (L >= nwg) return false;
        int wgid = (int)L; { const int q = nwg / NXCD, r = nwg % NXCD, xcd = wgid % NXCD, off = wgid / NXCD; wgid = (xcd < r ? xcd * (q + 1) : r * (q + 1) + (xcd - r) * q) + off; }
        const int nig = WGM * nN, gid = wgid / nig, fm = gid * WGM, gsz = (nM - fm) < WGM ? (nM - fm) : WGM;
        u.pm = fm + ((wgid % nig) % gsz); u.pn = (wgid % nig) / gsz; return true;
    }
};
__host__ __device__ __forceinline__ int panel_of(int vx, int pl) { return vx < 4 ? (pl < 4 ? 32 + 4 * vx + pl : 2 * vx + (pl - 4)) : 8 + 6 * (vx - 4) + pl; }
struct OwnerOrder {
    int nN, vx, rank;
    __host__ __device__ bool next(int i, Unit& u) const { const int L = i * 32 + rank; if (L >= 6 * nN) return false; u.pm = panel_of(vx, L % 6); u.pn = L / 6; return true; }
};
struct SsmOrder {
    int G, c;
    __host__ __device__ bool next(int i, Unit& u) const { const int L = i * G + c; if (L >= 192) return false; u.pm = L; u.pn = L / 3; return true; }
};

template <class Epi, class AL, class Sched>
__device__ __forceinline__ void gemm_phase(LAS unsigned char* lds, const Gemm g, const Sched& S, const Epi& E, int wave_) {
    int tid = wave_ * 64 + lane_id(); asm volatile("" : "+v"(tid));
    const int wid = __builtin_amdgcn_readfirstlane(tid >> 6), lane = tid & 63, wr = wid >> 2, wc = wid & 3, fr = lane & 15, fq = lane >> 4;
    const int K = g.K, nt = K / BK;
    unsigned voffA[2], voffB[2];
#pragma unroll
    for (int i = 0; i < 2; ++i) { int R, C; stage_rc(tid * 16 + i * 8192, R, C); const int Rb = Epi::PERM ? ((R & ~31) + perm32(R & 31)) : R;
        voffA[i] = AL::voff(R, C, g.lda); voffB[i] = (unsigned)(Rb * g.ldb + C) * 2u; }
    const size_t kstepA = g.kstepA, hstepA = g.hstepA, tstepA = g.tstepA;
    const size_t kstepB = (size_t)(BK * 2), hstepB = (size_t)HALF * g.ldb * 2, tstepB = 2 * hstepB;
    const unsigned ldsw = (unsigned)wid * 1024u;
    const int aoff = lds_byte(wr * 64 + fr, fq * 8), boff = lds_byte(wc * 32 + fr, fq * 8);
#define PG8_SA(b, h) (((b) * 2 + (h)) * HTB)
#define PG8_SB(b, h) ((4 + (b) * 2 + (h)) * HTB)
#define PG8_STAGE(bufoff, gbase, voff) do { _Pragma("unroll") for (int _i = 0; _i < 2; ++_i) \
        __builtin_amdgcn_global_load_lds((const GAS unsigned*)((const GAS char*)(gbase) + (voff)[_i]), (LAS unsigned*)(lds + (bufoff) + ldsw + _i * 8192), 16, 0, 0); } while (0)
#define PG8_LDA(dst, b, h) do { _Pragma("unroll") for (int m = 0; m < 4; ++m) _Pragma("unroll") for (int k = 0; k < 2; ++k) dst[m][k] = *(const LAS bf16x8*)(lds + PG8_SA(b, h) + aoff + m * 2048 + k * 1024); } while (0)
#define PG8_LDB(dst, b, h) do { _Pragma("unroll") for (int n = 0; n < 2; ++n) _Pragma("unroll") for (int k = 0; k < 2; ++k) dst[n][k] = *(const LAS bf16x8*)(lds + PG8_SB(b, h) + boff + n * 2048 + k * 1024); } while (0)
#define PG8_MMA(ai, bj, At, Bt) do { __builtin_amdgcn_s_setprio(1); _Pragma("unroll") for (int m = 0; m < 4; ++m) _Pragma("unroll") for (int n = 0; n < 2; ++n) _Pragma("unroll") for (int k = 0; k < 2; ++k) \
        acc[ai][bj][m][n] = __builtin_amdgcn_mfma_f32_16x16x32_bf16(Bt[n][k], At[m][k], acc[ai][bj][m][n], 0, 0, 0); __builtin_amdgcn_s_setprio(0); } while (0)
#define PG8_WAIT_V(n) asm volatile("s_waitcnt vmcnt(" #n ")" ::: "memory")
#define PG8_WAIT_L(n) asm volatile("s_waitcnt lgkmcnt(" #n ")" ::: "memory")
#define PG8_BAR __builtin_amdgcn_s_barrier()
#define PG8_SCHED __builtin_amdgcn_sched_barrier(0)
    Unit cur, nxt; int ui = 0;
    if (!S.next(0, cur)) return;
    f32x4 acc[2][2][4][2];
#pragma unroll
    for (int a = 0; a < 2; ++a)
#pragma unroll
        for (int b = 0; b < 2; ++b)
#pragma unroll
            for (int m = 0; m < 4; ++m)
#pragma unroll
                for (int n = 0; n < 2; ++n) acc[a][b][m][n] = (f32x4){0.f, 0.f, 0.f, 0.f};
    bf16x8 At[4][2], B0[2][2], B1[2][2];
    const GAS char* cA = g.A + (size_t)cur.pm * tstepA; const GAS char* cB = g.Bt + (size_t)cur.pn * tstepB;
    PG8_STAGE(PG8_SB(0, 0), cB, voffB); PG8_STAGE(PG8_SB(0, 1), cB + hstepB, voffB); PG8_STAGE(PG8_SA(0, 0), cA, voffA); PG8_STAGE(PG8_SA(0, 1), cA + hstepA, voffA);
    if (wr == 1) PG8_BAR;
    PG8_WAIT_V(2); PG8_BAR;
    PG8_STAGE(PG8_SB(1, 0), cB + kstepB, voffB); PG8_STAGE(PG8_SA(1, 0), cA + kstepA, voffA); PG8_STAGE(PG8_SB(1, 1), cB + hstepB + kstepB, voffB);
    PG8_WAIT_V(6); PG8_BAR;
    for (;;) {
        const bool has_next = S.next(ui + 1, nxt);
        const GAS char* nA = has_next ? g.A + (size_t)nxt.pm * tstepA : cA; const GAS char* nB = has_next ? g.Bt + (size_t)nxt.pn * tstepB : cB;
        for (int t = 0; t < nt; t += 2) {
            const bool last = (t == nt - 2);
            const GAS char* a1 = cA + (size_t)(t + 1) * kstepA;
            const GAS char* a2 = last ? nA : cA + (size_t)(t + 2) * kstepA; const GAS char* b2 = last ? nB : cB + (size_t)(t + 2) * kstepB;
            const GAS char* a3 = a2 + kstepA; const GAS char* b3 = b2 + kstepB;
            PG8_LDB(B0, 0, 0); PG8_LDB(B1, 0, 1); PG8_SCHED; PG8_LDA(At, 0, 0); PG8_STAGE(PG8_SA(1, 1), a1 + hstepA, voffA);
            PG8_WAIT_V(8); PG8_WAIT_L(0); PG8_BAR; PG8_MMA(0, 0, At, B0); PG8_MMA(0, 1, At, B1); PG8_BAR; PG8_SCHED;
            PG8_LDA(At, 0, 1); PG8_STAGE(PG8_SB(0, 0), b2, voffB); PG8_STAGE(PG8_SB(0, 1), b2 + hstepB, voffB); PG8_STAGE(PG8_SA(0, 0), a2, voffA);
            PG8_WAIT_V(8); PG8_WAIT_L(0); PG8_BAR; PG8_MMA(1, 0, At, B0); PG8_MMA(1, 1, At, B1); PG8_BAR; PG8_SCHED;
            PG8_LDB(B0, 1, 0); PG8_LDB(B1, 1, 1); PG8_SCHED; PG8_LDA(At, 1, 0); PG8_STAGE(PG8_SA(0, 1), a2 + hstepA, voffA);
            PG8_WAIT_V(8); PG8_WAIT_L(0); PG8_BAR; PG8_MMA(0, 0, At, B0); PG8_MMA(0, 1, At, B1); PG8_BAR; PG8_SCHED;
            PG8_LDA(At, 1, 1); PG8_STAGE(PG8_SB(1, 0), b3, voffB); PG8_STAGE(PG8_SB(1, 1), b3 + hstepB, voffB); PG8_STAGE(PG8_SA(1, 0), a3, voffA);
            PG8_WAIT_V(8); PG8_WAIT_L(0); PG8_BAR; PG8_MMA(1, 0, At, B0); PG8_MMA(1, 1, At, B1); PG8_BAR; PG8_SCHED;
        }
        if (wr == 0) PG8_BAR;
        int el_ = lane_id(); asm volatile("" : "+v"(el_));
        const int efr = el_ & 15, efq = el_ >> 4;
#ifdef MK_RANGE
        if constexpr (!Epi::AFTER_DRAIN) { if (g.mode != 1) E(acc, cur, ui, lds, wr, wc, efr, efq); else { asm volatile("" :: "v"(acc[0][0][0][0]), "v"(acc[1][1][3][1])); } }
#else
        if constexpr (!Epi::AFTER_DRAIN) E(acc, cur, ui, lds, wr, wc, efr, efq);
#endif
        if (!has_next) break;
#pragma unroll
        for (int a = 0; a < 2; ++a)
#pragma unroll
            for (int b = 0; b < 2; ++b)
#pragma unroll
                for (int m = 0; m < 4; ++m)
#pragma unroll
                    for (int n = 0; n < 2; ++n) acc[a][b][m][n] = (f32x4){0.f, 0.f, 0.f, 0.f};
        cur = nxt; cA = nA; cB = nB; ++ui;
        if (wr == 1) PG8_BAR;
    }
    PG8_WAIT_V(0);
    PG8_BAR;
    if constexpr (Epi::AFTER_DRAIN) E.fused(acc, cur, wr, wc, fr, fq, lds, tid);
#undef PG8_SA
#undef PG8_SB
#undef PG8_STAGE
#undef PG8_LDA
#undef PG8_LDB
#undef PG8_MMA
#undef PG8_WAIT_V
#undef PG8_WAIT_L
#undef PG8_BAR
#undef PG8_SCHED
}

typedef const f32x4 (&AccRef)[2][2][4][2];

constexpr int PTR_OFF = STAGE_BYTES + 256 + 10240;
__device__ __forceinline__ unsigned long long ldsptr(const LAS unsigned char* lds, int k) { const unsigned long long v = ((const LAS unsigned long long*)(lds + PTR_OFF))[k];
    return ((unsigned long long)(unsigned)__builtin_amdgcn_readfirstlane((int)(unsigned)(v >> 32)) << 32) | (unsigned)__builtin_amdgcn_readfirstlane((int)(unsigned)v); }
__device__ __forceinline__ const GAS float* inp(const LAS unsigned char* lds, int k) { return (const GAS float*)ldsptr(lds, k); }
constexpr int TAB_OFF = STAGE_BYTES + 256, T_RS = TAB_OFF, T_SW = T_RS + 3072, T_GATE = T_SW + 3072, T_GSN = T_GATE + 2048;
template <class Sched> __device__ __forceinline__ void fill_tables_in(LAS unsigned char* lds, const Sched& S, const GAS float* rowss, const GAS float* sw, int swld, int tid) {
    LAS float* trs = (LAS float*)(lds + T_RS); LAS float* tsw = (LAS float*)(lds + T_SW);
#pragma unroll 1
    for (int i = 0; i < 3; ++i) { Unit u; if (!S.next(i, u)) break;
        if (tid < 256) { const GAS f32x4* p = (const GAS f32x4*)(rowss + (size_t)(u.pm * BM + tid) * 32);
            const f32x4 a = ((p[0] + p[1]) + (p[2] + p[3])) + ((p[4] + p[5]) + (p[6] + p[7]));
            trs[i * 256 + tid] = rsq_f(((a[0] + a[1]) + (a[2] + a[3])) * (1.0f / D) + EPS); }
        else tsw[i * 256 + tid - 256] = sw[(unsigned)(cond_of_pm(u.pm) * swld + u.pn * BM + tid - 256)];
    }
    __syncthreads();
}
template <int NCOL, class Sched> __device__ __forceinline__ void fill_tables_res(LAS unsigned char* lds, const Sched& S, const GAS float* gate, const GAS float* gsn, int tid) {
    LAS float* tg = (LAS float*)(lds + T_GATE); LAS float* tn = (LAS float*)(lds + T_GSN);
#pragma unroll 1
    for (int i = 0; i < 2; ++i) { Unit u; if (!S.next(i, u)) break; const int ci = cond_of_pm(u.pm);
        if (tid < NCOL) tg[i * 256 + tid] = gate[(unsigned)(ci * 6144 + u.pn * NCOL + tid)];
        else if (tid >= 256 && tid < 256 + NCOL) tn[i * 256 + tid - 256] = gsn ? gsn[(unsigned)(ci * 1024 + u.pn * NCOL + tid - 256)] : 0.f;
    }
    __syncthreads();
}
__device__ __forceinline__ void load_rstd(const LAS unsigned char* lds, int ui, int wr, int fr, float (&rs)[2][4]) {
    const LAS float* trs = (const LAS float*)(lds + T_RS) + ui * 256 + wr * 64 + fr;
#pragma unroll
    for (int ai = 0; ai < 2; ++ai)
#pragma unroll
        for (int m = 0; m < 4; ++m) rs[ai][m] = trs[ai * HALF + m * 16];
}

template <int ACT, int LDC> struct EpiIn {
    static constexpr bool PERM = true, AFTER_DRAIN = false;
    GAS bf16_t* O; GAS float* vstat;
    __device__ __forceinline__ void operator()(AccRef acc, const Unit& u, int ui, const LAS unsigned char* lds, int wr, int wc, int fr, int fq) const {
        const int row0 = u.pm * BM + wr * 64 + fr, col0 = u.pn * BM + wc * 32 + 8 * fq;
        float rs[2][4]; load_rstd(lds, ui, wr, fr, rs);
        const LAS float* swp = (const LAS float*)(lds + T_SW) + ui * 256 + wc * 32 + 8 * fq;
        const bool stats = ACT == 2 && u.pn >= 8;
#pragma unroll
        for (int bj = 0; bj < 2; ++bj) {
            const f32x4 b0 = *(const LAS f32x4*)(swp + bj * HALF), b1 = *(const LAS f32x4*)(swp + bj * HALF + 4);
#pragma unroll
            for (int ai = 0; ai < 2; ++ai)
#pragma unroll
                for (int m = 0; m < 4; ++m) {
                    const unsigned r = (unsigned)(row0 + ai * HALF + m * 16);
                    f32x4 v0 = acc[ai][bj][m][0] * rs[ai][m] + b0, v1 = acc[ai][bj][m][1] * rs[ai][m] + b1;
                    if (ACT == 1) {
#pragma unroll
                        for (int j = 0; j < 4; ++j) { const float a = fmaxf(v0[j], 0.f), b = fmaxf(v1[j], 0.f); v0[j] = a * a; v1[j] = b * b; } }
                    if (ACT == 2) {
#pragma unroll
                        for (int j = 0; j < 4; ++j) { v0[j] = gelu_tanh(v0[j]); v1[j] = gelu_tanh(v1[j]); } }
                    u32x4 w; w.x = cvt_pk_bf16(v0[0], v0[1]); w.y = cvt_pk_bf16(v0[2], v0[3]); w.z = cvt_pk_bf16(v1[0], v1[1]); w.w = cvt_pk_bf16(v1[2], v1[3]);
                    *(GAS u32x4*)(O + (r * (unsigned)LDC + (unsigned)(col0 + bj * HALF))) = w;
                    if (ACT == 2) { if (stats) {
                        float a = (v0[0] + v0[1]) + (v0[2] + v0[3]) + (v1[0] + v1[1]) + (v1[2] + v1[3]);
                        float b = (v0[0] * v0[0] + v0[1] * v0[1]) + (v0[2] * v0[2] + v0[3] * v0[3]) + (v1[0] * v1[0] + v1[1] * v1[1]) + (v1[2] * v1[2] + v1[3] * v1[3]);
                        a += __shfl_xor(a, 16); a += __shfl_xor(a, 32); b += __shfl_xor(b, 16); b += __shfl_xor(b, 32);
                        if (fq == 0) *(GAS f32x2*)(vstat + (r * 64u + (unsigned)(((u.pn - 8) * 2 + bj) * 4 + wc)) * 2u) = (f32x2){a, b}; } }
                }
        }
    }
};
struct EpiU {
    static constexpr bool PERM = true, AFTER_DRAIN = false;
    GAS bf16_t* UgS;
    __device__ __forceinline__ void operator()(AccRef acc, const Unit& u, int ui, const LAS unsigned char* lds, int wr, int wc, int fr, int fq) const {
        const int col0 = u.pn * BM + wc * 32 + 8 * fq;
        float rs[2][4]; load_rstd(lds, ui, wr, fr, rs);
        const LAS float* swp = (const LAS float*)(lds + T_SW) + ui * 256 + wc * 32 + 8 * fq;
#pragma unroll
        for (int bj = 0; bj < 2; ++bj) {
            const f32x4 b0 = *(const LAS f32x4*)(swp + bj * HALF), b1 = *(const LAS f32x4*)(swp + bj * HALF + 4);
            const int g = (col0 + bj * HALF) >> 4, p0 = (col0 & 15);
#pragma unroll
            for (int ai = 0; ai < 2; ++ai)
#pragma unroll
                for (int m = 0; m < 4; ++m) {
                    const f32x4 v0 = acc[ai][bj][m][0] * rs[ai][m] + b0, v1 = acc[ai][bj][m][1] * rs[ai][m] + b1;
                    u32x4 w; w.x = cvt_pk_bf16(v0[0], v0[1]); w.y = cvt_pk_bf16(v0[2], v0[3]); w.z = cvt_pk_bf16(v1[0], v1[1]); w.w = cvt_pk_bf16(v1[2], v1[3]);
                    const int chunk = u.pm * 16 + ai * 8 + wr * 4 + m;
                    *(GAS u32x4*)(UgS + ((unsigned)(g * NCH + chunk) * 512u + (unsigned)(fr * 16 + p0))) = w;
                }
        }
    }
};
struct EpiScan {
    static constexpr bool PERM = true, AFTER_DRAIN = true;
    GAS bf16_t* UgS; const GAS float* lamT; const GAS float* h0_re; const GAS float* h0_im; GAS float* new_re; GAS float* new_im; int j;
    static __device__ __forceinline__ int lidx(int row, int col) { return row * 128 + ((((col >> 2) ^ row) & 31) << 2) + (col & 3); }
    __device__ __forceinline__ void fused(AccRef acc, const Unit& u, int wr, int wc, int fr, int fq, LAS unsigned char* lds, int tid) const {
        LAS float* T = (LAS float*)lds;
        const int g = u.pn, mt = u.pm - 3 * g, n = tid & 63, slot = __builtin_amdgcn_readfirstlane(tid >> 6);
        const int len = mt < 2 ? 16 : 64, nsq = mt < 2 ? 2 : (slot < 4 ? 1 : 0), sl0 = mt < 2 ? slot * 2 : slot;
#pragma unroll 1
        for (int k = 0; k < 2; ++k) {
#pragma unroll
            for (int ai = 0; ai < 2; ++ai)
#pragma unroll
                for (int m = 0; m < 4; ++m) { const int row = ai * HALF + wr * 64 + m * 16 + fr;
#pragma unroll
                    for (int nn = 0; nn < 2; ++nn) { const int col = wc * 32 + 8 * fq + 4 * nn; *(LAS f32x4*)(T + lidx(row, col)) = k == 0 ? acc[ai][0][m][nn] : acc[ai][1][m][nn]; } }
            __syncthreads();
            const float lr = lamT[(((unsigned)j * 64 + g) * 2 + k) * 128 + 2 * n], li = lamT[(((unsigned)j * 64 + g) * 2 + k) * 128 + 2 * n + 1];
            for (int q = 0; q < nsq; ++q) {
                const int sl = sl0 + q, r0 = sl * len;
                float sr = 0.f, si = 0.f;
                if (mt == 2) { const unsigned o = ((((unsigned)sl * 2 + j) * 2 + k) * 64 + g) * 64 + n; sr = h0_re[o]; si = h0_im[o]; }
                GAS bf16_t* so = UgS + ((size_t)g * NCH + mt * 256) * 512 + 256 + k * 128 + n;
                for (int i = 0; i < len; ++i) {
                    const int row = k == 0 ? r0 + i : r0 + len - 1 - i;
                    so[(unsigned)row * 512u] = (bf16_t)f2bf(sr); so[(unsigned)row * 512u + 64u] = (bf16_t)f2bf(si);
                    const float ar = T[lidx(row, n)], ai2 = T[lidx(row, 64 + n)];
                    const float nr = lr * sr - li * si + ar, ni = lr * si + li * sr + ai2; sr = nr; si = ni;
                }
                if (mt < 2) { const unsigned o = ((((unsigned)(mt * 16 + sl) * 2 + j) * 2 + k) * 64 + g) * 64 + n; new_re[o] = sr; new_im[o] = si; }
            }
            __syncthreads();
        }
    }
};
struct EpiY {
    static constexpr bool PERM = true, AFTER_DRAIN = false;
    GAS bf16_t* Zg;
    __device__ __forceinline__ void operator()(AccRef acc, const Unit& u, int ui, const LAS unsigned char* lds, int wr, int wc, int fr, int fq) const {
        const int row0 = u.pm * BM + wr * 64 + fr, col0 = wc * 32 + 8 * fq;
#pragma unroll
        for (int ai = 0; ai < 2; ++ai)
#pragma unroll
            for (int m = 0; m < 4; ++m) { GAS bf16_t* rp = Zg + (size_t)(row0 + ai * HALF + m * 16) * 256 + col0;
#pragma unroll
                for (int bj = 0; bj < 2; ++bj) { const f32x4 v0 = acc[ai][bj][m][0], v1 = acc[ai][bj][m][1];
                    u32x4 w; w.x = cvt_pk_bf16(gelu_tanh(v0[0]), gelu_tanh(v0[1])); w.y = cvt_pk_bf16(gelu_tanh(v0[2]), gelu_tanh(v0[3]));
                    w.z = cvt_pk_bf16(gelu_tanh(v1[0]), gelu_tanh(v1[1])); w.w = cvt_pk_bf16(gelu_tanh(v1[2]), gelu_tanh(v1[3]));
                    *(GAS u32x4*)(rp + bj * HALF) = w; } }
    }
};
template <bool GATED> struct EpiRes {
    static constexpr bool PERM = true, AFTER_DRAIN = false;
    GAS h16_t* X; GAS bf16_t* XN; GAS float* rowss_next; bool has_next;
    __device__ __forceinline__ void operator()(AccRef acc, const Unit& u, int ui, const LAS unsigned char* lds, int wr, int wc, int fr, int fq) const {
        constexpr int NB = GATED ? 1 : 2;
        const int row0 = u.pm * BM + wr * 64 + fr, col0 = u.pn * (GATED ? HALF : BM) + wc * 32 + 8 * fq;
        const LAS float* tg = (const LAS float*)(lds + T_GATE) + ui * 256 + wc * 32 + 8 * fq; const LAS float* tn = (const LAS float*)(lds + T_GSN) + ui * 256 + wc * 32 + 8 * fq;
        h16x8 xa[4], xb[4];
#define RES_LOAD(dst, b_) do { const int bj_ = (b_) / 2, ai_ = (b_) % 2; _Pragma("unroll") for (int m = 0; m < 4; ++m) \
            dst[m] = *(const GAS h16x8*)(X + ((unsigned)(row0 + ai_ * HALF + m * 16) * (unsigned)D + (unsigned)(col0 + bj_ * HALF))); } while (0)
#define RES_PROC(src, b_) do { const int bj = (b_) / 2, ai = (b_) % 2; \
            const f32x4 g0 = *(const LAS f32x4*)(tg + bj * HALF), g1 = *(const LAS f32x4*)(tg + bj * HALF + 4), n0 = *(const LAS f32x4*)(tn + bj * HALF), n1 = *(const LAS f32x4*)(tn + bj * HALF + 4); \
            _Pragma("unroll") for (int m = 0; m < 4; ++m) { \
                const unsigned r = (unsigned)(row0 + ai * HALF + m * 16), off = r * (unsigned)D + (unsigned)(col0 + bj * HALF); \
                f32x4 v0 = acc[ai][bj][m][0], v1 = acc[ai][bj][m][1]; \
                if (GATED) { const f32x4 q0 = acc[ai][1][m][0], q1 = acc[ai][1][m][1]; \
                    _Pragma("unroll") for (int j = 0; j < 4; ++j) { v0[j] *= sigmoid_f(q0[j]); v1[j] *= sigmoid_f(q1[j]); } } \
                const f32x8 xo = __builtin_convertvector(src[m], f32x8); \
                const f32x4 x0 = (f32x4){xo[0], xo[1], xo[2], xo[3]} + g0 * v0, x1 = (f32x4){xo[4], xo[5], xo[6], xo[7]} + g1 * v1; \
                *(GAS h16x8*)(X + off) = __builtin_convertvector(((f32x8){x0[0], x0[1], x0[2], x0[3], x1[0], x1[1], x1[2], x1[3]}), h16x8); \
                if (has_next) { \
                    float a = (x0[0] * x0[0] + x0[1] * x0[1]) + (x0[2] * x0[2] + x0[3] * x0[3]) + (x1[0] * x1[0] + x1[1] * x1[1]) + (x1[2] * x1[2] + x1[3] * x1[3]); \
                    const f32x4 y0 = x0 * n0, y1 = x1 * n1; \
                    u32x4 w; w.x = cvt_pk_bf16(y0[0], y0[1]); w.y = cvt_pk_bf16(y0[2], y0[3]); w.z = cvt_pk_bf16(y1[0], y1[1]); w.w = cvt_pk_bf16(y1[2], y1[3]); \
                    *(GAS u32x4*)(XN + off) = w; \
                    a += __shfl_xor(a, 16); a += __shfl_xor(a, 32); \
                    if (fq == 0) rowss_next[r * 32u + (unsigned)(GATED ? u.pn * 4 + wc : (u.pn * 2 + bj) * 4 + wc)] = a; } } } while (0)
        h16x8 xc[4], xd[4];
        RES_LOAD(xa, 0); RES_LOAD(xb, 1);
        if (NB > 1) { RES_LOAD(xc, 2); RES_LOAD(xd, 3); }
        RES_PROC(xa, 0); RES_PROC(xb, 1);
        if (NB > 1) { RES_PROC(xc, 2); RES_PROC(xd, 3); }
#undef RES_LOAD
#undef RES_PROC
    }
};

#define XB_TMO      128
#define XB_XCNT(j)  (256  + 64 * (j))
#define XB_XSUB(j)  (1280 + 64 * (j))
#define XB_XGEN(j)  (2304 + 64 * (j))
#define XB_TOP      3328
#define XB_TOPGEN   3392
#define XCD_BAR_WORDS 3456
#define XB_SPIN_CAP (1u << 18)
__device__ __forceinline__ unsigned xb_ld(GAS unsigned* p)              { return __hip_atomic_load(p, __ATOMIC_RELAXED, __HIP_MEMORY_SCOPE_AGENT); }
__device__ __forceinline__ unsigned xb_add(GAS unsigned* p, unsigned v) { return __hip_atomic_fetch_add(p, v, __ATOMIC_RELAXED, __HIP_MEMORY_SCOPE_AGENT); }
__device__ __forceinline__ unsigned xb_xcc_id() { return (unsigned)__builtin_amdgcn_s_getreg((3 << 11) | 20) & 0xFu; }
#define XB_SPIN(cond, bar) do { unsigned _sp = 0; while (cond) { __builtin_amdgcn_s_sleep(1); \
    if ((++_sp & 255u) == 0u) { if (xb_ld(&(bar)[XB_TMO])) break; if (_sp > XB_SPIN_CAP) { (void)xb_add(&(bar)[XB_TMO], 1u); break; } } } } while (0)
struct XcdBarrier { GAS unsigned* bar; unsigned x; volatile LAS unsigned* st; };
__device__ __forceinline__ XcdBarrier xcd_barrier_post(GAS unsigned* bar, volatile LAS unsigned* st) {
    XcdBarrier b; b.bar = bar; b.x = xb_xcc_id(); b.st = st;
    if (threadIdx.x == 0) st[2] = xb_add(&bar[XB_XCNT(b.x)], 1u);
    return b;
}
__device__ __forceinline__ void xcd_barrier_complete(GAS unsigned* bar, unsigned x, unsigned& nloc, unsigned& nx, unsigned& dense, unsigned& uni) {
    const unsigned G = gridDim.x * gridDim.y * gridDim.z;
    unsigned sum, cnt, mine, sp = 0u;
    for (;;) {
        sum = 0u; cnt = 0u; dense = 0u; uni = 1u;
#pragma unroll 1
        for (unsigned j = 0; j < 16; ++j) { const unsigned c = xb_ld(&bar[XB_XCNT(j)]); sum += c; cnt += (c > 0u) ? 1u : 0u; dense += (j < x && c > 0u) ? 1u : 0u; uni &= (c == 0u || c == 32u) ? 1u : 0u; }
        mine = xb_ld(&bar[XB_XCNT(x)]);
        if (sum == G) break;
        __builtin_amdgcn_s_sleep(1);
        if ((++sp & 255u) == 0u) { if (xb_ld(&bar[XB_TMO])) break; if (sp > XB_SPIN_CAP) { (void)xb_add(&bar[XB_TMO], 1u); break; } }
    }
    nloc = mine > 0u ? mine : 1u; nx = cnt > 0u ? cnt : 1u;
}
__device__ __forceinline__ void xcd_barrier(const XcdBarrier& b, bool leader) {
    asm volatile("s_waitcnt vmcnt(0)" ::: "memory");
    __syncthreads();
    if (leader) {
        GAS unsigned* bar = b.bar; unsigned bx_ = b.x;
        asm volatile("" : "+s"(bar), "+s"(bx_));
        __builtin_amdgcn_s_waitcnt(0);
        unsigned nloc = b.st[0], nx = b.st[1];
        if (nloc == 0u) { unsigned dense, uni; xcd_barrier_complete(bar, bx_, nloc, nx, dense, uni); b.st[0] = nloc; b.st[1] = nx; b.st[3] = dense;
            b.st[4] = (nx == 8u && uni != 0u && gridDim.x == 256u) ? 1u : 0u; }
        const unsigned old = xb_add(&bar[XB_XSUB(bx_)], 1u);
        const unsigned gen = old / nloc;
        if (old + 1u == (gen + 1u) * nloc) {
            __builtin_amdgcn_fence(__ATOMIC_RELEASE, "agent");
            asm volatile("s_waitcnt vmcnt(0)" ::: "memory");
            const unsigned og = xb_add(&bar[XB_TOP], 1u);
            const unsigned tg = og / nx;
            if (og + 1u == (tg + 1u) * nx) xb_add(&bar[XB_TOPGEN], 1u);
            else XB_SPIN(xb_ld(&bar[XB_TOPGEN]) == tg, bar);
            __builtin_amdgcn_fence(__ATOMIC_ACQUIRE, "agent");
            xb_add(&bar[XB_XGEN(bx_)], 1u);
            asm volatile("s_waitcnt vmcnt(0)" ::: "memory");
        } else {
            XB_SPIN(xb_ld(&bar[XB_XGEN(bx_)]) == gen, bar);
            __builtin_amdgcn_fence(__ATOMIC_ACQUIRE, "agent");
            asm volatile("s_waitcnt vmcnt(0)" ::: "memory");
        }
    }
    __syncthreads();
}

__device__ __forceinline__ void xcc_barrier(const XcdBarrier& b, bool leader) {
    asm volatile("s_waitcnt vmcnt(0)" ::: "memory");
    __syncthreads();
    if (leader) {
        GAS unsigned* bar = b.bar; unsigned bx_ = b.x;
        asm volatile("" : "+s"(bar), "+s"(bx_));
        __builtin_amdgcn_s_waitcnt(0);
        const unsigned nloc = b.st[0];
        const unsigned old = xb_add(&bar[XB_XSUB(bx_)], 1u);
        const unsigned gen = old / nloc;
        if (old + 1u == (gen + 1u) * nloc) xb_add(&bar[XB_XGEN(bx_)], 1u);
        else XB_SPIN(xb_ld(&bar[XB_XGEN(bx_)]) == gen, bar);
        __builtin_amdgcn_fence(__ATOMIC_ACQUIRE, "agent");
        asm volatile("s_waitcnt vmcnt(0)" ::: "memory");
    }
    __syncthreads();
}

constexpr size_t MiB = 1u << 20;
constexpr size_t WS_CTL = 0, CTL_BYTES = 2 * MiB;
constexpr int CW_BAR = 4096;
constexpr size_t WS_TAB = 2 * MiB;
constexpr size_t TAB_GSA = WS_TAB, TAB_GSB = TAB_GSA + 4 * 5 * 1024 * 4, TAB_SWA = TAB_GSB + 4 * 5 * 1024 * 4, TAB_SWB = TAB_SWA + 4 * 5 * 4096 * 4, TAB_LAMT = TAB_SWB + 4 * 5 * 4096 * 4;
static_assert(TAB_LAMT + 2 * 64 * 2 * 64 * 2 * 4 <= 4 * MiB, "tables");
constexpr size_t WS_W1 = 4 * MiB, WS_W2 = 36 * MiB, WS_SWIN = 68 * MiB, WS_SWOUT = 72 * MiB, WS_GWIN = 80 * MiB, WS_GWOUT = 88 * MiB, WS_GWS = 92 * MiB,
                 WS_CWIN = 93 * MiB, WS_CWOUT = 99 * MiB, WS_BTY = 101 * MiB, WS_BTS = 133 * MiB;
constexpr size_t WS_XN = 149 * MiB;
constexpr size_t WS_R = 173 * MiB;
constexpr size_t WS_R2 = 269 * MiB;
constexpr size_t WS_ROWSS = 317 * MiB;
constexpr size_t WS_VSTAT = 329 * MiB;
constexpr size_t WS_MODS = 335 * MiB;
constexpr size_t WS_X16 = 336 * MiB;
constexpr size_t WS_END = 360 * MiB;

constexpr int LDS_BYTES = 147456;
constexpr int MISC_OFF = STAGE_BYTES;

struct Args { const float* in[30]; float* out; unsigned char* ws; int ph_lo, ph_hi; int mode, pad; };

__device__ __forceinline__ unsigned pk2(float lo, float hi) { return f2bf(lo) | (f2bf(hi) << 16); }
__device__ __forceinline__ float wave_sum(float v) {
#pragma unroll
    for (int o = 1; o < 64; o <<= 1) v += __shfl_xor(v, o);
    return v;
}
template <int MAP> __device__ __forceinline__ int rowmap(int n) {
    if (MAP == 1) { const int half = n >> 10, c = n & 1023; return (c >> 7) * 256 + half * 128 + (c & 127); }
    return n;
}
template <int MAP> __device__ __forceinline__ void transpose_item(const GAS float* W, int K, int N, GAS bf16_t* WT, LAS float* scr, int item, int lane) {
    const int nblk = N / 32, kb = item / nblk, nb = item % nblk, k0 = 64 * kb, n0 = 32 * nb;
    float wv[32];
#pragma unroll
    for (int i = 0; i < 32; ++i) wv[i] = W[(size_t)(k0 + 2 * i + (lane >> 5)) * N + n0 + (lane & 31)];
#pragma unroll
    for (int i = 0; i < 32; ++i) scr[(2 * i + (lane >> 5)) * 33 + (lane & 31)] = wv[i];
    asm volatile("s_waitcnt lgkmcnt(0)" ::: "memory");
    const int c = lane & 7;
#pragma unroll
    for (int j = 0; j < 4; ++j) { const int n = (lane >> 3) + 8 * j; const LAS float* s = scr + (8 * c) * 33 + n;
        u32x4 o; o.x = pk2(s[0 * 33], s[1 * 33]); o.y = pk2(s[2 * 33], s[3 * 33]); o.z = pk2(s[4 * 33], s[5 * 33]); o.w = pk2(s[6 * 33], s[7 * 33]);
        *(GAS u32x4*)(WT + (size_t)rowmap<MAP>(n0 + n) * K + k0 + 8 * c) = o; }
    asm volatile("s_waitcnt lgkmcnt(0)" ::: "memory");
}

__device__ __forceinline__ void ssm_build(const Args& a, int j, int g, int part, LAS unsigned char* lds, GAS unsigned char* ws, int tid) {
#ifdef MK_RANGE
    const int PMODE = a.mode;
#else
    constexpr int PMODE = 0;
#endif
    LAS float* PR = (LAS float*)lds;
    LAS float* PI = PR + 2 * 17 * 64;
    LAS float* BR = PI + 2 * 17 * 64;
    LAS float* BI = BR + 2 * 64 * 16;
    LAS float* CR = BI + 2 * 64 * 16;
    LAS float* CI = CR + 2 * 16 * 64;
    LAS float* WR = CI + 2 * 16 * 64;
    LAS float* WI = WR + 2 * 64 * 16;
    LAS float* KT = WI + 2 * 64 * 16;
    const GAS float* lam_re = inp(lds, 13); const GAS float* lam_im = inp(lds, 14); const GAS float* log_dt = inp(lds, 15);
    const GAS float* b_re = inp(lds, 16); const GAS float* b_im = inp(lds, 17); const GAS float* c_re = inp(lds, 18); const GAS float* c_im = inp(lds, 19); const GAS float* dsk = inp(lds, 20);
    __syncthreads();
    LAS float* FR = WR; LAS float* FI = WR + 128; LAS float* DSK = WR + 256;
    if (tid >= 128 && tid < 144) DSK[tid - 128] = dsk[j * 1024 + g * 16 + tid - 128];
    if (tid < 128) {
        const int k = tid >> 6, n = tid & 63, pidx = (j * 2 + k) * 64 + g;
        const float dt = expf(log_dt[pidx]);
        const float lr = lam_re[pidx * 64 + n], li = lam_im[pidx * 64 + n];
        const float mag = expf(lr * dt); float sn, cs; sincosf(li * dt, &sn, &cs); const float abr = mag * cs, abi = mag * sn;
        const float den = lr * lr + li * li;
        const float nr = (abr - 1.0f) * lr + abi * li, ni = -(abr - 1.0f) * li + abi * lr;
        FR[tid] = nr / den; FI[tid] = ni / den;
    }
#pragma unroll 1
    for (int i = tid; i < 2 * 17 * 64; i += 512) {
        const int k = i / (17 * 64), e = (i >> 6) % 17, n = i & 63, pidx = (j * 2 + k) * 64 + g;
        const float dt = expf(log_dt[pidx]); const float lr = lam_re[pidx * 64 + n], li = lam_im[pidx * 64 + n];
        const float mag = expf((float)e * lr * dt); float sn, cs; sincosf((float)e * (li * dt), &sn, &cs); PR[i] = mag * cs; PI[i] = mag * sn; }
    for (int i = tid; i < 2048; i += 512) { const int k = i >> 10, po = (i >> 6) & 15, n = i & 63; const size_t o = ((size_t)(j * 2 + k) * 64 + g) * 1024 + (i & 1023);
        CR[(k * 64 + n) * 16 + po] = c_re[o]; CI[(k * 64 + n) * 16 + po] = c_im[o]; }
    __syncthreads();
    for (int i = tid; i < 2048; i += 512) { const int kn = i >> 4; const size_t o = ((size_t)(j * 2 + (kn >> 6)) * 64 + g) * 1024 + (i & 1023);
        const float br = b_re[o], bi = b_im[o], fr = FR[kn], fi = FI[kn]; BR[i] = fr * br - fi * bi; BI[i] = fr * bi + fi * br; }
    if (part == 1 && tid < 128) { const int k = tid >> 6, n = tid & 63; GAS float* lamT = (GAS float*)(ws + TAB_LAMT) + (((size_t)j * 64 + g) * 2 + k) * 128;
        lamT[2 * n] = PR[(k * 17 + 16) * 64 + n]; lamT[2 * n + 1] = PI[(k * 17 + 16) * 64 + n]; }
    __syncthreads();
    if (part == 0 && PMODE != 6) {
        const int e = tid >> 5, k = (tid >> 4) & 1, po4 = (tid >> 2) & 3, pi4 = tid & 3;
        float acc[4][4];
#pragma unroll
        for (int x = 0; x < 4; ++x)
#pragma unroll
            for (int y = 0; y < 4; ++y) acc[x][y] = 0.f;
#pragma unroll 2
        for (int n = 0; n < 64; ++n) {
            const float pr = PR[(k * 17 + e) * 64 + n], pim = PI[(k * 17 + e) * 64 + n];
            const f32x4 br = *(const LAS f32x4*)(BR + (k * 64 + n) * 16 + 4 * pi4), bi = *(const LAS f32x4*)(BI + (k * 64 + n) * 16 + 4 * pi4);
            const f32x4 cr = *(const LAS f32x4*)(CR + (k * 64 + n) * 16 + 4 * po4), ci = *(const LAS f32x4*)(CI + (k * 64 + n) * 16 + 4 * po4);
            const f32x4 wr = br * pr - bi * pim, wi = bi * pr + br * pim;
#pragma unroll
            for (int x = 0; x < 4; ++x)
#pragma unroll
                for (int y = 0; y < 4; ++y) acc[x][y] += cr[x] * wr[y] - ci[x] * wi[y];
        }
#pragma unroll
        for (int x = 0; x < 4; ++x) *(LAS f32x4*)(KT + ((k * 16 + e) * 16 + 4 * po4 + x) * 16 + 4 * pi4) = (f32x4){acc[x][0], acc[x][1], acc[x][2], acc[x][3]};
    }
    __syncthreads();
    GAS bf16_t* BtY = (GAS bf16_t*)(ws + WS_BTY) + ((size_t)j * 64 + g) * 256 * 512;
    GAS bf16_t* BtS = (GAS bf16_t*)(ws + WS_BTS) + ((size_t)j * 64 + g) * 256 * 256;
    if (part == 0) {
    if (PMODE != 7)
#pragma unroll 1
    for (int pc = tid; pc < 256 * 32; pc += 512) {
        const int row = pc >> 5, kc = (pc & 31) * 8, t = row >> 4, po = row & 15, s = kc >> 4, pi0 = kc & 15;
        float v[8];
#pragma unroll
        for (int q = 0; q < 8; ++q) { const int pi = pi0 + q; float x = 0.f;
            if (s <= t) x += KT[((0 * 16 + (t - s)) * 16 + po) * 16 + pi];
            if (s >= t) x += KT[((1 * 16 + (s - t)) * 16 + po) * 16 + pi];
            if (s == t && pi == po) x += DSK[po];
            v[q] = x; }
        u32x4 o; o.x = pk2(v[0], v[1]); o.y = pk2(v[2], v[3]); o.z = pk2(v[4], v[5]); o.w = pk2(v[6], v[7]);
        *(GAS u32x4*)(BtY + (size_t)row * 512 + kc) = o;
    }
    if (PMODE != 8)
#pragma unroll 1
    for (int pc = tid; pc < 256 * 32; pc += 512) {
        const int row = pc >> 5, kc = (pc & 31) * 8, t = row >> 4, po = row & 15, k = kc >> 7, ri = (kc >> 6) & 1, n0 = kc & 63;
        const int e = k == 0 ? t + 1 : 16 - t;
        float v[8];
#pragma unroll
        for (int q = 0; q < 8; ++q) { const int n = n0 + q; const float cr = CR[(k * 64 + n) * 16 + po], cim = CI[(k * 64 + n) * 16 + po], pr = PR[(k * 17 + e) * 64 + n], pim = PI[(k * 17 + e) * 64 + n];
            v[q] = ri == 0 ? (cr * pr - cim * pim) : -(cr * pim + cim * pr); }
        u32x4 o; o.x = pk2(v[0], v[1]); o.y = pk2(v[2], v[3]); o.z = pk2(v[4], v[5]); o.w = pk2(v[6], v[7]);
        *(GAS u32x4*)(BtY + (size_t)row * 512 + 256 + kc) = o;
    }
    } else {
    for (int pc = tid; pc < 256 * 32; pc += 512) {
        const int row = pc >> 5, kc = (pc & 31) * 8, k = row >> 7, ri = (row >> 6) & 1, n = row & 63, s = kc >> 4, pi0 = kc & 15;
        const int e = k == 0 ? 15 - s : s;
        const float pr = PR[(k * 17 + e) * 64 + n], pim = PI[(k * 17 + e) * 64 + n];
        float v[8];
#pragma unroll
        for (int q = 0; q < 8; ++q) { const float br = BR[(k * 64 + n) * 16 + pi0 + q], bi = BI[(k * 64 + n) * 16 + pi0 + q]; v[q] = ri == 0 ? (pr * br - pim * bi) : (pr * bi + pim * br); }
        u32x4 o; o.x = pk2(v[0], v[1]); o.y = pk2(v[2], v[3]); o.z = pk2(v[4], v[5]); o.w = pk2(v[6], v[7]);
        *(GAS u32x4*)(BtS + (size_t)row * 256 + kc) = o;
    }
    }
    __syncthreads();
}

__device__ __forceinline__ void mods_task(const Args& a, GAS float* mods, LAS unsigned char* lds, int task, int tid) {
    const int cg = task % 48, l = task / 48, wave = tid >> 6, lane = tid & 63, half = lane >> 5, c4 = lane & 31;
    const GAS float* c = inp(lds, 4); const GAS float* c_ctx = inp(lds, 5); const GAS float* w_mod = inp(lds, 6); const GAS float* b_mod = inp(lds, 7);
    LAS float* sil = (LAS float*)lds;
    LAS float* red = sil + 5 * 1024;
    __syncthreads();
    for (int i = tid; i < 5 * 1024; i += 512) { const int ci = i >> 10, k = i & 1023; const float v = ci == 0 ? c_ctx[k] : c[(ci - 1) * 1024 + k]; sil[i] = v / (1.0f + expf(-v)); }
    __syncthreads();
    const GAS float* w = w_mod + ((size_t)l * 1024 + wave * 128 + half) * 6144 + cg * 128 + c4 * 4;
    f32x4 acc[5];
#pragma unroll
    for (int ci = 0; ci < 5; ++ci) acc[ci] = (f32x4){0.f, 0.f, 0.f, 0.f};
#pragma unroll 1
    for (int b = 0; b < 2; ++b) {
        f32x4 wv[32];
#pragma unroll
        for (int i = 0; i < 32; ++i) wv[i] = *(const GAS f32x4*)(w + (size_t)(b * 64 + 2 * i) * 6144);
#pragma unroll
        for (int i = 0; i < 32; ++i) { const int k = wave * 128 + b * 64 + 2 * i + half;
#pragma unroll
            for (int ci = 0; ci < 5; ++ci) acc[ci] += wv[i] * sil[ci * 1024 + k]; }
    }
#pragma unroll
    for (int ci = 0; ci < 5; ++ci) {
#pragma unroll
        for (int q = 0; q < 4; ++q) acc[ci][q] += __shfl_xor(acc[ci][q], 32);
        if (half == 0) *(LAS f32x4*)(red + (wave * 5 + ci) * 128 + c4 * 4) = acc[ci]; }
    __syncthreads();
    for (int i = tid; i < 5 * 128; i += 512) { const int ci = i >> 7, cc = i & 127; float t = 0.f;
#pragma unroll
        for (int wv2 = 0; wv2 < 8; ++wv2) t += red[(wv2 * 5 + ci) * 128 + cc];
        mods[((size_t)l * 5 + ci) * 6144 + cg * 128 + cc] = t + b_mod[l * 6144 + cg * 128 + cc]; }
}

__device__ __forceinline__ void xinit_row(const LAS unsigned char* lds, GAS h16_t* X, int row, int lane) {
    GAS h16x4* o = (GAS h16x4*)(X + (size_t)row * D) + lane;
    if (row < MP) { const GAS f32x4* s = (const GAS f32x4*)(inp(lds, 0) + (size_t)row * D) + lane;
#pragma unroll
        for (int q = 0; q < 4; ++q) o[64 * q] = __builtin_convertvector(s[64 * q], h16x4);
        return; }
    const GAS f32x4* s = (const GAS f32x4*)(inp(lds, 1) + (size_t)(row - MP) * D) + lane;
    const int t = (row - MP) & 1023; const float rr = (float)(t >> 6), cc = (float)(t & 63);
    float freq[4];
#pragma unroll
    for (int e = 0; e < 4; ++e) freq[e] = expf(-(float)(4 * lane + e) * (9.210340371976184f / 256.0f));
    f32x4 v[4];
#pragma unroll
    for (int q = 0; q < 4; ++q) v[q] = s[64 * q];
#pragma unroll
    for (int e = 0; e < 4; ++e) { float sr, cr, sc, cc2; sincosf(rr * freq[e], &sr, &cr); sincosf(cc * freq[e], &sc, &cc2); v[0][e] += sr; v[1][e] += cr; v[2][e] += sc; v[3][e] += cc2; }
#pragma unroll
    for (int q = 0; q < 4; ++q) o[64 * q] = __builtin_convertvector(v[q], h16x4);
}


__device__ __forceinline__ void sw_job(const GAS float* mods, int l, int sidx, const GAS bf16_t* WT, int N, GAS float* dst, int dld, int wv, int nw, int lane) {
    float sh[5][16];
#pragma unroll
    for (int ci = 0; ci < 5; ++ci) { const GAS float* sp = mods + ((size_t)l * 5 + ci) * 6144 + sidx * 1024 + lane * 16;
#pragma unroll
        for (int q = 0; q < 4; ++q) { const f32x4 v = *(const GAS f32x4*)(sp + 4 * q); sh[ci][4 * q] = v[0]; sh[ci][4 * q + 1] = v[1]; sh[ci][4 * q + 2] = v[2]; sh[ci][4 * q + 3] = v[3]; } }
    for (int r = wv * 8; r < N; r += nw * 8) {
        u32x4 w0[8], w1[8];
#pragma unroll
        for (int nn = 0; nn < 8; ++nn) { w0[nn] = *(const GAS u32x4*)(WT + (size_t)(r + nn) * D + lane * 16); w1[nn] = *(const GAS u32x4*)(WT + (size_t)(r + nn) * D + lane * 16 + 8); }
#pragma unroll
        for (int nn = 0; nn < 8; ++nn) {
            const float wf[16] = {bf_lo(w0[nn].x), bf_hi(w0[nn].x), bf_lo(w0[nn].y), bf_hi(w0[nn].y), bf_lo(w0[nn].z), bf_hi(w0[nn].z), bf_lo(w0[nn].w), bf_hi(w0[nn].w),
                                  bf_lo(w1[nn].x), bf_hi(w1[nn].x), bf_lo(w1[nn].y), bf_hi(w1[nn].y), bf_lo(w1[nn].z), bf_hi(w1[nn].z), bf_lo(w1[nn].w), bf_hi(w1[nn].w)};
#pragma unroll
            for (int ci = 0; ci < 5; ++ci) { float t = 0.f;
#pragma unroll
                for (int q = 0; q < 16; ++q) t += wf[q] * sh[ci][q];
                t = wave_sum(t);
                if (lane == 0) dst[ci * dld + r + nn] = t; }
        }
    }
}
__device__ __forceinline__ void sw_mix_job(GAS unsigned char* ws, const GAS float* mods, int l, int wv, int nw, int lane) {
    GAS float* swA = (GAS float*)(ws + TAB_SWA);
    if (l == 0) sw_job(mods, 0, 0, (const GAS bf16_t*)(ws + WS_SWIN), 1024, swA, 1024, wv, nw, lane);
    else if (l == 1) sw_job(mods, 1, 0, (const GAS bf16_t*)(ws + WS_GWIN), 4096, swA + 1 * 5 * 4096, 4096, wv, nw, lane);
    else if (l == 2) sw_job(mods, 2, 0, (const GAS bf16_t*)(ws + WS_CWIN), 3072, swA + 2 * 5 * 4096, 3072, wv, nw, lane);
    else sw_job(mods, 3, 0, (const GAS bf16_t*)(ws + WS_SWIN) + (size_t)D * D, 1024, swA + 3 * 5 * 4096, 1024, wv, nw, lane);
}
__device__ __forceinline__ void sw_ffn_job(GAS unsigned char* ws, const GAS float* mods, int l, int wv, int nw, int lane) {
    sw_job(mods, l, 3, (const GAS bf16_t*)(ws + WS_W1) + (size_t)l * D * FF, 4096, (GAS float*)(ws + TAB_SWB) + l * 5 * 4096, 4096, wv, nw, lane);
}


constexpr int I_W1 = 2048, I_W2 = 2048, I_SI = 512, I_SO = 1024, I_GI = 2048, I_GO = 1024, I_CI = 1536, I_CO = 512;
constexpr int IT_W1 = 0, IT_W2 = 4 * I_W1, IT_SI = IT_W2 + 4 * I_W2, IT_SO = IT_SI + 2 * I_SI, IT_GI = IT_SO + 2 * I_SO, IT_GO = IT_GI + I_GI, IT_CI = IT_GO + I_GO, IT_CO = IT_CI + I_CI, IT_END = IT_CO + I_CO;
__device__ __forceinline__ void convert_items(const LAS unsigned char* lds, GAS unsigned char* ws, LAS float* scr, int first, int count, int wv, int nw, int lane) {
    for (int it = first + wv; it < first + count; it += nw) {
        int r = it;
        if (r < IT_W2) { const int l = r / I_W1; transpose_item<0>(inp(lds, 10) + (size_t)l * D * FF, D, FF, (GAS bf16_t*)(ws + WS_W1) + (size_t)l * D * FF, scr, r % I_W1, lane); continue; } r -= IT_W2;
        if (r < 4 * I_W2) { const int l = r / I_W2; transpose_item<0>(inp(lds, 11) + (size_t)l * D * FF, FF, D, (GAS bf16_t*)(ws + WS_W2) + (size_t)l * D * FF, scr, r % I_W2, lane); continue; } r -= 4 * I_W2;
        if (r < 2 * I_SI) { const int l = r / I_SI; transpose_item<0>(inp(lds, 12) + (size_t)l * D * D, D, D, (GAS bf16_t*)(ws + WS_SWIN) + (size_t)l * D * D, scr, r % I_SI, lane); continue; } r -= 2 * I_SI;
        if (r < 2 * I_SO) { const int l = r / I_SO; transpose_item<1>(inp(lds, 21) + (size_t)l * D * 2048, D, 2048, (GAS bf16_t*)(ws + WS_SWOUT) + (size_t)l * D * 2048, scr, r % I_SO, lane); continue; } r -= 2 * I_SO;
        if (r < I_GI) { transpose_item<0>(inp(lds, 22), D, 4096, (GAS bf16_t*)(ws + WS_GWIN), scr, r, lane); continue; } r -= I_GI;
        if (r < I_GO) { transpose_item<0>(inp(lds, 25), 2048, D, (GAS bf16_t*)(ws + WS_GWOUT), scr, r, lane); continue; } r -= I_GO;
        if (r < I_CI) { transpose_item<0>(inp(lds, 26), D, 3072, (GAS bf16_t*)(ws + WS_CWIN), scr, r, lane); continue; } r -= I_CI;
        transpose_item<0>(inp(lds, 28), D, D, (GAS bf16_t*)(ws + WS_CWOUT), scr, r, lane);
    }
}
constexpr int NPH = 28;
#ifdef MK_RANGE
#define GMODE(g) g.mode = args.mode
#else
#define GMODE(g)
#endif
#ifndef MK_ALLCG
#define MK_ALLCG 0
#endif
#ifndef MK_NOLOCAL
#define MK_NOLOCAL 0
#endif
__global__ void __launch_bounds__(512, 2) fwd(Args args) {
    extern __shared__ __attribute__((aligned(16))) unsigned char lds_raw[];
    LAS unsigned char* lds_k = (LAS unsigned char*)lds_raw;
    volatile LAS unsigned* MISC = (volatile LAS unsigned*)(lds_k + MISC_OFF);
    const int tid = threadIdx.x, lane = tid & 63, wave = __builtin_amdgcn_readfirstlane(tid >> 6);
    const int G = gridDim.x, bx = blockIdx.x;
    GAS unsigned* ctl = (GAS unsigned*)((GAS unsigned char*)args.ws + WS_CTL);
    for (int u = tid; u < 64; u += 512) MISC[u] = 0u;
    if (tid == 0) { LAS unsigned long long* pt = (LAS unsigned long long*)(lds_k + PTR_OFF);
#pragma unroll
        for (int k = 0; k < 30; ++k) pt[k] = (unsigned long long)args.in[k];
        pt[30] = (unsigned long long)args.out; pt[31] = (unsigned long long)args.ws; }
    __syncthreads();
    (void)xcd_barrier_post(ctl + CW_BAR, MISC + 8);
#ifdef MK_RANGE
    const int lo = args.ph_lo, hi = args.ph_hi;
#else
    constexpr int lo = 0, hi = 23;
#endif
    int ph = 0;
#define IN_PH (lo <= ph && ph < hi)
#define SEAM_GLOBAL(p) ((p) <= 3 || (p) == 6 || (p) == 11 || (p) == 16 || (p) == 17 || (p) == 18)
#define SEAM() do { if (IN_PH && ph + 1 < hi) { if (MK_ALLCG || args.mode == 0x7fffffff) cg::this_grid().sync();     \
        else { LAS unsigned char* lds_s_ = lds_k; asm volatile("" : "+s"(lds_s_)); XcdBarrier b_; b_.bar = (GAS unsigned*)((GAS unsigned char*)ldsptr(lds_s_, 31) + WS_CTL) + CW_BAR; b_.x = xb_xcc_id(); b_.st = (volatile LAS unsigned*)(lds_s_ + MISC_OFF) + 8; \
        const bool ldr_ = wave == 0 && lane_id() == 0; if (SEAM_GLOBAL(ph) || MK_NOLOCAL || b_.st[4] == 0u) xcd_barrier(b_, ldr_); else xcc_barrier(b_, ldr_); } } ++ph; } while (0)

#define PH_PTRS() LAS unsigned char* lds = lds_k; asm volatile("" : "+s"(lds)); GAS unsigned char* ws = (GAS unsigned char*)ldsptr(lds, 31); asm volatile("" : "+s"(ws)); \
    int tid_o_ = wave * 64 + lane_id(); asm volatile("" : "+v"(tid_o_)); const int tid = tid_o_, lane = tid_o_ & 63; (void)tid; (void)lane; \
    const int vcu = (G % 8 == 0) ? (bx % 8) * (G / 8) + bx / 8 : bx, gw = vcu * 8 + wave, NGW = G * 8; (void)vcu; (void)gw; (void)NGW; \
    const int o_mode = __builtin_amdgcn_readfirstlane((int)((volatile LAS unsigned*)(lds + MISC_OFF))[12]); \
    const int o_vx = o_mode ? __builtin_amdgcn_readfirstlane((int)((volatile LAS unsigned*)(lds + MISC_OFF))[11]) : (bx & 7), o_rank = o_mode ? __builtin_amdgcn_readfirstlane((int)((volatile LAS unsigned*)(lds + MISC_OFF))[10]) : (bx >> 3); (void)o_vx; (void)o_rank; \
    GAS h16_t* X = (GAS h16_t*)(ws + WS_X16); GAS bf16_t* XN = (GAS bf16_t*)(ws + WS_XN); GAS float* mods = (GAS float*)(ws + WS_MODS); \
    GAS float* gsA = (GAS float*)(ws + TAB_GSA); GAS float* gsB = (GAS float*)(ws + TAB_GSB); GAS float* swA = (GAS float*)(ws + TAB_SWA); GAS float* swB = (GAS float*)(ws + TAB_SWB); \
    GAS float* rowss = (GAS float*)(ws + WS_ROWSS); GAS float* vstat = (GAS float*)(ws + WS_VSTAT); \
    GAS bf16_t* Hb = (GAS bf16_t*)(ws + WS_R); GAS bf16_t* UgS = (GAS bf16_t*)(ws + WS_R); GAS float* Sloc = (GAS float*)(ws + WS_R + 48 * MiB); GAS bf16_t* Zg = (GAS bf16_t*)(ws + WS_R2); GAS bf16_t* A2 = (GAS bf16_t*)(ws + WS_R2); \
    (void)X; (void)XN; (void)mods; (void)gsA; (void)gsB; (void)swA; (void)swB; (void)rowss; (void)vstat; (void)Hb; (void)UgS; (void)Sloc; (void)Zg; (void)A2;
#define PH_LAYER() const GAS float* rs_mix = rowss + (size_t)(2 * layer) * M * 32; GAS float* rs_ffn = rowss + (size_t)(2 * layer + 1) * M * 32; GAS float* rs_next = rowss + (size_t)((2 * layer + 2) & 7) * M * 32; \
    const GAS float* modl = mods + (size_t)layer * 5 * 6144; (void)rs_mix; (void)rs_ffn; (void)rs_next; (void)modl;

#define SIDE_IDS() const int sidle = o_vx * 8 + o_rank - 24, swv = sidle * 8 + wave, snw = 512; (void)sidle; LAS float* scr = (LAS float*)(lds + wave * 16384); (void)scr; (void)swv; (void)snw
    if (IN_PH) { PH_PTRS();
#ifdef MK_RANGE
        const int pm_ = args.mode;
#else
        constexpr int pm_ = 0;
#endif
        if (bx < 128) { if (pm_ != 2) ssm_build(args, 0, bx & 63, bx >> 6, lds, ws, tid); } else { if (pm_ != 3) for (int t = bx - 128; t < 192; t += 128) mods_task(args, mods, lds, t, tid); }
        __syncthreads();
        if (bx >= 128 && pm_ != 4) { LAS float* scr = (LAS float*)(lds + wave * 16384); const int wv = (bx - 128) * 8 + wave, nw = (G - 128) * 8;
            convert_items(lds, ws, scr, IT_W1, I_W1, wv, nw, lane); convert_items(lds, ws, scr, IT_W2, I_W2, wv, nw, lane);
            convert_items(lds, ws, scr, IT_SI, I_SI, wv, nw, lane); convert_items(lds, ws, scr, IT_SO, I_SO, wv, nw, lane); }
        if (pm_ != 5 && bx >= 64) for (int row = (bx - 64) * 8 + wave; row < M; row += (G - 64) * 8) xinit_row(lds, X, row, lane);
    }
    SEAM();
    if (IN_PH) { PH_PTRS();
        for (int i = gw * 64 + lane; i < 4 * 5 * 1024; i += NGW * 64) { const int l = i / 5120, ci = (i / 1024) % 5, c = i & 1023;
            const GAS float* md = mods + ((size_t)l * 5 + ci) * 6144;
            gsA[i] = inp(lds, 8)[l * 1024 + c] * (1.0f + md[1024 + c]); gsB[i] = inp(lds, 9)[l * 1024 + c] * (1.0f + md[4 * 1024 + c]); }
        sw_mix_job(ws, mods, 0, gw, NGW, lane);
        for (int row = gw; row < M; row += 3 * NGW) {
            const GAS float* gm = inp(lds, 8);
            f32x4 v[3][4];
#pragma unroll
            for (int rr = 0; rr < 3; ++rr)
#pragma unroll
                for (int q = 0; q < 4; ++q) v[rr][q] = __builtin_convertvector(((const GAS h16x4*)(X + (size_t)(row + rr * NGW) * D) + lane)[64 * q], f32x4);
#pragma unroll
            for (int rr = 0; rr < 3; ++rr) {
                const int r = row + rr * NGW, ci = cond_of_row(r); const GAS float* md = mods + ((size_t)0 * 5 + ci) * 6144;
                float t = 0.f;
#pragma unroll
                for (int q = 0; q < 4; ++q) t += (v[rr][q][0] * v[rr][q][0] + v[rr][q][1] * v[rr][q][1]) + (v[rr][q][2] * v[rr][q][2] + v[rr][q][3] * v[rr][q][3]);
                t = wave_sum(t);
                if (lane < 32) rowss[(size_t)r * 32 + lane] = lane == 0 ? t : 0.f;
                GAS u32x2* o = (GAS u32x2*)(XN + (size_t)r * D) + lane;
#pragma unroll
                for (int q = 0; q < 4; ++q) { const int c = 256 * q + 4 * lane; const f32x4 gg = *(const GAS f32x4*)(gm + c), sc = *(const GAS f32x4*)(md + 1024 + c);
                    const f32x4 y = v[rr][q] * gg * (sc + 1.0f); u32x2 w; w.x = cvt_pk_bf16(y[0], y[1]); w.y = cvt_pk_bf16(y[2], y[3]); o[64 * q] = w; }
            }
        }
    }
    SEAM();
#pragma unroll 1
    for (int layer = 0; layer < 4; ++layer) {
        const int kind = layer % 3, j = layer / 3;
        if (kind == 0) {
            if (IN_PH) { PH_PTRS(); PH_LAYER(); Gemm g = gemm_rowmajor(XN, D, (const GAS bf16_t*)(ws + WS_SWIN) + (size_t)j * D * D, D, D); GMODE(g); OwnerOrder S{(D) / BM, o_vx, o_rank};
                fill_tables_in(lds, S, rs_mix, swA + layer * 5 * 4096, 1024, tid); EpiU E{UgS}; gemm_phase<EpiU, ARowMajor, OwnerOrder>(lds, g, S, E, wave);
                if (o_rank >= 24) { SIDE_IDS(); sw_ffn_job(ws, mods, layer, swv, snw, lane); if (layer == 0) convert_items(lds, ws, scr, IT_GI, I_GI, swv, snw, lane); } }
            SEAM();
            if (IN_PH) { PH_PTRS(); PH_LAYER(); SsmOrder S{G, bx};
                { Gemm g = gemm_rowmajor(UgS, 512, (const GAS bf16_t*)(ws + WS_BTS) + (size_t)j * 64 * 256 * 256, 256, 256); GMODE(g);
                  EpiScan E{UgS, (const GAS float*)(ws + TAB_LAMT), inp(lds, 2), inp(lds, 3), (GAS float*)ldsptr(lds, 30) + (size_t)M * D, (GAS float*)ldsptr(lds, 30) + (size_t)M * D + 32 * 2 * 2 * 64 * 64, j};
                  gemm_phase<EpiScan, ARowMajor, SsmOrder>(lds, g, S, E, wave); }
                asm volatile("s_waitcnt vmcnt(0)" ::: "memory"); __syncthreads(); __builtin_amdgcn_fence(__ATOMIC_ACQUIRE, "agent"); asm volatile("s_waitcnt vmcnt(0)" ::: "memory"); __syncthreads();
                { Gemm g = gemm_rowmajor(UgS, 512, (const GAS bf16_t*)(ws + WS_BTY) + (size_t)j * 64 * 256 * 512, 512, 512); GMODE(g);
                  EpiY E{Zg}; gemm_phase<EpiY, ARowMajor, SsmOrder>(lds, g, S, E, wave); }
                if (layer == 0 && bx >= 192) { const int swv = (bx - 192) * 8 + wave, snw = 512; LAS float* scr = (LAS float*)(lds + wave * 16384); convert_items(lds, ws, scr, IT_GO, I_GO + I_CI + I_CO, swv, snw, lane); convert_items(lds, ws, scr, IT_W1 + 1 * I_W1, I_W1, swv, snw, lane);
                    const GAS float* s_ = inp(lds, 23); GAS bf16_t* d_ = (GAS bf16_t*)(ws + WS_GWS);
                    for (int i = (swv * 64 + lane) * 8; i < 16 * 128 * 128; i += snw * 64 * 8) { const f32x4 a0 = *(const GAS f32x4*)(s_ + i), a1 = *(const GAS f32x4*)(s_ + i + 4);
                        u32x4 o; o.x = pk2(a0[0], a0[1]); o.y = pk2(a0[2], a0[3]); o.z = pk2(a1[0], a1[1]); o.w = pk2(a1[2], a1[3]); *(GAS u32x4*)(d_ + i) = o; } } }
            SEAM();
            if (IN_PH) { PH_PTRS(); PH_LAYER(); Gemm g = gemm_groupchunk(Zg, (const GAS bf16_t*)(ws + WS_SWOUT) + (size_t)j * D * 2048, D, D); GMODE(g); OwnerOrder S{(2048) / BM, o_vx, o_rank};
                fill_tables_res<128>(lds, S, modl + 2 * 1024, gsB + layer * 5 * 1024, tid); EpiRes<true> E{X, XN, rs_ffn, true}; gemm_phase<EpiRes<true>, AGroupChunk, OwnerOrder>(lds, g, S, E, wave); }
            SEAM();
        } else if (kind == 1) {
            if (IN_PH) { PH_PTRS(); PH_LAYER(); Gemm g = gemm_rowmajor(XN, D, (const GAS bf16_t*)(ws + WS_GWIN), D, D); GMODE(g); OwnerOrder S{(4096) / BM, o_vx, o_rank};
                fill_tables_in(lds, S, rs_mix, swA + layer * 5 * 4096, 4096, tid); EpiIn<2, 4096> E{Hb, vstat}; gemm_phase<EpiIn<2, 4096>, ARowMajor, OwnerOrder>(lds, g, S, E, wave); }
            SEAM();
            if (IN_PH) { PH_PTRS(); PH_LAYER();
                const GAS bf16_t* Wsb = (const GAS bf16_t*)(ws + WS_GWS); const GAS float* b_s = inp(lds, 24);
                constexpr int VST = 288;
                LAS f32x2* mr = (LAS f32x2*)(lds + 128 * VST);
                __syncthreads();
#define G2_UNIT(L_) (((2 * panel_of(o_vx, ((L_) >> 4) >> 1) + (((L_) >> 4) & 1)) << 4) | ((L_) & 15))
                { int ui = 0;
                  for (int L = o_rank; L < 192; L += 32, ++ui) { const int unit = G2_UNIT(L); const int row = tid >> 2, part = tid & 3;
                    const GAS f32x4* p = (const GAS f32x4*)(vstat + (size_t)((unit >> 4) * 128 + row) * 128) + part * 8; float s1 = 0.f, s2 = 0.f;
#pragma unroll
                    for (int q = 0; q < 8; ++q) { const f32x4 v = p[q]; s1 += v[0] + v[2]; s2 += v[1] + v[3]; }
                    s1 += __shfl_xor(s1, 1); s2 += __shfl_xor(s2, 1); s1 += __shfl_xor(s1, 2); s2 += __shfl_xor(s2, 2);
                    const float mu = s1 * (1.0f / 2048.0f), var = s2 * (1.0f / 2048.0f) - mu * mu; if (part == 0) mr[ui * 128 + row] = (f32x2){mu, rsq_f(fmaxf(var, 0.f) + EPS)}; } }
                u32x4 vr[4] = {(u32x4){0u, 0u, 0u, 0u}, (u32x4){0u, 0u, 0u, 0u}, (u32x4){0u, 0u, 0u, 0u}, (u32x4){0u, 0u, 0u, 0u}};
                { const int u0 = G2_UNIT(o_rank);
#pragma unroll
                    for (int i = 0; i < 4; ++i) { const int pc = tid + 512 * i, q = pc >> 4, d8 = pc & 15; vr[i] = *(const GAS u32x4*)(Hb + (size_t)((u0 >> 4) * 128 + q) * 4096 + 2048 + (u0 & 15) * 128 + d8 * 8); } }
                int ui = 0;
                for (int L = o_rank; L < 192; L += 32, ++ui) {
                    const int unit = G2_UNIT(L); const int c = unit >> 4, g = unit & 15, row0 = c * 128;
                    __syncthreads();
#pragma unroll
                    for (int i = 0; i < 4; ++i) { const int pc = tid + 512 * i, q = pc >> 4, d8 = pc & 15;
                        const u32x4 w = vr[i];
                        const f32x2 st = mr[ui * 128 + q]; const float mu = st[0], rstd = st[1];
                        u32x4 o; o.x = cvt_pk_bf16((bf_lo(w.x) - mu) * rstd, (bf_hi(w.x) - mu) * rstd); o.y = cvt_pk_bf16((bf_lo(w.y) - mu) * rstd, (bf_hi(w.y) - mu) * rstd);
                        o.z = cvt_pk_bf16((bf_lo(w.z) - mu) * rstd, (bf_hi(w.z) - mu) * rstd); o.w = cvt_pk_bf16((bf_lo(w.w) - mu) * rstd, (bf_hi(w.w) - mu) * rstd);
                        *(LAS u32x4*)(lds + q * VST + d8 * 16) = o; }
                    __syncthreads();
                    if (L + 32 < 192) { const int un = G2_UNIT(L + 32);
#pragma unroll
                        for (int i = 0; i < 4; ++i) { const int pc = tid + 512 * i, q = pc >> 4, d8 = pc & 15; vr[i] = *(const GAS u32x4*)(Hb + (size_t)((un >> 4) * 128 + q) * 4096 + 2048 + (un & 15) * 128 + d8 * 8); } }
                    f32x4 acc[8];
#pragma unroll
                    for (int nt = 0; nt < 8; ++nt) acc[nt] = (f32x4){0.f, 0.f, 0.f, 0.f};
                    const int fr = lane & 15, fq = lane >> 4;
#pragma unroll
                    for (int kk = 0; kk < 4; ++kk) {
                        const bf16x8 wf = *(const GAS bf16x8*)(Wsb + ((size_t)g * 128 + wave * 16 + fr) * 128 + kk * 32 + fq * 8);
#pragma unroll
                        for (int nt = 0; nt < 8; ++nt) {
                            const LAS unsigned char* p0 = lds + (kk * 32 + fq * 8 + (fr >> 2)) * VST + (nt * 16 + 4 * (fr & 3)) * 2;
                            const s16x4 lo4 = __builtin_bit_cast(s16x4, __builtin_amdgcn_ds_read_tr16_b64_v4i16((LAS s16x4*)p0));
                            const s16x4 hi4 = __builtin_bit_cast(s16x4, __builtin_amdgcn_ds_read_tr16_b64_v4i16((LAS s16x4*)(p0 + 4 * VST)));
                            const bf16x8 vf = {lo4[0], lo4[1], lo4[2], lo4[3], hi4[0], hi4[1], hi4[2], hi4[3]};
                            acc[nt] = __builtin_amdgcn_mfma_f32_16x16x32_bf16(vf, wf, acc[nt], 0, 0, 0);
                        }
                    }
                    const int p = wave * 16 + fr, row = row0 + p; const float bs = b_s[g * 128 + p];
#pragma unroll
                    for (int nt = 0; nt < 8; ++nt) { const int ch = g * 128 + nt * 16 + 4 * fq;
                        const u32x2 uu = *(const GAS u32x2*)(Hb + (size_t)row * 4096 + ch);
                        u32x2 o; o.x = cvt_pk_bf16(bf_lo(uu.x) * (acc[nt][0] + bs), bf_hi(uu.x) * (acc[nt][1] + bs)); o.y = cvt_pk_bf16(bf_lo(uu.y) * (acc[nt][2] + bs), bf_hi(uu.y) * (acc[nt][3] + bs));
                        *(GAS u32x2*)(A2 + (size_t)row * 2048 + ch) = o; }
                }
                __syncthreads();
            }
            SEAM();
            if (IN_PH) { PH_PTRS(); PH_LAYER(); Gemm g = gemm_rowmajor(A2, 2048, (const GAS bf16_t*)(ws + WS_GWOUT), 2048, 2048); GMODE(g); OwnerOrder S{(D) / BM, o_vx, o_rank};
                fill_tables_res<256>(lds, S, modl + 2 * 1024, gsB + layer * 5 * 1024, tid); EpiRes<false> E{X, XN, rs_ffn, true}; gemm_phase<EpiRes<false>, ARowMajor, OwnerOrder>(lds, g, S, E, wave);
                if (o_rank >= 24) { SIDE_IDS(); ssm_build(args, 1, sidle, 1, lds, ws, tid); } }
            SEAM();
        } else {
            if (IN_PH) { PH_PTRS(); PH_LAYER(); Gemm g = gemm_rowmajor(XN, D, (const GAS bf16_t*)(ws + WS_CWIN), D, D); GMODE(g); OwnerOrder S{(3072) / BM, o_vx, o_rank};
                fill_tables_in(lds, S, rs_mix, swA + layer * 5 * 4096, 3072, tid); EpiIn<0, 3072> E{Hb, nullptr}; gemm_phase<EpiIn<0, 3072>, ARowMajor, OwnerOrder>(lds, g, S, E, wave); }
            SEAM();
            if (IN_PH) { PH_PTRS(); PH_LAYER();
                const GAS float* cw = inp(lds, 27);
                for (int it = o_rank * 512 + tid; it < 6 * 256 * 128; it += 32 * 512) {
                    const int row = panel_of(o_vx, it >> 15) * 256 + ((it >> 7) & 255), c8 = (it & 127) * 8;
                    const int L = row < MP ? 256 : 1024, t = row < MP ? (row & 255) : ((row - MP) & 1023);
                    const GAS bf16_t* pr = Hb + (size_t)row * 3072 + c8;
                    float y[8];
#pragma unroll
                    for (int q = 0; q < 8; ++q) y[q] = 0.f;
#pragma unroll
                    for (int w = 0; w < 3; ++w) { const int tt = t + w - 1; if (tt < 0 || tt >= L) continue;
                        const u32x4 gc = *(const GAS u32x4*)(pr + (ptrdiff_t)(w - 1) * 3072 + 1024), xh = *(const GAS u32x4*)(pr + (ptrdiff_t)(w - 1) * 3072 + 2048);
                        const f32x4 k0 = *(const GAS f32x4*)(cw + w * 1024 + c8), k1 = *(const GAS f32x4*)(cw + w * 1024 + c8 + 4);
                        y[0] += k0[0] * bf_lo(gc.x) * bf_lo(xh.x); y[1] += k0[1] * bf_hi(gc.x) * bf_hi(xh.x); y[2] += k0[2] * bf_lo(gc.y) * bf_lo(xh.y); y[3] += k0[3] * bf_hi(gc.y) * bf_hi(xh.y);
                        y[4] += k1[0] * bf_lo(gc.z) * bf_lo(xh.z); y[5] += k1[1] * bf_hi(gc.z) * bf_hi(xh.z); y[6] += k1[2] * bf_lo(gc.w) * bf_lo(xh.w); y[7] += k1[3] * bf_hi(gc.w) * bf_hi(xh.w); }
                    const u32x4 gb = *(const GAS u32x4*)pr;
                    u32x4 o; o.x = cvt_pk_bf16(bf_lo(gb.x) * y[0], bf_hi(gb.x) * y[1]); o.y = cvt_pk_bf16(bf_lo(gb.y) * y[2], bf_hi(gb.y) * y[3]);
                    o.z = cvt_pk_bf16(bf_lo(gb.z) * y[4], bf_hi(gb.z) * y[5]); o.w = cvt_pk_bf16(bf_lo(gb.w) * y[6], bf_hi(gb.w) * y[7]);
                    *(GAS u32x4*)(A2 + (size_t)row * D + c8) = o;
                }
            }
            SEAM();
            if (IN_PH) { PH_PTRS(); PH_LAYER(); Gemm g = gemm_rowmajor(A2, D, (const GAS bf16_t*)(ws + WS_CWOUT), D, D); GMODE(g); OwnerOrder S{(D) / BM, o_vx, o_rank};
                fill_tables_res<256>(lds, S, modl + 2 * 1024, gsB + layer * 5 * 1024, tid); EpiRes<false> E{X, XN, rs_ffn, true}; gemm_phase<EpiRes<false>, ARowMajor, OwnerOrder>(lds, g, S, E, wave); }
            SEAM();
        }
        if (IN_PH) { PH_PTRS(); PH_LAYER(); Gemm g = gemm_rowmajor(XN, D, (const GAS bf16_t*)(ws + WS_W1) + (size_t)layer * D * FF, D, D); GMODE(g); OwnerOrder S{(FF) / BM, o_vx, o_rank};
            fill_tables_in(lds, S, rs_ffn, swB + layer * 5 * 4096, 4096, tid); EpiIn<1, 4096> E{Hb, nullptr}; gemm_phase<EpiIn<1, 4096>, ARowMajor, OwnerOrder>(lds, g, S, E, wave); }
        SEAM();
        if (IN_PH) { PH_PTRS(); PH_LAYER(); Gemm g = gemm_rowmajor(Hb, FF, (const GAS bf16_t*)(ws + WS_W2) + (size_t)layer * D * FF, FF, FF); GMODE(g); OwnerOrder S{(D) / BM, o_vx, o_rank};
            fill_tables_res<256>(lds, S, modl + 5 * 1024, layer < 3 ? gsA + (layer + 1) * 5 * 1024 : (const GAS float*)nullptr, tid); EpiRes<false> E{X, XN, rs_next, layer < 3}; gemm_phase<EpiRes<false>, ARowMajor, OwnerOrder>(lds, g, S, E, wave);
            if (layer < 3 && o_rank >= 24) { SIDE_IDS();
                if (layer == 0) { convert_items(lds, ws, scr, IT_W2 + 1 * I_W2, I_W2, swv, snw, lane); convert_items(lds, ws, scr, IT_W1 + 2 * I_W1, I_W1, swv, snw, lane); sw_mix_job(ws, mods, 1, swv, snw, lane); sw_ffn_job(ws, mods, 1, swv, snw, lane); }
                else if (layer == 1) { convert_items(lds, ws, scr, IT_W2 + 2 * I_W2, I_W2, swv, snw, lane); convert_items(lds, ws, scr, IT_SI + I_SI, I_SI, swv, snw, lane); convert_items(lds, ws, scr, IT_SO + I_SO, I_SO, swv, snw, lane);
                    sw_mix_job(ws, mods, 2, swv, snw, lane); sw_ffn_job(ws, mods, 2, swv, snw, lane); }
                else { ssm_build(args, 1, sidle, 0, lds, ws, tid);
                    convert_items(lds, ws, scr, IT_W1 + 3 * I_W1, I_W1, swv, snw, lane); convert_items(lds, ws, scr, IT_W2 + 3 * I_W2, I_W2, swv, snw, lane); sw_mix_job(ws, mods, 3, swv, snw, lane); } } }
        SEAM();
    }
    if (IN_PH) { PH_PTRS();
        const GAS float* gf = inp(lds, 29);
        GAS float* Y = (GAS float*)ldsptr(lds, 30);
        for (int t3 = 0; t3 < 2; ++t3) {
            int rws[3];
#pragma unroll
            for (int rr = 0; rr < 3; ++rr) { const int rl = o_rank * 8 + wave + 256 * (3 * t3 + rr); rws[rr] = panel_of(o_vx, rl >> 8) * 256 + (rl & 255); }
            f32x4 v[3][4];
#pragma unroll
            for (int rr = 0; rr < 3; ++rr)
#pragma unroll
                for (int q = 0; q < 4; ++q) v[rr][q] = __builtin_convertvector(((const GAS h16x4*)(X + (size_t)rws[rr] * D) + lane)[64 * q], f32x4);
            f32x4 gq[4];
#pragma unroll
            for (int q = 0; q < 4; ++q) gq[q] = *(const GAS f32x4*)(gf + 256 * q + 4 * lane);
#pragma unroll
            for (int rr = 0; rr < 3; ++rr) { float t = 0.f;
#pragma unroll
                for (int q = 0; q < 4; ++q) t += (v[rr][q][0] * v[rr][q][0] + v[rr][q][1] * v[rr][q][1]) + (v[rr][q][2] * v[rr][q][2] + v[rr][q][3] * v[rr][q][3]);
                t = wave_sum(t); const float r0 = rsq_f(t * (1.0f / D) + EPS);
                GAS f32x4* yr = (GAS f32x4*)(Y + (size_t)rws[rr] * D) + lane;
#pragma unroll
                for (int q = 0; q < 4; ++q) yr[64 * q] = v[rr][q] * r0 * gq[q]; }
        }
    }
    ++ph;
#undef IN_PH
#undef SEAM
}

static bool launch(void* const* d_in, float* out, unsigned char* ws, int lo, int hi, hipStream_t stream, int mode = 0) {
    static int grid = 0;
    if (grid == 0) {
        int dev = 0, cus = 0, per_cu = 0;
        if (hipGetDevice(&dev) != hipSuccess || hipDeviceGetAttribute(&cus, hipDeviceAttributeMultiprocessorCount, dev) != hipSuccess) { grid = -1; return false; }
        if (hipFuncSetAttribute((const void*)fwd, hipFuncAttributeMaxDynamicSharedMemorySize, LDS_BYTES) != hipSuccess) { fprintf(stderr, "hipFuncSetAttribute failed\n"); grid = -1; return false; }
        if (hipOccupancyMaxActiveBlocksPerMultiprocessor(&per_cu, (const void*)fwd, 512, LDS_BYTES) != hipSuccess || per_cu < 1) { fprintf(stderr, "occupancy query: %d\n", per_cu); (void)hipGetLastError(); per_cu = 1; }
        grid = cus;
    }
    if (grid < 0) return false;
    Args a{};
    for (int i = 0; i < 30; ++i) a.in[i] = (const float*)d_in[i];
    a.out = out; a.ws = ws; a.ph_lo = lo; a.ph_hi = hi; a.mode = mode;
    void* kargs[] = {&a};
    const hipError_t e = hipLaunchCooperativeKernel((const void*)fwd, dim3(grid), dim3(512), kargs, LDS_BYTES, stream);
    if (e != hipSuccess) { fprintf(stderr, "cooperative launch failed: %s (grid %d)\n", hipGetErrorString(e), grid); return false; }
    return true;
}
}
extern "C" void kernel_launch(void* const* d_in, const int* in_sizes, int n_in, void* d_out, int out_size, void* d_ws, size_t ws_size, hipStream_t stream) {
    if (n_in != 30 || ws_size < mk::WS_END) { fprintf(stderr, "kernel_launch: unexpected n_in %d / ws %zu\n", n_in, ws_size); return; }
    (void)hipMemsetAsync((char*)d_ws + mk::WS_CTL, 0, mk::CTL_BYTES, stream);
    mk::launch(d_in, (float*)d_out, (unsigned char*)d_ws, 0, 23, stream);
}
```

```cpp
#include <hip/hip_runtime.h>
#include <cstdio>
#include <cstdint>
#include <hip/hip_cooperative_groups.h>
#ifndef MK_FORCE_VIRTUAL
#define MK_FORCE_VIRTUAL 0
#endif
namespace mk {
namespace cg = cooperative_groups;
#define LAS __attribute__((address_space(3)))
#define GAS __attribute__((address_space(1)))
typedef unsigned short bf16_t;
typedef short bf16x8 __attribute__((ext_vector_type(8)));
typedef short s16x4 __attribute__((ext_vector_type(4)));
typedef float f32x4 __attribute__((ext_vector_type(4)));
typedef float f32x2 __attribute__((ext_vector_type(2)));
typedef unsigned u32x4 __attribute__((ext_vector_type(4)));
typedef unsigned u32x2 __attribute__((ext_vector_type(2)));
typedef _Float16 h16_t;
typedef _Float16 h16x4 __attribute__((ext_vector_type(4)));
typedef _Float16 h16x8 __attribute__((ext_vector_type(8)));
typedef float f32x8 __attribute__((ext_vector_type(8)));

constexpr int D = 1024, M = 12288, MP = 8192, FF = 4096, NCH = 768;
constexpr float EPS = 1e-6f;
constexpr int BM = 256, BK = 64, HALF = 128, HTB = HALF * BK * 2, STAGE_BYTES = 8 * HTB, NXCD = 8, WGM = 8;

typedef __bf16 bf16x2_t __attribute__((ext_vector_type(2)));
__device__ __forceinline__ unsigned cvt_pk_bf16(float lo, float hi) { const f32x2 v = {lo, hi}; const bf16x2_t b = __builtin_convertvector(v, bf16x2_t); return __builtin_bit_cast(unsigned, b); }
__device__ __forceinline__ unsigned f2bf(float f) { unsigned u = __builtin_bit_cast(unsigned, f); return (u + 0x7fffu + ((u >> 16) & 1u)) >> 16; }
__device__ __forceinline__ float bf_lo(unsigned w) { return __uint_as_float(w << 16); }
__device__ __forceinline__ float bf_hi(unsigned w) { return __uint_as_float(w & 0xffff0000u); }
__device__ __forceinline__ float rcp_f(float x) { return __builtin_amdgcn_rcpf(x); }
__device__ __forceinline__ float rsq_f(float x) { return __builtin_amdgcn_rsqf(x); }
__device__ __forceinline__ float gelu_tanh(float x) {
    const float t = x * x * (0.044715f * -2.0f * 0.7978845608028654f * 1.4426950408889634f) + (-2.0f * 0.7978845608028654f * 1.4426950408889634f);
    return x * rcp_f(1.0f + __builtin_amdgcn_exp2f(x * t));
}
__device__ __forceinline__ float sigmoid_f(float x) { return rcp_f(1.0f + __builtin_amdgcn_exp2f(x * -1.4426950408889634f)); }
__device__ __forceinline__ int lane_id() { int r; asm volatile("v_mbcnt_lo_u32_b32 %0, -1, 0\n\tv_mbcnt_hi_u32_b32 %0, -1, %0" : "=v"(r)); return r; }
__device__ __forceinline__ int cond_of_pm(int pm) { return pm < 32 ? 0 : 1 + ((pm - 32) >> 2); }
__device__ __forceinline__ int cond_of_row(int row) { return row < MP ? 0 : 1 + ((row - MP) >> 10); }

__host__ __device__ __forceinline__ int lds_byte(int r, int c) { const int st = (r >> 4) * 2 + (c >> 5), rr = r & 15, cc = c & 31, ob = rr * 64 + cc * 2; return st * 1024 + (ob ^ (((ob >> 9) & 1) << 5)); }
__host__ __device__ __forceinline__ void stage_rc(int b, int& R, int& C) { const int st = b / 1024, sb = b % 1024, swz = sb ^ (((sb >> 9) & 1) << 5); R = (st >> 1) * 16 + swz / 64; C = (st & 1) * 32 + (swz % 64) / 2; }
__host__ __device__ __forceinline__ int perm32(int rho) { const int n = rho >> 4, i = rho & 15; return 8 * (i >> 2) + 4 * n + (i & 3); }

struct Unit { int pm, pn; };
struct Gemm { const GAS char* A; const GAS char* Bt; int K; int lda; int ldb; size_t kstepA, hstepA, tstepA; int mode; int preb; };
struct ARowMajor { static __device__ __forceinline__ unsigned voff(int R, int C, int lda) { return (unsigned)(R * lda + C) * 2u; } };
struct AGroupChunk { static __device__ __forceinline__ unsigned voff(int R, int C, int) { return (unsigned)((((C >> 4) * NCH + (R >> 4)) * 256) + (R & 15) * 16 + (C & 15)) * 2u; } };
__device__ inline Gemm gemm_rowmajor(const GAS void* A, int lda, const GAS void* Bt, int ldb, int K) {
    Gemm g; g.A = (const GAS char*)A; g.Bt = (const GAS char*)Bt; g.K = K; g.lda = lda; g.ldb = ldb; g.kstepA = BK * 2; g.hstepA = (size_t)HALF * lda * 2; g.tstepA = 2 * g.hstepA; g.mode = 0; g.preb = 0; return g; }
__device__ inline Gemm gemm_groupchunk(const GAS void* A, const GAS void* Bt, int ldb, int K) {
    Gemm g; g.A = (const GAS char*)A; g.Bt = (const GAS char*)Bt; g.K = K; g.lda = 0; g.ldb = ldb; g.kstepA = (size_t)4 * NCH * 256 * 2; g.hstepA = 8 * 256 * 2; g.tstepA = 16 * 256 * 2; g.mode = 0; g.preb = 0; return g; }

struct StaticOrder {
    int nM, nN, nwg, G, c;
    __host__ __device__ void init(int M_, int N_, int G_, int c_) { nM = M_ / BM; nN = N_ / BM; nwg = nM * nN; G = G_; c = c_; }
    __host__ __device__ bool next(int i, Unit& u) const {
        const long L = (long)i * G + c; if (L >= nwg) return false;
        int wgid = (int)L; { const int q = nwg / NXCD, r = nwg % NXCD, xcd = wgid % NXCD, off = wgid / NXCD; wgid = (xcd < r ? xcd * (q + 1) : r * (q + 1) + (xcd - r) * q) + off; }
        const int nig = WGM * nN, gid = wgid / nig, fm = gid * WGM, gsz = (nM - fm) < WGM ? (nM - fm) : WGM;
        u.pm = fm + ((wgid % nig) % gsz); u.pn = (wgid % nig) / gsz; return true;
    }
};
__host__ __device__ __forceinline__ int panel_of(int vx, int pl) { return vx < 4 ? (pl < 4 ? 32 + 4 * vx + pl : 2 * vx + (pl - 4)) : 8 + 6 * (vx - 4) + pl; }
struct OwnerOrder {
    int nN, vx, rank;
    __host__ __device__ __forceinline__ bool next(int i, Unit& u) const { const int L = i * 32 + rank; if (L >= 6 * nN) return false; u.pm = panel_of(vx, L % 6); u.pn = L / 6; return true; }
};
struct OwnerR0 { int vx, rank; __host__ __device__ __forceinline__ bool next(int i, Unit& u) const { if (i != 0) return false; u.pm = panel_of(vx, rank % 6); u.pn = rank / 6; return true; } };
struct OwnerR1 { int vx, r15;  __host__ __device__ __forceinline__ bool next(int i, Unit& u) const { if (i != 0) return false; const int L = 32 + r15; u.pm = panel_of(vx, L % 6); u.pn = L / 6; return true; } };
struct SsmOrder {
    int G, c;
    __host__ __device__ __forceinline__ bool next(int i, Unit& u) const { const int L = i * G + c; if (L >= 192) return false; u.pm = L; u.pn = L / 3; return true; }
};

constexpr int PTR_OFF = STAGE_BYTES + 256 + 10240;
__device__ __forceinline__ unsigned long long ldsptr(const LAS unsigned char* lds, int k) { const unsigned long long v = ((const LAS unsigned long long*)(lds + PTR_OFF))[k];
    return ((unsigned long long)(unsigned)__builtin_amdgcn_readfirstlane((int)(unsigned)(v >> 32)) << 32) | (unsigned)__builtin_amdgcn_readfirstlane((int)(unsigned)v); }
__device__ __forceinline__ const GAS float* inp(const LAS unsigned char* lds, int k) { return (const GAS float*)ldsptr(lds, k); }
constexpr int TAB_OFF = STAGE_BYTES + 256, T_RS = TAB_OFF, T_SW = T_RS + 3072, T_GATE = T_SW + 3072, T_GSN = T_GATE + 2048;
struct PreNone { struct Regs {}; template <class Sched> __device__ __forceinline__ void issue(Regs&, const Sched&, int) const {} __device__ __forceinline__ void commit(const Regs&, LAS unsigned char*, int) const {} };
struct PreIn {
    const GAS float* rowss; const GAS float* sw; int swld;
    struct Regs { f32x4 r[3][4]; float s[3]; int n; };
    template <class Sched> __device__ __forceinline__ void issue(Regs& R, const Sched& S, int tid) const {
        R.n = 0;
#pragma unroll
        for (int i = 0; i < 3; ++i) { Unit u; const bool ok = S.next(i, u); if (ok) R.n = i + 1;
            const int pm = ok ? u.pm : 0, pn = ok ? u.pn : 0;
            const GAS f32x4* p = (const GAS f32x4*)(rowss + (size_t)(pm * BM + (tid >> 1)) * 32) + (tid & 1) * 4;
#pragma unroll
            for (int q = 0; q < 4; ++q) R.r[i][q] = p[q];
            R.s[i] = sw[(unsigned)(cond_of_pm(pm) * swld + pn * BM + (tid & 255))]; }
    }
    __device__ __forceinline__ void commit(const Regs& R, LAS unsigned char* lds, int tid) const {
        LAS float* trs = (LAS float*)(lds + T_RS); LAS float* tsw = (LAS float*)(lds + T_SW);
#pragma unroll
        for (int i = 0; i < 3; ++i) { if (i < R.n) {
            const f32x4 a = (R.r[i][0] + R.r[i][1]) + (R.r[i][2] + R.r[i][3]); float t = (a[0] + a[1]) + (a[2] + a[3]); t += __shfl_xor(t, 1);
            if ((tid & 1) == 0) trs[i * 256 + (tid >> 1)] = rsq_f(t * (1.0f / D) + EPS);
            if (tid < 256) tsw[i * 256 + tid] = R.s[i]; } }
    }
};
template <int NCOL> struct PreRes {
    const GAS float* gate; const GAS float* gw; const GAS float* gsc;
    struct Regs { float g[2], nn[2], w[2]; int n; };
    template <class Sched> __device__ __forceinline__ void issue(Regs& R, const Sched& S, int tid) const {
        R.n = 0;
#pragma unroll
        for (int i = 0; i < 2; ++i) { Unit u; const bool ok = S.next(i, u); if (ok) R.n = i + 1; const int pm = ok ? u.pm : 0, pn = ok ? u.pn : 0, ci = cond_of_pm(pm), c = tid & (NCOL - 1);
            R.g[i] = gate[(unsigned)(ci * 6144 + pn * NCOL + c)]; R.nn[i] = gw ? gsc[(unsigned)(ci * 6144 + pn * NCOL + c)] : -1.f; R.w[i] = gw ? gw[(unsigned)(pn * NCOL + c)] : 0.f; }
    }
    __device__ __forceinline__ void commit(const Regs& R, LAS unsigned char* lds, int tid) const {
        LAS float* tg = (LAS float*)(lds + T_GATE); LAS float* tn = (LAS float*)(lds + T_GSN);
#pragma unroll
        for (int i = 0; i < 2; ++i) { if (i < R.n && tid < NCOL) { tg[i * 256 + tid] = R.g[i]; tn[i * 256 + tid] = R.w[i] * (1.0f + R.nn[i]); } }
    }
};

__device__ __forceinline__ void stage_b0(LAS unsigned char* lds, const GAS char* cB, int ldb, int wave_) {
    int tid = wave_ * 64 + lane_id(); asm volatile("" : "+v"(tid));
    const unsigned ldsw = (unsigned)wave_ * 1024u; const size_t hstepB = (size_t)HALF * ldb * 2;
    __syncthreads();
#pragma unroll
    for (int h = 0; h < 2; ++h)
#pragma unroll
        for (int i = 0; i < 2; ++i) { int R, C; stage_rc(tid * 16 + i * 8192, R, C); const int Rb = (R & ~31) + perm32(R & 31);
            __builtin_amdgcn_global_load_lds((const GAS unsigned*)(cB + h * hstepB + (unsigned)(Rb * ldb + C) * 2u), (LAS unsigned*)(lds + (4 + h) * HTB + ldsw + i * 8192), 16, 0, 0); }
}
template <class Epi, class AL, class Sched, class Pre = PreNone, int HM = 0>
__device__ __forceinline__ void gemm_phase(LAS unsigned char* lds, const Gemm g, const Sched& S, const Epi& E, int wave_, const Pre& P = Pre()) {
    int tid = wave_ * 64 + lane_id(); asm volatile("" : "+v"(tid));
    const int wid = __builtin_amdgcn_readfirstlane(tid >> 6), lane = tid & 63, wr = wid >> 2, wc = wid & 3, fr = lane & 15, fq = lane >> 4;
    const int K = g.K, nt = K / BK;
    unsigned voffA[2], voffB[2];
#pragma unroll
    for (int i = 0; i < 2; ++i) { int R, C; stage_rc(tid * 16 + i * 8192, R, C); const int Rb = Epi::PERM ? ((R & ~31) + perm32(R & 31)) : R;
        voffA[i] = AL::voff(R, C, g.lda); voffB[i] = (unsigned)(Rb * g.ldb + C) * 2u; }
    const size_t kstepA = g.kstepA, hstepA = g.hstepA, tstepA = g.tstepA;
    const size_t kstepB = (size_t)(BK * 2), hstepB = (size_t)HALF * g.ldb * 2, tstepB = 2 * hstepB;
    const unsigned ldsw = (unsigned)wid * 1024u;
    const int aoff = lds_byte(wr * 64 + fr, fq * 8), boff = lds_byte(wc * 32 + fr, fq * 8);
#define PG8_SA(b, h) (((b) * 2 + (h)) * HTB)
#define PG8_SB(b, h) ((4 + (b) * 2 + (h)) * HTB)
#define PG8_STAGE(bufoff, gbase, voff) do { _Pragma("unroll") for (int _i = 0; _i < 2; ++_i) \
        __builtin_amdgcn_global_load_lds((const GAS unsigned*)((const GAS char*)(gbase) + (voff)[_i]), (LAS unsigned*)(lds + (bufoff) + ldsw + _i * 8192), 16, 0, 0); } while (0)
#define PG8_LDA(dst, b, h) do { _Pragma("unroll") for (int m = 0; m < 4; ++m) _Pragma("unroll") for (int k = 0; k < 2; ++k) dst[m][k] = *(const LAS bf16x8*)(lds + PG8_SA(b, h) + aoff + m * 2048 + k * 1024); } while (0)
#define PG8_LDB(dst, b, h) do { _Pragma("unroll") for (int n = 0; n < 2; ++n) _Pragma("unroll") for (int k = 0; k < 2; ++k) dst[n][k] = *(const LAS bf16x8*)(lds + PG8_SB(b, h) + boff + n * 2048 + k * 1024); } while (0)
#define PG8_MMA(ai, bj, At, Bt) do { __builtin_amdgcn_s_setprio(1); _Pragma("unroll") for (int m = 0; m < 4; ++m) _Pragma("unroll") for (int n = 0; n < 2; ++n) _Pragma("unroll") for (int k = 0; k < 2; ++k) \
        acc[ai][bj][m][n] = __builtin_amdgcn_mfma_f32_16x16x32_bf16(Bt[n][k], At[m][k], acc[ai][bj][m][n], 0, 0, 0); __builtin_amdgcn_s_setprio(0); } while (0)
#define PG8_WAIT_V(n) asm volatile("s_waitcnt vmcnt(" #n ")" ::: "memory")
#define PG8_STGA0(b, src) do { if constexpr (HM != 2) PG8_STAGE(PG8_SA(b, 0), (src), voffA); } while (0)
#define PG8_STGA1(b, src) do { if constexpr (HM != 1) PG8_STAGE(PG8_SA(b, 1), (src) + hstepA, voffA); } while (0)
#define PG8_WAIT_VK do { if constexpr (HM == 0) PG8_WAIT_V(8); else PG8_WAIT_V(6); } while (0)
#define PG8_WAIT_L(n) asm volatile("s_waitcnt lgkmcnt(" #n ")" ::: "memory")
#define PG8_BAR __builtin_amdgcn_s_barrier()
#define PG8_SCHED __builtin_amdgcn_sched_barrier(0)
    Unit cur, nxt; int ui = 0;
    if (!S.next(0, cur)) return;
    typename Pre::Regs preg; P.issue(preg, S, tid);
    f32x4 acc[2][2][4][2];
#pragma unroll
    for (int a = 0; a < 2; ++a)
#pragma unroll
        for (int b = 0; b < 2; ++b)
#pragma unroll
            for (int m = 0; m < 4; ++m)
#pragma unroll
                for (int n = 0; n < 2; ++n) acc[a][b][m][n] = (f32x4){0.f, 0.f, 0.f, 0.f};
    bf16x8 At[4][2], B0[2][2], B1[2][2];
    const GAS char* cA = g.A + (size_t)cur.pm * tstepA; const GAS char* cB = g.Bt + (size_t)cur.pn * tstepB;
    if (!g.preb) { PG8_STAGE(PG8_SB(0, 0), cB, voffB); PG8_STAGE(PG8_SB(0, 1), cB + hstepB, voffB); }
    PG8_STGA0(0, cA); PG8_STGA1(0, cA);
    if (wr == 1) PG8_BAR;
    if constexpr (HM == 1) PG8_WAIT_V(0); else PG8_WAIT_V(2);
    PG8_BAR;
    P.commit(preg, lds, tid);
    PG8_STAGE(PG8_SB(1, 0), cB + kstepB, voffB); PG8_STGA0(1, cA + kstepA); PG8_STAGE(PG8_SB(1, 1), cB + hstepB + kstepB, voffB);
    PG8_WAIT_V(6); PG8_BAR;
    for (;;) {
        const bool has_next = S.next(ui + 1, nxt);
        const GAS char* nA = has_next ? g.A + (size_t)nxt.pm * tstepA : cA; const GAS char* nB = has_next ? g.Bt + (size_t)nxt.pn * tstepB : cB;
        for (int t = 0; t < nt; t += 2) {
            const bool last = (t == nt - 2);
            const GAS char* a1 = cA + (size_t)(t + 1) * kstepA;
            const GAS char* a2 = last ? nA : cA + (size_t)(t + 2) * kstepA; const GAS char* b2 = last ? nB : cB + (size_t)(t + 2) * kstepB;
            const GAS char* a3 = a2 + kstepA; const GAS char* b3 = b2 + kstepB;
            PG8_LDB(B0, 0, 0); PG8_LDB(B1, 0, 1); PG8_SCHED; if constexpr (HM != 2) PG8_LDA(At, 0, 0); PG8_STGA1(1, a1);
            PG8_WAIT_VK; PG8_WAIT_L(0); PG8_BAR; if constexpr (HM != 2) { PG8_MMA(0, 0, At, B0); PG8_MMA(0, 1, At, B1); } PG8_BAR; PG8_SCHED;
            if constexpr (HM != 1) PG8_LDA(At, 0, 1); PG8_STAGE(PG8_SB(0, 0), b2, voffB); PG8_STAGE(PG8_SB(0, 1), b2 + hstepB, voffB); PG8_STGA0(0, a2);
            PG8_WAIT_VK; PG8_WAIT_L(0); PG8_BAR; if constexpr (HM != 1) { PG8_MMA(1, 0, At, B0); PG8_MMA(1, 1, At, B1); } PG8_BAR; PG8_SCHED;
            PG8_LDB(B0, 1, 0); PG8_LDB(B1, 1, 1); PG8_SCHED; if constexpr (HM != 2) PG8_LDA(At, 1, 0); PG8_STGA1(0, a2);
            PG8_WAIT_VK; PG8_WAIT_L(0); PG8_BAR; if constexpr (HM != 2) { PG8_MMA(0, 0, At, B0); PG8_MMA(0, 1, At, B1); } PG8_BAR; PG8_SCHED;
            if constexpr (HM != 1) PG8_LDA(At, 1, 1); PG8_STAGE(PG8_SB(1, 0), b3, voffB); PG8_STAGE(PG8_SB(1, 1), b3 + hstepB, voffB); PG8_STGA0(1, a3);
            PG8_WAIT_VK; PG8_WAIT_L(0); PG8_BAR; if constexpr (HM != 1) { PG8_MMA(1, 0, At, B0); PG8_MMA(1, 1, At, B1); } PG8_BAR; PG8_SCHED;
        }
        if (wr == 0) PG8_BAR;
        int el_ = lane_id(); asm volatile("" : "+v"(el_));
        const int efr = el_ & 15, efq = el_ >> 4;
#ifdef MK_RANGE
        if constexpr (!Epi::AFTER_DRAIN) { if (g.mode != 1) E(acc, cur, ui, lds, wr, wc, efr, efq); else { asm volatile("" :: "v"(acc[0][0][0][0]), "v"(acc[1][1][3][1])); } }
#else
        if constexpr (!Epi::AFTER_DRAIN) E(acc, cur, ui, lds, wr, wc, efr, efq);
#endif
        if (!has_next) break;
#pragma unroll
        for (int a = 0; a < 2; ++a)
#pragma unroll
            for (int b = 0; b < 2; ++b)
#pragma unroll
                for (int m = 0; m < 4; ++m)
#pragma unroll
                    for (int n = 0; n < 2; ++n) acc[a][b][m][n] = (f32x4){0.f, 0.f, 0.f, 0.f};
        cur = nxt; cA = nA; cB = nB; ++ui;
        if (wr == 1) PG8_BAR;
    }
    PG8_WAIT_V(0);
    PG8_BAR;
    if constexpr (Epi::AFTER_DRAIN) E.fused(acc, cur, wr, wc, fr, fq, lds, tid);
#undef PG8_SA
#undef PG8_SB
#undef PG8_STAGE
#undef PG8_LDA
#undef PG8_LDB
#undef PG8_MMA
#undef PG8_WAIT_V
#undef PG8_WAIT_VK
#undef PG8_STGA0
#undef PG8_STGA1
#undef PG8_WAIT_L
#undef PG8_BAR
#undef PG8_SCHED
}

typedef const f32x4 (&AccRef)[2][2][4][2];

__device__ __forceinline__ void load_rstd(const LAS unsigned char* lds, int ui, int wr, int fr, float (&rs)[2][4]) {
    const LAS float* trs = (const LAS float*)(lds + T_RS) + ui * 256 + wr * 64 + fr;
#pragma unroll
    for (int ai = 0; ai < 2; ++ai)
#pragma unroll
        for (int m = 0; m < 4; ++m) rs[ai][m] = trs[ai * HALF + m * 16];
}

template <int ACT, int LDC> struct EpiIn {
    static constexpr bool PERM = true, AFTER_DRAIN = false;
    GAS bf16_t* O; GAS float* vstat;
    __device__ __forceinline__ void operator()(AccRef acc, const Unit& u, int ui, const LAS unsigned char* lds, int wr, int wc, int fr, int fq) const {
        const int row0 = u.pm * BM + wr * 64 + fr, col0 = u.pn * BM + wc * 32 + 8 * fq;
        float rs[2][4]; load_rstd(lds, ui, wr, fr, rs);
        const LAS float* swp = (const LAS float*)(lds + T_SW) + ui * 256 + wc * 32 + 8 * fq;
        const bool stats = ACT == 2 && u.pn >= 8;
#pragma unroll
        for (int bj = 0; bj < 2; ++bj) {
            const f32x4 b0 = *(const LAS f32x4*)(swp + bj * HALF), b1 = *(const LAS f32x4*)(swp + bj * HALF + 4);
#pragma unroll
            for (int ai = 0; ai < 2; ++ai)
#pragma unroll
                for (int m = 0; m < 4; ++m) {
                    const unsigned r = (unsigned)(row0 + ai * HALF + m * 16);
                    f32x4 v0 = acc[ai][bj][m][0] * rs[ai][m] + b0, v1 = acc[ai][bj][m][1] * rs[ai][m] + b1;
                    if (ACT == 1) {
#pragma unroll
                        for (int j = 0; j < 4; ++j) { const float a = fmaxf(v0[j], 0.f), b = fmaxf(v1[j], 0.f); v0[j] = a * a; v1[j] = b * b; } }
                    if (ACT == 2) {
#pragma unroll
                        for (int j = 0; j < 4; ++j) { v0[j] = gelu_tanh(v0[j]); v1[j] = gelu_tanh(v1[j]); } }
                    u32x4 w; w.x = cvt_pk_bf16(v0[0], v0[1]); w.y = cvt_pk_bf16(v0[2], v0[3]); w.z = cvt_pk_bf16(v1[0], v1[1]); w.w = cvt_pk_bf16(v1[2], v1[3]);
                    *(GAS u32x4*)(O + (r * (unsigned)LDC + (unsigned)(col0 + bj * HALF))) = w;
                    if (ACT == 2) { if (stats) {
                        float a = (v0[0] + v0[1]) + (v0[2] + v0[3]) + (v1[0] + v1[1]) + (v1[2] + v1[3]);
                        float b = (v0[0] * v0[0] + v0[1] * v0[1]) + (v0[2] * v0[2] + v0[3] * v0[3]) + (v1[0] * v1[0] + v1[1] * v1[1]) + (v1[2] * v1[2] + v1[3] * v1[3]);
                        a += __shfl_xor(a, 16); a += __shfl_xor(a, 32); b += __shfl_xor(b, 16); b += __shfl_xor(b, 32);
                        if (fq == 0) *(GAS f32x2*)(vstat + (r * 64u + (unsigned)(((u.pn - 8) * 2 + bj) * 4 + wc)) * 2u) = (f32x2){a, b}; } }
                }
        }
    }
};
struct EpiU {
    static constexpr bool PERM = true, AFTER_DRAIN = false;
    GAS bf16_t* UgS;
    __device__ __forceinline__ void operator()(AccRef acc, const Unit& u, int ui, const LAS unsigned char* lds, int wr, int wc, int fr, int fq) const {
        const int col0 = u.pn * BM + wc * 32 + 8 * fq;
        float rs[2][4]; load_rstd(lds, ui, wr, fr, rs);
        const LAS float* swp = (const LAS float*)(lds + T_SW) + ui * 256 + wc * 32 + 8 * fq;
#pragma unroll
        for (int bj = 0; bj < 2; ++bj) {
            const f32x4 b0 = *(const LAS f32x4*)(swp + bj * HALF), b1 = *(const LAS f32x4*)(swp + bj * HALF + 4);
            const int g = (col0 + bj * HALF) >> 4, p0 = (col0 & 15);
#pragma unroll
            for (int ai = 0; ai < 2; ++ai)
#pragma unroll
                for (int m = 0; m < 4; ++m) {
                    const f32x4 v0 = acc[ai][bj][m][0] * rs[ai][m] + b0, v1 = acc[ai][bj][m][1] * rs[ai][m] + b1;
                    u32x4 w; w.x = cvt_pk_bf16(v0[0], v0[1]); w.y = cvt_pk_bf16(v0[2], v0[3]); w.z = cvt_pk_bf16(v1[0], v1[1]); w.w = cvt_pk_bf16(v1[2], v1[3]);
                    const int chunk = u.pm * 16 + ai * 8 + wr * 4 + m;
                    *(GAS u32x4*)(UgS + ((unsigned)(g * NCH + chunk) * 512u + (unsigned)(fr * 16 + p0))) = w;
                }
        }
    }
};
struct EpiScan {
    static constexpr bool PERM = true, AFTER_DRAIN = true;
    GAS bf16_t* UgS; const GAS float* lamT; const GAS float* h0_re; const GAS float* h0_im; GAS float* new_re; GAS float* new_im; int j;
    static __device__ __forceinline__ int lidx(int row, int col) { return row * 128 + ((((col >> 2) ^ row) & 31) << 2) + (col & 3); }
    __device__ __forceinline__ void fused(AccRef acc, const Unit& u, int wr, int wc, int fr, int fq, LAS unsigned char* lds, int tid) const {
        LAS float* T = (LAS float*)lds;
        const int g = u.pn, mt = u.pm - 3 * g, n = tid & 63, slot = __builtin_amdgcn_readfirstlane(tid >> 6);
        const int len = mt < 2 ? 16 : 64, nsq = mt < 2 ? 2 : (slot < 4 ? 1 : 0), sl0 = mt < 2 ? slot * 2 : slot;
#pragma unroll 1
        for (int k = 0; k < 2; ++k) {
#pragma unroll
            for (int ai = 0; ai < 2; ++ai)
#pragma unroll
                for (int m = 0; m < 4; ++m) { const int row = ai * HALF + wr * 64 + m * 16 + fr;
#pragma unroll
                    for (int nn = 0; nn < 2; ++nn) { const int col = wc * 32 + 8 * fq + 4 * nn; *(LAS f32x4*)(T + lidx(row, col)) = k == 0 ? acc[ai][0][m][nn] : acc[ai][1][m][nn]; } }
            __syncthreads();
            const float lr = lamT[(((unsigned)j * 64 + g) * 2 + k) * 128 + 2 * n], li = lamT[(((unsigned)j * 64 + g) * 2 + k) * 128 + 2 * n + 1];
            for (int q = 0; q < nsq; ++q) {
                const int sl = sl0 + q, r0 = sl * len;
                float sr = 0.f, si = 0.f;
                if (mt == 2) { const unsigned o = ((((unsigned)sl * 2 + j) * 2 + k) * 64 + g) * 64 + n; sr = h0_re[o]; si = h0_im[o]; }
                GAS bf16_t* so = UgS + ((size_t)g * NCH + mt * 256) * 512 + 256 + k * 128 + n;
                for (int i0 = 0; i0 < len; i0 += 8) {
                    float ar[8], ai2[8];
#pragma unroll
                    for (int q = 0; q < 8; ++q) { const int row = k == 0 ? r0 + i0 + q : r0 + len - 1 - i0 - q; ar[q] = T[lidx(row, n)]; ai2[q] = T[lidx(row, 64 + n)]; }
#pragma unroll
                    for (int q = 0; q < 8; ++q) { const int row = k == 0 ? r0 + i0 + q : r0 + len - 1 - i0 - q;
                        so[(unsigned)row * 512u] = (bf16_t)f2bf(sr); so[(unsigned)row * 512u + 64u] = (bf16_t)f2bf(si);
                        const float nr = lr * sr - li * si + ar[q], ni = lr * si + li * sr + ai2[q]; sr = nr; si = ni; }
                }
                if (mt < 2) { const unsigned o = ((((unsigned)(mt * 16 + sl) * 2 + j) * 2 + k) * 64 + g) * 64 + n; new_re[o] = sr; new_im[o] = si; }
            }
            __syncthreads();
        }
    }
};
struct EpiY {
    static constexpr bool PERM = true, AFTER_DRAIN = false;
    GAS bf16_t* Zg;
    __device__ __forceinline__ void operator()(AccRef acc, const Unit& u, int ui, const LAS unsigned char* lds, int wr, int wc, int fr, int fq) const {
        const int row0 = u.pm * BM + wr * 64 + fr, col0 = wc * 32 + 8 * fq;
#pragma unroll
        for (int ai = 0; ai < 2; ++ai)
#pragma unroll
            for (int m = 0; m < 4; ++m) { GAS bf16_t* rp = Zg + (size_t)(row0 + ai * HALF + m * 16) * 256 + col0;
#pragma unroll
                for (int bj = 0; bj < 2; ++bj) { const f32x4 v0 = acc[ai][bj][m][0], v1 = acc[ai][bj][m][1];
                    u32x4 w; w.x = cvt_pk_bf16(gelu_tanh(v0[0]), gelu_tanh(v0[1])); w.y = cvt_pk_bf16(gelu_tanh(v0[2]), gelu_tanh(v0[3]));
                    w.z = cvt_pk_bf16(gelu_tanh(v1[0]), gelu_tanh(v1[1])); w.w = cvt_pk_bf16(gelu_tanh(v1[2]), gelu_tanh(v1[3]));
                    *(GAS u32x4*)(rp + bj * HALF) = w; } }
    }
};
template <bool GATED> struct EpiRes {
    static constexpr bool PERM = true, AFTER_DRAIN = false;
    GAS h16_t* X; GAS bf16_t* XN; GAS float* rowss_next; bool has_next; int hm = 0;
    __device__ __forceinline__ void operator()(AccRef acc, const Unit& u, int ui, const LAS unsigned char* lds, int wr, int wc, int fr, int fq) const {
        constexpr int NB = GATED ? 1 : 2;
        const int row0 = u.pm * BM + wr * 64 + fr, col0 = u.pn * (GATED ? HALF : BM) + wc * 32 + 8 * fq;
        const LAS float* tg = (const LAS float*)(lds + T_GATE) + ui * 256 + wc * 32 + 8 * fq; const LAS float* tn = (const LAS float*)(lds + T_GSN) + ui * 256 + wc * 32 + 8 * fq;
        h16x8 xa[4], xb[4];
#define RES_LOAD(dst, b_) do { const int bj_ = (b_) / 2, ai_ = (b_) % 2; _Pragma("unroll") for (int m = 0; m < 4; ++m) \
            dst[m] = *(const GAS h16x8*)(X + ((unsigned)(row0 + ai_ * HALF + m * 16) * (unsigned)D + (unsigned)(col0 + bj_ * HALF))); } while (0)
#define RES_PROC(src, b_) do { const int bj = (b_) / 2, ai = (b_) % 2; \
            const f32x4 g0 = *(const LAS f32x4*)(tg + bj * HALF), g1 = *(const LAS f32x4*)(tg + bj * HALF + 4), n0 = *(const LAS f32x4*)(tn + bj * HALF), n1 = *(const LAS f32x4*)(tn + bj * HALF + 4); \
            _Pragma("unroll") for (int m = 0; m < 4; ++m) { \
                const unsigned r = (unsigned)(row0 + ai * HALF + m * 16), off = r * (unsigned)D + (unsigned)(col0 + bj * HALF); \
                f32x4 v0 = acc[ai][bj][m][0], v1 = acc[ai][bj][m][1]; \
                if (GATED) { const f32x4 q0 = acc[ai][1][m][0], q1 = acc[ai][1][m][1]; \
                    _Pragma("unroll") for (int j = 0; j < 4; ++j) { v0[j] *= sigmoid_f(q0[j]); v1[j] *= sigmoid_f(q1[j]); } } \
                const f32x8 xo = __builtin_convertvector(src[m], f32x8); \
                const f32x4 x0 = (f32x4){xo[0], xo[1], xo[2], xo[3]} + g0 * v0, x1 = (f32x4){xo[4], xo[5], xo[6], xo[7]} + g1 * v1; \
                *(GAS h16x8*)(X + off) = __builtin_convertvector(((f32x8){x0[0], x0[1], x0[2], x0[3], x1[0], x1[1], x1[2], x1[3]}), h16x8); \
                if (has_next) { \
                    float a = (x0[0] * x0[0] + x0[1] * x0[1]) + (x0[2] * x0[2] + x0[3] * x0[3]) + (x1[0] * x1[0] + x1[1] * x1[1]) + (x1[2] * x1[2] + x1[3] * x1[3]); \
                    const f32x4 y0 = x0 * n0, y1 = x1 * n1; \
                    u32x4 w; w.x = cvt_pk_bf16(y0[0], y0[1]); w.y = cvt_pk_bf16(y0[2], y0[3]); w.z = cvt_pk_bf16(y1[0], y1[1]); w.w = cvt_pk_bf16(y1[2], y1[3]); \
                    *(GAS u32x4*)(XN + off) = w; \
                    a += __shfl_xor(a, 16); a += __shfl_xor(a, 32); \
                    if (fq == 0) rowss_next[r * 32u + (unsigned)(GATED ? u.pn * 4 + wc : (u.pn * 2 + bj) * 4 + wc)] = a; } } } while (0)
        h16x8 xc[4], xd[4];
        if (GATED && hm != 0) { if (hm == 1) { RES_LOAD(xa, 0); RES_PROC(xa, 0); } else { RES_LOAD(xb, 1); RES_PROC(xb, 1); } }
        else {
        RES_LOAD(xa, 0); RES_LOAD(xb, 1);
        if (NB > 1) { RES_LOAD(xc, 2); RES_LOAD(xd, 3); }
        RES_PROC(xa, 0); RES_PROC(xb, 1);
        if (NB > 1) { RES_PROC(xc, 2); RES_PROC(xd, 3); } }
#undef RES_LOAD
#undef RES_PROC
    }
};

#define XB_TMO      128
#define CW_BAR_WORDS 4096
#define XB_XCNT(j)  (256  + 64 * (j))
#define XB_XSUB(j)  (1280 + 64 * (j))
#define XB_XGEN(j)  (2304 + 64 * (j))
#define XB_TOP      3328
#define XB_TOPGEN   3392
#define XCD_BAR_WORDS 3456
#define XB_SPIN_CAP (1u << 18)
__device__ __forceinline__ unsigned xb_ld(GAS unsigned* p)              { return __hip_atomic_load(p, __ATOMIC_RELAXED, __HIP_MEMORY_SCOPE_AGENT); }
__device__ __forceinline__ unsigned xb_add(GAS unsigned* p, unsigned v) { return __hip_atomic_fetch_add(p, v, __ATOMIC_RELAXED, __HIP_MEMORY_SCOPE_AGENT); }
__device__ __forceinline__ unsigned xb_xcc_id() { return (unsigned)__builtin_amdgcn_s_getreg((3 << 11) | 20) & 0xFu; }
#define XB_SPIN(cond, bar) do { unsigned _sp = 0; while (cond) { __builtin_amdgcn_s_sleep(1); \
    if ((++_sp & 255u) == 0u) { if (xb_ld(&(bar)[XB_TMO])) break; if (_sp > XB_SPIN_CAP) { (void)xb_add(&(bar)[XB_TMO], 1u); break; } } } } while (0)
struct XcdBarrier { GAS unsigned* bar; unsigned x; volatile LAS unsigned* st; };
__device__ __forceinline__ XcdBarrier xcd_barrier_post(GAS unsigned* bar, volatile LAS unsigned* st) {
    XcdBarrier b; b.bar = bar; b.x = xb_xcc_id(); b.st = st;
    if (threadIdx.x == 0) st[2] = xb_add(&bar[XB_XCNT(b.x)], 1u);
    return b;
}
__device__ __forceinline__ void xcd_barrier_complete(GAS unsigned* bar, unsigned x, unsigned& nloc, unsigned& nx, unsigned& dense, unsigned& uni) {
    const unsigned G = gridDim.x * gridDim.y * gridDim.z;
    unsigned sum, cnt, mine, sp = 0u;
    for (;;) {
        sum = 0u; cnt = 0u; dense = 0u; uni = 1u;
#pragma unroll 1
        for (unsigned j = 0; j < 16; ++j) { const unsigned c = xb_ld(&bar[XB_XCNT(j)]); sum += c; cnt += (c > 0u) ? 1u : 0u; dense += (j < x && c > 0u) ? 1u : 0u; uni &= (c == 0u || c == 32u) ? 1u : 0u; }
        mine = xb_ld(&bar[XB_XCNT(x)]);
        if (sum == G) break;
        __builtin_amdgcn_s_sleep(1);
        if ((++sp & 255u) == 0u) { if (xb_ld(&bar[XB_TMO])) break; if (sp > XB_SPIN_CAP) { (void)xb_add(&bar[XB_TMO], 1u); break; } }
    }
    nloc = mine > 0u ? mine : 1u; nx = cnt > 0u ? cnt : 1u;
}
__device__ __forceinline__ void xcd_barrier(const XcdBarrier& b, bool leader) {
    asm volatile("s_waitcnt vmcnt(0)" ::: "memory");
    __syncthreads();
    if (leader) {
        GAS unsigned* bar = b.bar; unsigned bx_ = b.x;
        asm volatile("" : "+s"(bar), "+s"(bx_));
        __builtin_amdgcn_s_waitcnt(0);
        unsigned nloc = b.st[0], nx = b.st[1];
        if (nloc == 0u) { unsigned dense, uni; xcd_barrier_complete(bar, bx_, nloc, nx, dense, uni); b.st[0] = nloc; b.st[1] = nx; b.st[3] = dense;
            b.st[4] = (nx == 8u && uni != 0u && gridDim.x == 256u && !MK_FORCE_VIRTUAL) ? 1u : 0u; }
        const unsigned old = xb_add(&bar[XB_XSUB(bx_)], 1u);
        const unsigned gen = old / nloc;
        if (old + 1u == (gen + 1u) * nloc) {
            __builtin_amdgcn_fence(__ATOMIC_RELEASE, "agent");
            asm volatile("s_waitcnt vmcnt(0)" ::: "memory");
            const unsigned og = xb_add(&bar[XB_TOP], 1u);
            const unsigned tg = og / nx;
            if (og + 1u == (tg + 1u) * nx) xb_add(&bar[XB_TOPGEN], 1u);
            else XB_SPIN(xb_ld(&bar[XB_TOPGEN]) == tg, bar);
            __builtin_amdgcn_fence(__ATOMIC_ACQUIRE, "agent");
            xb_add(&bar[XB_XGEN(bx_)], 1u);
            asm volatile("s_waitcnt vmcnt(0)" ::: "memory");
        } else {
            XB_SPIN(xb_ld(&bar[XB_XGEN(bx_)]) == gen, bar);
            __builtin_amdgcn_fence(__ATOMIC_ACQUIRE, "agent");
            asm volatile("s_waitcnt vmcnt(0)" ::: "memory");
        }
    }
    __syncthreads();
}

__device__ __forceinline__ void xcc_barrier(const XcdBarrier& b, bool leader) {
    asm volatile("s_waitcnt vmcnt(0)" ::: "memory");
    __syncthreads();
    if (leader) {
        GAS unsigned* bar = b.bar; unsigned bx_ = b.x;
        asm volatile("" : "+s"(bar), "+s"(bx_));
        __builtin_amdgcn_s_waitcnt(0);
        const unsigned nloc = b.st[0];
        const unsigned old = xb_add(&bar[XB_XSUB(bx_)], 1u);
        const unsigned gen = old / nloc;
        if (old + 1u == (gen + 1u) * nloc) xb_add(&bar[XB_XGEN(bx_)], 1u);
        else XB_SPIN(xb_ld(&bar[XB_XGEN(bx_)]) == gen, bar);
        __builtin_amdgcn_fence(__ATOMIC_ACQUIRE, "agent");
        asm volatile("s_waitcnt vmcnt(0)" ::: "memory");
    }
    __syncthreads();
}

#define XS_SUB(j) (3072 + 32 * (j))
#define XS_TOP    3648
#define XS_DONE   3712
__device__ __forceinline__ void xcd_split_arrive(const XcdBarrier& b, bool leader) {
    asm volatile("s_waitcnt vmcnt(0)" ::: "memory");
    __syncthreads();
    if (leader) {
        GAS unsigned* bar = b.bar; unsigned bx_ = b.x;
        asm volatile("" : "+s"(bar), "+s"(bx_));
        __builtin_amdgcn_s_waitcnt(0);
        unsigned nloc = b.st[0], nx = b.st[1];
        if (nloc == 0u) { unsigned dense, uni; xcd_barrier_complete(bar, bx_, nloc, nx, dense, uni); b.st[0] = nloc; b.st[1] = nx; b.st[3] = dense;
            b.st[4] = (nx == 8u && uni != 0u && gridDim.x == 256u && !MK_FORCE_VIRTUAL) ? 1u : 0u; }
        GAS unsigned* ctl = bar - CW_BAR_WORDS;
        const unsigned old = xb_add(&ctl[XS_SUB(bx_)], 1u);
        if (old + 1u == nloc) {
            __builtin_amdgcn_fence(__ATOMIC_RELEASE, "agent");
            asm volatile("s_waitcnt vmcnt(0)" ::: "memory");
            const unsigned og = xb_add(&ctl[XS_TOP], 1u);
            if (og + 1u == nx) (void)xb_add(&ctl[XS_DONE], 1u);
            asm volatile("s_waitcnt vmcnt(0)" ::: "memory");
        }
    }
    __syncthreads();
}
__device__ __forceinline__ void xcd_split_wait(const XcdBarrier& b, bool leader) {
    __syncthreads();
    if (leader) {
        GAS unsigned* bar = b.bar; asm volatile("" : "+s"(bar));
        GAS unsigned* ctl = bar - CW_BAR_WORDS;
        XB_SPIN(xb_ld(&ctl[XS_DONE]) == 0u, bar);
        __builtin_amdgcn_fence(__ATOMIC_ACQUIRE, "agent");
        asm volatile("s_waitcnt vmcnt(0)" ::: "memory");
    }
    __syncthreads();
}

struct EpiFinal {
    static constexpr bool PERM = true, AFTER_DRAIN = false, PREX = false; struct XPre {};
    const GAS h16_t* X; GAS float* Y; const GAS float* gf; GAS float* PS; GAS unsigned* cnt; GAS unsigned* tmo; bool need_release;
    __device__ __forceinline__ void operator()(AccRef acc_c, const Unit& u, int ui, const LAS unsigned char* lds_c, int wr, int wc, int fr, int fq) const {
        f32x4 (&acc)[2][2][4][2] = const_cast<f32x4 (&)[2][2][4][2]>(acc_c);
        LAS unsigned char* lds = (LAS unsigned char*)lds_c;
        const int row0 = u.pm * BM + wr * 64 + fr, col0 = u.pn * BM + wc * 32 + 8 * fq, t = (wr * 4 + wc) * 64 + fq * 16 + fr;
        const LAS float* tg = (const LAS float*)(lds + T_GATE) + ui * 256 + wc * 32 + 8 * fq;
        LAS float* T1 = (LAS float*)(lds + T_RS);
        LAS float* T2 = T1 + 1024;
        h16x8 xv[2][2][4];
#pragma unroll
        for (int bj = 0; bj < 2; ++bj)
#pragma unroll
            for (int ai = 0; ai < 2; ++ai)
#pragma unroll
                for (int m = 0; m < 4; ++m) xv[bj][ai][m] = *(const GAS h16x8*)(X + ((unsigned)(row0 + ai * HALF + m * 16) * (unsigned)D + (unsigned)(col0 + bj * HALF)));
        float ss[2][4];
#pragma unroll
        for (int ai = 0; ai < 2; ++ai)
#pragma unroll
            for (int m = 0; m < 4; ++m) ss[ai][m] = 0.f;
#pragma unroll
        for (int bj = 0; bj < 2; ++bj) { const f32x4 g0 = *(const LAS f32x4*)(tg + bj * HALF), g1 = *(const LAS f32x4*)(tg + bj * HALF + 4);
#pragma unroll
            for (int ai = 0; ai < 2; ++ai)
#pragma unroll
                for (int m = 0; m < 4; ++m) { const f32x8 xo = __builtin_convertvector(xv[bj][ai][m], f32x8);
                    const f32x4 x0 = (f32x4){xo[0], xo[1], xo[2], xo[3]} + g0 * acc[ai][bj][m][0], x1 = (f32x4){xo[4], xo[5], xo[6], xo[7]} + g1 * acc[ai][bj][m][1];
                    acc[ai][bj][m][0] = x0; acc[ai][bj][m][1] = x1;
                    ss[ai][m] += (x0[0] * x0[0] + x0[1] * x0[1]) + (x0[2] * x0[2] + x0[3] * x0[3]) + (x1[0] * x1[0] + x1[1] * x1[1]) + (x1[2] * x1[2] + x1[3] * x1[3]); } }
#pragma unroll
        for (int ai = 0; ai < 2; ++ai)
#pragma unroll
            for (int m = 0; m < 4; ++m) { float a = ss[ai][m]; a += __shfl_xor(a, 16); a += __shfl_xor(a, 32); if (fq == 0) T1[(ai * HALF + wr * 64 + m * 16 + fr) * 4 + wc] = a; }
        asm volatile("s_waitcnt lgkmcnt(0)" ::: "memory"); __builtin_amdgcn_s_barrier(); asm volatile("" ::: "memory");
        if (t < 256) { const f32x4 p = *(const LAS f32x4*)(T1 + t * 4); PS[(unsigned)(u.pm * BM + t) * 4u + (unsigned)u.pn] = (p[0] + p[1]) + (p[2] + p[3]); }
        asm volatile("s_waitcnt vmcnt(0)" ::: "memory"); __builtin_amdgcn_s_barrier(); asm volatile("" ::: "memory");
        if (t == 0) {
            if (need_release) { __builtin_amdgcn_fence(__ATOMIC_RELEASE, "agent"); asm volatile("s_waitcnt vmcnt(0)" ::: "memory"); }
            const unsigned old = xb_add(cnt + 64 * u.pm, 1u);
            if (old + 1u < 4u) XB_SPIN(xb_ld(cnt + 64 * u.pm) < 4u, tmo - XB_TMO);
            __builtin_amdgcn_fence(__ATOMIC_ACQUIRE, "agent");
            asm volatile("s_waitcnt vmcnt(0)" ::: "memory");
        }
        asm volatile("s_waitcnt vmcnt(0) lgkmcnt(0)" ::: "memory"); __builtin_amdgcn_s_barrier(); asm volatile("" ::: "memory");
        if (t < 256) { const f32x4 q = *(const GAS f32x4*)(PS + (unsigned)(u.pm * BM + t) * 4u); T2[t] = rsq_f(((q[0] + q[1]) + (q[2] + q[3])) * (1.0f / D) + EPS); }
        asm volatile("s_waitcnt vmcnt(0) lgkmcnt(0)" ::: "memory"); __builtin_amdgcn_s_barrier(); asm volatile("" ::: "memory");
#pragma unroll
        for (int bj = 0; bj < 2; ++bj) { const f32x4 f0 = *(const GAS f32x4*)(gf + col0 + bj * HALF), f1 = *(const GAS f32x4*)(gf + col0 + bj * HALF + 4);
#pragma unroll
            for (int ai = 0; ai < 2; ++ai)
#pragma unroll
                for (int m = 0; m < 4; ++m) { const float rs = T2[ai * HALF + wr * 64 + m * 16 + fr]; GAS float* yp = Y + ((unsigned)(row0 + ai * HALF + m * 16) * (unsigned)D + (unsigned)(col0 + bj * HALF));
                    *(GAS f32x4*)yp = acc[ai][bj][m][0] * rs * f0; *(GAS f32x4*)(yp + 4) = acc[ai][bj][m][1] * rs * f1; } }
    }
};

constexpr size_t MiB = 1u << 20;
constexpr size_t WS_CTL = 0, CTL_BYTES = 32 * 1024;
constexpr int CW_BAR = CW_BAR_WORDS;
constexpr size_t WS_TAB = 2 * MiB;
constexpr size_t TAB_GSA = WS_TAB, TAB_GSB = TAB_GSA + 4 * 5 * 1024 * 4, TAB_SWA = TAB_GSB + 4 * 5 * 1024 * 4, TAB_SWB = TAB_SWA + 4 * 5 * 4096 * 4, TAB_LAMT = TAB_SWB + 4 * 5 * 4096 * 4;
static_assert(TAB_LAMT + 2 * 64 * 2 * 64 * 2 * 4 <= 4 * MiB, "tables");
constexpr size_t WS_W1 = 4 * MiB, WS_W2 = 36 * MiB, WS_SWIN = 68 * MiB, WS_SWOUT = 72 * MiB, WS_GWIN = 80 * MiB, WS_GWOUT = 88 * MiB, WS_GWS = 92 * MiB,
                 WS_CWIN = 93 * MiB, WS_CWOUT = 99 * MiB, WS_BTY = 101 * MiB, WS_BTS = 133 * MiB;
constexpr size_t WS_XN = 149 * MiB;
constexpr size_t WS_R = 173 * MiB;
constexpr size_t WS_R2 = 269 * MiB;
constexpr size_t WS_ROWSS = 317 * MiB;
constexpr size_t WS_VSTAT = 329 * MiB;
constexpr size_t WS_MODS = 335 * MiB;
constexpr size_t WS_X16 = 336 * MiB;
constexpr size_t WS_PS = 360 * MiB;
constexpr size_t WS_END = 361 * MiB;

constexpr int LDS_BYTES = 147456;
constexpr int MISC_OFF = STAGE_BYTES;

struct Args { const float* in[30]; float* out; unsigned char* ws; int ph_lo, ph_hi; int mode, pad; };

__device__ __forceinline__ unsigned pk2(float lo, float hi) { return f2bf(lo) | (f2bf(hi) << 16); }
__device__ __forceinline__ float wave_sum(float v) {
#pragma unroll
    for (int o = 1; o < 64; o <<= 1) v += __shfl_xor(v, o);
    return v;
}
template <int MAP> __device__ __forceinline__ int rowmap(int n) {
    if (MAP == 1) { const int half = n >> 10, c = n & 1023; return (c >> 7) * 256 + half * 128 + (c & 127); }
    return n;
}
template <int MAP> __device__ __forceinline__ void transpose_item(const GAS float* W, int K, int N, GAS bf16_t* WT, LAS float* scr, int item, int lane) {
    const int nblk = N / 32, kb = item / nblk, nb = item % nblk, k0 = 64 * kb, n0 = 32 * nb;
    float wv[32];
#pragma unroll
    for (int i = 0; i < 32; ++i) wv[i] = __builtin_nontemporal_load(W + (size_t)(k0 + 2 * i + (lane >> 5)) * N + n0 + (lane & 31));
#pragma unroll
    for (int i = 0; i < 32; ++i) scr[(2 * i + (lane >> 5)) * 33 + (lane & 31)] = wv[i];
    asm volatile("s_waitcnt lgkmcnt(0)" ::: "memory");
    const int c = lane & 7;
#pragma unroll
    for (int j = 0; j < 4; ++j) { const int n = (lane >> 3) + 8 * j; const LAS float* s = scr + (8 * c) * 33 + n;
        u32x4 o; o.x = pk2(s[0 * 33], s[1 * 33]); o.y = pk2(s[2 * 33], s[3 * 33]); o.z = pk2(s[4 * 33], s[5 * 33]); o.w = pk2(s[6 * 33], s[7 * 33]);
        *(GAS u32x4*)(WT + (size_t)rowmap<MAP>(n0 + n) * K + k0 + 8 * c) = o; }
    asm volatile("s_waitcnt lgkmcnt(0)" ::: "memory");
}

__device__ __forceinline__ void ssm_build(const Args& a, int j, int g, int part, LAS unsigned char* lds, GAS unsigned char* ws, int tid) {
#ifdef MK_RANGE
    const int PMODE = a.mode;
#else
    constexpr int PMODE = 0;
#endif
    constexpr int PS = 68, CS = 68, KS = 260;
    LAS float* PR = (LAS float*)lds;
    LAS float* PI = PR + 2 * 17 * PS;
    LAS float* BR = PI + 2 * 17 * PS;
    LAS float* BI = BR + 2 * 64 * 16;
    LAS float* CR = BI + 2 * 64 * 16;
    LAS float* CI = CR + 2 * 16 * CS;
    LAS float* WR = CI + 2 * 16 * CS;
    LAS float* WI = WR + 2 * 64 * 16;
    LAS float* KT = WI + 2 * 64 * 16;
    const GAS float* lam_re = inp(lds, 13); const GAS float* lam_im = inp(lds, 14); const GAS float* log_dt = inp(lds, 15);
    const GAS float* b_re = inp(lds, 16); const GAS float* b_im = inp(lds, 17); const GAS float* c_re = inp(lds, 18); const GAS float* c_im = inp(lds, 19); const GAS float* dsk = inp(lds, 20);
    __syncthreads();
    LAS float* FR = WR; LAS float* FI = WR + 128; LAS float* DSK = WR + 256;
    if (tid >= 128 && tid < 144) DSK[tid - 128] = dsk[j * 1024 + g * 16 + tid - 128];
    if (tid < 128) {
        const int k = tid >> 6, n = tid & 63, pidx = (j * 2 + k) * 64 + g;
        const float dt = expf(log_dt[pidx]);
        const float lr = lam_re[pidx * 64 + n], li = lam_im[pidx * 64 + n];
        const float mag = expf(lr * dt); float sn, cs; sincosf(li * dt, &sn, &cs); const float abr = mag * cs, abi = mag * sn;
        const float den = lr * lr + li * li;
        const float nr = (abr - 1.0f) * lr + abi * li, ni = -(abr - 1.0f) * li + abi * lr;
        FR[tid] = nr / den; FI[tid] = ni / den;
    }
#pragma unroll 1
    for (int i = tid; i < 2 * 17 * 64; i += 512) {
        const int k = i / (17 * 64), e = (i >> 6) % 17, n = i & 63, pidx = (j * 2 + k) * 64 + g;
        const float dt = expf(log_dt[pidx]); const float lr = lam_re[pidx * 64 + n], li = lam_im[pidx * 64 + n];
        const float mag = expf((float)e * lr * dt); float sn, cs; sincosf((float)e * (li * dt), &sn, &cs); PR[(i >> 6) * PS + n] = mag * cs; PI[(i >> 6) * PS + n] = mag * sn; }
    for (int i = tid; i < 2048; i += 512) { const int k = i >> 10, po = (i >> 6) & 15, n = i & 63; const size_t o = ((size_t)(j * 2 + k) * 64 + g) * 1024 + (i & 1023);
        if (part == 2) { CR[(k * 16 + po) * CS + n] = c_re[o]; CI[(k * 16 + po) * CS + n] = c_im[o]; }
        else { CR[(k * 64 + n) * 16 + po] = c_re[o]; CI[(k * 64 + n) * 16 + po] = c_im[o]; } }
    __syncthreads();
    for (int i = tid; i < 2048; i += 512) { const int kn = i >> 4; const size_t o = ((size_t)(j * 2 + (kn >> 6)) * 64 + g) * 1024 + (i & 1023);
        const float br = b_re[o], bi = b_im[o], fr = FR[kn], fi = FI[kn]; BR[i] = fr * br - fi * bi; BI[i] = fr * bi + fi * br; }
    if (part == 1 && tid < 128) { const int k = tid >> 6, n = tid & 63; GAS float* lamT = (GAS float*)(ws + TAB_LAMT) + (((size_t)j * 64 + g) * 2 + k) * 128;
        lamT[2 * n] = PR[(k * 17 + 16) * PS + n]; lamT[2 * n + 1] = PI[(k * 17 + 16) * PS + n]; }
    __syncthreads();
    if (part == 0 && PMODE != 6) {
        const int pi4 = tid & 3, po4 = (tid >> 2) & 3, k = (tid >> 4) & 1, nh = (tid >> 5) & 1, e8 = tid >> 6;
        float acc[2][4][4];
#pragma unroll
        for (int h = 0; h < 2; ++h)
#pragma unroll
            for (int x = 0; x < 4; ++x)
#pragma unroll
                for (int y = 0; y < 4; ++y) acc[h][x][y] = 0.f;
#pragma unroll 2
        for (int nn = 0; nn < 32; ++nn) { const int n = nh * 32 + nn;
            const f32x4 br = *(const LAS f32x4*)(BR + (k * 64 + n) * 16 + 4 * pi4), bi = *(const LAS f32x4*)(BI + (k * 64 + n) * 16 + 4 * pi4);
            const f32x4 cr = *(const LAS f32x4*)(CR + (k * 64 + n) * 16 + 4 * po4), ci = *(const LAS f32x4*)(CI + (k * 64 + n) * 16 + 4 * po4);
#pragma unroll
            for (int h = 0; h < 2; ++h) { const int e = e8 + 8 * h;
                const float pr = PR[(k * 17 + e) * PS + n], pim = PI[(k * 17 + e) * PS + n];
                const f32x4 wr = br * pr - bi * pim, wi = bi * pr + br * pim;
#pragma unroll
                for (int x = 0; x < 4; ++x)
#pragma unroll
                    for (int y = 0; y < 4; ++y) acc[h][x][y] += cr[x] * wr[y] - ci[x] * wi[y]; }
        }
#pragma unroll
        for (int h = 0; h < 2; ++h)
#pragma unroll
            for (int x = 0; x < 4; ++x)
#pragma unroll
                for (int y = 0; y < 4; ++y) acc[h][x][y] += __shfl_xor(acc[h][x][y], 32);
        const int e = e8 + 8 * nh;
#pragma unroll
        for (int x = 0; x < 4; ++x) *(LAS f32x4*)(KT + (k * 16 + e) * KS + (4 * po4 + x) * 16 + 4 * pi4) =
            (f32x4){nh ? acc[1][x][0] : acc[0][x][0], nh ? acc[1][x][1] : acc[0][x][1], nh ? acc[1][x][2] : acc[0][x][2], nh ? acc[1][x][3] : acc[0][x][3]};
    }
    __syncthreads();
    GAS bf16_t* BtY = (GAS bf16_t*)(ws + WS_BTY) + ((size_t)j * 64 + g) * 256 * 512;
    GAS bf16_t* BtS = (GAS bf16_t*)(ws + WS_BTS) + ((size_t)j * 64 + g) * 256 * 256;
    if (part != 1) {
    if (PMODE != 7 && part == 0)
#pragma unroll 1
    for (int pc = tid; pc < 256 * 32; pc += 512) {
        const int row = pc >> 5, kc = (pc & 31) * 8, t = row >> 4, po = row & 15, s = kc >> 4, pi0 = kc & 15;
        float v[8];
        { const f32x4 z4 = (f32x4){0.f, 0.f, 0.f, 0.f}; f32x4 a0 = z4, a1 = z4, b0 = z4, b1 = z4;
          if (s <= t) { const LAS f32x4* p = (const LAS f32x4*)(KT + (0 * 16 + (t - s)) * KS + po * 16 + pi0); a0 = p[0]; a1 = p[1]; }
          if (s >= t) { const LAS f32x4* p = (const LAS f32x4*)(KT + (1 * 16 + (s - t)) * KS + po * 16 + pi0); b0 = p[0]; b1 = p[1]; }
          const float dk = (s == t) ? DSK[po] : 0.f;
#pragma unroll
          for (int q = 0; q < 4; ++q) { v[q] = a0[q] + b0[q] + ((pi0 + q == po) ? dk : 0.f); v[4 + q] = a1[q] + b1[q] + ((pi0 + 4 + q == po) ? dk : 0.f); } }
        u32x4 o; o.x = pk2(v[0], v[1]); o.y = pk2(v[2], v[3]); o.z = pk2(v[4], v[5]); o.w = pk2(v[6], v[7]);
        *(GAS u32x4*)(BtY + (size_t)row * 512 + kc) = o;
    }
    if (PMODE != 8 && part == 2)
#pragma unroll 1
    for (int pc = tid; pc < 256 * 32; pc += 512) {
        const int row = pc >> 5, kc = (pc & 31) * 8, t = row >> 4, po = row & 15, k = kc >> 7, ri = (kc >> 6) & 1, n0 = kc & 63;
        const int e = k == 0 ? t + 1 : 16 - t;
        float v[8];
        { const LAS f32x4* pc_ = (const LAS f32x4*)(CR + (k * 16 + po) * CS + n0); const LAS f32x4* pi_ = (const LAS f32x4*)(CI + (k * 16 + po) * CS + n0);
          const LAS f32x4* pp_ = (const LAS f32x4*)(PR + (k * 17 + e) * PS + n0); const LAS f32x4* pq_ = (const LAS f32x4*)(PI + (k * 17 + e) * PS + n0);
#pragma unroll
          for (int h = 0; h < 2; ++h) { const f32x4 cr = pc_[h], cim = pi_[h], pr = pp_[h], pim = pq_[h];
#pragma unroll
              for (int q = 0; q < 4; ++q) v[4 * h + q] = ri == 0 ? (cr[q] * pr[q] - cim[q] * pim[q]) : -(cr[q] * pim[q] + cim[q] * pr[q]); } }
        u32x4 o; o.x = pk2(v[0], v[1]); o.y = pk2(v[2], v[3]); o.z = pk2(v[4], v[5]); o.w = pk2(v[6], v[7]);
        *(GAS u32x4*)(BtY + (size_t)row * 512 + 256 + kc) = o;
    }
    } else {
    for (int pc = tid; pc < 256 * 32; pc += 512) {
        const int row = pc >> 5, kc = (pc & 31) * 8, k = row >> 7, ri = (row >> 6) & 1, n = row & 63, s = kc >> 4, pi0 = kc & 15;
        const int e = k == 0 ? 15 - s : s;
        const float pr = PR[(k * 17 + e) * PS + n], pim = PI[(k * 17 + e) * PS + n];
        float v[8];
#pragma unroll
        for (int h = 0; h < 2; ++h) { const f32x4 br = ((const LAS f32x4*)(BR + (k * 64 + n) * 16 + pi0))[h], bi = ((const LAS f32x4*)(BI + (k * 64 + n) * 16 + pi0))[h];
#pragma unroll
            for (int q = 0; q < 4; ++q) v[4 * h + q] = ri == 0 ? (pr * br[q] - pim * bi[q]) : (pr * bi[q] + pim * br[q]); }
        u32x4 o; o.x = pk2(v[0], v[1]); o.y = pk2(v[2], v[3]); o.z = pk2(v[4], v[5]); o.w = pk2(v[6], v[7]);
        *(GAS u32x4*)(BtS + (size_t)row * 256 + kc) = o;
    }
    }
    __syncthreads();
}

template <class VEC> __device__ __forceinline__ void gemv5_task(const VEC& vec, const GAS float* W, int ldw, int c0, const GAS float* bias, GAS float* out, int old_, LAS unsigned char* lds, int tid) {
    const int wave = tid >> 6, lane = tid & 63, half = lane >> 5, c4 = lane & 31;
    LAS float* tab = (LAS float*)lds;
    LAS float* red = tab + 5 * 1024;
    __syncthreads();
    for (int i = tid; i < 5 * 1024; i += 512) tab[i] = vec(i >> 10, i & 1023);
    __syncthreads();
    const GAS float* w = W + (size_t)(wave * 128 + half) * ldw + c0 + c4 * 4;
    f32x4 acc[5];
#pragma unroll
    for (int ci = 0; ci < 5; ++ci) acc[ci] = (f32x4){0.f, 0.f, 0.f, 0.f};
#pragma unroll 1
    for (int b = 0; b < 2; ++b) {
        f32x4 wv[32];
#pragma unroll
        for (int i = 0; i < 32; ++i) wv[i] = __builtin_nontemporal_load((const GAS f32x4*)(w + (size_t)(b * 64 + 2 * i) * ldw));
#pragma unroll
        for (int i = 0; i < 32; ++i) { const int k = wave * 128 + b * 64 + 2 * i + half;
#pragma unroll
            for (int ci = 0; ci < 5; ++ci) acc[ci] += wv[i] * tab[ci * 1024 + k]; }
    }
#pragma unroll
    for (int ci = 0; ci < 5; ++ci) {
#pragma unroll
        for (int q = 0; q < 4; ++q) acc[ci][q] += __shfl_xor(acc[ci][q], 32);
        if (half == 0) *(LAS f32x4*)(red + (wave * 5 + ci) * 128 + c4 * 4) = acc[ci]; }
    __syncthreads();
    for (int i = tid; i < 5 * 128; i += 512) { const int ci = i >> 7, cc = i & 127; float t = 0.f;
#pragma unroll
        for (int wv2 = 0; wv2 < 8; ++wv2) t += red[(wv2 * 5 + ci) * 128 + cc];
        out[(size_t)ci * old_ + c0 + cc] = t + (bias ? bias[c0 + cc] : 0.f); }
}
struct VecSilu { const GAS float* c; const GAS float* c_ctx; __device__ __forceinline__ float operator()(int ci, int k) const { const float v = ci == 0 ? c_ctx[k] : c[(ci - 1) * 1024 + k]; return v / (1.0f + expf(-v)); } };
struct VecShift { const GAS float* sh; __device__ __forceinline__ float operator()(int ci, int k) const { return sh[(size_t)ci * 6144 + k]; } };
__device__ __forceinline__ void mods_task(const Args& a, GAS float* mods, LAS unsigned char* lds, int task, int tid) {
    const int cg = task % 48, l = task / 48;
    gemv5_task(VecSilu{inp(lds, 4), inp(lds, 5)}, inp(lds, 6) + (size_t)l * 1024 * 6144, 6144, cg * 128, inp(lds, 7) + l * 6144, mods + (size_t)l * 5 * 6144, 6144, lds, tid);
}

template <class VEC> __device__ __forceinline__ void gemv5_task32(const VEC& vec, const GAS float* W, int ldw, int c0, const GAS float* bias, GAS float* out, int old_, LAS unsigned char* lds, int tid) {
    const int wave = tid >> 6, lane = tid & 63, rs = lane >> 3, c4 = lane & 7;
    LAS float* tab = (LAS float*)lds;
    LAS float* red = tab + 5 * 1024;
    __syncthreads();
    const GAS float* w = W + (size_t)(wave * 128 + rs) * ldw + c0 + c4 * 4;
    f32x4 wv[16];
#pragma unroll
    for (int i = 0; i < 16; ++i) wv[i] = __builtin_nontemporal_load((const GAS f32x4*)(w + (size_t)(8 * i) * ldw));
    for (int i = tid; i < 5 * 1024; i += 512) tab[i] = vec(i >> 10, i & 1023);
    __syncthreads();
    f32x4 acc[5];
#pragma unroll
    for (int ci = 0; ci < 5; ++ci) acc[ci] = (f32x4){0.f, 0.f, 0.f, 0.f};
#pragma unroll
    for (int i = 0; i < 16; ++i) { const int k = wave * 128 + 8 * i + rs;
#pragma unroll
        for (int ci = 0; ci < 5; ++ci) acc[ci] += wv[i] * tab[ci * 1024 + k]; }
#pragma unroll
    for (int ci = 0; ci < 5; ++ci) {
#pragma unroll
        for (int q = 0; q < 4; ++q) { float t = acc[ci][q]; t += __shfl_xor(t, 8); t += __shfl_xor(t, 16); t += __shfl_xor(t, 32); acc[ci][q] = t; }
        if (rs == 0) *(LAS f32x4*)(red + (wave * 5 + ci) * 32 + c4 * 4) = acc[ci]; }
    __syncthreads();
    for (int i = tid; i < 5 * 32; i += 512) { const int ci = i >> 5, cc = i & 31; float t = 0.f;
#pragma unroll
        for (int wv2 = 0; wv2 < 8; ++wv2) t += red[(wv2 * 5 + ci) * 32 + cc];
        out[(size_t)ci * old_ + c0 + cc] = t + (bias ? bias[c0 + cc] : 0.f); }
}
__device__ __forceinline__ void mods_task32(const Args& a, GAS float* mods, LAS unsigned char* lds, int l, int cg32, int tid) {
    gemv5_task32(VecSilu{inp(lds, 4), inp(lds, 5)}, inp(lds, 6) + (size_t)l * 1024 * 6144, 6144, cg32 * 32, inp(lds, 7) + l * 6144, mods + (size_t)l * 5 * 6144, 6144, lds, tid);
}
__device__ __forceinline__ void xinit_row(const LAS unsigned char* lds, GAS h16_t* X, int row, int lane, f32x4 (&v)[4]) {
    GAS h16x4* o = (GAS h16x4*)(X + (size_t)row * D) + lane;
    if (row < MP) { const GAS f32x4* s = (const GAS f32x4*)(inp(lds, 0) + (size_t)row * D) + lane;
#pragma unroll
        for (int q = 0; q < 4; ++q) { v[q] = s[64 * q]; o[64 * q] = __builtin_convertvector(v[q], h16x4); }
        return; }
    const GAS f32x4* s = (const GAS f32x4*)(inp(lds, 1) + (size_t)(row - MP) * D) + lane;
    const int t = (row - MP) & 1023; const float rr = (float)(t >> 6), cc = (float)(t & 63);
    float freq[4];
#pragma unroll
    for (int e = 0; e < 4; ++e) freq[e] = expf(-(float)(4 * lane + e) * (9.210340371976184f / 256.0f));
#pragma unroll
    for (int q = 0; q < 4; ++q) v[q] = s[64 * q];
#pragma unroll
    for (int e = 0; e < 4; ++e) { float sr, cr, sc, cc2; sincosf(rr * freq[e], &sr, &cr); sincosf(cc * freq[e], &sc, &cc2); v[0][e] += sr; v[1][e] += cr; v[2][e] += sc; v[3][e] += cc2; }
#pragma unroll
    for (int q = 0; q < 4; ++q) o[64 * q] = __builtin_convertvector(v[q], h16x4);
}


__device__ __forceinline__ void xn0_rows2(const LAS unsigned char* lds, GAS h16_t* X, GAS bf16_t* XN, GAS float* rowss, const GAS float* mods, int r0, int r1, int lane) {
    const GAS float* gm = inp(lds, 8);
    f32x4 v[2][4];
#pragma unroll
    for (int rr = 0; rr < 2; ++rr) { const int row = rr == 0 ? r0 : (r1 < 0 ? r0 : r1);
        const GAS f32x4* sp = (const GAS f32x4*)(row < MP ? inp(lds, 0) + (size_t)row * D : inp(lds, 1) + (size_t)(row - MP) * D) + lane;
#pragma unroll
        for (int q = 0; q < 4; ++q) v[rr][q] = __builtin_nontemporal_load(sp + 64 * q); }
#pragma unroll
    for (int rr = 0; rr < 2; ++rr) { const int row = rr == 0 ? r0 : r1; if (row < 0) continue;
        if (row >= MP) { const int t = (row - MP) & 1023; const float rp = (float)(t >> 6), cp = (float)(t & 63);
#pragma unroll
            for (int e = 0; e < 4; ++e) { const float fq_ = expf(-(float)(4 * lane + e) * (9.210340371976184f / 256.0f)); float sr, cr, sc, cc2; sincosf(rp * fq_, &sr, &cr); sincosf(cp * fq_, &sc, &cc2);
                v[rr][0][e] += sr; v[rr][1][e] += cr; v[rr][2][e] += sc; v[rr][3][e] += cc2; } }
        GAS h16x4* xo = (GAS h16x4*)(X + (size_t)row * D) + lane;
        float tt = 0.f;
#pragma unroll
        for (int q = 0; q < 4; ++q) { xo[64 * q] = __builtin_convertvector(v[rr][q], h16x4); tt += (v[rr][q][0] * v[rr][q][0] + v[rr][q][1] * v[rr][q][1]) + (v[rr][q][2] * v[rr][q][2] + v[rr][q][3] * v[rr][q][3]); }
        tt = wave_sum(tt);
        if (lane < 32) rowss[(size_t)row * 32 + lane] = lane == 0 ? tt : 0.f;
        const GAS float* md = mods + (size_t)cond_of_row(row) * 6144;
        GAS u32x2* o = (GAS u32x2*)(XN + (size_t)row * D) + lane;
#pragma unroll
        for (int q = 0; q < 4; ++q) { const int c = 256 * q + 4 * lane; const f32x4 gg = *(const GAS f32x4*)(gm + c), sc = *(const GAS f32x4*)(md + 1024 + c);
            const f32x4 y = v[rr][q] * gg * (sc + 1.0f); u32x2 w; w.x = cvt_pk_bf16(y[0], y[1]); w.y = cvt_pk_bf16(y[2], y[3]); o[64 * q] = w; }
    }
}

__device__ __forceinline__ void sw_job(const GAS float* mods, int l, int sidx, const GAS bf16_t* WT, int N, GAS float* dst, int dld, int wv, int nw, int lane) {
    float sh[5][16];
#pragma unroll
    for (int ci = 0; ci < 5; ++ci) { const GAS float* sp = mods + ((size_t)l * 5 + ci) * 6144 + sidx * 1024 + lane * 16;
#pragma unroll
        for (int q = 0; q < 4; ++q) { const f32x4 v = *(const GAS f32x4*)(sp + 4 * q); sh[ci][4 * q] = v[0]; sh[ci][4 * q + 1] = v[1]; sh[ci][4 * q + 2] = v[2]; sh[ci][4 * q + 3] = v[3]; } }
    for (int r = wv * 8; r < N; r += nw * 8) {
        u32x4 w0[8], w1[8];
#pragma unroll
        for (int nn = 0; nn < 8; ++nn) { w0[nn] = *(const GAS u32x4*)(WT + (size_t)(r + nn) * D + lane * 16); w1[nn] = *(const GAS u32x4*)(WT + (size_t)(r + nn) * D + lane * 16 + 8); }
#pragma unroll
        for (int nn = 0; nn < 8; ++nn) {
            const float wf[16] = {bf_lo(w0[nn].x), bf_hi(w0[nn].x), bf_lo(w0[nn].y), bf_hi(w0[nn].y), bf_lo(w0[nn].z), bf_hi(w0[nn].z), bf_lo(w0[nn].w), bf_hi(w0[nn].w),
                                  bf_lo(w1[nn].x), bf_hi(w1[nn].x), bf_lo(w1[nn].y), bf_hi(w1[nn].y), bf_lo(w1[nn].z), bf_hi(w1[nn].z), bf_lo(w1[nn].w), bf_hi(w1[nn].w)};
#pragma unroll
            for (int ci = 0; ci < 5; ++ci) { float t = 0.f;
#pragma unroll
                for (int q = 0; q < 16; ++q) t += wf[q] * sh[ci][q];
                t = wave_sum(t);
                if (lane == 0) dst[ci * dld + r + nn] = t; }
        }
    }
}
__device__ __forceinline__ void sw_mix_job(GAS unsigned char* ws, const GAS float* mods, int l, int wv, int nw, int lane) {
    GAS float* swA = (GAS float*)(ws + TAB_SWA);
    if (l == 0) sw_job(mods, 0, 0, (const GAS bf16_t*)(ws + WS_SWIN), 1024, swA, 1024, wv, nw, lane);
    else if (l == 1) sw_job(mods, 1, 0, (const GAS bf16_t*)(ws + WS_GWIN), 4096, swA + 1 * 5 * 4096, 4096, wv, nw, lane);
    else if (l == 2) sw_job(mods, 2, 0, (const GAS bf16_t*)(ws + WS_CWIN), 3072, swA + 2 * 5 * 4096, 3072, wv, nw, lane);
    else sw_job(mods, 3, 0, (const GAS bf16_t*)(ws + WS_SWIN) + (size_t)D * D, 1024, swA + 3 * 5 * 4096, 1024, wv, nw, lane);
}
__device__ __forceinline__ void sw_ffn_job(GAS unsigned char* ws, const GAS float* mods, int l, int wv, int nw, int lane) {
    sw_job(mods, l, 3, (const GAS bf16_t*)(ws + WS_W1) + (size_t)l * D * FF, 4096, (GAS float*)(ws + TAB_SWB) + l * 5 * 4096, 4096, wv, nw, lane);
}


constexpr int I_W1 = 2048, I_W2 = 2048, I_SI = 512, I_SO = 1024, I_GI = 2048, I_GO = 1024, I_CI = 1536, I_CO = 512;
constexpr int IT_W1 = 0, IT_W2 = 4 * I_W1, IT_SI = IT_W2 + 4 * I_W2, IT_SO = IT_SI + 2 * I_SI, IT_GI = IT_SO + 2 * I_SO, IT_GO = IT_GI + I_GI, IT_CI = IT_GO + I_GO, IT_CO = IT_CI + I_CI, IT_END = IT_CO + I_CO;
struct CvItem { const GAS float* W; GAS bf16_t* WT; int K, N, item, map; };
__device__ __forceinline__ CvItem cv_decode(const LAS unsigned char* lds, GAS unsigned char* ws, int it) {
    CvItem c; int r = it; c.map = 0;
    if (r < IT_W2) { const int l = r / I_W1; c.W = inp(lds, 10) + (size_t)l * D * FF; c.K = D; c.N = FF; c.WT = (GAS bf16_t*)(ws + WS_W1) + (size_t)l * D * FF; c.item = r % I_W1; return c; } r -= IT_W2;
    if (r < 4 * I_W2) { const int l = r / I_W2; c.W = inp(lds, 11) + (size_t)l * D * FF; c.K = FF; c.N = D; c.WT = (GAS bf16_t*)(ws + WS_W2) + (size_t)l * D * FF; c.item = r % I_W2; return c; } r -= 4 * I_W2;
    if (r < 2 * I_SI) { const int l = r / I_SI; c.W = inp(lds, 12) + (size_t)l * D * D; c.K = D; c.N = D; c.WT = (GAS bf16_t*)(ws + WS_SWIN) + (size_t)l * D * D; c.item = r % I_SI; return c; } r -= 2 * I_SI;
    if (r < 2 * I_SO) { const int l = r / I_SO; c.W = inp(lds, 21) + (size_t)l * D * 2048; c.K = D; c.N = 2048; c.WT = (GAS bf16_t*)(ws + WS_SWOUT) + (size_t)l * D * 2048; c.item = r % I_SO; c.map = 1; return c; } r -= 2 * I_SO;
    if (r < I_GI) { c.W = inp(lds, 22); c.K = D; c.N = 4096; c.WT = (GAS bf16_t*)(ws + WS_GWIN); c.item = r; return c; } r -= I_GI;
    if (r < I_GO) { c.W = inp(lds, 25); c.K = 2048; c.N = D; c.WT = (GAS bf16_t*)(ws + WS_GWOUT); c.item = r; return c; } r -= I_GO;
    if (r < I_CI) { c.W = inp(lds, 26); c.K = D; c.N = 3072; c.WT = (GAS bf16_t*)(ws + WS_CWIN); c.item = r; return c; } r -= I_CI;
    c.W = inp(lds, 28); c.K = D; c.N = D; c.WT = (GAS bf16_t*)(ws + WS_CWOUT); c.item = r; return c;
}
__device__ __forceinline__ void cv_load(const CvItem& c, int lane, float (&wv)[32]) {
    const int nblk = c.N >> 5, kb = c.item / nblk, nb = c.item - kb * nblk, k0 = 64 * kb, n0 = 32 * nb;
    const GAS float* p = c.W + (size_t)(k0 + (lane >> 5)) * c.N + n0 + (lane & 31);
#pragma unroll
    for (int i = 0; i < 32; ++i) wv[i] = __builtin_nontemporal_load(p + (size_t)(2 * i) * c.N);
}
__device__ __forceinline__ void cv_store(const CvItem& c, LAS float* scr, int lane, const float (&wv)[32]) {
    const int nblk = c.N >> 5, kb = c.item / nblk, nb = c.item - kb * nblk, k0 = 64 * kb, n0 = 32 * nb;
#pragma unroll
    for (int i = 0; i < 32; ++i) scr[(2 * i + (lane >> 5)) * 33 + (lane & 31)] = wv[i];
    asm volatile("s_waitcnt lgkmcnt(0)" ::: "memory");
    const int cc = lane & 7;
#pragma unroll
    for (int j = 0; j < 4; ++j) { const int n = (lane >> 3) + 8 * j; const LAS float* s_ = scr + (8 * cc) * 33 + n;
        u32x4 o; o.x = pk2(s_[0 * 33], s_[1 * 33]); o.y = pk2(s_[2 * 33], s_[3 * 33]); o.z = pk2(s_[4 * 33], s_[5 * 33]); o.w = pk2(s_[6 * 33], s_[7 * 33]);
        const int nn = n0 + n, ro = c.map ? rowmap<1>(nn) : nn;
        *(GAS u32x4*)(c.WT + (size_t)ro * c.K + k0 + 8 * cc) = o; }
    asm volatile("s_waitcnt lgkmcnt(0)" ::: "memory");
}
template <class IDX> __device__ __forceinline__ void convert_seq(const LAS unsigned char* lds, GAS unsigned char* ws, LAS float* scr, int n, const IDX& idx, int lane) {
    if (n <= 0) return;
    CvItem cur = cv_decode(lds, ws, idx(0)); float a[32]; cv_load(cur, lane, a);
#pragma unroll 1
    for (int i = 0; i < n; ++i) {
        const bool more = i + 1 < n; CvItem nxt = cur; float b[32];
#pragma unroll
        for (int q = 0; q < 32; ++q) b[q] = 0.f;
        if (more) { nxt = cv_decode(lds, ws, idx(i + 1)); cv_load(nxt, lane, b); }
        cv_store(cur, scr, lane, a);
        cur = nxt;
#pragma unroll
        for (int q = 0; q < 32; ++q) a[q] = b[q];
    }
}
struct IdxStride { int first, step; __device__ __forceinline__ int operator()(int i) const { return first + i * step; } };
__device__ __forceinline__ void convert_items(const LAS unsigned char* lds, GAS unsigned char* ws, LAS float* scr, int first, int count, int wv, int nw, int lane) {
    const int n = (count - wv + nw - 1) / nw;
    convert_seq(lds, ws, scr, wv < count ? n : 0, IdxStride{first + wv, nw}, lane);
}
constexpr int NPH = 28;
#ifdef MK_RANGE
#define GMODE(g) g.mode = args.mode
#else
#define GMODE(g)
#endif
#ifndef MK_ALLCG
#define MK_ALLCG 0
#endif
#ifndef MK_NOLOCAL
#define MK_NOLOCAL 0
#endif

__global__ void __launch_bounds__(512, 2) fwd(Args args) {
    extern __shared__ __attribute__((aligned(16))) unsigned char lds_raw[];
    LAS unsigned char* lds_k = (LAS unsigned char*)lds_raw;
    volatile LAS unsigned* MISC = (volatile LAS unsigned*)(lds_k + MISC_OFF);
    const int tid = threadIdx.x, lane = tid & 63, wave = __builtin_amdgcn_readfirstlane(tid >> 6);
    const int G = gridDim.x, bx = blockIdx.x;
    GAS unsigned* ctl = (GAS unsigned*)((GAS unsigned char*)args.ws + WS_CTL);
    for (int u = tid; u < 64; u += 512) MISC[u] = 0u;
    if (tid == 0) { LAS unsigned long long* pt = (LAS unsigned long long*)(lds_k + PTR_OFF);
#pragma unroll
        for (int k = 0; k < 30; ++k) pt[k] = (unsigned long long)args.in[k];
        pt[30] = (unsigned long long)args.out; pt[31] = (unsigned long long)args.ws; }
    __syncthreads();
    (void)xcd_barrier_post(ctl + CW_BAR, MISC + 8);
#ifdef MK_RANGE
    const int lo = args.ph_lo, hi = args.ph_hi;
#else
    constexpr int lo = 0, hi = 22;
#endif
    int ph = 0;
#define IN_PH (lo <= ph && ph < hi)
#define SEAM_GLOBAL(p) ((p) <= 3 || (p) == 6 || (p) == 11 || (p) == 16 || (p) == 17 || (p) == 18)
#define SEAM() do { if (IN_PH && ph + 1 < hi) { if (MK_ALLCG || args.mode == 0x7fffffff) cg::this_grid().sync();     \
        else { LAS unsigned char* lds_s_ = lds_k; asm volatile("" : "+s"(lds_s_)); XcdBarrier b_; b_.bar = (GAS unsigned*)((GAS unsigned char*)ldsptr(lds_s_, 31) + WS_CTL) + CW_BAR; b_.x = xb_xcc_id(); b_.st = (volatile LAS unsigned*)(lds_s_ + MISC_OFF) + 8; \
        const bool ldr_ = wave == 0 && lane_id() == 0; if (SEAM_GLOBAL(ph) || MK_NOLOCAL || b_.st[4] == 0u) xcd_barrier(b_, ldr_); else xcc_barrier(b_, ldr_); } } ++ph; } while (0)

#define PH_PTRS() LAS unsigned char* lds = lds_k; asm volatile("" : "+s"(lds)); GAS unsigned char* ws = (GAS unsigned char*)ldsptr(lds, 31); asm volatile("" : "+s"(ws)); \
    int tid_o_ = wave * 64 + lane_id(); asm volatile("" : "+v"(tid_o_)); const int tid = tid_o_, lane = tid_o_ & 63; (void)tid; (void)lane; \
    const int vcu = (G % 8 == 0) ? (bx % 8) * (G / 8) + bx / 8 : bx, gw = vcu * 8 + wave, NGW = G * 8; (void)vcu; (void)gw; (void)NGW; \
    const int o_mode = __builtin_amdgcn_readfirstlane((int)((volatile LAS unsigned*)(lds + MISC_OFF))[12]); \
    const int o_vx = o_mode ? __builtin_amdgcn_readfirstlane((int)((volatile LAS unsigned*)(lds + MISC_OFF))[11]) : (bx & 7), o_rank = o_mode ? __builtin_amdgcn_readfirstlane((int)((volatile LAS unsigned*)(lds + MISC_OFF))[10]) : (bx >> 3); (void)o_vx; (void)o_rank; \
    GAS h16_t* X = (GAS h16_t*)(ws + WS_X16); GAS bf16_t* XN = (GAS bf16_t*)(ws + WS_XN); GAS float* mods = (GAS float*)(ws + WS_MODS); \
    GAS float* gsA = (GAS float*)(ws + TAB_GSA); GAS float* gsB = (GAS float*)(ws + TAB_GSB); GAS float* swA = (GAS float*)(ws + TAB_SWA); GAS float* swB = (GAS float*)(ws + TAB_SWB); \
    GAS float* rowss = (GAS float*)(ws + WS_ROWSS); GAS float* vstat = (GAS float*)(ws + WS_VSTAT); \
    GAS bf16_t* Hb = (GAS bf16_t*)(ws + WS_R); GAS bf16_t* UgS = (GAS bf16_t*)(ws + WS_R); GAS float* Sloc = (GAS float*)(ws + WS_R + 48 * MiB); GAS bf16_t* Zg = (GAS bf16_t*)(ws + WS_R2); GAS bf16_t* A2 = (GAS bf16_t*)(ws + WS_R2); \
    (void)X; (void)XN; (void)mods; (void)gsA; (void)gsB; (void)swA; (void)swB; (void)rowss; (void)vstat; (void)Hb; (void)UgS; (void)Sloc; (void)Zg; (void)A2;
#define PH_LAYER() const GAS float* rs_mix = rowss + (size_t)(2 * layer) * M * 32; GAS float* rs_ffn = rowss + (size_t)(2 * layer + 1) * M * 32; GAS float* rs_next = rowss + (size_t)((2 * layer + 2) & 7) * M * 32; \
    const GAS float* modl = mods + (size_t)layer * 5 * 6144; (void)rs_mix; (void)rs_ffn; (void)rs_next; (void)modl;

#define SIDE_IDS() const int sidle = o_vx * 8 + o_rank - 24, swv = sidle * 8 + wave, snw = 512; (void)sidle; LAS float* scr = (LAS float*)(lds + wave * 16384); (void)scr; (void)swv; (void)snw
#ifdef MK_RANGE
#define PREB_NEXT(Bt_, ldb_, nN_) do { } while (0)
#define PREB_SET(g_) do { } while (0)
#else
#define PREB_NEXT(Bt_, ldb_, nN_) do { OwnerOrder Sn_{(nN_), o_vx, o_rank}; Unit un_; if (Sn_.next(0, un_)) stage_b0(lds, (const GAS char*)(Bt_) + (size_t)un_.pn * 256 * (ldb_) * 2, (ldb_), wave); } while (0)
#define PREB_SET(g_) (g_).preb = 1
#endif
    if (IN_PH) { PH_PTRS();
#ifdef MK_RANGE
        const int pm_ = args.mode;
#else
        constexpr int pm_ = 0;
#endif
        for (int t = bx; t < 192 + 48; t += G) { if (t < 192) mods_task32(args, mods, lds, 0, t, tid); else mods_task(args, mods, lds, 48 + (t - 192), tid); }
#ifndef MK_RANGE
        { XcdBarrier b_; b_.bar = (GAS unsigned*)(ws + WS_CTL) + CW_BAR; b_.x = xb_xcc_id(); b_.st = (volatile LAS unsigned*)(lds + MISC_OFF) + 8; xcd_split_arrive(b_, wave == 0 && lane_id() == 0); }
#endif
        __syncthreads();
        if (bx < 192) { if (pm_ != 2) ssm_build(args, 0, bx & 63, bx < 64 ? 0 : (bx < 128 ? 2 : 1), lds, ws, tid); }
        __syncthreads();
        {
            struct IdxP1 { int s0; __device__ __forceinline__ int operator()(int i) const { int r = s0 + i;
                if (r < I_W1) return IT_W1 + r; r -= I_W1; if (r < I_W2) return IT_W2 + r; r -= I_W2; if (r < I_SI) return IT_SI + r; return IT_SO + (r - I_SI); } };
            static_assert(64 * 8 * 7 + 64 * 8 * 2 + 128 * 8 == I_W1 + I_W2 + I_SI + I_SO, "P0 conversion deal");
            LAS float* scr = (LAS float*)(lds + wave * 16384);
            if (pm_ != 4) { if (bx >= 192) convert_seq(lds, ws, scr, 7, IdxP1{((bx - 192) * 8 + wave) * 7}, lane);
                else if (bx < 64) convert_seq(lds, ws, scr, 2, IdxP1{3584 + (bx * 8 + wave) * 2}, lane);
                else convert_seq(lds, ws, scr, 1, IdxP1{4608 + (bx - 64) * 8 + wave}, lane); }
        }
#ifndef MK_RANGE
        { XcdBarrier b_; b_.bar = (GAS unsigned*)(ws + WS_CTL) + CW_BAR; b_.x = xb_xcc_id(); b_.st = (volatile LAS unsigned*)(lds + MISC_OFF) + 8; xcd_split_wait(b_, wave == 0 && lane_id() == 0); }
#endif
    }
#ifdef MK_RANGE
    SEAM();
#else
    ++ph;
#endif
    if (IN_PH) { PH_PTRS();
        if (bx >= 192 && bx < 200) gemv5_task(VecShift{mods}, inp(lds, 12), 1024, (bx - 192) * 128, (const GAS float*)nullptr, swA, 1024, lds, tid);
        else { const int w_ = (bx < 192 ? bx : bx - 8) * 8 + wave;
            for (int p = w_; p < M / 2; p += 248 * 8) xn0_rows2(lds, X, XN, rowss, mods, 2 * p, 2 * p + 1, lane); }
    }
    SEAM();
#pragma unroll 1
    for (int layer = 0; layer < 4; ++layer) {
        const int kind = layer % 3, j = layer / 3;
        if (kind == 0) {
            if (IN_PH) { PH_PTRS(); PH_LAYER(); Gemm g = gemm_rowmajor(XN, D, (const GAS bf16_t*)(ws + WS_SWIN) + (size_t)j * D * D, D, D); GMODE(g); if (layer != 0) PREB_SET(g); OwnerOrder S{(D) / BM, o_vx, o_rank};
                PreIn P{rs_mix, swA + layer * 5 * 4096, 1024}; EpiU E{UgS}; gemm_phase<EpiU, ARowMajor, OwnerOrder, PreIn>(lds, g, S, E, wave, P);
                if (o_rank >= 24) { SIDE_IDS(); sw_ffn_job(ws, mods, layer, swv, snw, lane); if (layer == 0) convert_items(lds, ws, scr, IT_GI, I_GI, swv, snw, lane); }
#ifndef MK_RANGE
                if (bx < 192) stage_b0(lds, (const GAS char*)(ws + WS_BTS) + ((size_t)j * 64 + bx / 3) * 256 * 256 * 2, 256, wave);
#endif
            }
            SEAM();
            if (IN_PH) { PH_PTRS(); PH_LAYER(); SsmOrder S{G, bx};
                { Gemm g = gemm_rowmajor(UgS, 512, (const GAS bf16_t*)(ws + WS_BTS) + (size_t)j * 64 * 256 * 256, 256, 256); GMODE(g); PREB_SET(g);
                  EpiScan E{UgS, (const GAS float*)(ws + TAB_LAMT), inp(lds, 2), inp(lds, 3), (GAS float*)ldsptr(lds, 30) + (size_t)M * D, (GAS float*)ldsptr(lds, 30) + (size_t)M * D + 32 * 2 * 2 * 64 * 64, j};
                  gemm_phase<EpiScan, ARowMajor, SsmOrder>(lds, g, S, E, wave); }
                asm volatile("s_waitcnt vmcnt(0)" ::: "memory"); __syncthreads(); __builtin_amdgcn_fence(__ATOMIC_ACQUIRE, "agent"); asm volatile("s_waitcnt vmcnt(0)" ::: "memory"); __syncthreads();
                { Gemm g = gemm_rowmajor(UgS, 512, (const GAS bf16_t*)(ws + WS_BTY) + (size_t)j * 64 * 256 * 512, 512, 512); GMODE(g);
                  EpiY E{Zg}; gemm_phase<EpiY, ARowMajor, SsmOrder>(lds, g, S, E, wave); }
                if (layer == 0 && bx >= 192) { const int swv = (bx - 192) * 8 + wave, snw = 512; LAS float* scr = (LAS float*)(lds + wave * 16384); convert_items(lds, ws, scr, IT_W1 + 1 * I_W1, I_W1, swv, snw, lane);
                    const GAS float* s_ = inp(lds, 23); GAS bf16_t* d_ = (GAS bf16_t*)(ws + WS_GWS);
                    for (int i = (swv * 64 + lane) * 8; i < 16 * 128 * 128; i += snw * 64 * 8) { const f32x4 a0 = *(const GAS f32x4*)(s_ + i), a1 = *(const GAS f32x4*)(s_ + i + 4);
                        u32x4 o; o.x = pk2(a0[0], a0[1]); o.y = pk2(a0[2], a0[3]); o.z = pk2(a1[0], a1[1]); o.w = pk2(a1[2], a1[3]); *(GAS u32x4*)(d_ + i) = o; } }
                PREB_NEXT(ws + WS_SWOUT + (size_t)j * D * 2048 * 2, D, 8); }
            SEAM();
            if (IN_PH) { PH_PTRS(); PH_LAYER(); Gemm g = gemm_groupchunk(Zg, (const GAS bf16_t*)(ws + WS_SWOUT) + (size_t)j * D * 2048, D, D); GMODE(g); PREB_SET(g);
                PreRes<128> P{modl + 2 * 1024, inp(lds, 9) + layer * 1024, modl + 4 * 1024}; EpiRes<true> E{X, XN, rs_ffn, true};
                { OwnerR0 S{o_vx, o_rank}; gemm_phase<EpiRes<true>, AGroupChunk, OwnerR0, PreRes<128>>(lds, g, S, E, wave, P); }
                { OwnerR1 S{o_vx, o_rank & 15}; Gemm g2 = g; g2.preb = 0; EpiRes<true> E2 = E; E2.hm = o_rank < 16 ? 1 : 2;
                  if (o_rank < 16) gemm_phase<EpiRes<true>, AGroupChunk, OwnerR1, PreRes<128>, 1>(lds, g2, S, E2, wave, P);
                  else             gemm_phase<EpiRes<true>, AGroupChunk, OwnerR1, PreRes<128>, 2>(lds, g2, S, E2, wave, P); }
                PREB_NEXT(ws + WS_W1 + (size_t)layer * D * FF * 2, D, 16); }
            SEAM();
        } else if (kind == 1) {
            if (IN_PH) { PH_PTRS(); PH_LAYER(); Gemm g = gemm_rowmajor(XN, D, (const GAS bf16_t*)(ws + WS_GWIN), D, D); GMODE(g); PREB_SET(g); OwnerOrder S{(4096) / BM, o_vx, o_rank};
                PreIn P{rs_mix, swA + layer * 5 * 4096, 4096}; EpiIn<2, 4096> E{Hb, vstat}; gemm_phase<EpiIn<2, 4096>, ARowMajor, OwnerOrder, PreIn>(lds, g, S, E, wave, P); }
            SEAM();
            if (IN_PH) { PH_PTRS(); PH_LAYER();
                const GAS bf16_t* Wsb = (const GAS bf16_t*)(ws + WS_GWS); const GAS float* b_s = inp(lds, 24);
                constexpr int VST = 288;
                LAS f32x2* mr = (LAS f32x2*)(lds + 128 * VST);
                __syncthreads();
#define G2_UNIT(L_) (((2 * panel_of(o_vx, ((L_) >> 4) >> 1) + (((L_) >> 4) & 1)) << 4) | ((L_) & 15))
                { int ui = 0;
                  for (int L = o_rank; L < 192; L += 32, ++ui) { const int unit = G2_UNIT(L); const int row = tid >> 2, part = tid & 3;
                    const GAS f32x4* p = (const GAS f32x4*)(vstat + (size_t)((unit >> 4) * 128 + row) * 128) + part * 8; float s1 = 0.f, s2 = 0.f;
#pragma unroll
                    for (int q = 0; q < 8; ++q) { const f32x4 v = p[q]; s1 += v[0] + v[2]; s2 += v[1] + v[3]; }
                    s1 += __shfl_xor(s1, 1); s2 += __shfl_xor(s2, 1); s1 += __shfl_xor(s1, 2); s2 += __shfl_xor(s2, 2);
                    const float mu = s1 * (1.0f / 2048.0f), var = s2 * (1.0f / 2048.0f) - mu * mu; if (part == 0) mr[ui * 128 + row] = (f32x2){mu, rsq_f(fmaxf(var, 0.f) + EPS)}; } }
                u32x4 vr[4] = {(u32x4){0u, 0u, 0u, 0u}, (u32x4){0u, 0u, 0u, 0u}, (u32x4){0u, 0u, 0u, 0u}, (u32x4){0u, 0u, 0u, 0u}};
                { const int u0 = G2_UNIT(o_rank);
#pragma unroll
                    for (int i = 0; i < 4; ++i) { const int pc = tid + 512 * i, q = pc >> 4, d8 = pc & 15; vr[i] = *(const GAS u32x4*)(Hb + (size_t)((u0 >> 4) * 128 + q) * 4096 + 2048 + (u0 & 15) * 128 + d8 * 8); } }
                int ui = 0;
                for (int L = o_rank; L < 192; L += 32, ++ui) {
                    const int unit = G2_UNIT(L); const int c = unit >> 4, g = unit & 15, row0 = c * 128;
                    __syncthreads();
#pragma unroll
                    for (int i = 0; i < 4; ++i) { const int pc = tid + 512 * i, q = pc >> 4, d8 = pc & 15;
                        const u32x4 w = vr[i];
                        const f32x2 st = mr[ui * 128 + q]; const float mu = st[0], rstd = st[1];
                        u32x4 o; o.x = cvt_pk_bf16((bf_lo(w.x) - mu) * rstd, (bf_hi(w.x) - mu) * rstd); o.y = cvt_pk_bf16((bf_lo(w.y) - mu) * rstd, (bf_hi(w.y) - mu) * rstd);
                        o.z = cvt_pk_bf16((bf_lo(w.z) - mu) * rstd, (bf_hi(w.z) - mu) * rstd); o.w = cvt_pk_bf16((bf_lo(w.w) - mu) * rstd, (bf_hi(w.w) - mu) * rstd);
                        *(LAS u32x4*)(lds + q * VST + d8 * 16) = o; }
                    __syncthreads();
                    if (L + 32 < 192) { const int un = G2_UNIT(L + 32);
#pragma unroll
                        for (int i = 0; i < 4; ++i) { const int pc = tid + 512 * i, q = pc >> 4, d8 = pc & 15; vr[i] = *(const GAS u32x4*)(Hb + (size_t)((un >> 4) * 128 + q) * 4096 + 2048 + (un & 15) * 128 + d8 * 8); } }
                    f32x4 acc[8];
#pragma unroll
                    for (int nt = 0; nt < 8; ++nt) acc[nt] = (f32x4){0.f, 0.f, 0.f, 0.f};
                    const int fr = lane & 15, fq = lane >> 4;
#pragma unroll
                    for (int kk = 0; kk < 4; ++kk) {
                        const bf16x8 wf = *(const GAS bf16x8*)(Wsb + ((size_t)g * 128 + wave * 16 + fr) * 128 + kk * 32 + fq * 8);
#pragma unroll
                        for (int nt = 0; nt < 8; ++nt) {
                            const LAS unsigned char* p0 = lds + (kk * 32 + fq * 8 + (fr >> 2)) * VST + ((nt >> 1) * 32 + 8 * (fr & 3) + 4 * (nt & 1)) * 2;
                            const s16x4 lo4 = __builtin_bit_cast(s16x4, __builtin_amdgcn_ds_read_tr16_b64_v4i16((LAS s16x4*)p0));
                            const s16x4 hi4 = __builtin_bit_cast(s16x4, __builtin_amdgcn_ds_read_tr16_b64_v4i16((LAS s16x4*)(p0 + 4 * VST)));
                            const bf16x8 vf = {lo4[0], lo4[1], lo4[2], lo4[3], hi4[0], hi4[1], hi4[2], hi4[3]};
                            acc[nt] = __builtin_amdgcn_mfma_f32_16x16x32_bf16(vf, wf, acc[nt], 0, 0, 0);
                        }
                    }
                    const int p = wave * 16 + fr, row = row0 + p; const float bs = b_s[g * 128 + p];
#pragma unroll
                    for (int tp = 0; tp < 4; ++tp) { const int ch = g * 128 + tp * 32 + 8 * fq;
                        const u32x4 uu = *(const GAS u32x4*)(Hb + (size_t)row * 4096 + ch);
                        const f32x4 a0 = acc[2 * tp], a1 = acc[2 * tp + 1];
                        u32x4 o; o.x = cvt_pk_bf16(bf_lo(uu.x) * (a0[0] + bs), bf_hi(uu.x) * (a0[1] + bs)); o.y = cvt_pk_bf16(bf_lo(uu.y) * (a0[2] + bs), bf_hi(uu.y) * (a0[3] + bs));
                        o.z = cvt_pk_bf16(bf_lo(uu.z) * (a1[0] + bs), bf_hi(uu.z) * (a1[1] + bs)); o.w = cvt_pk_bf16(bf_lo(uu.w) * (a1[2] + bs), bf_hi(uu.w) * (a1[3] + bs));
                        *(GAS u32x4*)(A2 + (size_t)row * 2048 + ch) = o; }
                }
                __syncthreads();
                PREB_NEXT(ws + WS_GWOUT, 2048, 4);
            }
            SEAM();
            if (IN_PH) { PH_PTRS(); PH_LAYER(); Gemm g = gemm_rowmajor(A2, 2048, (const GAS bf16_t*)(ws + WS_GWOUT), 2048, 2048); GMODE(g); PREB_SET(g); OwnerOrder S{(D) / BM, o_vx, o_rank};
                PreRes<256> P{modl + 2 * 1024, inp(lds, 9) + layer * 1024, modl + 4 * 1024}; EpiRes<false> E{X, XN, rs_ffn, true}; gemm_phase<EpiRes<false>, ARowMajor, OwnerOrder, PreRes<256>>(lds, g, S, E, wave, P);
                if (o_rank >= 24) { SIDE_IDS(); convert_items(lds, ws, scr, IT_W1 + 3 * I_W1, I_W1, swv, snw, lane); ssm_build(args, 1, sidle, 1, lds, ws, tid); }
                PREB_NEXT(ws + WS_W1 + (size_t)layer * D * FF * 2, D, 16); }
            SEAM();
        } else {
            if (IN_PH) { PH_PTRS(); PH_LAYER(); Gemm g = gemm_rowmajor(XN, D, (const GAS bf16_t*)(ws + WS_CWIN), D, D); GMODE(g); PREB_SET(g); OwnerOrder S{(3072) / BM, o_vx, o_rank};
                PreIn P{rs_mix, swA + layer * 5 * 4096, 3072}; EpiIn<0, 3072> E{Hb, nullptr}; gemm_phase<EpiIn<0, 3072>, ARowMajor, OwnerOrder, PreIn>(lds, g, S, E, wave, P); }
            SEAM();
            if (IN_PH) { PH_PTRS(); PH_LAYER();
                const GAS float* cw = inp(lds, 27);
                for (int it = o_rank * 512 + tid; it < 6 * 256 * 128; it += 32 * 512) {
                    const int row = panel_of(o_vx, it >> 15) * 256 + ((it >> 7) & 255), c8 = (it & 127) * 8;
                    const int L = row < MP ? 256 : 1024, t = row < MP ? (row & 255) : ((row - MP) & 1023);
                    const GAS bf16_t* pr = Hb + (size_t)row * 3072 + c8;
                    float y[8];
#pragma unroll
                    for (int q = 0; q < 8; ++q) y[q] = 0.f;
#pragma unroll
                    for (int w = 0; w < 3; ++w) { const int tt = t + w - 1; if (tt < 0 || tt >= L) continue;
                        const u32x4 gc = *(const GAS u32x4*)(pr + (ptrdiff_t)(w - 1) * 3072 + 1024), xh = *(const GAS u32x4*)(pr + (ptrdiff_t)(w - 1) * 3072 + 2048);
                        const f32x4 k0 = *(const GAS f32x4*)(cw + w * 1024 + c8), k1 = *(const GAS f32x4*)(cw + w * 1024 + c8 + 4);
                        y[0] += k0[0] * bf_lo(gc.x) * bf_lo(xh.x); y[1] += k0[1] * bf_hi(gc.x) * bf_hi(xh.x); y[2] += k0[2] * bf_lo(gc.y) * bf_lo(xh.y); y[3] += k0[3] * bf_hi(gc.y) * bf_hi(xh.y);
                        y[4] += k1[0] * bf_lo(gc.z) * bf_lo(xh.z); y[5] += k1[1] * bf_hi(gc.z) * bf_hi(xh.z); y[6] += k1[2] * bf_lo(gc.w) * bf_lo(xh.w); y[7] += k1[3] * bf_hi(gc.w) * bf_hi(xh.w); }
                    const u32x4 gb = *(const GAS u32x4*)pr;
                    u32x4 o; o.x = cvt_pk_bf16(bf_lo(gb.x) * y[0], bf_hi(gb.x) * y[1]); o.y = cvt_pk_bf16(bf_lo(gb.y) * y[2], bf_hi(gb.y) * y[3]);
                    o.z = cvt_pk_bf16(bf_lo(gb.z) * y[4], bf_hi(gb.z) * y[5]); o.w = cvt_pk_bf16(bf_lo(gb.w) * y[6], bf_hi(gb.w) * y[7]);
                    *(GAS u32x4*)(A2 + (size_t)row * D + c8) = o;
                }
                PREB_NEXT(ws + WS_CWOUT, D, 4);
            }
            SEAM();
            if (IN_PH) { PH_PTRS(); PH_LAYER(); Gemm g = gemm_rowmajor(A2, D, (const GAS bf16_t*)(ws + WS_CWOUT), D, D); GMODE(g); PREB_SET(g); OwnerOrder S{(D) / BM, o_vx, o_rank};
                PreRes<256> P{modl + 2 * 1024, inp(lds, 9) + layer * 1024, modl + 4 * 1024}; EpiRes<false> E{X, XN, rs_ffn, true}; gemm_phase<EpiRes<false>, ARowMajor, OwnerOrder, PreRes<256>>(lds, g, S, E, wave, P);
                if (o_rank >= 24) { SIDE_IDS(); ssm_build(args, 1, sidle, 2, lds, ws, tid); }
                PREB_NEXT(ws + WS_W1 + (size_t)layer * D * FF * 2, D, 16); }
            SEAM();
        }
        if (IN_PH) { PH_PTRS(); PH_LAYER(); Gemm g = gemm_rowmajor(XN, D, (const GAS bf16_t*)(ws + WS_W1) + (size_t)layer * D * FF, D, D); GMODE(g); PREB_SET(g); OwnerOrder S{(FF) / BM, o_vx, o_rank};
            PreIn P{rs_ffn, swB + layer * 5 * 4096, 4096}; EpiIn<1, 4096> E{Hb, nullptr}; gemm_phase<EpiIn<1, 4096>, ARowMajor, OwnerOrder, PreIn>(lds, g, S, E, wave, P);
            PREB_NEXT(ws + WS_W2 + (size_t)layer * D * FF * 2, FF, 4); }
        SEAM();
        if (IN_PH) { PH_PTRS(); PH_LAYER(); Gemm g = gemm_rowmajor(Hb, FF, (const GAS bf16_t*)(ws + WS_W2) + (size_t)layer * D * FF, FF, FF); GMODE(g); PREB_SET(g); OwnerOrder S{(D) / BM, o_vx, o_rank};
            if (layer < 3) { PreRes<256> P{modl + 5 * 1024, inp(lds, 8) + (layer + 1) * 1024, modl + 5 * 6144 + 1024}; EpiRes<false> E{X, XN, rs_next, true}; gemm_phase<EpiRes<false>, ARowMajor, OwnerOrder, PreRes<256>>(lds, g, S, E, wave, P); }
            else { PreRes<256> P{modl + 5 * 1024, (const GAS float*)nullptr, (const GAS float*)nullptr};
                EpiFinal E{X, (GAS float*)ldsptr(lds, 30), inp(lds, 29), (GAS float*)(ws + WS_PS), (GAS unsigned*)(ws + WS_CTL), (GAS unsigned*)(ws + WS_CTL) + CW_BAR + XB_TMO, o_mode == 0};
                gemm_phase<EpiFinal, ARowMajor, OwnerOrder, PreRes<256>>(lds, g, S, E, wave, P); }
            if (layer < 3 && o_rank >= 24) { SIDE_IDS();
                if (layer < 2) { if (sidle < 48) mods_task(args, mods, lds, (layer + 2) * 48 + sidle, tid); __syncthreads(); }
                if (layer == 0) {
                    convert_items(lds, ws, scr, IT_GO, I_GO, swv, snw, lane); convert_items(lds, ws, scr, IT_W2 + 1 * I_W2, I_W2, swv, snw, lane); convert_items(lds, ws, scr, IT_CI, I_CI + I_CO, swv, snw, lane); convert_items(lds, ws, scr, IT_W1 + 2 * I_W1, I_W1, swv, snw, lane); sw_mix_job(ws, mods, 1, swv, snw, lane); sw_ffn_job(ws, mods, 1, swv, snw, lane); }
                else if (layer == 1) { convert_items(lds, ws, scr, IT_W2 + 2 * I_W2, I_W2, swv, snw, lane); convert_items(lds, ws, scr, IT_SI + I_SI, I_SI, swv, snw, lane); convert_items(lds, ws, scr, IT_SO + I_SO, I_SO, swv, snw, lane);
                    sw_mix_job(ws, mods, 2, swv, snw, lane); sw_ffn_job(ws, mods, 2, swv, snw, lane); }
                else { ssm_build(args, 1, sidle, 0, lds, ws, tid);
                    convert_items(lds, ws, scr, IT_W2 + 3 * I_W2, I_W2, swv, snw, lane); sw_mix_job(ws, mods, 3, swv, snw, lane); } }
            if (layer == 0) PREB_NEXT(ws + WS_GWIN, D, 16); else if (layer == 1) PREB_NEXT(ws + WS_CWIN, D, 12); else if (layer == 2) PREB_NEXT(ws + WS_SWIN + (size_t)D * D * 2, D, 4); }
        SEAM();
    }
    ++ph;
#undef IN_PH
#undef SEAM
}

static bool launch(void* const* d_in, float* out, unsigned char* ws, int lo, int hi, hipStream_t stream, int mode = 0) {
    static int grid = 0;
    if (grid == 0) {
        int dev = 0, cus = 0, per_cu = 0;
        if (hipGetDevice(&dev) != hipSuccess || hipDeviceGetAttribute(&cus, hipDeviceAttributeMultiprocessorCount, dev) != hipSuccess) { grid = -1; return false; }
        if (hipFuncSetAttribute((const void*)fwd, hipFuncAttributeMaxDynamicSharedMemorySize, LDS_BYTES) != hipSuccess) { fprintf(stderr, "hipFuncSetAttribute failed\n"); grid = -1; return false; }
        if (hipOccupancyMaxActiveBlocksPerMultiprocessor(&per_cu, (const void*)fwd, 512, LDS_BYTES) != hipSuccess || per_cu < 1) { fprintf(stderr, "occupancy query: %d\n", per_cu); (void)hipGetLastError(); per_cu = 1; }
        grid = cus;
    }
    if (grid < 0) return false;
    Args a{};
    for (int i = 0; i < 30; ++i) a.in[i] = (const float*)d_in[i];
    a.out = out; a.ws = ws; a.ph_lo = lo; a.ph_hi = hi; a.mode = mode;
    void* kargs[] = {&a};
    const hipError_t e = hipLaunchCooperativeKernel((const void*)fwd, dim3(grid), dim3(512), kargs, LDS_BYTES, stream);
    if (e != hipSuccess) { fprintf(stderr, "cooperative launch failed: %s (grid %d)\n", hipGetErrorString(e), grid); return false; }
    return true;
}
}
extern "C" void kernel_launch(void* const* d_in, const int* in_sizes, int n_in, void* d_out, int out_size, void* d_ws, size_t ws_size, hipStream_t stream) {
    if (n_in != 30 || ws_size < mk::WS_END) { fprintf(stderr, "kernel_launch: unexpected n_in %d / ws %zu\n", n_in, ws_size); return; }
    (void)hipMemsetAsync((char*)d_ws + mk::WS_CTL, 0, mk::CTL_BYTES, stream);
    mk::launch(d_in, (float*)d_out, (unsigned char*)d_ws, 0, 22, stream);
}
```
